# Optimizing an MI355X kernel written in HIP

```python
import jax, jax.numpy as jnp
from jax import lax
import numpy as np

D_MODEL = 2048
BATCH = 4
SEQ = 4096
DEPTH = 1

SB_HEADS = 8
SB_HEAD_DIM = 128
SB_WIDTH = SB_HEADS * SB_HEAD_DIM
MLA_HEADS = 8
MLA_NOPE_DIM = 128
MLA_ROPE_DIM = 64
MLA_V_DIM = 128
MLA_QK_DIM = MLA_NOPE_DIM + MLA_ROPE_DIM
Q_LORA_RANK = 512
KV_LORA_RANK = 512
MLA_WIDTH = MLA_HEADS * MLA_V_DIM
ROPE_THETA = 10000.0
MIX_WIDTH = SB_WIDTH + MLA_WIDTH
IN_SPLITS = [SB_WIDTH, 2 * SB_WIDTH, 3 * SB_WIDTH,
             3 * SB_WIDTH + Q_LORA_RANK, 3 * SB_WIDTH + Q_LORA_RANK + KV_LORA_RANK]
IN_WIDTH = 3 * SB_WIDTH + Q_LORA_RANK + KV_LORA_RANK + MLA_ROPE_DIM
Q_BLOCK = 128
N_EXPERTS = 32
TOP_K = 4
D_EXPERT = D_MODEL
SWIGLU_ALPHA = 1.702
SWIGLU_LIMIT = 7.0
ROW_BLOCK = 128
NORM_EPS = 1e-6
N_MOD = 6

kernel_name = "hybrid_sb_mla_moe_adaln_layer"


def rmsnorm(x, gain):
    x32 = x.astype(jnp.float32)
    y = x32 * lax.rsqrt(jnp.mean(x32 * x32, axis=-1, keepdims=True) + NORM_EPS)
    return (y * gain.astype(jnp.float32)).astype(x.dtype)


def modulate(h, shift, scale):
    return h * (1.0 + scale[:, None, :]) + shift[:, None, :]


def rope_tables(positions, rot_dim):
    half = rot_dim // 2
    inv_freq = 1.0 / (ROPE_THETA ** (jnp.arange(half, dtype=jnp.float32) * 2.0 / rot_dim))
    ang = positions.astype(jnp.float32)[..., None] * inv_freq
    return jnp.cos(ang)[:, :, None, :], jnp.sin(ang)[:, :, None, :]


def apply_rope(x, cos, sin):
    x32 = x.astype(jnp.float32)
    x1, x2 = jnp.split(x32, 2, axis=-1)
    return jnp.concatenate([x1 * cos - x2 * sin, x2 * cos + x1 * sin], axis=-1).astype(x.dtype)


def to_blocks(t):
    b, s = t.shape[:2]
    return t.reshape((b, s // Q_BLOCK, Q_BLOCK) + t.shape[2:]).swapaxes(0, 1)


def from_blocks(t):
    nb, b = t.shape[:2]
    return t.swapaxes(0, 1).reshape((b, nb * Q_BLOCK) + t.shape[3:])


def stick_breaking_attention(q, k, v):
    s_len, dh = q.shape[1], q.shape[-1]
    k32 = k.astype(jnp.float32)
    key_idx = jnp.arange(s_len)
    n_blocks = s_len // Q_BLOCK

    def block(args):
        q_blk, i = args
        z = jnp.einsum("bqhd,bkhd->bhqk", q_blk.astype(jnp.float32), k32) * (dh ** -0.5)
        q_idx = i * Q_BLOCK + jnp.arange(Q_BLOCK)
        mask = key_idx[None, :] < q_idx[:, None]
        log_keep = jnp.where(mask, jax.nn.log_sigmoid(-z), 0.0)
        shifted = jnp.concatenate([log_keep[..., 1:], jnp.zeros_like(log_keep[..., :1])], axis=-1)
        later = lax.cumsum(shifted, axis=3, reverse=True)
        a = jnp.where(mask, jnp.exp(jax.nn.log_sigmoid(z) + later), 0.0)
        return jnp.einsum("bhqk,bkhd->bqhd", a.astype(v.dtype), v)

    out = lax.map(block, (to_blocks(q), jnp.arange(n_blocks)))
    return from_blocks(out)


def mla_attention(q_nope, q_rope, k_nope, k_rope, v):
    s_len = q_nope.shape[1]
    kn32 = k_nope.astype(jnp.float32)
    kr32 = k_rope.astype(jnp.float32)
    key_idx = jnp.arange(s_len)
    n_blocks = s_len // Q_BLOCK
    scale = MLA_QK_DIM ** -0.5

    def block(args):
        qn, qr, i = args
        sc = (jnp.einsum("bqhd,bkhd->bhqk", qn.astype(jnp.float32), kn32)
              + jnp.einsum("bqhr,bkr->bhqk", qr.astype(jnp.float32), kr32)) * scale
        q_idx = i * Q_BLOCK + jnp.arange(Q_BLOCK)
        mask = key_idx[None, :] <= q_idx[:, None]
        p = jax.nn.softmax(jnp.where(mask, sc, -jnp.inf), axis=-1)
        return jnp.einsum("bhqk,bkhd->bqhd", p.astype(v.dtype), v)

    out = lax.map(block, (to_blocks(q_nope), to_blocks(q_rope), jnp.arange(n_blocks)))
    return from_blocks(out)


def clamped_swiglu(u):
    glu = jnp.minimum(u[..., ::2], SWIGLU_LIMIT)
    lin = jnp.clip(u[..., 1::2], -SWIGLU_LIMIT, SWIGLU_LIMIT)
    return glu * jax.nn.sigmoid(SWIGLU_ALPHA * glu) * (lin + 1.0)


def moe_ffn(h, w_router, b_router, w1, b1, w2, b2):
    b, s, d = h.shape
    n = b * s
    hf = h.reshape(n, d)
    logits = (hf @ w_router + b_router).astype(jnp.float32)
    top_val, top_idx = lax.top_k(logits, TOP_K)
    top_w = jax.nn.softmax(top_val, axis=-1)
    n_assign = n * TOP_K
    e_flat = top_idx.reshape(-1)
    w_flat = top_w.reshape(-1)
    tok_flat = jnp.arange(n_assign, dtype=jnp.int32) // TOP_K
    order = jnp.argsort(e_flat)
    e_sorted = e_flat[order]
    counts = jnp.bincount(e_flat, length=N_EXPERTS)
    starts = jnp.cumsum(counts) - counts
    padded = (counts + ROW_BLOCK - 1) // ROW_BLOCK * ROW_BLOCK
    padded_ends = jnp.cumsum(padded)
    padded_starts = padded_ends - padded
    dest = padded_starts[e_sorted] + jnp.arange(n_assign, dtype=jnp.int32) - starts[e_sorted]
    n_rows = n_assign + N_EXPERTS * ROW_BLOCK
    n_row_blocks = n_rows // ROW_BLOCK
    row_tok = jnp.zeros((n_rows,), jnp.int32).at[dest].set(tok_flat[order])
    row_w = jnp.zeros((n_rows,), jnp.float32).at[dest].set(w_flat[order])
    block_start = jnp.arange(n_row_blocks, dtype=jnp.int32) * ROW_BLOCK
    block_e = jnp.minimum(jnp.searchsorted(padded_ends, block_start, side="right"), N_EXPERTS - 1)
    xs = hf[row_tok].reshape(n_row_blocks, ROW_BLOCK, d)

    def expert_block(args):
        x_blk, e = args
        u = x_blk @ w1[e] + b1[e]
        return clamped_swiglu(u) @ w2[e] + b2[e]

    ys = lax.map(expert_block, (xs, block_e)).reshape(n_rows, d)
    out = jnp.zeros((n, d), jnp.float32).at[row_tok].add(row_w[:, None] * ys.astype(jnp.float32))
    return out.astype(h.dtype).reshape(b, s, d)


def setup_inputs(seed: int = 0) -> dict:
    key = jax.random.key(seed)
    ks = jax.random.split(key, 24)
    f32 = jnp.float32

    def nrm(k, shape, fan_in):
        return jax.random.normal(k, shape, f32) * (fan_in ** -0.5)

    def gain(k, shape):
        return 1.0 + 0.05 * jax.random.normal(k, shape, f32)

    def small(k, shape, s=0.02):
        return s * jax.random.normal(k, shape, f32)

    offsets = jax.random.randint(ks[2], (BATCH, 1), 0, 1024, dtype=jnp.int32)
    positions = offsets + jnp.arange(SEQ, dtype=jnp.int32)[None, :]
    return {
        "x": jax.random.normal(ks[0], (BATCH, SEQ, D_MODEL), f32),
        "c": jax.random.normal(ks[1], (BATCH, D_MODEL), f32),
        "positions": positions,
        "g_attn": gain(ks[3], (DEPTH, D_MODEL)),
        "w_mod": nrm(ks[4], (DEPTH, D_MODEL, N_MOD * D_MODEL), D_MODEL),
        "b_mod": small(ks[5], (DEPTH, N_MOD * D_MODEL)),
        "w_in": nrm(ks[6], (DEPTH, D_MODEL, IN_WIDTH), D_MODEL),
        "g_q_lat": gain(ks[7], (DEPTH, Q_LORA_RANK)),
        "w_q_up": nrm(ks[8], (DEPTH, Q_LORA_RANK, MLA_HEADS * MLA_QK_DIM), Q_LORA_RANK),
        "g_kv_lat": gain(ks[9], (DEPTH, KV_LORA_RANK)),
        "w_kv_up": nrm(ks[10], (DEPTH, KV_LORA_RANK, MLA_HEADS * (MLA_NOPE_DIM + MLA_V_DIM)), KV_LORA_RANK),
        "w_out": nrm(ks[11], (DEPTH, MIX_WIDTH, D_MODEL), MIX_WIDTH),
        "g_ffn": gain(ks[12], (DEPTH, D_MODEL)),
        "w_router": nrm(ks[13], (DEPTH, D_MODEL, N_EXPERTS), D_MODEL),
        "b_router": small(ks[14], (DEPTH, N_EXPERTS), 0.01),
        "w1": nrm(ks[15], (DEPTH, N_EXPERTS, D_MODEL, 2 * D_EXPERT), D_MODEL),
        "b1": small(ks[16], (DEPTH, N_EXPERTS, 2 * D_EXPERT)),
        "w2": nrm(ks[17], (DEPTH, N_EXPERTS, D_EXPERT, D_MODEL), D_EXPERT),
        "b2": small(ks[18], (DEPTH, N_EXPERTS, D_MODEL)),
        "g_final": gain(ks[19], (D_MODEL,)),
    }


def reference(x, c, positions, g_attn, w_mod, b_mod, w_in, g_q_lat, w_q_up, g_kv_lat, w_kv_up,
              w_out, g_ffn, w_router, b_router, w1, b1, w2, b2, g_final):
    b, s, _ = x.shape
    cos, sin = rope_tables(positions, MLA_ROPE_DIM)
    c_act = jax.nn.silu(c)
    for l in range(DEPTH):
        mod = c_act @ w_mod[l] + b_mod[l]
        shift1, scale1, gate1, shift2, scale2, gate2 = jnp.split(mod, N_MOD, axis=-1)

        h = modulate(rmsnorm(x, g_attn[l]), shift1, scale1)
        proj = h @ w_in[l]
        sb_q, sb_k, sb_v, q_lat, kv_lat, k_rope = jnp.split(proj, IN_SPLITS, axis=-1)
        sb_out = stick_breaking_attention(
            sb_q.reshape(b, s, SB_HEADS, SB_HEAD_DIM),
            sb_k.reshape(b, s, SB_HEADS, SB_HEAD_DIM),
            sb_v.reshape(b, s, SB_HEADS, SB_HEAD_DIM))
        q = (rmsnorm(q_lat, g_q_lat[l]) @ w_q_up[l]).reshape(b, s, MLA_HEADS, MLA_QK_DIM)
        q_nope, q_rope = q[..., :MLA_NOPE_DIM], q[..., MLA_NOPE_DIM:]
        kv = (rmsnorm(kv_lat, g_kv_lat[l]) @ w_kv_up[l]).reshape(b, s, MLA_HEADS, MLA_NOPE_DIM + MLA_V_DIM)
        k_nope, v = kv[..., :MLA_NOPE_DIM], kv[..., MLA_NOPE_DIM:]
        q_rope = apply_rope(q_rope, cos, sin)
        k_rope = apply_rope(k_rope[:, :, None, :], cos, sin)[:, :, 0, :]
        mla_out = mla_attention(q_nope, q_rope, k_nope, k_rope, v)
        mixed = jnp.concatenate([sb_out.reshape(b, s, SB_WIDTH), mla_out.reshape(b, s, MLA_WIDTH)], axis=-1)
        x = x + gate1[:, None, :] * (mixed @ w_out[l])

        h2 = modulate(rmsnorm(x, g_ffn[l]), shift2, scale2)
        x = x + gate2[:, None, :] * moe_ffn(h2, w_router[l], b_router[l], w1[l], b1[l], w2[l], b2[l])
    return rmsnorm(x, g_final)
```

```cpp
#include <hip/hip_runtime.h>
#include <stdint.h>
#include <stdio.h>

constexpr int D = 2048, NB = 4, SEQ = 4096, NTOK = NB * SEQ;
constexpr int SBH = 8, DH = 128, SBW = SBH * DH;
constexpr int MH = 8, NOPE = 128, ROPE = 64, VD = 128, QKD = 192, QR = 512, KVR = 512;
constexpr int INW = 3 * SBW + QR + KVR + ROPE;
constexpr int NE = 32, TOPK = 4, DE = 2048;
constexpr int NMOD = 6;
constexpr float EPS = 1e-6f;
constexpr int MAXSLOT = NTOK * TOPK + NE * 256;

typedef unsigned short bf16_t;
typedef float f32x2_t __attribute__((ext_vector_type(2)));
typedef __bf16 bf16x2_t __attribute__((ext_vector_type(2)));

__device__ __forceinline__ float bf2f(bf16_t v) { return __uint_as_float(((unsigned)v) << 16); }
__device__ __forceinline__ unsigned pk2(float a, float b) { f32x2_t v = {a, b}; bf16x2_t r = __builtin_convertvector(v, bf16x2_t); return __builtin_bit_cast(unsigned, r); }
__device__ __forceinline__ bf16_t f2bf(float a) { return (bf16_t)(pk2(a, 0.f) & 0xffffu); }

constexpr size_t al256(size_t x) { return (x + 255) & ~(size_t)255; }
constexpr size_t WS_CTL   = 0;
constexpr size_t WS_MOD   = 65536;
constexpr size_t WS_CS    = WS_MOD + al256((size_t)NB * NMOD * D * 4);
constexpr size_t WS_H     = WS_CS + (size_t)NTOK * 32 * 8;
constexpr size_t WS_SBQ   = WS_H + (size_t)NTOK * D * 2;
constexpr size_t WS_SBK   = WS_SBQ + (size_t)NTOK * SBW * 2;
constexpr size_t WS_SBVT  = WS_SBK + (size_t)NTOK * SBW * 2;
constexpr size_t WS_QLAT  = WS_SBVT + (size_t)NTOK * SBW * 2;
constexpr size_t WS_KVLAT = WS_QLAT + (size_t)NTOK * QR * 2;
constexpr size_t WS_SSQP  = WS_KVLAT + (size_t)NTOK * KVR * 2;
constexpr size_t WS_KROPE = WS_SSQP + (size_t)NTOK * 16 * 4;
constexpr size_t WS_QMLA  = WS_KROPE + (size_t)NTOK * 64 * 2;
constexpr size_t WS_KNOPE = WS_QMLA + (size_t)NTOK * 1536 * 2;
constexpr size_t WS_VMT   = WS_KNOPE + (size_t)NTOK * 1024 * 2;
constexpr size_t WS_MIXED = WS_VMT + (size_t)NTOK * 1024 * 2;
constexpr size_t WS_X1    = WS_MIXED + (size_t)NTOK * D * 2;
constexpr size_t WS_H2    = WS_X1 + (size_t)NTOK * D * 4;
constexpr size_t WS_TOPE  = WS_H2 + (size_t)NTOK * D * 2;
constexpr size_t WS_TOPW  = WS_TOPE + (size_t)NTOK * 4 * 4;
constexpr size_t WS_TPOS  = WS_TOPW + (size_t)NTOK * 4 * 4;
constexpr size_t WS_CNT   = WS_CTL + 62464;
constexpr size_t WS_ROWTOK= WS_TPOS + (size_t)NTOK * 4 * 4;
constexpr size_t WS_ACT   = WS_ROWTOK + (size_t)NE * NTOK * 4;
constexpr size_t WS_Y     = WS_ACT + (size_t)MAXSLOT * DE * 2;
constexpr size_t WS_GTMP  = WS_Y + (size_t)MAXSLOT * D * 2;
constexpr size_t WS_G_QRAW  = WS_GTMP;
constexpr size_t WS_G_KRRAW = WS_G_QRAW + (size_t)NTOK * 1536 * 4;
constexpr size_t WS_G_SLOTTOK = WS_G_KRRAW + (size_t)NTOK * 64 * 4;
constexpr size_t WS_G_SLOTE   = WS_G_SLOTTOK + (size_t)MAXSLOT * 4;
constexpr size_t WS_END   = WS_G_SLOTE + (size_t)MAXSLOT * 4;

struct P {
    const float *x, *c; const int* pos; const float *g_attn, *w_mod, *b_mod, *w_in, *g_q, *w_q_up, *g_kv, *w_kv_up, *w_out, *g_ffn, *w_router, *b_router, *w1, *b1, *w2, *b2, *g_final;
    float* out; unsigned char* ws;
};
#define WSP(T, off) ((T*)(p.ws + (off)))


#define LAS __attribute__((address_space(3)))
typedef short bf16x8 __attribute__((ext_vector_type(8)));
typedef float f32x4 __attribute__((ext_vector_type(4)));
typedef float f32x16 __attribute__((ext_vector_type(16)));
typedef unsigned u32x4 __attribute__((ext_vector_type(4)));
typedef unsigned u32x2 __attribute__((ext_vector_type(2)));
typedef int i32x8 __attribute__((ext_vector_type(8)));
typedef int i32x4 __attribute__((ext_vector_type(4)));
constexpr bool MOE_FP8 = true;
constexpr float W8_SCALE = 256.f, W8_INV = 1.f / 256.f;
typedef __bf16 bf16x32_t __attribute__((ext_vector_type(32)));
typedef unsigned u32x6 __attribute__((ext_vector_type(6)));
typedef unsigned u32x16 __attribute__((ext_vector_type(16)));
constexpr bool Y_FP8 = true;
constexpr float Y_SCALE = 32.f;
constexpr bool MOE1_FP6 = true;
__device__ __forceinline__ void fp6_block(const float (&v)[32], u32x4& out_lo, u32x4& out_hi) {
    float amax = 0.f;
#pragma unroll
    for (int i = 0; i < 32; ++i) amax = fmaxf(amax, fabsf(v[i]));
    int e = (int)((__float_as_uint(amax) >> 23) & 0xffu) - 127 - 2;
    if (amax * __uint_as_float((unsigned)(127 - e) << 23) > 7.5f) e += 1;
    e = e < -120 ? -120 : e;
    const float inv = __uint_as_float((unsigned)(127 - e) << 23);
    u32x16 w;
#pragma unroll
    for (int i = 0; i < 16; ++i) w[i] = pk2(v[2 * i] * inv, v[2 * i + 1] * inv);
    const u32x6 c = __builtin_amdgcn_cvt_scalef32_pk32_fp6_bf16(__builtin_bit_cast(bf16x32_t, w), 1.0f);
    out_lo.x = c[0]; out_lo.y = c[1]; out_lo.z = c[2]; out_lo.w = c[3];
    out_hi.x = c[4]; out_hi.y = c[5]; out_hi.z = (unsigned)(e + 127); out_hi.w = 0u;
}

__device__ __forceinline__ unsigned pk4_fp8(float a, float b, float c, float d) { int w = 0; w = __builtin_amdgcn_cvt_pk_fp8_f32(a, b, w, false); w = __builtin_amdgcn_cvt_pk_fp8_f32(c, d, w, true); return (unsigned)w; }

constexpr size_t WS_WIN_T  = WS_END;
constexpr size_t WS_WQ_T   = WS_WIN_T + (size_t)4352 * 2048 * 2;
constexpr size_t WS_WKV_T  = WS_WQ_T + (size_t)1536 * 512 * 2;
constexpr size_t WS_WOUT_T = WS_WKV_T + (size_t)2048 * 512 * 2;
constexpr size_t WS_W1_T   = WS_WOUT_T + (size_t)2048 * 2048 * 2;
constexpr size_t WS_W2_T   = WS_W1_T + (size_t)NE * 4096 * 2048 * 2;
constexpr size_t WS_WR_HI  = WS_W2_T + (size_t)NE * 2048 * 2048 * 2;
constexpr size_t WS_WR_LO  = WS_WR_HI + (size_t)32 * 2048 * 2;
constexpr size_t WS_CB     = WS_WR_LO + (size_t)32 * 2048 * 2;
constexpr size_t WS_END2   = WS_CB + 512;

#define XB_TMO      128
#define XB_XCNT(j)  (256  + 64 * (j))
#define XB_XSUB(j)  (1280 + 64 * (j))
#define XB_XGEN(j)  (2304 + 64 * (j))
#define XB_TOP      3328
#define XB_TOPGEN   3392
#define XCD_BAR_WORDS 3456
#define XB_SPIN_CAP (1u << 18)
__device__ __forceinline__ unsigned xb_ld(unsigned* p)              { return __hip_atomic_load(p, __ATOMIC_RELAXED, __HIP_MEMORY_SCOPE_AGENT); }
__device__ __forceinline__ unsigned xb_add(unsigned* p, unsigned v) { return __hip_atomic_fetch_add(p, v, __ATOMIC_RELAXED, __HIP_MEMORY_SCOPE_AGENT); }
__device__ __forceinline__ unsigned xb_xcc_id() { return (unsigned)__builtin_amdgcn_s_getreg((3 << 11) | 20) & 0xFu; }
#define XB_SPIN(cond, bar) do { unsigned _sp = 0; while (cond) { __builtin_amdgcn_s_sleep(1); \
    if ((++_sp & 255u) == 0u) { if (xb_ld(&(bar)[XB_TMO])) break; if (_sp > XB_SPIN_CAP) { atomicAdd(&(bar)[XB_TMO], 1u); break; } } } } while (0)
struct XcdBarrier { unsigned* bar; unsigned x; volatile LAS unsigned* st; };
__device__ __forceinline__ XcdBarrier xcd_barrier_post(unsigned* bar, volatile LAS unsigned* st) {
    XcdBarrier b; b.bar = bar; b.x = xb_xcc_id(); b.st = st;
    if (threadIdx.x == 0) (void)xb_add(&bar[XB_XCNT(b.x)], 1u);
    return b;
}
__device__ __forceinline__ void xcd_barrier_complete(unsigned* bar, unsigned x, unsigned& nloc, unsigned& nx) {
    const unsigned G = gridDim.x * gridDim.y * gridDim.z;
    unsigned sum, cnt, mine, sp = 0u;
    for (;;) {
        sum = 0u; cnt = 0u; mine = 0u;
#pragma unroll
        for (unsigned j = 0; j < 16; ++j) { const unsigned c = xb_ld(&bar[XB_XCNT(j)]); sum += c; cnt += (c > 0u) ? 1u : 0u; mine = (j == x) ? c : mine; }
        if (sum == G) break;
        __builtin_amdgcn_s_sleep(1);
        if ((++sp & 255u) == 0u) { if (xb_ld(&bar[XB_TMO])) break; if (sp > XB_SPIN_CAP) { atomicAdd(&bar[XB_TMO], 1u); break; } }
    }
    nloc = mine > 0u ? mine : 1u; nx = cnt > 0u ? cnt : 1u;
}
__device__ __forceinline__ void xcd_barrier(const XcdBarrier& b) {
    asm volatile("s_waitcnt vmcnt(0)" ::: "memory");
    __syncthreads();
    if (threadIdx.x == 0) {
        unsigned* bar = b.bar;
        __builtin_amdgcn_s_waitcnt(0);
        unsigned nloc = b.st[0], nx = b.st[1];
        if (nloc == 0u) { xcd_barrier_complete(bar, b.x, nloc, nx); b.st[0] = nloc; b.st[1] = nx; }
        const unsigned old = xb_add(&bar[XB_XSUB(b.x)], 1u);
        const unsigned gen = old / nloc;
        if (old + 1u == (gen + 1u) * nloc) {
            __builtin_amdgcn_fence(__ATOMIC_RELEASE, "agent");
            asm volatile("s_waitcnt vmcnt(0)" ::: "memory");
            const unsigned og = xb_add(&bar[XB_TOP], 1u);
            const unsigned tg = og / nx;
            if (og + 1u == (tg + 1u) * nx) xb_add(&bar[XB_TOPGEN], 1u);
            else XB_SPIN(xb_ld(&bar[XB_TOPGEN]) == tg, bar);
            __builtin_amdgcn_fence(__ATOMIC_ACQUIRE, "agent");
            xb_add(&bar[XB_XGEN(b.x)], 1u);
            asm volatile("s_waitcnt vmcnt(0)" ::: "memory");
        } else {
            XB_SPIN(xb_ld(&bar[XB_XGEN(b.x)]) == gen, bar);
            __builtin_amdgcn_fence(__ATOMIC_ACQUIRE, "agent");
            asm volatile("s_waitcnt vmcnt(0)" ::: "memory");
        }
    }
    __syncthreads();
}

constexpr int LDS_STAGE = 0;
constexpr int LDS_GIDX  = 131072;
constexpr int LDS_BIAS  = LDS_GIDX + 9216;
constexpr int LDS_TP    = LDS_BIAS + 18432;
constexpr int LDS_CNT   = LDS_TP + 256;
constexpr int LDS_MISC  = LDS_CNT + 128;
constexpr int LDS_BYTES = LDS_MISC + 128;

namespace pg {
constexpr int BM = 256, BK = 64, HALF = 128, HTB = HALF * BK * 2, STAGE_BYTES = 8 * HTB, NXCD = 8, WGM = 8;
__device__ __forceinline__ int lds_byte(int r, int c) { const int st = (r >> 4) * 2 + (c >> 5), rr = r & 15, cc = c & 31, ob = rr * 64 + cc * 2; return st * 1024 + (ob ^ (((ob >> 9) & 1) << 5)); }
__device__ __forceinline__ void stage_rc(int b, int& R, int& C) { const int st = b / 1024, sb = b % 1024, swz = sb ^ (((sb >> 9) & 1) << 5); R = (st >> 1) * 16 + swz / 64; C = (st & 1) * 32 + (swz % 64) / 2; }
__device__ __forceinline__ int perm32(int rho) { const int n = rho >> 4, i = rho & 15; return 8 * (i >> 2) + 4 * n + (i & 3); }

struct Unit { int pm, pn, pb, e, ko, ui; };
struct DenseOrder {
    int nM, nN, nwg, G, c, skip_from, skip_by;
    __device__ void init(int nM_, int nN_, int G_, int c_, int sf = 1 << 30, int sb = 0) { nM = nM_; nN = nN_; nwg = nM * nN; G = G_; c = c_; skip_from = sf; skip_by = sb; }
    __device__ bool next(int i, Unit& u) const {
        const long L = (long)i * G + c; if (L >= nwg) return false;
        int wgid = (int)L; { const int q = nwg / NXCD, r = nwg % NXCD, xcd = wgid % NXCD, off = wgid / NXCD; wgid = (xcd < r ? xcd * (q + 1) : r * (q + 1) + (xcd - r) * q) + off; }
        const int nig = WGM * nN, gid = wgid / nig, fm = gid * WGM, gsz = (nM - fm) < WGM ? (nM - fm) : WGM;
        u.pm = fm + ((wgid % nig) % gsz); u.pn = (wgid % nig) / gsz; u.pb = u.pn >= skip_from ? u.pn + skip_by : u.pn; u.e = 0; u.ko = 0; u.ui = i; return true;
    }
    __device__ __forceinline__ unsigned arow(const Unit& u, int h, int R, int, const LAS int*) const { return (unsigned)(u.pm * 256 + h * 128 + R); }
};

template <int FPM  , class Epi, class Sched>
__device__ __forceinline__ void gemm_phase(LAS unsigned char* lds, const void* A, const void* Bt, const int RB  , const Sched& S, const Epi& E, const LAS int* gidx, const int nt_ = 0  ,
        const bool primed = false  , const bool chain = false  ,
        const void* cA = nullptr, const char* cBn = nullptr, const unsigned c00 = 0, const unsigned c01 = 0, const unsigned c10 = 0, const unsigned c11 = 0) {
    constexpr bool FP8 = FPM != 0;
    const int tid = threadIdx.x, wid = __builtin_amdgcn_readfirstlane(tid >> 6), lane = tid & 63, wr = wid >> 2, wc = wid & 3, fr = lane & 15, fq = lane >> 4;
    const int nt = nt_ ? nt_ : RB / (BK * 2);
    unsigned voffB[2];
#pragma unroll
    for (int i = 0; i < 2; ++i) { int R_, C_; stage_rc(tid * 16 + i * 8192, R_, C_); const int Rb = Epi::PERM ? ((R_ & ~31) + perm32(R_ & 31)) : R_; voffB[i] = (unsigned)(Rb * RB + C_ * 2); }
    const size_t kstep = (size_t)(BK * 2);
    const size_t hstep = (size_t)HALF * RB;
    const size_t tstep = 2 * hstep;
    const unsigned ldsw = (unsigned)wid * 1024u;
    const unsigned lds0 = __builtin_amdgcn_readfirstlane((unsigned)(size_t)lds + ldsw);
    const int aoff = lds_byte(wr * 64 + fr, fq * 8), boff = lds_byte(wc * 32 + fr, fq * 8);
#define PG_SA(b, h) (((b) * 2 + (h)) * HTB)
#define PG_SB(b, h) ((4 + (b) * 2 + (h)) * HTB)
#define PG_DMA(voff_, sbase_, ldsoff_) asm volatile("s_mov_b32 m0, %2\n\ts_nop 0\n\tglobal_load_lds_dwordx4 %0, %1" :: "v"(voff_), "s"(sbase_), "s"(ldsoff_) : "memory", "m0")
#define PG_STAGE_B(bufoff, gbase) do { const char* _sb = (const char*)(gbase); _Pragma("unroll") for (int _i = 0; _i < 2; ++_i) \
        PG_DMA(voffB[_i], _sb, lds0 + (unsigned)((bufoff) + _i * 8192)); } while (0)
#define PG_STAGE_A(bufoff, usenext, h, kb) do { const char* _sa = Ab + (size_t)(kb); _Pragma("unroll") for (int _i = 0; _i < 2; ++_i) { const unsigned _o = rac[h][_i]; \
        PG_DMA(_o, _sa, lds0 + (unsigned)((bufoff) + _i * 8192)); } } while (0)
#define PG_LDA(dst, b, h) do { _Pragma("unroll") for (int m = 0; m < 4; ++m) { if constexpr (FP8) { const i32x4 lo_ = *(const LAS i32x4*)(lds + PG_SA(b, h) + aoff + m * 2048), hi_ = *(const LAS i32x4*)(lds + PG_SA(b, h) + aoff + m * 2048 + 1024); dst##8[m] = __builtin_shufflevector(lo_, hi_, 0, 1, 2, 3, 4, 5, 6, 7); } \
        else { _Pragma("unroll") for (int k = 0; k < 2; ++k) dst[m][k] = *(const LAS bf16x8*)(lds + PG_SA(b, h) + aoff + m * 2048 + k * 1024); } } } while (0)
#define PG_LDB(dst, b, h) do { _Pragma("unroll") for (int n = 0; n < 2; ++n) { if constexpr (FP8) { const i32x4 lo_ = *(const LAS i32x4*)(lds + PG_SB(b, h) + boff + n * 2048), hi_ = *(const LAS i32x4*)(lds + PG_SB(b, h) + boff + n * 2048 + 1024); dst##8[n] = __builtin_shufflevector(lo_, hi_, 0, 1, 2, 3, 4, 5, 6, 7); } \
        else { _Pragma("unroll") for (int k = 0; k < 2; ++k) dst[n][k] = *(const LAS bf16x8*)(lds + PG_SB(b, h) + boff + n * 2048 + k * 1024); } } } while (0)
#define PG_MMA(ai, bj, At, Bt_) do { __builtin_amdgcn_s_setprio(1); _Pragma("unroll") for (int m = 0; m < 4; ++m) _Pragma("unroll") for (int n = 0; n < 2; ++n) { \
        if constexpr (FPM == 2) { acc[ai][bj][m][n] = __builtin_amdgcn_mfma_scale_f32_16x16x128_f8f6f4(Bt_##8[n], At##8[m], acc[ai][bj][m][n], 2, 2, 0, Bt_##8[n][6], 0, At##8[m][6]); } \
        else if constexpr (FPM == 1) { acc[ai][bj][m][n] = __builtin_amdgcn_mfma_scale_f32_16x16x128_f8f6f4(Bt_##8[n], At##8[m], acc[ai][bj][m][n], 0, 0, 0, 0x7F7F7F7F, 0, 0x7F7F7F7F); } \
        else { _Pragma("unroll") for (int k = 0; k < 2; ++k) acc[ai][bj][m][n] = __builtin_amdgcn_mfma_f32_16x16x32_bf16(Bt_[n][k], At[m][k], acc[ai][bj][m][n], 0, 0, 0); } } \
        __builtin_amdgcn_s_setprio(0); } while (0)
#define PG_WAIT_V(n) asm volatile("s_waitcnt vmcnt(" #n ")" ::: "memory")
#define PG_WAIT_L(n) asm volatile("s_waitcnt lgkmcnt(" #n ")" ::: "memory")
#define PG_WAIT_VN(n) asm volatile("s_waitcnt vmcnt(%0)" :: "n"(n) : "memory")
#define PG_KPAIR(t, WV_) do { \
            const bool last = (t == nt - 2); \
            const size_t kb1 = (size_t)(t + 1) * kstep; \
            const size_t kb2 = last ? 0 : (size_t)(t + 2) * kstep, kb3 = kb2 + kstep; \
            const char* b2 = last ? nB : cB + (size_t)(t + 2) * kstep; const char* b3 = b2 + kstep; \
            PG_LDB(B0, 0, 0); PG_LDB(B1, 0, 1); PG_SCHED; PG_LDA(At, 0, 0); PG_STAGE_A(PG_SA(1, 1), false, 1, kb1); \
            if (last) { if (has_next) { PG_RA(rac, nxt, ui + 1); } else if (chain) { rac[0][0] = c00; rac[0][1] = c01; rac[1][0] = c10; rac[1][1] = c11; Ab = (const char*)cA; } } \
            PG_WAIT_VN(WV_); PG_WAIT_L(0); PG_BAR; PG_MMA(0, 0, At, B0); PG_MMA(0, 1, At, B1); PG_BAR; PG_SCHED; \
            PG_LDA(At, 0, 1); PG_STAGE_B(PG_SB(0, 0), b2); PG_STAGE_B(PG_SB(0, 1), b2 + hstep); PG_STAGE_A(PG_SA(0, 0), last, 0, kb2); \
            PG_WAIT_VN(WV_); PG_WAIT_L(0); PG_BAR; PG_MMA(1, 0, At, B0); PG_MMA(1, 1, At, B1); PG_BAR; PG_SCHED; \
            PG_LDB(B0, 1, 0); PG_LDB(B1, 1, 1); PG_SCHED; PG_LDA(At, 1, 0); PG_STAGE_A(PG_SA(0, 1), last, 1, kb2); \
            PG_WAIT_V(8); PG_WAIT_L(0); PG_BAR; PG_MMA(0, 0, At, B0); PG_MMA(0, 1, At, B1); PG_BAR; PG_SCHED; \
            PG_LDA(At, 1, 1); PG_STAGE_B(PG_SB(1, 0), b3); PG_STAGE_B(PG_SB(1, 1), b3 + hstep); PG_STAGE_A(PG_SA(1, 0), last, 0, kb3); \
            PG_WAIT_V(8); PG_WAIT_L(0); PG_BAR; PG_MMA(1, 0, At, B0); PG_MMA(1, 1, At, B1); PG_BAR; PG_SCHED; \
        } while (0)
#define PG_BAR __builtin_amdgcn_s_barrier()
#define PG_SCHED __builtin_amdgcn_sched_barrier(0)
#define PG_RA(dst, u, ui_) do { _Pragma("unroll") for (int _i = 0; _i < 2; ++_i) { int R_, C_; stage_rc(tid * 16 + _i * 8192, R_, C_); _Pragma("unroll") for (int _h = 0; _h < 2; ++_h) dst[_h][_i] = S.arow(u, _h, R_, ui_, gidx) * (unsigned)RB + (unsigned)C_ * 2u + (unsigned)u.ko; } } while (0)
    Unit cur, nxt; int ui = 0;
    if (!S.next(0, cur)) return;
    f32x4 acc[2][2][4][2];
#pragma unroll
    for (int a = 0; a < 2; ++a)
#pragma unroll
        for (int b = 0; b < 2; ++b)
#pragma unroll
            for (int m = 0; m < 4; ++m)
#pragma unroll
                for (int n = 0; n < 2; ++n) acc[a][b][m][n] = (f32x4){0.f, 0.f, 0.f, 0.f};
    bf16x8 At[4][2], B0[2][2], B1[2][2]; i32x8 At8[4], B08[2], B18[2];
    unsigned rac[2][2];
    PG_RA(rac, cur, 0);
    const char* Ab = (const char*)A;
    const char* cB = (const char*)Bt + (size_t)cur.pb * tstep + cur.ko;
    if (!primed) {
    PG_STAGE_B(PG_SB(0, 0), cB); PG_STAGE_B(PG_SB(0, 1), cB + hstep); PG_STAGE_A(PG_SA(0, 0), false, 0, 0); PG_STAGE_A(PG_SA(0, 1), false, 1, 0);
    if (wr == 1) PG_BAR;
    PG_WAIT_V(2); PG_BAR;
    PG_STAGE_B(PG_SB(1, 0), cB + kstep); PG_STAGE_A(PG_SA(1, 0), false, 0, kstep); PG_STAGE_B(PG_SB(1, 1), cB + hstep + kstep);
    PG_WAIT_V(6); PG_BAR;
    }
    for (;;) {
        const bool has_next = S.next(ui + 1, nxt);
        const char* nB = has_next ? (const char*)Bt + (size_t)nxt.pb * tstep + nxt.ko : (chain ? cBn : cB);
        int t0 = 0;
        if (Epi::NST > 0 && ui > 0) { PG_KPAIR(0, 8 + Epi::NST); t0 = 2; }
        for (int t = t0; t < nt; t += 2) PG_KPAIR(t, 8);
        E(acc, cur, wr, wc, fr, fq);
        if (!has_next) break;
#pragma unroll
        for (int a = 0; a < 2; ++a)
#pragma unroll
            for (int b = 0; b < 2; ++b)
#pragma unroll
                for (int m = 0; m < 4; ++m)
#pragma unroll
                    for (int n = 0; n < 2; ++n) acc[a][b][m][n] = (f32x4){0.f, 0.f, 0.f, 0.f};
        cur = nxt; cB = nB; ++ui;
    }
    if (!chain) {
    PG_WAIT_V(0);
    if (wr == 0) PG_BAR;
    PG_BAR;
    }
#undef PG_SA
#undef PG_SB
#undef PG_STAGE_A
#undef PG_STAGE_B
#undef PG_DMA
#undef PG_LDA
#undef PG_LDB
#undef PG_MMA
#undef PG_WAIT_V
#undef PG_WAIT_L
#undef PG_WAIT_VN
#undef PG_KPAIR
#undef PG_BAR
#undef PG_SCHED
#undef PG_RA
}

template <class Sched>
__device__ __forceinline__ void first_unit_of(const Sched& S, const void* Bt, const int RB, const char*& cB, unsigned& r00, unsigned& r01, unsigned& r10, unsigned& r11) {
    Unit u; u.pm = 0; u.pn = 0; u.pb = 0; u.e = 0; u.ko = 0; u.ui = 0; S.next(0, u);
    const int tid = threadIdx.x; int R0, C0, R1, C1; stage_rc(tid * 16, R0, C0); stage_rc(tid * 16 + 8192, R1, C1);
    r00 = S.arow(u, 0, R0, 0, nullptr) * (unsigned)RB + (unsigned)C0 * 2u + (unsigned)u.ko; r01 = S.arow(u, 0, R1, 0, nullptr) * (unsigned)RB + (unsigned)C1 * 2u + (unsigned)u.ko;
    r10 = S.arow(u, 1, R0, 0, nullptr) * (unsigned)RB + (unsigned)C0 * 2u + (unsigned)u.ko; r11 = S.arow(u, 1, R1, 0, nullptr) * (unsigned)RB + (unsigned)C1 * 2u + (unsigned)u.ko;
    cB = (const char*)Bt + (size_t)u.pb * (2 * (size_t)HALF * RB) + u.ko;
}
__device__ __forceinline__ u32x4 pack8(const f32x4 a, const f32x4 b, float s) { u32x4 w; w.x = pk2(a[0] * s, a[1] * s); w.y = pk2(a[2] * s, a[3] * s); w.z = pk2(b[0] * s, b[1] * s); w.w = pk2(b[2] * s, b[3] * s); return w; }
typedef f32x4 Acc[2][2][4][2];

__device__ __forceinline__ float rstd_from(const float* ssq8) { const f32x4 a0 = *(const f32x4*)ssq8, a1 = *(const f32x4*)(ssq8 + 4);
    return 1.0f / sqrtf(((a0[0] + a0[1]) + (a0[2] + a0[3]) + (a1[0] + a1[1]) + (a1[2] + a1[3])) * (1.f / 512.f) + EPS); }
struct EpiProjMain {
    static constexpr bool PERM = true; static constexpr int NST = 0; P p;
    __device__ __forceinline__ void operator()(const Acc& acc, const Unit& u, int wr, int wc, int fr, int fq) const {
        const int row0 = u.pm * 256 + wr * 64 + fr;
        if (u.pn < 8) {
            bf16_t* base = WSP(bf16_t, u.pn < 4 ? WS_SBQ : WS_SBK); const float sc = u.pn < 4 ? 0.08838834764831845f * 1.4426950408889634f : 1.f;    const int col0 = (u.pn & 3) * 256 + wc * 32 + 8 * fq;
#pragma unroll
            for (int ai = 0; ai < 2; ++ai)
#pragma unroll
                for (int m = 0; m < 4; ++m) { bf16_t* rp = base + (size_t)(row0 + ai * 128 + m * 16) * 1024 + col0;
#pragma unroll
                    for (int bj = 0; bj < 2; ++bj) *(u32x4*)(rp + bj * 128) = pack8(acc[ai][bj][m][0], acc[ai][bj][m][1], sc); }
        } else {
            const int lat = (u.pn - 8) >> 1, ct = (u.pn - 8) & 1; bf16_t* base = WSP(bf16_t, lat ? WS_KVLAT : WS_QLAT); const int col0 = ct * 256 + wc * 32 + 8 * fq;
            float* ssqp = WSP(float, WS_SSQP);
#pragma unroll
            for (int ai = 0; ai < 2; ++ai)
#pragma unroll
                for (int m = 0; m < 4; ++m) { const int row = row0 + ai * 128 + m * 16; bf16_t* rp = base + (size_t)row * 512 + col0; float s = 0.f;
#pragma unroll
                    for (int bj = 0; bj < 2; ++bj) { *(u32x4*)(rp + bj * 128) = pack8(acc[ai][bj][m][0], acc[ai][bj][m][1], 1.f);
#pragma unroll
                        for (int n = 0; n < 2; ++n) { const f32x4 v = acc[ai][bj][m][n]; s += (v[0] * v[0] + v[1] * v[1]) + (v[2] * v[2] + v[3] * v[3]); } }
                    s += __shfl_xor(s, 16); s += __shfl_xor(s, 32);
                    if (fq == 0) ssqp[(size_t)row * 16 + lat * 8 + ct * 4 + wc] = s; }
        }
    }
};
template <bool SCALE>
__device__ __forceinline__ void epi_vt_r(const Acc& acc, const float* __restrict__ ssqp, bf16_t* __restrict__ dst, int f0, int tokb) {
#pragma unroll
    for (int bj = 0; bj < 2; ++bj) {
        const int tok0 = tokb + bj * 128, b = tok0 / SEQ, s0 = tok0 % SEQ;
        float sc[8];
#pragma unroll
        for (int j = 0; j < 8; ++j) sc[j] = SCALE ? rstd_from(ssqp + (size_t)(tok0 + j) * 16 + 8) : 1.f;
#pragma unroll
        for (int ai = 0; ai < 2; ++ai)
#pragma unroll
            for (int m = 0; m < 4; ++m) { const int f = f0 + ai * 128 + m * 16, h = f >> 7, d = f & 127;
                const f32x4 v0 = acc[ai][bj][m][0], v1 = acc[ai][bj][m][1]; u32x4 w;
                w.x = pk2(v0[0] * sc[0], v0[1] * sc[1]); w.y = pk2(v0[2] * sc[2], v0[3] * sc[3]); w.z = pk2(v1[0] * sc[4], v1[1] * sc[5]); w.w = pk2(v1[2] * sc[6], v1[3] * sc[7]);
                *(u32x4*)(dst + ((size_t)(b * 8 + h) * 128 + d) * SEQ + s0) = w; }
    }
}
template <bool SCALE> struct EpiVt {
    static constexpr bool PERM = true; static constexpr int NST = 0; P p; size_t dst_off;
    __device__ __forceinline__ void operator()(const Acc& acc, const Unit& u, int wr, int wc, int fr, int fq) const {
        epi_vt_r<SCALE>(acc, WSP(float, WS_SSQP), WSP(bf16_t, dst_off), u.pm * 256 + wr * 64 + fr, u.pn * 256 + wc * 32 + 8 * fq);
    }
};
__device__ __forceinline__ void epi_krope_r(const Acc& acc, const float2* __restrict__ cs, bf16_t* __restrict__ dst, int row0, int col0) {
#pragma unroll
    for (int ai = 0; ai < 2; ++ai) {
        f32x4 cv[4][2];
#pragma unroll
        for (int m = 0; m < 4; ++m) { const float2* cr = cs + (size_t)(row0 + ai * 128 + m * 16) * 32 + (col0 >> 1); cv[m][0] = *(const f32x4*)cr; cv[m][1] = *(const f32x4*)(cr + 2); }
        asm volatile("" ::: "memory");
#pragma unroll
        for (int m = 0; m < 4; ++m) { const int row = row0 + ai * 128 + m * 16; const f32x4 v0 = acc[ai][0][m][0], v1 = acc[ai][0][m][1], c0 = cv[m][0], c1 = cv[m][1];
            u32x4 w; w.x = pk2(v0[0] * c0[0] - v0[1] * c0[1], v0[1] * c0[0] + v0[0] * c0[1]); w.y = pk2(v0[2] * c0[2] - v0[3] * c0[3], v0[3] * c0[2] + v0[2] * c0[3]);
            w.z = pk2(v1[0] * c1[0] - v1[1] * c1[1], v1[1] * c1[0] + v1[0] * c1[1]); w.w = pk2(v1[2] * c1[2] - v1[3] * c1[3], v1[3] * c1[2] + v1[2] * c1[3]);
            *(u32x4*)(dst + (size_t)row * 64 + col0) = w; }
        asm volatile("" ::: "memory");
    }
}
struct EpiKrope {
    static constexpr bool PERM = true; static constexpr int NST = 0; P p;
    __device__ __forceinline__ void operator()(const Acc& acc, const Unit& u, int wr, int wc, int fr, int fq) const {
        if (wc >= 2) return;
        epi_krope_r(acc, WSP(float2, WS_CS), WSP(bf16_t, WS_KROPE), u.pm * 256 + wr * 64 + fr, wc * 32 + 8 * fq);
    }
};

__device__ __forceinline__ void epi_q_r(const Acc& acc, const float* __restrict__ ssqp, const float2* __restrict__ cs, bf16_t* __restrict__ dst, int row0, int cbase) {
    const int j0 = cbase % 192, j1 = (cbase + 128) % 192; const bool rp0 = j0 >= 128, rp1 = j1 >= 128; const int i00 = rp0 ? (j0 - 128) >> 1 : 0, i01 = rp1 ? (j1 - 128) >> 1 : 0;
#pragma unroll
    for (int qq = 0; qq < 4; ++qq) {
        f32x4 ca0[2], ca1[2], cb0[2], cb1[2]; float rsv[2];
#pragma unroll
        for (int h = 0; h < 2; ++h) { const int q = 2 * qq + h, ai = q >> 2, m = q & 3, row = row0 + ai * 128 + m * 16; const float2* cr = cs + (size_t)row * 32;
            ca0[h] = *(const f32x4*)(cr + i00); ca1[h] = *(const f32x4*)(cr + i00 + 2); cb0[h] = *(const f32x4*)(cr + i01); cb1[h] = *(const f32x4*)(cr + i01 + 2);
            rsv[h] = rstd_from(ssqp + (size_t)row * 16) * (0.07216878364870322f * 1.4426950408889634f); }
        asm volatile("" ::: "memory");
#pragma unroll
        for (int h = 0; h < 2; ++h) { const int q = 2 * qq + h, ai = q >> 2, m = q & 3, row = row0 + ai * 128 + m * 16;
#pragma unroll
            for (int bj = 0; bj < 2; ++bj) { const bool rp = bj ? rp1 : rp0;
                f32x4 v0 = acc[ai][bj][m][0] * rsv[h], v1 = acc[ai][bj][m][1] * rsv[h];
                if (rp) { const f32x4 c0v = bj ? cb0[h] : ca0[h], c1v = bj ? cb1[h] : ca1[h], t0 = v0, t1 = v1;
                    v0[0] = t0[0] * c0v[0] - t0[1] * c0v[1]; v0[1] = t0[1] * c0v[0] + t0[0] * c0v[1]; v0[2] = t0[2] * c0v[2] - t0[3] * c0v[3]; v0[3] = t0[3] * c0v[2] + t0[2] * c0v[3];
                    v1[0] = t1[0] * c1v[0] - t1[1] * c1v[1]; v1[1] = t1[1] * c1v[0] + t1[0] * c1v[1]; v1[2] = t1[2] * c1v[2] - t1[3] * c1v[3]; v1[3] = t1[3] * c1v[2] + t1[2] * c1v[3]; }
                *(u32x4*)(dst + (size_t)row * 1536 + cbase + bj * 128) = pack8(v0, v1, 1.f); } }
        asm volatile("" ::: "memory");
    }
}
struct EpiQ {
    static constexpr bool PERM = true; static constexpr int NST = 0; P p;
    __device__ __forceinline__ void operator()(const Acc& acc, const Unit& u, int wr, int wc, int fr, int fq) const {
        epi_q_r(acc, WSP(float, WS_SSQP), WSP(float2, WS_CS), WSP(bf16_t, WS_QMLA), u.pm * 256 + wr * 64 + fr, u.pn * 256 + wc * 32 + 8 * fq);
    }
};
__device__ __forceinline__ void epi_knope_r(const Acc& acc, const float* __restrict__ ssqp, bf16_t* __restrict__ dst, int row0, int c0) {
    float rs[2][4];
#pragma unroll
    for (int ai = 0; ai < 2; ++ai)
#pragma unroll
        for (int m = 0; m < 4; ++m) rs[ai][m] = rstd_from(ssqp + (size_t)(row0 + ai * 128 + m * 16) * 16 + 8);
    asm volatile("" ::: "memory");
#pragma unroll
    for (int ai = 0; ai < 2; ++ai)
#pragma unroll
        for (int m = 0; m < 4; ++m) { const int row = row0 + ai * 128 + m * 16;
#pragma unroll
            for (int bj = 0; bj < 2; ++bj) *(u32x4*)(dst + (size_t)row * 1024 + c0 + bj * 128) = pack8(acc[ai][bj][m][0], acc[ai][bj][m][1], rs[ai][m]); }
}
struct EpiKnope {
    static constexpr bool PERM = true; static constexpr int NST = 0; P p;
    __device__ __forceinline__ void operator()(const Acc& acc, const Unit& u, int wr, int wc, int fr, int fq) const {
        epi_knope_r(acc, WSP(float, WS_SSQP), WSP(bf16_t, WS_KNOPE), u.pm * 256 + wr * 64 + fr, u.pn * 256 + wc * 32 + 8 * fq);
    }
};
__device__ __forceinline__ void epi_out_r(const Acc& acc, const float* __restrict__ xin, const float* __restrict__ g1, bf16_t* __restrict__ x1, int row0, int col0) {
    f32x4 gv[2][2];
#pragma unroll
    for (int bj = 0; bj < 2; ++bj)
#pragma unroll
        for (int n = 0; n < 2; ++n) gv[bj][n] = *(const f32x4*)(g1 + col0 + bj * 128 + n * 4);
#pragma unroll
    for (int ai = 0; ai < 2; ++ai) {
        f32x4 xv[4][2][2];
#pragma unroll
        for (int m = 0; m < 4; ++m)
#pragma unroll
            for (int bj = 0; bj < 2; ++bj)
#pragma unroll
                for (int n = 0; n < 2; ++n) xv[m][bj][n] = *(const f32x4*)(xin + (size_t)(row0 + ai * 128 + m * 16) * D + col0 + bj * 128 + n * 4);
        asm volatile("" ::: "memory");
#pragma unroll
        for (int m = 0; m < 4; ++m)
#pragma unroll
            for (int bj = 0; bj < 2; ++bj)
                *(u32x4*)(x1 + (size_t)(row0 + ai * 128 + m * 16) * D + col0 + bj * 128) = pack8(xv[m][bj][0] + gv[bj][0] * acc[ai][bj][m][0], xv[m][bj][1] + gv[bj][1] * acc[ai][bj][m][1], 1.f);
        asm volatile("" ::: "memory");
    }
}
struct EpiOut {
    static constexpr bool PERM = true; static constexpr int NST = 0; P p;
    __device__ __forceinline__ void operator()(const Acc& acc, const Unit& u, int wr, int wc, int fr, int fq) const {
        const int row0 = u.pm * 256 + wr * 64 + fr, b = (u.pm * 256) / SEQ, col0 = u.pn * 256 + wc * 32 + 8 * fq;
        epi_out_r(acc, p.x, WSP(float, WS_MOD) + (size_t)b * NMOD * D + 2 * D, WSP(bf16_t, WS_X1), row0, col0);
    }
};
struct EpiMoe1 {
    static constexpr bool PERM = true; static constexpr int NST = 8; P p; size_t dst_off; const LAS float* bias_lds;
    __device__ __forceinline__ void operator()(const Acc& acc, const Unit& u, int wr, int wc, int fr, int fq) const {
        const int row0 = u.pm * 256 + wr * 64 + fr, a0 = u.pn * 128 + wc * 32 + 8 * fq; const LAS float* b1 = bias_lds + (u.ui < 18 ? u.ui : 0) * 256 + 2 * (wc * 32 + 8 * fq); bf16_t* dst = WSP(bf16_t, dst_off);
        float bg[8], bl[8];
#pragma unroll
        for (int q = 0; q < 4; ++q) { const f32x4 t = *(const LAS f32x4*)(b1 + 4 * q); bg[2 * q] = t[0]; bl[2 * q] = t[1] + 1.f; bg[2 * q + 1] = t[2]; bl[2 * q + 1] = t[3] + 1.f; }
#pragma unroll
        for (int ai = 0; ai < 2; ++ai)
#pragma unroll
            for (int m = 0; m < 4; ++m) { const int row = row0 + ai * 128 + m * 16; float o[8];
#pragma unroll
                for (int j = 0; j < 8; ++j) { float g = acc[ai][0][m][j >> 2][j & 3] * (MOE1_FP6 ? 1.f : W8_INV) + bg[j], l = acc[ai][1][m][j >> 2][j & 3] * (MOE1_FP6 ? 1.f : W8_INV) + bl[j];
                    g = fminf(g, 7.f); l = fminf(fmaxf(l, -6.f), 8.f);
                    o[j] = g * __builtin_amdgcn_rcpf(1.f + __builtin_amdgcn_exp2f(-2.4554669595930156f * g)) * l; }
                if (MOE_FP8) { u32x2 w; w.x = pk4_fp8(o[0], o[1], o[2], o[3]); w.y = pk4_fp8(o[4], o[5], o[6], o[7]); *(u32x2*)((unsigned char*)dst + (size_t)row * DE + a0) = w; }
                else { u32x4 w; w.x = pk2(o[0], o[1]); w.y = pk2(o[2], o[3]); w.z = pk2(o[4], o[5]); w.w = pk2(o[6], o[7]);
                *(u32x4*)(dst + (size_t)row * DE + a0) = w; } }
    }
};
struct EpiMoe2 {
    static constexpr bool PERM = true; static constexpr int NST = 16; P p; const LAS float* bias_lds;
    __device__ __forceinline__ void operator()(const Acc& acc, const Unit& u, int wr, int wc, int fr, int fq) const {
        const int row0 = u.pm * 256 + wr * 64 + fr, c0 = u.pn * 256 + wc * 32 + 8 * fq; const LAS float* b2 = bias_lds + (u.ui < 18 ? u.ui : 0) * 256 + wc * 32 + 8 * fq; bf16_t* dst = WSP(bf16_t, WS_Y);
        f32x4 bv[2][2];
#pragma unroll
        for (int bj = 0; bj < 2; ++bj)
#pragma unroll
            for (int n = 0; n < 2; ++n) bv[bj][n] = *(const LAS f32x4*)(b2 + bj * 128 + 4 * n) * (Y_FP8 ? Y_SCALE : 1.f);
#pragma unroll
        for (int ai = 0; ai < 2; ++ai)
#pragma unroll
            for (int m = 0; m < 4; ++m) { const int row = row0 + ai * 128 + m * 16;
#pragma unroll
                for (int bj = 0; bj < 2; ++bj) {
                    if (Y_FP8) { f32x4 t0 = acc[ai][bj][m][0] * ((MOE_FP8 ? W8_INV : 1.f) * Y_SCALE) + bv[bj][0], t1 = acc[ai][bj][m][1] * ((MOE_FP8 ? W8_INV : 1.f) * Y_SCALE) + bv[bj][1];
#pragma unroll
                        for (int j = 0; j < 4; ++j) { t0[j] = __builtin_amdgcn_fmed3f(t0[j], -448.f, 448.f); t1[j] = __builtin_amdgcn_fmed3f(t1[j], -448.f, 448.f); }
                        u32x2 w; w.x = pk4_fp8(t0[0], t0[1], t0[2], t0[3]); w.y = pk4_fp8(t1[0], t1[1], t1[2], t1[3]);
                        *(u32x2*)((unsigned char*)dst + (size_t)row * D + c0 + bj * 128) = w; }
                    else *(u32x4*)(dst + (size_t)row * D + c0 + bj * 128) = pack8(acc[ai][bj][m][0] * (MOE_FP8 ? W8_INV : 1.f) + bv[bj][0], acc[ai][bj][m][1] * (MOE_FP8 ? W8_INV : 1.f) + bv[bj][1], 1.f); } }
    }
};
template <int NCT, bool GATHER> struct MoeOrder {
    const LAS int* tp; int T, rtr, ctr, rpr, G, c;
    __device__ void init(const LAS int* tp_, int G_, int c_) { tp = tp_; T = tp_[32]; G = G_; c = c_;
        const int x = c_ & 7, a = (c_ >> 3) & 31;
        if (NCT == 16) { rtr = (x >> 2) * 8 + (a >> 2); ctr = (x & 3) * 4 + (a & 3); rpr = 16; } else { rtr = (x >> 1) * 8 + (a >> 2); ctr = (x & 1) * 4 + (a & 3); rpr = 32; } }
    __device__ bool next(int i, Unit& u) const {
        int g, ct;
        if (G == 256) { g = i * rpr + rtr; ct = ctr; } else { const long L = (long)i * G + c; g = (int)(L / NCT); ct = (int)(L % NCT); }
        if (g >= T) return false;
        int e;
        if (G == 256 && i < 20 && tp[63]) { e = tp[40 + i]; }
        else { e = 0; while (e < 31 && tp[e + 1] <= g) ++e; }
        u.pm = g; u.pn = ct; u.pb = e * NCT + ct; u.e = e; u.ko = 0; u.ui = i; return true;
    }
    __device__ __forceinline__ unsigned arow(const Unit& u, int h, int R, int ui, const LAS int* gidx) const { return GATHER ? (unsigned)((const LAS unsigned short*)gidx)[ui * 256 + h * 128 + R] : (unsigned)(u.pm * 256 + h * 128 + R); }
};
struct KropeOrder {
    int G, c;
    __device__ bool next(int i, Unit& u) const { const int L = i * G + c; if (L >= 256) return false; u.pm = L >> 2; u.pn = L & 3; u.pb = 16; u.e = 0; u.ko = (L & 3) * 1024; u.ui = i; return true; }
    __device__ __forceinline__ unsigned arow(const Unit& u, int h, int R, int, const LAS int*) const { return (unsigned)(u.pm * 256 + h * 128 + R); }
};
struct EpiKropeP {
    static constexpr bool PERM = true; static constexpr int NST = 0; P p;
    __device__ __forceinline__ void operator()(const Acc& acc, const Unit& u, int wr, int wc, int fr, int fq) const {
        if (wc >= 2) return;
        float* dst = WSP(float, WS_G_QRAW) + (size_t)u.pn * NTOK * 64; const int row0 = u.pm * 256 + wr * 64 + fr, col0 = wc * 32 + 8 * fq;
#pragma unroll
        for (int ai = 0; ai < 2; ++ai)
#pragma unroll
            for (int m = 0; m < 4; ++m) { float* rp = dst + (size_t)(row0 + ai * 128 + m * 16) * 64 + col0; *(f32x4*)rp = acc[ai][0][m][0]; *(f32x4*)(rp + 4) = acc[ai][0][m][1]; }
    }
};
}

__device__ __forceinline__ void krope_fixup(const float* __restrict__ part, const float2* __restrict__ cs, bf16_t* __restrict__ dst, int G, int bid) {
    for (int r0 = bid * 64; r0 < NTOK; r0 += G * 64) { const int row = r0 + (threadIdx.x >> 3), c8 = (threadIdx.x & 7) * 8;
        f32x4 a = {0.f, 0.f, 0.f, 0.f}, b = {0.f, 0.f, 0.f, 0.f};
#pragma unroll
        for (int q = 0; q < 4; ++q) { const float* pp = part + ((size_t)q * NTOK + row) * 64 + c8; a += *(const f32x4*)pp; b += *(const f32x4*)(pp + 4); }
        const f32x4 c0 = *(const f32x4*)(cs + (size_t)row * 32 + (c8 >> 1)), c1 = *(const f32x4*)(cs + (size_t)row * 32 + (c8 >> 1) + 2);
        u32x4 w; w.x = pk2(a[0] * c0[0] - a[1] * c0[1], a[1] * c0[0] + a[0] * c0[1]); w.y = pk2(a[2] * c0[2] - a[3] * c0[3], a[3] * c0[2] + a[2] * c0[3]);
        w.z = pk2(b[0] * c1[0] - b[1] * c1[1], b[1] * c1[0] + b[0] * c1[1]); w.w = pk2(b[2] * c1[2] - b[3] * c1[3], b[3] * c1[2] + b[2] * c1[3]);
        *(u32x4*)(dst + (size_t)row * 64 + c8) = w; }
}

struct DmIdent { __device__ int operator()(int n) const { return n; } };
struct DmWin { __device__ int operator()(int n) const { if (n < 4096) return n; const int j = n - 4096; return j < 32 ? 4096 + 2 * j : 4096 + 2 * (j - 32) + 1; } };
struct DmWq { __device__ int operator()(int n) const { const int h = n / 192, j = n - h * 192; if (j < 128) return n; return j < 160 ? h * 192 + 128 + 2 * (j - 128) : h * 192 + 128 + 2 * (j - 160) + 1; } };
struct DmWkv { __device__ int operator()(int n) const { const int h = n >> 8, r = n & 255; return r < 128 ? h * 128 + r : 1024 + h * 128 + (r - 128); } };
struct DmW1 { __device__ int operator()(int n) const { const int a = n >> 1; return (a >> 7) * 256 + (n & 1) * 128 + (a & 127); } };
template <class DM>
__device__ __forceinline__ void conv_tile(const float* W, int ldw, int k0, int n0, bf16_t* Bt, int K, DM dm, const float* kscale, LAS unsigned* T) {
    const int tid = threadIdx.x, kp = tid >> 4, nc = tid & 15;
    f32x4 a[2], b[2];
#pragma unroll
    for (int ps = 0; ps < 2; ++ps) { const int k = k0 + 2 * (kp + 32 * ps);
        a[ps] = *(const f32x4*)(W + (size_t)k * ldw + n0 + 4 * nc); b[ps] = *(const f32x4*)(W + (size_t)(k + 1) * ldw + n0 + 4 * nc);
        if (kscale) { a[ps] *= kscale[k]; b[ps] *= kscale[k + 1]; } }
#pragma unroll
    for (int ps = 0; ps < 2; ++ps)
#pragma unroll
        for (int j = 0; j < 4; ++j) T[(4 * nc + j) * 66 + kp + 32 * ps] = pk2(a[ps][j], b[ps][j]);
    __syncthreads();
#pragma unroll
    for (int q = 0; q < 2; ++q) { const int ch = tid + 512 * q, n = ch >> 4, c = ch & 15;
        const u32x2 lo = *(const LAS u32x2*)(T + n * 66 + 4 * c), hi = *(const LAS u32x2*)(T + n * 66 + 4 * c + 2);
        u32x4 w; w.x = lo.x; w.y = lo.y; w.z = hi.x; w.w = hi.y;
        *(u32x4*)(Bt + (size_t)dm(n0 + n) * K + k0 + 8 * c) = w; }
    __syncthreads();
}

template <class DM>
__device__ __forceinline__ void conv_tile8(const float* W, int ldw, int k0, int n0, unsigned char* Bt, int K, DM dm, LAS unsigned* T) {
    const int tid = threadIdx.x, k4 = tid >> 4, nc = tid & 15;
    f32x4 a[4];
#pragma unroll
    for (int r = 0; r < 4; ++r) a[r] = *(const f32x4*)(W + (size_t)(k0 + 4 * k4 + r) * ldw + n0 + 4 * nc) * W8_SCALE;
#pragma unroll
    for (int j = 0; j < 4; ++j) T[(4 * nc + j) * 36 + k4] = pk4_fp8(a[0][j], a[1][j], a[2][j], a[3][j]);
    __syncthreads();
    { const int n = tid >> 3, c = tid & 7; const u32x4 w = *(const LAS u32x4*)(T + n * 36 + 4 * c); *(u32x4*)(Bt + (size_t)dm(n0 + n) * K + k0 + 16 * c) = w; }
    __syncthreads();
}

template <class DM>
__device__ __forceinline__ void conv_tile8x2(const float* Wa, const float* Wb, int ldw, int k0a, int n0a, int k0b, int n0b, unsigned char* Bta, unsigned char* Btb, int K, DM dm, LAS unsigned* T) {
    const int tid = threadIdx.x, k4 = tid >> 4, nc = tid & 15;
    f32x4 a[4], b[4];
#pragma unroll
    for (int r = 0; r < 4; ++r) a[r] = __builtin_nontemporal_load((const f32x4*)(Wa + (size_t)(k0a + 4 * k4 + r) * ldw + n0a + 4 * nc));
#pragma unroll
    for (int r = 0; r < 4; ++r) b[r] = __builtin_nontemporal_load((const f32x4*)(Wb + (size_t)(k0b + 4 * k4 + r) * ldw + n0b + 4 * nc));
#pragma unroll
    for (int j = 0; j < 4; ++j) T[(4 * nc + j) * 36 + k4] = pk4_fp8(a[0][j] * W8_SCALE, a[1][j] * W8_SCALE, a[2][j] * W8_SCALE, a[3][j] * W8_SCALE);
#pragma unroll
    for (int j = 0; j < 4; ++j) T[2304 + (4 * nc + j) * 36 + k4] = pk4_fp8(b[0][j] * W8_SCALE, b[1][j] * W8_SCALE, b[2][j] * W8_SCALE, b[3][j] * W8_SCALE);
    __syncthreads();
    { const int n = tid >> 3, c = tid & 7; const u32x4 wa = *(const LAS u32x4*)(T + n * 36 + 4 * c), wb = *(const LAS u32x4*)(T + 2304 + n * 36 + 4 * c);
      __builtin_nontemporal_store(wa, (u32x4*)(Bta + (size_t)dm(n0a + n) * K + k0a + 16 * c)); __builtin_nontemporal_store(wb, (u32x4*)(Btb + (size_t)dm(n0b + n) * K + k0b + 16 * c)); }
    __syncthreads();
}

template <class DM>
__device__ __forceinline__ void conv_macro8(const float* W, int ldw, int k0, int n0, unsigned char* Bt, int K, DM dm, LAS unsigned char* Tb) {
    const int tid = threadIdx.x, kq = tid >> 6, nc = tid & 63;
    const float* src = W + (size_t)(k0 + 4 * kq) * ldw + n0 + 4 * nc;
    f32x4 a[2][8];
#define CM_LOAD(buf, slab) do { _Pragma("unroll") for (int h_ = 0; h_ < 2; ++h_) _Pragma("unroll") for (int r_ = 0; r_ < 4; ++r_) a[buf][h_ * 4 + r_] = __builtin_nontemporal_load((const f32x4*)(src + (size_t)((slab) * 64 + h_ * 32 + r_) * ldw)); } while (0)
#define CM_PUT(buf, slab) do { _Pragma("unroll") for (int h_ = 0; h_ < 2; ++h_) _Pragma("unroll") for (int j_ = 0; j_ < 4; ++j_) \
        *(LAS unsigned*)(Tb + (4 * nc + j_) * 260 + ((slab) * 64 + h_ * 32 + 4 * kq)) = pk4_fp8(a[buf][h_ * 4][j_] * W8_SCALE, a[buf][h_ * 4 + 1][j_] * W8_SCALE, a[buf][h_ * 4 + 2][j_] * W8_SCALE, a[buf][h_ * 4 + 3][j_] * W8_SCALE); } while (0)
    CM_LOAD(0, 0); CM_LOAD(1, 1);
    CM_PUT(0, 0); CM_LOAD(0, 2);
    CM_PUT(1, 1); CM_LOAD(1, 3);
    CM_PUT(0, 2); CM_PUT(1, 3);
#undef CM_LOAD
#undef CM_PUT
    __syncthreads();
#pragma unroll
    for (int ps = 0; ps < 8; ++ps) { const int n = ps * 32 + (tid >> 4), c = tid & 15; const LAS unsigned* tp_ = (const LAS unsigned*)(Tb + n * 260 + 16 * c);
        u32x4 w; w.x = tp_[0]; w.y = tp_[1]; w.z = tp_[2]; w.w = tp_[3];
        __builtin_nontemporal_store(w, (u32x4*)(Bt + (size_t)dm(n0 + n) * K + k0 + 16 * c)); }
    __syncthreads();
}

__device__ __forceinline__ void phase_prologue(const P& p, LAS unsigned char* lds, int G, int bid) {
    const int tid = threadIdx.x, lane = tid & 63, wid = tid >> 6;
    LAS float* cact = (LAS float*)lds;
    LAS float* red = (LAS float*)(lds + 32768);
    LAS unsigned* T = (LAS unsigned*)(lds + 81920);
    constexpr int U_MOD = 96, U_CS = 64 + 8;
    constexpr int T_WIN = 16 * 65, T_WQ = 4 * 24, T_WKV = 4 * 32, T_WOUT = 16 * 32;
    constexpr int U_REST = U_CS + T_WIN + T_WQ + T_WKV + T_WOUT;
    const bool split = G > 2 * U_MOD;
    if (!split || bid < U_MOD) {
        for (int i = tid; i < 4 * 2048; i += 512) { const int b = i >> 11, k = i & 2047; const float c = p.c[i]; cact[k * 4 + b] = c / (1.f + __expf(-c)); }
        __syncthreads();
        for (int mu = bid; mu < U_MOD; mu += G) {
            f32x4 acc[4] = {{0.f, 0.f, 0.f, 0.f}, {0.f, 0.f, 0.f, 0.f}, {0.f, 0.f, 0.f, 0.f}, {0.f, 0.f, 0.f, 0.f}};
            const int hh = lane >> 5, cl = lane & 31;
            const float* w = p.w_mod + (size_t)(wid * 256 + hh) * (NMOD * D) + mu * 128 + 4 * cl;
#pragma unroll 16
            for (int k = 0; k < 128; ++k) { const f32x4 wv = __builtin_nontemporal_load((const f32x4*)(w + (size_t)(2 * k) * (NMOD * D))); const f32x4 c = *(const LAS f32x4*)(cact + (wid * 256 + 2 * k + hh) * 4);
                acc[0] += wv * c[0]; acc[1] += wv * c[1]; acc[2] += wv * c[2]; acc[3] += wv * c[3]; }
#pragma unroll
            for (int b = 0; b < 4; ++b) *(LAS f32x4*)(red + ((wid * 64 + lane) * 4 + b) * 4) = acc[b];
            __syncthreads();
            if (tid < 128) { const int l = tid >> 2, b = tid & 3; f32x4 sum = *(const f32x4*)(p.b_mod + mu * 128 + 4 * l);
#pragma unroll
                for (int w8 = 0; w8 < 16; ++w8) sum += *(const LAS f32x4*)(red + ((w8 * 32 + l) * 4 + b) * 4);
                *(f32x4*)(WSP(float, WS_MOD) + (size_t)b * NMOD * D + mu * 128 + 4 * l) = sum; }
            __syncthreads();
        }
        if (split) return;
    }
    const int c0 = split ? bid - U_MOD : bid, GS = split ? G - U_MOD : G;
    for (int v = c0; v < U_CS; v += GS) {
        if (v >= 64) {
            for (int j = 0; j < 16; ++j) { const int idx = (v - 64) * 8192 + j * 512 + tid, k = idx >> 5, e = idx & 31; const float w = p.w_router[idx];
                const bf16_t hi = f2bf(w); WSP(bf16_t, WS_WR_HI)[e * 2048 + k] = hi; WSP(bf16_t, WS_WR_LO)[e * 2048 + k] = f2bf(w - bf2f(hi)); }
        } else {
            for (int j = 0; j < 16; ++j) { const int idx = v * 8192 + j * 512 + tid; const int tok = idx >> 5, i = idx & 31;
                double inv = 1.0; for (int q = 0; q < i; ++q) inv *= 0.7498942093324559;
                const double rev = (double)p.pos[tok] * inv * 0.15915494309189535; const float fr = (float)(rev - floor(rev));
                float2 cs; cs.x = __builtin_amdgcn_cosf(fr); cs.y = __builtin_amdgcn_sinf(fr); WSP(float2, WS_CS)[idx] = cs; }
        }
    }
    constexpr int NT = T_WIN + T_WQ + T_WKV + T_WOUT;
    const int kp = tid >> 4, nc = tid & 15;
    f32x4 ra[2][2], rb[2][2];
#define CT_DECL(P_) const float* P_##W = p.w_in; bf16_t* P_##Bt = WSP(bf16_t, WS_WIN_T); const float* P_##ks = nullptr; int P_##ldw = INW, P_##k0 = 0, P_##n0 = 0, P_##K = 2048, P_##dmt = 0
#define CT_SET(P_, vv) do { int v_ = (vv); \
        if (v_ < T_WIN) { P_##W = p.w_in; P_##Bt = WSP(bf16_t, WS_WIN_T); P_##ks = nullptr; P_##ldw = INW; P_##k0 = (v_ / 65) * 128; P_##n0 = (v_ % 65) * 64; P_##K = 2048; P_##dmt = 0; } \
        else if ((v_ -= T_WIN) < T_WQ) { P_##W = p.w_q_up; P_##Bt = WSP(bf16_t, WS_WQ_T); P_##ks = p.g_q; P_##ldw = 1536; P_##k0 = (v_ / 24) * 128; P_##n0 = (v_ % 24) * 64; P_##K = 512; P_##dmt = 1; } \
        else if ((v_ -= T_WQ) < T_WKV) { P_##W = p.w_kv_up; P_##Bt = WSP(bf16_t, WS_WKV_T); P_##ks = p.g_kv; P_##ldw = 2048; P_##k0 = (v_ / 32) * 128; P_##n0 = (v_ % 32) * 64; P_##K = 512; P_##dmt = 2; } \
        else { v_ -= T_WKV; P_##W = p.w_out; P_##Bt = WSP(bf16_t, WS_WOUT_T); P_##ks = nullptr; P_##ldw = 2048; P_##k0 = (v_ / 32) * 128; P_##n0 = (v_ % 32) * 64; P_##K = 2048; P_##dmt = 3; } } while (0)
#define PT_LOAD(buf, P_) do { _Pragma("unroll") for (int ps = 0; ps < 2; ++ps) { const int k = P_##k0 + 2 * (kp + 32 * ps); \
        ra[buf][ps] = *(const f32x4*)(P_##W + (size_t)k * P_##ldw + P_##n0 + 4 * nc); rb[buf][ps] = *(const f32x4*)(P_##W + (size_t)(k + 1) * P_##ldw + P_##n0 + 4 * nc); } } while (0)
#define PT_DO(buf, P_) do { _Pragma("unroll") for (int ps = 0; ps < 2; ++ps) { const int k = P_##k0 + 2 * (kp + 32 * ps); f32x4 x = ra[buf][ps], y = rb[buf][ps]; \
            if (P_##ks) { x *= P_##ks[k]; y *= P_##ks[k + 1]; } \
            _Pragma("unroll") for (int j = 0; j < 4; ++j) T[(4 * nc + j) * 66 + kp + 32 * ps] = pk2(x[j], y[j]); } \
        __syncthreads(); \
        _Pragma("unroll") for (int q = 0; q < 2; ++q) { const int ch = tid + 512 * q, n = ch >> 4, cc = ch & 15; \
            const u32x2 lo = *(const LAS u32x2*)(T + n * 66 + 4 * cc), hi = *(const LAS u32x2*)(T + n * 66 + 4 * cc + 2); \
            u32x4 w; w.x = lo.x; w.y = lo.y; w.z = hi.x; w.w = hi.y; const int nn = P_##n0 + n; \
            const int dn = P_##dmt == 0 ? DmWin{}(nn) : P_##dmt == 1 ? DmWq{}(nn) : P_##dmt == 2 ? DmWkv{}(nn) : nn; \
            *(u32x4*)(P_##Bt + (size_t)dn * P_##K + P_##k0 + 8 * cc) = w; } \
        __syncthreads(); } while (0)
    int v = c0;
    if (v < NT) {
        CT_DECL(c_); CT_DECL(n_);
        CT_SET(c_, v); PT_LOAD(0, c_);
        for (;;) {
            const int vn = v + GS; const bool more = vn < NT;
            if (more) { CT_SET(n_, vn); PT_LOAD(1, n_); }
            PT_DO(0, c_);
            if (!more) break;
            const int vnn = vn + GS; const bool more2 = vnn < NT;
            if (more2) { CT_SET(c_, vnn); PT_LOAD(0, c_); }
            PT_DO(1, n_);
            if (!more2) break;
            v = vnn;
        }
    }
#undef CT_DECL
#undef CT_SET
#undef PT_LOAD
#undef PT_DO
}

__device__ __forceinline__ void phase_normmod_r(const float* __restrict__ mod, const float* __restrict__ x, const float* __restrict__ g, int shift_idx, int scale_idx, bf16_t* __restrict__ out, int G, int bid) {
    const int lane = threadIdx.x & 63, wid = threadIdx.x >> 6;
    for (int row = bid * 8 + wid; row < NTOK; row += G * 8) {
        const int b = row / SEQ; const float* xr = x + (size_t)row * D; f32x4 v[8]; float ss = 0.f;
#pragma unroll
        for (int j = 0; j < 8; ++j) { v[j] = *(const f32x4*)(xr + (j * 64 + lane) * 4); ss += (v[j][0] * v[j][0] + v[j][1] * v[j][1]) + (v[j][2] * v[j][2] + v[j][3] * v[j][3]); }
#pragma unroll
        for (int o = 32; o >= 1; o >>= 1) ss += __shfl_xor(ss, o);
        const float rstd = 1.0f / sqrtf(ss * (1.f / D) + EPS);
        const float* sh = mod + (size_t)b * NMOD * D + shift_idx * D; const float* sc = mod + (size_t)b * NMOD * D + scale_idx * D;
#pragma unroll
        for (int j = 0; j < 8; ++j) { const int k = (j * 64 + lane) * 4; const f32x4 gg = *(const f32x4*)(g + k), s1 = *(const f32x4*)(sc + k), s0 = *(const f32x4*)(sh + k);
            const f32x4 h = v[j] * rstd * gg * (s1 + 1.f) + s0; u32x2 w; w.x = pk2(h[0], h[1]); w.y = pk2(h[2], h[3]); *(u32x2*)(out + (size_t)row * D + k) = w; }
    }
}


__device__ __forceinline__ void phase_cb(const P& p, LAS unsigned char* lds, int bid) {
    if (bid >= NB) return;
    const int tid = threadIdx.x, e = tid & 31, kc = tid >> 5; LAS float* red = (LAS float*)lds;
    const float* sh = WSP(float, WS_MOD) + (size_t)bid * NMOD * D + 3 * D; float s = 0.f;
#pragma unroll 16
    for (int k = kc * 128; k < kc * 128 + 128; ++k) s += sh[k] * p.w_router[k * 32 + e];
    red[tid] = s; __syncthreads();
    if (tid < 32) { float t = p.b_router[tid]; for (int q = 0; q < 16; ++q) t += red[q * 32 + tid]; WSP(float, WS_CB)[bid * 32 + tid] = t; }
    __syncthreads();
}
__device__ __forceinline__ void route_h2_out(const bf16_t* __restrict__ xr, const float* __restrict__ gf, const float* __restrict__ sc, const float* __restrict__ sh, unsigned char* __restrict__ hr8, const float rs, const int kbase) {
#pragma unroll 4
    for (int s = 0; s < 32; ++s) {
        const int k = kbase + 16 * s;
        const f32x4 g0 = *(const f32x4*)(gf + k), g1 = *(const f32x4*)(gf + k + 4), s0 = *(const f32x4*)(sc + k), s1 = *(const f32x4*)(sc + k + 4), h0 = *(const f32x4*)(sh + k), h1 = *(const f32x4*)(sh + k + 4);
        f32x4 xa, xb; { const u32x4 xw = *(const u32x4*)(xr + 16 * s); xa[0] = __uint_as_float(xw.x << 16); xa[1] = __uint_as_float(xw.x & 0xffff0000u); xa[2] = __uint_as_float(xw.y << 16); xa[3] = __uint_as_float(xw.y & 0xffff0000u);
            xb[0] = __uint_as_float(xw.z << 16); xb[1] = __uint_as_float(xw.z & 0xffff0000u); xb[2] = __uint_as_float(xw.w << 16); xb[3] = __uint_as_float(xw.w & 0xffff0000u); }
        const f32x4 y0 = xa * rs * g0 * (s0 + 1.f) + h0, y1 = xb * rs * g1 * (s1 + 1.f) + h1;
        if (MOE_FP8) { u32x2 w; w.x = pk4_fp8(y0[0], y0[1], y0[2], y0[3]); w.y = pk4_fp8(y1[0], y1[1], y1[2], y1[3]); *(u32x2*)(hr8 + 16 * s) = w; }
        else { u32x4 w; w.x = pk2(y0[0], y0[1]); w.y = pk2(y0[2], y0[3]); w.z = pk2(y1[0], y1[1]); w.w = pk2(y1[2], y1[3]); *(u32x4*)(hr8 + 32 * s) = w; }
    }
}
__device__ __forceinline__ void route_h2_fp6(const bf16_t* __restrict__ x1g, const LAS float* gsl, const LAS float* shl, unsigned char* __restrict__ h2g, const LAS float* rsd) {
    const int blk = threadIdx.x & 63, k0 = blk * 32;
    f32x4 gs[8], hs[8];
#pragma unroll
    for (int q = 0; q < 8; ++q) { gs[q] = *(const LAS f32x4*)(gsl + k0 + 4 * q); hs[q] = *(const LAS f32x4*)(shl + k0 + 4 * q); }
#pragma unroll 2
    for (int ps = 0; ps < 8; ++ps) { const int id = threadIdx.x + 512 * ps, r = id >> 6; const float rs = rsd[r];
        float v[32]; const u32x4* xp = (const u32x4*)(x1g + (size_t)r * D + k0);
#pragma unroll
        for (int q = 0; q < 4; ++q) { const u32x4 xw = xp[q]; const f32x4 g0 = gs[2 * q] * rs, g1 = gs[2 * q + 1] * rs, h0 = hs[2 * q], h1 = hs[2 * q + 1];
            v[8 * q + 0] = __uint_as_float(xw.x << 16) * g0[0] + h0[0]; v[8 * q + 1] = __uint_as_float(xw.x & 0xffff0000u) * g0[1] + h0[1];
            v[8 * q + 2] = __uint_as_float(xw.y << 16) * g0[2] + h0[2]; v[8 * q + 3] = __uint_as_float(xw.y & 0xffff0000u) * g0[3] + h0[3];
            v[8 * q + 4] = __uint_as_float(xw.z << 16) * g1[0] + h1[0]; v[8 * q + 5] = __uint_as_float(xw.z & 0xffff0000u) * g1[1] + h1[1];
            v[8 * q + 6] = __uint_as_float(xw.w << 16) * g1[2] + h1[2]; v[8 * q + 7] = __uint_as_float(xw.w & 0xffff0000u) * g1[3] + h1[3]; }
        u32x4 lo, hi; fp6_block(v, lo, hi);
        unsigned char* dst = h2g + (size_t)r * D + (blk >> 2) * 128 + (blk & 3) * 16;
        *(u32x4*)dst = lo; *(u32x4*)(dst + 64) = hi; }
}
__device__ __forceinline__ void phase_route(const P& p, LAS unsigned char* lds, int G, int bid) {
    const int tid = threadIdx.x, lane = tid & 63, wid = __builtin_amdgcn_readfirstlane(tid >> 6), hf = wid >> 2, wq = wid & 3, r32 = lane & 31, kg = lane >> 5;
    LAS float* red = (LAS float*)lds;
    LAS float* ssr = (LAS float*)(lds + 32768);
    LAS float* lg = (LAS float*)(lds + 32768 + 2048);
    LAS float* rsd = (LAS float*)(lds + 32768 + 2048 + 8192);
    LAS int* hist = (LAS int*)(lds + 32768 + 2048 + 8192 + 256);
    LAS int* gbase = hist + 32;
    LAS float* gsl = (LAS float*)(lds + 49152);
    LAS float* shl = (LAS float*)(lds + 57344);
    const bf16_t* wrh = WSP(bf16_t, WS_WR_HI); const bf16_t* wrl = WSP(bf16_t, WS_WR_LO);
    for (int gp = bid; gp < NTOK / 64; gp += G) {
        const int row = gp * 64 + hf * 32 + r32, b = (gp * 64) / SEQ, kb0 = wq * 512 + 8 * kg;
        const float* mod = WSP(float, WS_MOD) + (size_t)b * NMOD * D; const float* sh = mod + 3 * D; const float* sc = mod + 4 * D;
        const bf16_t* xr = WSP(bf16_t, WS_X1) + (size_t)row * D + kb0;
        f32x16 C = {}; float ss = 0.f;
        if (tid < 32) hist[tid] = 0;
        { const int k4 = tid * 4; *(LAS f32x4*)(gsl + k4) = *(const f32x4*)(p.g_ffn + k4) * (*(const f32x4*)(sc + k4) + 1.f); *(LAS f32x4*)(shl + k4) = *(const f32x4*)(sh + k4); }
        __syncthreads();
#pragma unroll 4
        for (int s = 0; s < 32; ++s) {
            const int k = kb0 + 16 * s;
            const f32x4 gs0 = *(const LAS f32x4*)(gsl + k), gs1 = *(const LAS f32x4*)(gsl + k + 4);
            f32x4 x0, x1; { const u32x4 xw = *(const u32x4*)(xr + 16 * s); x0[0] = __uint_as_float(xw.x << 16); x0[1] = __uint_as_float(xw.x & 0xffff0000u); x0[2] = __uint_as_float(xw.y << 16); x0[3] = __uint_as_float(xw.y & 0xffff0000u);
                x1[0] = __uint_as_float(xw.z << 16); x1[1] = __uint_as_float(xw.z & 0xffff0000u); x1[2] = __uint_as_float(xw.w << 16); x1[3] = __uint_as_float(xw.w & 0xffff0000u); }
            ss += (x0[0] * x0[0] + x0[1] * x0[1]) + (x0[2] * x0[2] + x0[3] * x0[3]) + (x1[0] * x1[0] + x1[1] * x1[1]) + (x1[2] * x1[2] + x1[3] * x1[3]);
            const f32x4 y0 = x0 * gs0, y1 = x1 * gs1;
            u32x4 hi; hi.x = pk2(y0[0], y0[1]); hi.y = pk2(y0[2], y0[3]); hi.z = pk2(y1[0], y1[1]); hi.w = pk2(y1[2], y1[3]);
            f32x4 r0, r1;
            r0[0] = y0[0] - __uint_as_float(hi.x << 16); r0[1] = y0[1] - __uint_as_float(hi.x & 0xffff0000u); r0[2] = y0[2] - __uint_as_float(hi.y << 16); r0[3] = y0[3] - __uint_as_float(hi.y & 0xffff0000u);
            r1[0] = y1[0] - __uint_as_float(hi.z << 16); r1[1] = y1[1] - __uint_as_float(hi.z & 0xffff0000u); r1[2] = y1[2] - __uint_as_float(hi.w << 16); r1[3] = y1[3] - __uint_as_float(hi.w & 0xffff0000u);
            u32x4 lo; lo.x = pk2(r0[0], r0[1]); lo.y = pk2(r0[2], r0[3]); lo.z = pk2(r1[0], r1[1]); lo.w = pk2(r1[2], r1[3]);
            const bf16x8 ah = *(const bf16x8*)(wrh + (size_t)r32 * 2048 + k), al = *(const bf16x8*)(wrl + (size_t)r32 * 2048 + k);
            const bf16x8 bh = __builtin_bit_cast(bf16x8, hi), bl = __builtin_bit_cast(bf16x8, lo);
            C = __builtin_amdgcn_mfma_f32_32x32x16_bf16(ah, bh, C, 0, 0, 0);
            C = __builtin_amdgcn_mfma_f32_32x32x16_bf16(al, bh, C, 0, 0, 0);
            C = __builtin_amdgcn_mfma_f32_32x32x16_bf16(ah, bl, C, 0, 0, 0);
        }
#pragma unroll
        for (int r = 0; r < 16; ++r) red[((hf * 4 + wq) * 32 + ((r & 3) + 8 * (r >> 2) + 4 * kg)) * 32 + r32] = C[r];
        ssr[(hf * 8 + wq * 2 + kg) * 32 + r32] = ss;
        __syncthreads();
        { const int h2 = tid >> 8, t2 = tid & 255;
#pragma unroll
          for (int q = 0; q < 4; ++q) { const int e = (t2 >> 5) + 8 * q; float t = 0.f;
#pragma unroll
              for (int w4 = 0; w4 < 4; ++w4) t += red[((h2 * 4 + w4) * 32 + e) * 32 + (t2 & 31)]; lg[(h2 * 32 + e) * 32 + (t2 & 31)] = t; } }
        if (tid < 64) { float t = 0.f;
#pragma unroll
            for (int q = 0; q < 8; ++q) t += ssr[((tid >> 5) * 8 + q) * 32 + (tid & 31)]; rsd[tid] = 1.0f / sqrtf(t * (1.f / D) + EPS); }
        __syncthreads();
        int i0 = 0, i1 = 0, i2 = 0, i3 = 0, l0 = 0, l1 = 0, l2 = 0, l3 = 0; float w0 = 0.f, w1 = 0.f, w2 = 0.f, w3 = 0.f;
        if (tid < 64) {
            const float rs = rsd[tid]; const float* cb = WSP(float, WS_CB) + b * 32; const LAS float* lgr = lg + (tid >> 5) * 1024 + (tid & 31);
            unsigned used = 0; float v0 = 0, v1 = 0, v2 = 0, v3 = 0;
            float xv[32];
#pragma unroll
            for (int e = 0; e < 32; ++e) xv[e] = lgr[e * 32] * rs + cb[e];
#pragma unroll
            for (int k = 0; k < 4; ++k) { float best = -3.0e38f; int bi = 0;
#pragma unroll
                for (int e = 0; e < 32; ++e) { const bool ok = !((used >> e) & 1u) && xv[e] > best; best = ok ? xv[e] : best; bi = ok ? e : bi; }
                used |= 1u << bi;
                if (k == 0) { i0 = bi; v0 = best; } else if (k == 1) { i1 = bi; v1 = best; } else if (k == 2) { i2 = bi; v2 = best; } else { i3 = bi; v3 = best; } }
            const float e1 = __expf(v1 - v0), e2 = __expf(v2 - v0), e3 = __expf(v3 - v0), inv = 1.f / (1.f + e1 + e2 + e3);
            w0 = inv; w1 = e1 * inv; w2 = e2 * inv; w3 = e3 * inv;
            l0 = atomicAdd((int*)(hist + i0), 1); l1 = atomicAdd((int*)(hist + i1), 1); l2 = atomicAdd((int*)(hist + i2), 1); l3 = atomicAdd((int*)(hist + i3), 1);
        }
        __syncthreads();
        if (tid < 32) { const int c = hist[tid]; gbase[tid] = c ? atomicAdd(WSP(int, WS_CNT) + tid, c) : 0; }
        __syncthreads();
        if (tid < 64) { const int rw = gp * 64 + tid;
            const int p0 = gbase[i0] + l0, p1 = gbase[i1] + l1, p2 = gbase[i2] + l2, p3 = gbase[i3] + l3;
            int* te = WSP(int, WS_TOPE) + rw * 4; float* tw = WSP(float, WS_TOPW) + rw * 4; int* tp = WSP(int, WS_TPOS) + rw * 4; int* rt = WSP(int, WS_ROWTOK);
            te[0] = i0; te[1] = i1; te[2] = i2; te[3] = i3; tw[0] = w0; tw[1] = w1; tw[2] = w2; tw[3] = w3; tp[0] = p0; tp[1] = p1; tp[2] = p2; tp[3] = p3;
            rt[(size_t)i0 * NTOK + p0] = rw * 4; rt[(size_t)i1 * NTOK + p1] = rw * 4 + 1; rt[(size_t)i2 * NTOK + p2] = rw * 4 + 2; rt[(size_t)i3 * NTOK + p3] = rw * 4 + 3; }
        if (MOE1_FP6) route_h2_fp6(WSP(bf16_t, WS_X1) + (size_t)(gp * 64) * D, gsl, shl, p.ws + WS_H2 + (size_t)(gp * 64) * D, rsd);
        else route_h2_out(xr, p.g_ffn, sc, sh, p.ws + WS_H2 + (size_t)row * D + kb0, rsd[hf * 32 + r32], kb0);
        __syncthreads();
    }
}
__device__ __forceinline__ void phase_final_r(const bf16_t* __restrict__ Y, const bf16_t* __restrict__ X1, const float* __restrict__ modp, const int* __restrict__ tope, const int* __restrict__ tpos, const float* __restrict__ topw, const float* __restrict__ gfin, float* __restrict__ outp, LAS unsigned char* lds, int G, int bid) {
    const int lane = threadIdx.x & 63, wid = threadIdx.x >> 6; const LAS int* tp = (const LAS int*)(lds + LDS_TP);
    int e_n = 0, ps_n = 0; float wk_n = 0.f;
    { const int r0 = bid * 8 + wid; if (r0 < NTOK && lane < 4) { e_n = tope[r0 * 4 + lane]; ps_n = tpos[r0 * 4 + lane]; wk_n = topw[r0 * 4 + lane]; } }
    for (int row = bid * 8 + wid; row < NTOK; row += G * 8) {
        const int b = row / SEQ; const float* g2 = modp + (size_t)b * NMOD * D + 5 * D;
        int slot = 0; float wk = 0.f;
        if (lane < 4) { slot = tp[e_n] * 256 + ps_n; wk = wk_n; }
        { const int nr = row + G * 8; if (nr < NTOK && lane < 4) { e_n = tope[nr * 4 + lane]; ps_n = tpos[nr * 4 + lane]; wk_n = topw[nr * 4 + lane]; } }
        const int sl0 = __shfl(slot, 0), sl1 = __shfl(slot, 1), sl2 = __shfl(slot, 2), sl3 = __shfl(slot, 3);
        const float ysc = Y_FP8 ? 1.f / Y_SCALE : 1.f, q0 = __shfl(wk, 0) * ysc, q1 = __shfl(wk, 1) * ysc, q2 = __shfl(wk, 2) * ysc, q3 = __shfl(wk, 3) * ysc;
        f32x4 v[8]; float ss = 0.f;
#pragma unroll
        for (int j = 0; j < 8; ++j) { const int k = (j * 64 + lane) * 4;
            f32x4 m;
            if (Y_FP8) { const unsigned char* Y8 = (const unsigned char*)Y;
                const int a0 = *(const int*)(Y8 + (size_t)sl0 * D + k), a1 = *(const int*)(Y8 + (size_t)sl1 * D + k), a2 = *(const int*)(Y8 + (size_t)sl2 * D + k), a3 = *(const int*)(Y8 + (size_t)sl3 * D + k);
                const auto l0 = __builtin_amdgcn_cvt_pk_f32_fp8(a0, false), h0 = __builtin_amdgcn_cvt_pk_f32_fp8(a0, true), l1 = __builtin_amdgcn_cvt_pk_f32_fp8(a1, false), h1 = __builtin_amdgcn_cvt_pk_f32_fp8(a1, true);
                const auto l2 = __builtin_amdgcn_cvt_pk_f32_fp8(a2, false), h2 = __builtin_amdgcn_cvt_pk_f32_fp8(a2, true), l3 = __builtin_amdgcn_cvt_pk_f32_fp8(a3, false), h3 = __builtin_amdgcn_cvt_pk_f32_fp8(a3, true);
                m[0] = q0 * l0[0] + q1 * l1[0] + q2 * l2[0] + q3 * l3[0]; m[1] = q0 * l0[1] + q1 * l1[1] + q2 * l2[1] + q3 * l3[1];
                m[2] = q0 * h0[0] + q1 * h1[0] + q2 * h2[0] + q3 * h3[0]; m[3] = q0 * h0[1] + q1 * h1[1] + q2 * h2[1] + q3 * h3[1];
            } else {
            const u32x2 a0 = *(const u32x2*)(Y + (size_t)sl0 * D + k), a1 = *(const u32x2*)(Y + (size_t)sl1 * D + k), a2 = *(const u32x2*)(Y + (size_t)sl2 * D + k), a3 = *(const u32x2*)(Y + (size_t)sl3 * D + k);
            m[0] = q0 * __uint_as_float(a0.x << 16) + q1 * __uint_as_float(a1.x << 16) + q2 * __uint_as_float(a2.x << 16) + q3 * __uint_as_float(a3.x << 16);
            m[1] = q0 * __uint_as_float(a0.x & 0xffff0000u) + q1 * __uint_as_float(a1.x & 0xffff0000u) + q2 * __uint_as_float(a2.x & 0xffff0000u) + q3 * __uint_as_float(a3.x & 0xffff0000u);
            m[2] = q0 * __uint_as_float(a0.y << 16) + q1 * __uint_as_float(a1.y << 16) + q2 * __uint_as_float(a2.y << 16) + q3 * __uint_as_float(a3.y << 16);
            m[3] = q0 * __uint_as_float(a0.y & 0xffff0000u) + q1 * __uint_as_float(a1.y & 0xffff0000u) + q2 * __uint_as_float(a2.y & 0xffff0000u) + q3 * __uint_as_float(a3.y & 0xffff0000u);
            }
            { const u32x2 xw = *(const u32x2*)(X1 + (size_t)row * D + k); f32x4 xv; xv[0] = __uint_as_float(xw.x << 16); xv[1] = __uint_as_float(xw.x & 0xffff0000u); xv[2] = __uint_as_float(xw.y << 16); xv[3] = __uint_as_float(xw.y & 0xffff0000u);
              v[j] = xv + *(const f32x4*)(g2 + k) * m; }
            ss += (v[j][0] * v[j][0] + v[j][1] * v[j][1]) + (v[j][2] * v[j][2] + v[j][3] * v[j][3]); }
#pragma unroll
        for (int o = 32; o >= 1; o >>= 1) ss += __shfl_xor(ss, o);
        const float rstd = 1.0f / sqrtf(ss * (1.f / D) + EPS);
#pragma unroll
        for (int j = 0; j < 8; ++j) { const int k = (j * 64 + lane) * 4; *(f32x4*)(outp + (size_t)row * D + k) = v[j] * rstd * *(const f32x4*)(gfin + k); }
    }
}
__device__ __forceinline__ void phase_final(const P& p, LAS unsigned char* lds, int G, int bid) { phase_final_r(WSP(bf16_t, WS_Y), WSP(bf16_t, WS_X1), WSP(float, WS_MOD), WSP(int, WS_TOPE), WSP(int, WS_TPOS), WSP(float, WS_TOPW), p.g_final, p.out, lds, G, bid); }

namespace at {
constexpr int VSTR = 144, VT = 128 * VSTR;
constexpr int LDS_AL = 90112, LDS_FLAG = LDS_AL + 1024;
constexpr float LOG2E = 1.4426950408889634f;
__device__ __forceinline__ bf16x8 packf(const f32x16& x, int s) { u32x4 w; w.x = pk2(x[8 * s], x[8 * s + 1]); w.y = pk2(x[8 * s + 2], x[8 * s + 3]); w.z = pk2(x[8 * s + 4], x[8 * s + 5]); w.w = pk2(x[8 * s + 6], x[8 * s + 7]); return __builtin_bit_cast(bf16x8, w); }
#define AT_MFMA(a, b, c) __builtin_amdgcn_mfma_f32_32x32x16_bf16((a), (b), (c), 0, 0, 0)

template <bool MLA>
__device__ __forceinline__ void attn_unit(const P& p, LAS unsigned char* lds, const int b, const int h, const int qb) {
    constexpr int DK = MLA ? 192 : 128, KSTR = MLA ? 400 : 272, KT = 64 * KSTR, BUF = KT + VT, NQF = DK / 16, NKR = MLA ? 3 : 2;
    static_assert(2 * (64 * 400 + VT) <= LDS_AL, "attention LDS map");
    const int tid = threadIdx.x, wid = __builtin_amdgcn_readfirstlane(tid >> 6), lane = tid & 63, r32 = lane & 31, hi = lane >> 5;
    const int q0 = qb * 256, qw = q0 + 32 * wid, qi = qw + r32, nt = (q0 + 256) / 64;
    const bf16_t* Kn = MLA ? WSP(bf16_t, WS_KNOPE) : WSP(bf16_t, WS_SBK);
    const bf16_t* Kr = WSP(bf16_t, WS_KROPE);
    const bf16_t* Vt = WSP(bf16_t, MLA ? WS_VMT : WS_SBVT) + (size_t)(b * 8 + h) * 128 * SEQ;
    LAS float* al = (LAS float*)(lds + LDS_AL) + wid * 32;
    LAS int* flag = (LAS int*)(lds + LDS_FLAG);
    bf16x8 qf[NQF];
    { const char* qb_ = MLA ? (const char*)WSP(bf16_t, WS_QMLA) + ((size_t)(b * SEQ + qw) * 1536 + h * 192) * 2 : (const char*)WSP(bf16_t, WS_SBQ) + ((size_t)(b * SEQ + qw) * 1024 + h * 128) * 2;
      const unsigned qo = (unsigned)((r32 * (MLA ? 1536 : 1024) + 8 * hi) * 2);
#pragma unroll
      for (int s = 0; s < NQF; ++s) qf[s] = *(const bf16x8*)(qb_ + qo + 32 * s); }
    bf16x8 tri0, tri1, ones;
#pragma unroll
    for (int j = 0; j < 8; ++j) { const int k0_ = 8 * (j >> 2) + 4 * hi + (j & 3); tri0[j] = (k0_ > r32) ? (short)0x3F80 : (short)0; tri1[j] = (16 + k0_ > r32) ? (short)0x3F80 : (short)0; ones[j] = (short)0x3F80; }
    u32x4 kreg[NKR], vreg[2];
    const unsigned kofs0 = (unsigned)(((tid >> 4) * 1024 + (tid & 15) * 8) * 2), kofs1 = kofs0 + 32u * 1024u * 2u;
    const unsigned rofs = (unsigned)(((tid >> 3) * 64 + (tid & 7) * 8) * 2);
    const unsigned vofs0 = (unsigned)(((tid >> 3) * SEQ + (tid & 7) * 8) * 2), vofs1 = vofs0 + 64u * SEQ * 2u;
    const unsigned kw0 = (unsigned)((tid >> 4) * KSTR + (tid & 15) * 16), kw1 = kw0 + 32u * KSTR, rw = (unsigned)((tid >> 3) * KSTR + 256 + (tid & 7) * 16);
    const unsigned vw0 = (unsigned)(KT + (tid >> 3) * VSTR + (16 * ((tid & 7) >> 1) + 4 * (tid & 1)) * 2), vw1 = vw0 + 64u * VSTR;
    const char* Knb = (const char*)Kn + ((size_t)b * SEQ * 1024 + h * 128) * 2; const char* Krb = (const char*)Kr + (size_t)b * SEQ * 64 * 2; const char* Vtb = (const char*)Vt;
#define AT_LOAD(tile) do { const int k0_ = (tile) * 64; const char* kp_ = Knb + (size_t)k0_ * 2048; const char* vp_ = Vtb + (size_t)k0_ * 2; \
        kreg[0] = *(const u32x4*)(kp_ + kofs0); kreg[1] = *(const u32x4*)(kp_ + kofs1); if (MLA) kreg[NKR - 1] = *(const u32x4*)(Krb + (size_t)k0_ * 128 + rofs); \
        vreg[0] = *(const u32x4*)(vp_ + vofs0); vreg[1] = *(const u32x4*)(vp_ + vofs1); } while (0)
#define AT_WRITE(buf) do { LAS unsigned char* kb_ = lds + (buf) * BUF; \
        *(LAS u32x4*)(kb_ + kw0) = kreg[0]; *(LAS u32x4*)(kb_ + kw1) = kreg[1]; if (MLA) *(LAS u32x4*)(kb_ + rw) = kreg[NKR - 1]; \
        { u32x2 lo_, hi_; lo_.x = vreg[0].x; lo_.y = vreg[0].y; hi_.x = vreg[0].z; hi_.y = vreg[0].w; *(LAS u32x2*)(kb_ + vw0) = lo_; *(LAS u32x2*)(kb_ + vw0 + 16) = hi_; } \
        { u32x2 lo_, hi_; lo_.x = vreg[1].x; lo_.y = vreg[1].y; hi_.x = vreg[1].z; hi_.y = vreg[1].w; *(LAS u32x2*)(kb_ + vw1) = lo_; *(LAS u32x2*)(kb_ + vw1 + 16) = hi_; } } while (0)
    f32x16 o[4];
#pragma unroll
    for (int d0 = 0; d0 < 4; ++d0)
#pragma unroll
        for (int r = 0; r < 16; ++r) o[d0][r] = 0.f;
    float m_run = -1e30f, l_run = 0.f, R2 = 0.f;
    if (!MLA && tid < 8) flag[tid] = 0;
    AT_LOAD(MLA ? 0 : nt - 1);
    AT_WRITE(0);
    __syncthreads();
    for (int it = 0; it < nt; ++it) {
        const int tile = MLA ? it : nt - 1 - it, cb = it & 1, k0 = tile * 64;
        const bool more = it + 1 < nt;
        if (more) AT_LOAD(MLA ? tile + 1 : tile - 1);
        const bool active = MLA ? (k0 <= qw + 31) : (k0 < qw + 31 && !__all(R2 < -160.f));
        if (active) {
            const LAS unsigned char* kb = lds + cb * BUF;
            f32x16 p0, p1;
#pragma unroll
            for (int r = 0; r < 16; ++r) { p0[r] = 0.f; p1[r] = 0.f; }
#pragma unroll
            for (int s = 0; s < NQF; ++s) { const bf16x8 a0 = *(const LAS bf16x8*)(kb + r32 * KSTR + s * 32 + hi * 16), a1 = *(const LAS bf16x8*)(kb + (32 + r32) * KSTR + s * 32 + hi * 16);
                p0 = AT_MFMA(a0, qf[s], p0); p1 = AT_MFMA(a1, qf[s], p1); if ((s & 3) == 3) __builtin_amdgcn_sched_barrier(0); }
            const int dq = qi - k0 - 4 * hi;
            bf16x8 pf0, pf1, pf2, pf3;
            if (MLA) {
                float pm = -3.0e38f;
                if (k0 + 63 > qw) {
#pragma unroll
                    for (int r = 0; r < 16; ++r) { const int c = (r & 3) + 8 * (r >> 2);
                        if (c > dq) p0[r] = -__builtin_inff(); if (c + 32 > dq) p1[r] = -__builtin_inff(); }
                }
#pragma unroll
                for (int r = 0; r < 16; ++r) pm = fmaxf(pm, fmaxf(p0[r], p1[r]));
                pm = fmaxf(pm, __shfl_xor(pm, 32));
                const float mn = fmaxf(m_run, pm), alpha = __builtin_amdgcn_exp2f(m_run - mn); m_run = mn;
                float ps = 0.f;
#pragma unroll
                for (int r = 0; r < 16; ++r) { p0[r] = __builtin_amdgcn_exp2f(p0[r] - mn); p1[r] = __builtin_amdgcn_exp2f(p1[r] - mn); ps += p0[r] + p1[r]; }
                ps += __shfl_xor(ps, 32);
                l_run = l_run * alpha + ps;
                if (__any(alpha < 1.f)) { if (hi == 0) al[r32] = alpha; asm volatile("s_waitcnt lgkmcnt(0)" ::: "memory");
#pragma unroll
                    for (int r = 0; r < 16; ++r) { const float a = al[(r & 3) + 8 * (r >> 2) + 4 * hi];
#pragma unroll
                        for (int d0 = 0; d0 < 4; ++d0) o[d0][r] *= a; } }
                pf0 = packf(p0, 0); pf1 = packf(p0, 1); pf2 = packf(p1, 0); pf3 = packf(p1, 1);
            } else {
                if (k0 + 63 >= qw) {
#pragma unroll
                    for (int r = 0; r < 16; ++r) { const int c = (r & 3) + 8 * (r >> 2); if (c >= dq) p0[r] = -__builtin_inff(); if (c + 32 >= dq) p1[r] = -__builtin_inff(); } }
                float lsum = 0.f; bf16x8 lf[4];
#pragma unroll
                for (int g = 0; g < 4; ++g) {
                    float Lv[8];
#pragma unroll
                    for (int j = 0; j < 8; ++j) { const int r = 8 * (g & 1) + j;
                        const float z = (g < 2 ? p0[r] : p1[r]);
                        const float t = __builtin_amdgcn_logf(1.f + __builtin_amdgcn_exp2f(-fabsf(z)));
                        const float L = -(fmaxf(z, 0.f) + t);
                        const float ls = fminf(z, 0.f) - t;
                        if (g < 2) p0[r] = ls; else p1[r] = ls;
                        Lv[j] = L; lsum += L; }
                    u32x4 w; w.x = pk2(Lv[0], Lv[1]); w.y = pk2(Lv[2], Lv[3]); w.z = pk2(Lv[4], Lv[5]); w.w = pk2(Lv[6], Lv[7]); lf[g] = __builtin_bit_cast(bf16x8, w);
                }
                p0 = AT_MFMA(tri0, lf[0], p0); p0 = AT_MFMA(tri1, lf[1], p0); p0 = AT_MFMA(ones, lf[2], p0); p0 = AT_MFMA(ones, lf[3], p0);
                p1 = AT_MFMA(tri0, lf[2], p1); p1 = AT_MFMA(tri1, lf[3], p1);
#pragma unroll
                for (int r = 0; r < 16; ++r) { p0[r] = __builtin_amdgcn_exp2f(p0[r] + R2); p1[r] = __builtin_amdgcn_exp2f(p1[r] + R2); }
                lsum += __shfl_xor(lsum, 32);
                R2 += lsum;
                pf0 = packf(p0, 0); pf1 = packf(p0, 1); pf2 = packf(p1, 0); pf3 = packf(p1, 1);
            }
            const LAS unsigned char* vb = kb + KT;
#pragma unroll
            for (int d0 = 0; d0 < 4; ++d0) { const LAS unsigned char* vr = vb + (32 * d0 + r32) * VSTR + hi * 16;
                o[d0] = AT_MFMA(pf0, *(const LAS bf16x8*)(vr), o[d0]); o[d0] = AT_MFMA(pf1, *(const LAS bf16x8*)(vr + 32), o[d0]);
                o[d0] = AT_MFMA(pf2, *(const LAS bf16x8*)(vr + 64), o[d0]); o[d0] = AT_MFMA(pf3, *(const LAS bf16x8*)(vr + 96), o[d0]); __builtin_amdgcn_sched_barrier(0); }
        }
        if (more) AT_WRITE(cb ^ 1);
        if (!MLA) { const bool dn = __all(R2 < -160.f); if (lane == 0) flag[wid] = dn ? 1 : 0; }
        __syncthreads();
        if (!MLA) { int all = 1;
#pragma unroll
            for (int w8 = 0; w8 < 8; ++w8) all &= flag[w8];
            if (all) break; }
    }
    if (!MLA) __syncthreads();
    if (MLA) { if (hi == 0) al[r32] = 1.0f / l_run; asm volatile("s_waitcnt lgkmcnt(0)" ::: "memory"); }
    char* Ob = (char*)(WSP(bf16_t, WS_MIXED) + (size_t)(b * SEQ + qw) * 2048 + (MLA ? 1024 : 0) + h * 128);
    const bool odd = (r32 & 1) != 0;
    const unsigned oo = (unsigned)((4 * hi * 2048 + r32) * 2) + (odd ? 4094u : 0u);
#pragma unroll
    for (int q = 0; q < 8; ++q) { const int ra = 2 * q, c = (ra & 3) + 8 * (ra >> 2); const float iva = MLA ? al[c + 4 * hi] : 1.f, ivb = MLA ? al[c + 1 + 4 * hi] : 1.f;
#pragma unroll
        for (int d0 = 0; d0 < 4; ++d0) { const float A = o[d0][ra] * iva, Bv = o[d0][ra + 1] * ivb;
            const float snd = odd ? A : Bv;
            const float rcv = __int_as_float(__builtin_amdgcn_update_dpp(0, __float_as_int(snd), 0xB1, 0xF, 0xF, true));
            const unsigned w = odd ? pk2(rcv, Bv) : pk2(A, rcv);
            *(unsigned*)(Ob + oo + (unsigned)((c * 2048 + d0 * 32) * 2)) = w; } }
    __syncthreads();
#undef AT_LOAD
#undef AT_WRITE
}
constexpr int CQ_NMT = NE * 16 * 16 + NE * 16 * 8, CQ_DEFER = 512, CQ_END = 1 << 30;
__device__ __forceinline__ void conv_queue(const P& p, LAS unsigned char* lds, int* ctr, int max_tiles, const int base, const int count) {
    constexpr int NM1 = NE * 16 * 16;
    LAS int* qs = (LAS int*)(lds + LDS_FLAG + 96); LAS unsigned char* Tb = lds + 16384;
    const int tid = threadIdx.x, kq = tid >> 6, nc = tid & 63;
    int pulled = 0;
#define CQ_CAN (max_tiles < 0 || pulled < max_tiles)
#define CQ_MAP(v_) ((v_) < count ? base + (v_) : CQ_END)
#define CQ_PULL(dst) do { __syncthreads(); if (tid == 0) qs[0] = CQ_CAN ? atomicAdd(ctr, 1) : count; __syncthreads(); dst = CQ_MAP(qs[0]); ++pulled; } while (0)
    int t_cur, t_nxt;
    CQ_PULL(t_cur); if (t_cur >= CQ_END) { __syncthreads(); return; }
    CQ_PULL(t_nxt);
    f32x4 a[4][4];
#define CQ_SRC(t, src, ldw) const float* src; int ldw; { const bool w1_ = (t) < NM1; const int t2_ = w1_ ? (t) : (t) - NM1, e_ = w1_ ? t2_ >> 8 : t2_ >> 7, r_ = w1_ ? t2_ & 255 : t2_ & 127; \
        ldw = w1_ ? 4096 : 2048; const int k0_ = (w1_ ? r_ >> 4 : r_ >> 3) * 128, n0_ = (w1_ ? r_ & 15 : r_ & 7) * 256; \
        src = (w1_ ? p.w1 + (size_t)e_ * 2048 * 4096 : p.w2 + (size_t)e_ * 2048 * 2048) + (size_t)(k0_ + 4 * kq) * ldw + n0_ + 4 * nc; }
#define CQ_LOAD(buf, slab, src, ldw) do { _Pragma("unroll") for (int r_ = 0; r_ < 4; ++r_) a[buf][r_] = __builtin_nontemporal_load((const f32x4*)(src + (size_t)((slab) * 32 + r_) * ldw)); } while (0)
#define CQ_PUT(buf, slab) do { if (cur_w1) { _Pragma("unroll") for (int j_ = 0; j_ < 4; ++j_) { u32x2 d_; d_.x = pk2(a[buf][0][j_], a[buf][1][j_]); d_.y = pk2(a[buf][2][j_], a[buf][3][j_]); \
            *(LAS u32x2*)(Tb + (4 * nc + j_) * 264 + ((slab) * 32 + 4 * kq) * 2) = d_; } } \
        else { _Pragma("unroll") for (int j_ = 0; j_ < 4; ++j_) *(LAS unsigned*)(Tb + (4 * nc + j_) * 132 + ((slab) * 32 + 4 * kq)) = pk4_fp8(a[buf][0][j_] * W8_SCALE, a[buf][1][j_] * W8_SCALE, a[buf][2][j_] * W8_SCALE, a[buf][3][j_] * W8_SCALE); } } while (0)
    { CQ_SRC(t_cur, s0, l0); CQ_LOAD(0, 0, s0, l0); CQ_LOAD(1, 1, s0, l0); CQ_LOAD(2, 2, s0, l0); CQ_LOAD(3, 3, s0, l0); }
    for (int it = 0;; ++it) {
        const bool more = t_nxt < CQ_END, cur_w1 = t_cur < NM1;
        if (tid == 0) qs[1 + (it & 1)] = (more && CQ_CAN) ? atomicAdd(ctr, 1) : count;
        ++pulled;
        CQ_PUT(0, 0); CQ_PUT(1, 1);
        CQ_SRC(t_nxt < CQ_END ? t_nxt : 0, s1, l1);
        if (more) { CQ_LOAD(0, 0, s1, l1); CQ_LOAD(1, 1, s1, l1); }
        CQ_PUT(2, 2); CQ_PUT(3, 3);
        __syncthreads();
        { const int t2_ = cur_w1 ? t_cur : t_cur - NM1, e_ = cur_w1 ? t2_ >> 8 : t2_ >> 7, r_ = cur_w1 ? t2_ & 255 : t2_ & 127;
          const int k0 = (cur_w1 ? r_ >> 4 : r_ >> 3) * 128, n0 = (cur_w1 ? r_ & 15 : r_ & 7) * 256;
          if (cur_w1) {
              unsigned char* Bt = p.ws + WS_W1_T + (size_t)e_ * 4096 * 2048;
#pragma unroll 1
              for (int ps = 0; ps < 2; ++ps) { const int id = tid + 512 * ps, n = id >> 2, q = id & 3; const LAS u32x2* tp_ = (const LAS u32x2*)(Tb + n * 264 + q * 64);
                  float v[32];
#pragma unroll
                  for (int i = 0; i < 8; ++i) { const u32x2 w = tp_[i]; v[4 * i] = __uint_as_float(w.x << 16); v[4 * i + 1] = __uint_as_float(w.x & 0xffff0000u); v[4 * i + 2] = __uint_as_float(w.y << 16); v[4 * i + 3] = __uint_as_float(w.y & 0xffff0000u); }
                  u32x4 lo, hi; fp6_block(v, lo, hi);
                  unsigned char* dst = Bt + (size_t)DmW1{}(n0 + n) * 2048 + k0 + 16 * q;
                  __builtin_nontemporal_store(lo, (u32x4*)dst); __builtin_nontemporal_store(hi, (u32x4*)(dst + 64)); }
          } else {
              unsigned char* Bt = p.ws + WS_W2_T + (size_t)e_ * 2048 * 2048;
#pragma unroll
              for (int ps = 0; ps < 4; ++ps) { const int n = ps * 64 + (tid >> 3), c = tid & 7; const LAS unsigned* tp_ = (const LAS unsigned*)(Tb + n * 132 + 16 * c);
                  u32x4 w; w.x = tp_[0]; w.y = tp_[1]; w.z = tp_[2]; w.w = tp_[3];
                  __builtin_nontemporal_store(w, (u32x4*)(Bt + (size_t)(n0 + n) * 2048 + k0 + 16 * c)); }
          } }
        __syncthreads();
        if (!more) break;
        CQ_LOAD(2, 2, s1, l1); CQ_LOAD(3, 3, s1, l1);
        t_cur = t_nxt; t_nxt = CQ_MAP(qs[1 + (it & 1)]);
    }
#undef CQ_PULL
#undef CQ_MAP
#undef CQ_CAN
#undef CQ_SRC
#undef CQ_LOAD
#undef CQ_PUT
    __syncthreads();
}
__device__ __forceinline__ void attn_queues(const P& p, LAS unsigned char* lds, int* ctr) {
    LAS int* qs = (LAS int*)(lds + LDS_FLAG + 64);
    const int tid = threadIdx.x;
    {   if (tid == 0) qs[0] = atomicAdd(ctr, 1);
        __syncthreads();
        int v = qs[0];
        while (v < NB * 8 * 16) {
            __syncthreads();
            if (tid == 0) qs[0] = atomicAdd(ctr, 1);
            const int bh = v & 31, qb = 15 - (v >> 5);
            attn_unit<true>(p, lds, bh >> 3, bh & 7, qb);
            v = qs[0];
        }
        __syncthreads();
    }
    {   if (tid == 0) qs[0] = atomicAdd(ctr + 64, 1);
        __syncthreads();
        int v = qs[0];
        while (v < NB * 8 * 16) {
            __syncthreads();
            if (tid == 0) qs[0] = atomicAdd(ctr + 64, 1);
            const int bh = v & 31, qb = 15 - (v >> 5);
            attn_unit<false>(p, lds, bh >> 3, bh & 7, qb);
            v = qs[0];
        }
        __syncthreads();
    }
}
__device__ __forceinline__ void phase_attn(const P& p, LAS unsigned char* lds, int G, int bid) {
    int* ctr = (int*)(p.ws + WS_CTL + 61440);
    const int cqn = (G == 256) ? CQ_NMT - CQ_DEFER : CQ_NMT;
    if (MOE_FP8 && (bid & 7) < 3) { conv_queue(p, lds, ctr + 128, -1, 0, cqn); attn_queues(p, lds, ctr); }
    else { attn_queues(p, lds, ctr); if (MOE_FP8) conv_queue(p, lds, ctr + 128, -1, 0, cqn); }
}
}

__device__ __forceinline__ void phase_normmod(const P& p, const float* x, const float* g, int shift_idx, int scale_idx, bf16_t* out, int G, int bid) { phase_normmod_r(WSP(float, WS_MOD), x, g, shift_idx, scale_idx, out, G, bid); }
template <class Sched>
__device__ __forceinline__ void moe_tables(const P& p, LAS unsigned char* lds, int G, int bid, bool gather, const float* bias, int bias_ld) {
    LAS int* tp = (LAS int*)(lds + LDS_TP); LAS int* cn = (LAS int*)(lds + LDS_CNT); LAS unsigned short* gidx = (LAS unsigned short*)(lds + LDS_GIDX); LAS float* bl = (LAS float*)(lds + LDS_BIAS);
    const int tid = threadIdx.x;
    if (tid < 32) cn[tid] = WSP(int, WS_CNT)[tid];
    __syncthreads();
    if (tid == 0) { int s = 0; for (int e = 0; e < 32; ++e) { tp[e] = s; s += (cn[e] + 255) >> 8; } tp[32] = s; tp[63] = 0; }
    __syncthreads();
    if (tid < 20) { Sched S; S.init(tp, G, bid); pg::Unit u; tp[40 + tid] = S.next(tid, u) ? u.e : 0; }
    __syncthreads();
    if (tid == 0) tp[63] = 1;
    __syncthreads();
    if (bias) {
        Sched S; S.init(tp, G, bid);
        const int t = tid & 255, i0 = tid >> 8;
        float bv[9]; int rv[9]; bool ok[9];
#pragma unroll
        for (int j = 0; j < 9; ++j) { pg::Unit u; u.e = 0; u.pn = 0; u.pm = 0; ok[j] = S.next(i0 + 2 * j, u);
            const size_t bo = ok[j] ? (size_t)u.e * bias_ld + u.pn * 256 + t : 0;
            bv[j] = bias[bo];
            rv[j] = 0;
            if (gather) { const int e_ = ok[j] ? u.e : 0, r = ok[j] ? (u.pm - tp[e_]) * 256 + t : 0; const bool gk = ok[j] && r < cn[e_];
                const int v = WSP(int, WS_ROWTOK)[gk ? (size_t)e_ * NTOK + r : 0]; rv[j] = gk ? (v >> 2) : 0; } }
#pragma unroll
        for (int j = 0; j < 9; ++j) if (ok[j]) { const int i = i0 + 2 * j; bl[i * 256 + t] = bv[j]; if (gather) gidx[i * 256 + t] = (unsigned short)rv[j]; }
        __syncthreads();
    }
}

__global__ void __launch_bounds__(512, 2) mega(P p, int lo, int hi, int bar_idx) {
    extern __shared__ __attribute__((aligned(16))) unsigned char lds_raw[];
    LAS unsigned char* lds = (LAS unsigned char*)lds_raw;
    const int tid = threadIdx.x, G = gridDim.x, bid = blockIdx.x;
    if (tid < 4) ((LAS unsigned*)(lds + LDS_MISC))[tid] = 0u;
    __syncthreads();
    XcdBarrier bar = xcd_barrier_post((unsigned*)(p.ws + WS_CTL) + bar_idx * XCD_BAR_WORDS, (volatile LAS unsigned*)(lds + LDS_MISC));
#define IN(k) (lo <= (k) && (k) < hi)
#define RUN(k, ...) do { __VA_ARGS__; } while (0)
#define SEAM(k) do { if (IN(k) && IN((k) + 1)) xcd_barrier(bar); } while (0)
    if (IN(0)) RUN(0, phase_prologue(p, lds, G, bid));
    SEAM(0);
    if (IN(1)) RUN(1, { phase_cb(p, lds, bid); phase_normmod(p, p.x, p.g_attn, 0, 1, WSP(bf16_t, WS_H), G, bid); });
    SEAM(1);
    if (IN(2)) RUN(2, {
        const bool ch = (G == 256);
        pg::DenseOrder S1; S1.init(64, 12, G, bid, 8, 4); pg::EpiProjMain E1{p};
        pg::DenseOrder S2; S2.init(4, 64, G, bid); pg::EpiVt<false> E2{p, WS_SBVT};
        pg::KropeOrder S3{G, bid}; pg::EpiKropeP E3{p};
        const bf16_t* A2 = WSP(bf16_t, WS_WIN_T) + (size_t)2048 * 2048;
        const char* b2n = nullptr; unsigned q00 = 0, q01 = 0, q10 = 0, q11 = 0; const char* b3n = nullptr; unsigned k00 = 0, k01 = 0, k10 = 0, k11 = 0;
        if (ch) { pg::first_unit_of(S2, WSP(bf16_t, WS_H), 4096, b2n, q00, q01, q10, q11); pg::first_unit_of(S3, WSP(bf16_t, WS_WIN_T), 4096, b3n, k00, k01, k10, k11); }
        pg::gemm_phase<0>(lds, WSP(bf16_t, WS_H), WSP(bf16_t, WS_WIN_T), 4096, S1, E1, nullptr, 0, false, ch, A2, b2n, q00, q01, q10, q11);
        pg::gemm_phase<0>(lds, A2, WSP(bf16_t, WS_H), 4096, S2, E2, nullptr, 0, ch, ch, WSP(bf16_t, WS_H), b3n, k00, k01, k10, k11);
        pg::gemm_phase<0>(lds, WSP(bf16_t, WS_H), WSP(bf16_t, WS_WIN_T), 4096, S3, E3, nullptr, 8, ch, false);
    });
    SEAM(2);
    if (IN(3)) RUN(3, {
        krope_fixup(WSP(float, WS_G_QRAW), WSP(float2, WS_CS), WSP(bf16_t, WS_KROPE), G, bid);
        const bool ch = (G == 256);
        pg::DenseOrder S1; S1.init(64, 6, G, bid); pg::EpiQ E1{p};
        pg::DenseOrder S2; S2.init(64, 4, G, bid); pg::EpiKnope E2{p};
        pg::DenseOrder S3; S3.init(4, 64, G, bid); pg::EpiVt<true> E3{p, WS_VMT};
        const bf16_t* A3 = WSP(bf16_t, WS_WKV_T) + (size_t)1024 * 512;
        const char* b2n = nullptr; unsigned q00 = 0, q01 = 0, q10 = 0, q11 = 0; const char* b3n = nullptr; unsigned k00 = 0, k01 = 0, k10 = 0, k11 = 0;
        if (ch) { pg::first_unit_of(S2, WSP(bf16_t, WS_WKV_T), 1024, b2n, q00, q01, q10, q11); pg::first_unit_of(S3, WSP(bf16_t, WS_KVLAT), 1024, b3n, k00, k01, k10, k11); }
        pg::gemm_phase<0>(lds, WSP(bf16_t, WS_QLAT), WSP(bf16_t, WS_WQ_T), 1024, S1, E1, nullptr, 0, false, ch, WSP(bf16_t, WS_KVLAT), b2n, q00, q01, q10, q11);
        pg::gemm_phase<0>(lds, WSP(bf16_t, WS_KVLAT), WSP(bf16_t, WS_WKV_T), 1024, S2, E2, nullptr, 0, ch, ch, A3, b3n, k00, k01, k10, k11);
        pg::gemm_phase<0>(lds, A3, WSP(bf16_t, WS_KVLAT), 1024, S3, E3, nullptr, 0, ch, false);
        if (MOE_FP8 && G == 256 && bid >= 128) at::conv_queue(p, lds, (int*)(p.ws + WS_CTL + 61440) + 128, 3, 0, at::CQ_NMT - at::CQ_DEFER);
    });
    SEAM(3);
    if (IN(4)) RUN(4, at::phase_attn(p, lds, G, bid));
    SEAM(4);
    if (IN(5)) RUN(5, { pg::DenseOrder S; S.init(64, 8, G, bid); pg::EpiOut E{p};
        pg::gemm_phase<0>(lds, WSP(bf16_t, WS_MIXED), WSP(bf16_t, WS_WOUT_T), 4096, S, E, nullptr); });
    SEAM(5);
    if (IN(6)) { phase_route(p, lds, G, bid);
        if (MOE_FP8 && G == 256) at::conv_queue(p, lds, (int*)(p.ws + WS_CTL + 61440) + 192, 2, at::CQ_NMT - at::CQ_DEFER, at::CQ_DEFER); }
    SEAM(6);
    if (IN(7)) RUN(7, { typedef pg::MoeOrder<16, true> SO; moe_tables<SO>(p, lds, G, bid, true, p.b1, 4096);
        SO S; S.init((const LAS int*)(lds + LDS_TP), G, bid); pg::EpiMoe1 E{p, WS_ACT, (const LAS float*)(lds + LDS_BIAS)};
        pg::gemm_phase<MOE1_FP6 ? 2 : 1>(lds, p.ws + WS_H2, p.ws + WS_W1_T, 2048, S, E, (const LAS int*)(lds + LDS_GIDX)); });
    SEAM(7);
    if (IN(8)) RUN(8, { typedef pg::MoeOrder<8, false> SO; moe_tables<SO>(p, lds, G, bid, false, p.b2, 2048);
        SO S; S.init((const LAS int*)(lds + LDS_TP), G, bid); pg::EpiMoe2 E{p, (const LAS float*)(lds + LDS_BIAS)};
        pg::gemm_phase<1>(lds, p.ws + WS_ACT, p.ws + WS_W2_T, 2048, S, E, nullptr); });
    SEAM(8);
    if (IN(9)) RUN(9, { moe_tables<pg::MoeOrder<8, false> >(p, lds, G, bid, false, nullptr, 0); phase_final(p, lds, G, bid); });
#undef IN
#undef SEAM
}

extern "C" void kernel_launch(void* const* d_in, const int* in_sizes, int n_in, void* d_out, int out_size, void* d_ws, size_t ws_size, hipStream_t stream) {
    if (n_in != 20 || out_size != NTOK * D || ws_size < WS_END2) { fprintf(stderr, "kernel_launch: unexpected shapes (n_in %d out %d ws %zu need %zu)\n", n_in, out_size, ws_size, (size_t)WS_END2); return; }
    P p{};
    p.x = (const float*)d_in[0]; p.c = (const float*)d_in[1]; p.pos = (const int*)d_in[2]; p.g_attn = (const float*)d_in[3]; p.w_mod = (const float*)d_in[4]; p.b_mod = (const float*)d_in[5];
    p.w_in = (const float*)d_in[6]; p.g_q = (const float*)d_in[7]; p.w_q_up = (const float*)d_in[8]; p.g_kv = (const float*)d_in[9]; p.w_kv_up = (const float*)d_in[10]; p.w_out = (const float*)d_in[11];
    p.g_ffn = (const float*)d_in[12]; p.w_router = (const float*)d_in[13]; p.b_router = (const float*)d_in[14]; p.w1 = (const float*)d_in[15]; p.b1 = (const float*)d_in[16]; p.w2 = (const float*)d_in[17];
    p.b2 = (const float*)d_in[18]; p.g_final = (const float*)d_in[19]; p.out = (float*)d_out; p.ws = (unsigned char*)d_ws;
    static int grid = 0;
    if (grid == 0) {
        int dev = 0, cus = 0, per_cu = 0;
        if (hipGetDevice(&dev) != hipSuccess || hipDeviceGetAttribute(&cus, hipDeviceAttributeMultiprocessorCount, dev) != hipSuccess || cus <= 0) cus = 256;
        if (hipFuncSetAttribute((const void*)mega, hipFuncAttributeMaxDynamicSharedMemorySize, LDS_BYTES) != hipSuccess) fprintf(stderr, "kernel_launch: hipFuncSetAttribute failed\n");
        if (hipOccupancyMaxActiveBlocksPerMultiprocessor(&per_cu, (const void*)mega, 512, LDS_BYTES) != hipSuccess || per_cu < 1) fprintf(stderr, "kernel_launch: occupancy query says %d\n", per_cu);
        (void)hipGetLastError();
        grid = cus;
    }
    (void)hipMemsetAsync((char*)d_ws + WS_CTL, 0, 65536, stream);
    mega<<<grid, 512, LDS_BYTES, stream>>>(p, 0, 10, 0);
}
```

```cpp
#include <hip/hip_runtime.h>
#include <stdint.h>
#include <stdio.h>

constexpr int D = 2048, NB = 4, SEQ = 4096, NTOK = NB * SEQ;
constexpr int SBH = 8, DH = 128, SBW = SBH * DH;
constexpr int MH = 8, NOPE = 128, ROPE = 64, VD = 128, QKD = 192, QR = 512, KVR = 512;
constexpr int INW = 3 * SBW + QR + KVR + ROPE;
constexpr int NE = 32, TOPK = 4, DE = 2048;
constexpr int NMOD = 6;
constexpr float EPS = 1e-6f;
constexpr int MAXSLOT = NTOK * TOPK + NE * 256;

typedef unsigned short bf16_t;
typedef float f32x2_t __attribute__((ext_vector_type(2)));
typedef __bf16 bf16x2_t __attribute__((ext_vector_type(2)));

__device__ __forceinline__ float bf2f(bf16_t v) { return __uint_as_float(((unsigned)v) << 16); }
__device__ __forceinline__ unsigned pk2(float a, float b) { f32x2_t v = {a, b}; bf16x2_t r = __builtin_convertvector(v, bf16x2_t); return __builtin_bit_cast(unsigned, r); }
__device__ __forceinline__ bf16_t f2bf(float a) { return (bf16_t)(pk2(a, 0.f) & 0xffffu); }

constexpr size_t al256(size_t x) { return (x + 255) & ~(size_t)255; }
constexpr size_t WS_CTL   = 0;
constexpr size_t WS_MOD   = 65536;
constexpr size_t WS_CS    = WS_MOD + al256((size_t)NB * NMOD * D * 4);
constexpr size_t WS_H     = WS_CS + (size_t)NTOK * 32 * 8;
constexpr size_t WS_SBQ   = WS_H + (size_t)NTOK * D * 2;
constexpr size_t WS_SBK   = WS_SBQ + (size_t)NTOK * SBW * 2;
constexpr size_t WS_SBVT  = WS_SBK + (size_t)NTOK * SBW * 2;
constexpr size_t WS_QLAT  = WS_SBVT + (size_t)NTOK * SBW * 2;
constexpr size_t WS_KVLAT = WS_QLAT + (size_t)NTOK * QR * 2;
constexpr size_t WS_SSQP  = WS_KVLAT + (size_t)NTOK * KVR * 2;
constexpr size_t WS_KROPE = WS_SSQP + (size_t)NTOK * 16 * 4;
constexpr size_t WS_QMLA  = WS_KROPE + (size_t)NTOK * 64 * 2;
constexpr size_t WS_KNOPE = WS_QMLA + (size_t)NTOK * 1536 * 2;
constexpr size_t WS_VMT   = WS_KNOPE + (size_t)NTOK * 1024 * 2;
constexpr size_t WS_MIXED = WS_VMT + (size_t)NTOK * 1024 * 2;
constexpr size_t WS_X1    = WS_MIXED + (size_t)NTOK * D * 2;
constexpr size_t WS_H2    = WS_X1 + (size_t)NTOK * D * 4;
constexpr size_t WS_TOPE  = WS_H2 + (size_t)NTOK * D * 2;
constexpr size_t WS_TOPW  = WS_TOPE + (size_t)NTOK * 4 * 4;
constexpr size_t WS_TPOS  = WS_TOPW + (size_t)NTOK * 4 * 4;
constexpr size_t WS_CNT   = WS_CTL + 62464;
constexpr size_t WS_ROWTOK= WS_TPOS + (size_t)NTOK * 4 * 4;
constexpr size_t WS_ACT   = WS_ROWTOK + (size_t)NE * NTOK * 4;
constexpr size_t WS_Y     = WS_ACT + (size_t)MAXSLOT * DE * 2;
constexpr size_t WS_GTMP  = WS_Y + (size_t)MAXSLOT * D * 2;
constexpr size_t WS_G_QRAW  = WS_GTMP;
constexpr size_t WS_G_KRRAW = WS_G_QRAW + (size_t)NTOK * 1536 * 4;
constexpr size_t WS_G_SLOTTOK = WS_G_KRRAW + (size_t)NTOK * 64 * 4;
constexpr size_t WS_G_SLOTE   = WS_G_SLOTTOK + (size_t)MAXSLOT * 4;
constexpr size_t WS_END   = WS_G_SLOTE + (size_t)MAXSLOT * 4;

struct P {
    const float *x, *c; const int* pos; const float *g_attn, *w_mod, *b_mod, *w_in, *g_q, *w_q_up, *g_kv, *w_kv_up, *w_out, *g_ffn, *w_router, *b_router, *w1, *b1, *w2, *b2, *g_final;
    float* out; unsigned char* ws;
};
#define WSP(T, off) ((T*)(p.ws + (off)))


#define LAS __attribute__((address_space(3)))
typedef short bf16x8 __attribute__((ext_vector_type(8)));
typedef float f32x4 __attribute__((ext_vector_type(4)));
typedef float f32x16 __attribute__((ext_vector_type(16)));
typedef unsigned u32x4 __attribute__((ext_vector_type(4)));
typedef unsigned u32x2 __attribute__((ext_vector_type(2)));
typedef int i32x8 __attribute__((ext_vector_type(8)));
typedef int i32x4 __attribute__((ext_vector_type(4)));
constexpr bool MOE_FP8 = true;
constexpr float W8_SCALE = 256.f, W8_INV = 1.f / 256.f;
typedef __bf16 bf16x32_t __attribute__((ext_vector_type(32)));
typedef unsigned u32x6 __attribute__((ext_vector_type(6)));
typedef unsigned u32x16 __attribute__((ext_vector_type(16)));
constexpr bool Y_FP8 = true;
constexpr float Y_SCALE = 32.f;
constexpr bool MOE1_FP6 = true;
__device__ __forceinline__ void fp6_block(const float (&v)[32], u32x4& out_lo, u32x4& out_hi) {
    float amax = 0.f;
#pragma unroll
    for (int i = 0; i < 32; ++i) amax = fmaxf(amax, fabsf(v[i]));
    int e = (int)((__float_as_uint(amax) >> 23) & 0xffu) - 127 - 2;
    if (amax * __uint_as_float((unsigned)(127 - e) << 23) > 7.5f) e += 1;
    e = e < -120 ? -120 : e;
    const float inv = __uint_as_float((unsigned)(127 - e) << 23);
    u32x16 w;
#pragma unroll
    for (int i = 0; i < 16; ++i) w[i] = pk2(v[2 * i] * inv, v[2 * i + 1] * inv);
    const u32x6 c = __builtin_amdgcn_cvt_scalef32_pk32_fp6_bf16(__builtin_bit_cast(bf16x32_t, w), 1.0f);
    out_lo.x = c[0]; out_lo.y = c[1]; out_lo.z = c[2]; out_lo.w = c[3];
    out_hi.x = c[4]; out_hi.y = c[5]; out_hi.z = (unsigned)(e + 127); out_hi.w = 0u;
}

__device__ __forceinline__ unsigned pk4_fp8(float a, float b, float c, float d) { int w = 0; w = __builtin_amdgcn_cvt_pk_fp8_f32(a, b, w, false); w = __builtin_amdgcn_cvt_pk_fp8_f32(c, d, w, true); return (unsigned)w; }

constexpr size_t WS_WIN_T  = WS_END;
constexpr size_t WS_WQ_T   = WS_WIN_T + (size_t)4352 * 2048 * 2;
constexpr size_t WS_WKV_T  = WS_WQ_T + (size_t)1536 * 512 * 2;
constexpr size_t WS_WOUT_T = WS_WKV_T + (size_t)2048 * 512 * 2;
constexpr size_t WS_W1_T   = WS_WOUT_T + (size_t)2048 * 2048 * 2;
constexpr size_t WS_W2_T   = WS_W1_T + (size_t)NE * 4096 * 2048 * 2;
constexpr size_t WS_WR_HI  = WS_W2_T + (size_t)NE * 2048 * 2048 * 2;
constexpr size_t WS_WR_LO  = WS_WR_HI + (size_t)32 * 2048 * 2;
constexpr size_t WS_CB     = WS_WR_LO + (size_t)32 * 2048 * 2;
constexpr size_t WS_END2   = WS_CB + 512;

#define XB_TMO      128
#define XB_XCNT(j)  (256  + 64 * (j))
#define XB_XSUB(j)  (1280 + 64 * (j))
#define XB_XGEN(j)  (2304 + 64 * (j))
#define XB_TOP      3328
#define XB_TOPGEN   3392
#define XCD_BAR_WORDS 3456
#define XB_SPIN_CAP (1u << 18)
__device__ __forceinline__ unsigned xb_ld(unsigned* p)              { return __hip_atomic_load(p, __ATOMIC_RELAXED, __HIP_MEMORY_SCOPE_AGENT); }
__device__ __forceinline__ unsigned xb_add(unsigned* p, unsigned v) { return __hip_atomic_fetch_add(p, v, __ATOMIC_RELAXED, __HIP_MEMORY_SCOPE_AGENT); }
__device__ __forceinline__ unsigned xb_xcc_id() { return (unsigned)__builtin_amdgcn_s_getreg((3 << 11) | 20) & 0xFu; }
#define XB_SPIN(cond, bar) do { unsigned _sp = 0; while (cond) { __builtin_amdgcn_s_sleep(1); \
    if ((++_sp & 255u) == 0u) { if (xb_ld(&(bar)[XB_TMO])) break; if (_sp > XB_SPIN_CAP) { atomicAdd(&(bar)[XB_TMO], 1u); break; } } } } while (0)
struct XcdBarrier { unsigned* bar; unsigned x; volatile LAS unsigned* st; };
__device__ __forceinline__ XcdBarrier xcd_barrier_post(unsigned* bar, volatile LAS unsigned* st) {
    XcdBarrier b; b.bar = bar; b.x = xb_xcc_id(); b.st = st;
    if (threadIdx.x == 0) (void)xb_add(&bar[XB_XCNT(b.x)], 1u);
    return b;
}
__device__ __forceinline__ void xcd_barrier_complete(unsigned* bar, unsigned x, unsigned& nloc, unsigned& nx) {
    const unsigned G = gridDim.x * gridDim.y * gridDim.z;
    unsigned sum, cnt, mine, sp = 0u;
    for (;;) {
        sum = 0u; cnt = 0u; mine = 0u;
#pragma unroll
        for (unsigned j = 0; j < 16; ++j) { const unsigned c = xb_ld(&bar[XB_XCNT(j)]); sum += c; cnt += (c > 0u) ? 1u : 0u; mine = (j == x) ? c : mine; }
        if (sum == G) break;
        __builtin_amdgcn_s_sleep(1);
        if ((++sp & 255u) == 0u) { if (xb_ld(&bar[XB_TMO])) break; if (sp > XB_SPIN_CAP) { atomicAdd(&bar[XB_TMO], 1u); break; } }
    }
    nloc = mine > 0u ? mine : 1u; nx = cnt > 0u ? cnt : 1u;
}
__device__ __forceinline__ void xcd_barrier(const XcdBarrier& b) {
    asm volatile("s_waitcnt vmcnt(0)" ::: "memory");
    __syncthreads();
    if (threadIdx.x == 0) {
        unsigned* bar = b.bar;
        __builtin_amdgcn_s_waitcnt(0);
        unsigned nloc = b.st[0], nx = b.st[1];
        if (nloc == 0u) { xcd_barrier_complete(bar, b.x, nloc, nx); b.st[0] = nloc; b.st[1] = nx; }
        const unsigned old = xb_add(&bar[XB_XSUB(b.x)], 1u);
        const unsigned gen = old / nloc;
        if (old + 1u == (gen + 1u) * nloc) {
            __builtin_amdgcn_fence(__ATOMIC_RELEASE, "agent");
            asm volatile("s_waitcnt vmcnt(0)" ::: "memory");
            const unsigned og = xb_add(&bar[XB_TOP], 1u);
            const unsigned tg = og / nx;
            if (og + 1u == (tg + 1u) * nx) xb_add(&bar[XB_TOPGEN], 1u);
            else XB_SPIN(xb_ld(&bar[XB_TOPGEN]) == tg, bar);
            __builtin_amdgcn_fence(__ATOMIC_ACQUIRE, "agent");
            xb_add(&bar[XB_XGEN(b.x)], 1u);
            asm volatile("s_waitcnt vmcnt(0)" ::: "memory");
        } else {
            XB_SPIN(xb_ld(&bar[XB_XGEN(b.x)]) == gen, bar);
            __builtin_amdgcn_fence(__ATOMIC_ACQUIRE, "agent");
            asm volatile("s_waitcnt vmcnt(0)" ::: "memory");
        }
    }
    __syncthreads();
}

constexpr int LDS_STAGE = 0;
constexpr int LDS_GIDX  = 131072;
constexpr int LDS_BIAS  = LDS_GIDX + 9216;
constexpr int LDS_TP    = LDS_BIAS + 18432;
constexpr int LDS_CNT   = LDS_TP + 256;
constexpr int LDS_MISC  = LDS_CNT + 128;
constexpr int LDS_BYTES = LDS_MISC + 128;

namespace pg {
constexpr int BM = 256, BK = 64, HALF = 128, HTB = HALF * BK * 2, STAGE_BYTES = 8 * HTB, NXCD = 8, WGM = 8;
__device__ __forceinline__ int lds_byte(int r, int c) { const int st = (r >> 4) * 2 + (c >> 5), rr = r & 15, cc = c & 31, ob = rr * 64 + cc * 2; return st * 1024 + (ob ^ (((ob >> 9) & 1) << 5)); }
__device__ __forceinline__ void stage_rc(int b, int& R, int& C) { const int st = b / 1024, sb = b % 1024, swz = sb ^ (((sb >> 9) & 1) << 5); R = (st >> 1) * 16 + swz / 64; C = (st & 1) * 32 + (swz % 64) / 2; }
__device__ __forceinline__ int perm32(int rho) { const int n = rho >> 4, i = rho & 15; return 8 * (i >> 2) + 4 * n + (i & 3); }

struct Unit { int pm, pn, pb, e, ko, ui; };
struct DenseOrder {
    int nM, nN, nwg, G, c, skip_from, skip_by;
    __device__ void init(int nM_, int nN_, int G_, int c_, int sf = 1 << 30, int sb = 0) { nM = nM_; nN = nN_; nwg = nM * nN; G = G_; c = c_; skip_from = sf; skip_by = sb; }
    __device__ bool next(int i, Unit& u) const {
        const long L = (long)i * G + c; if (L >= nwg) return false;
        int wgid = (int)L; { const int q = nwg / NXCD, r = nwg % NXCD, xcd = wgid % NXCD, off = wgid / NXCD; wgid = (xcd < r ? xcd * (q + 1) : r * (q + 1) + (xcd - r) * q) + off; }
        const int nig = WGM * nN, gid = wgid / nig, fm = gid * WGM, gsz = (nM - fm) < WGM ? (nM - fm) : WGM;
        u.pm = fm + ((wgid % nig) % gsz); u.pn = (wgid % nig) / gsz; u.pb = u.pn >= skip_from ? u.pn + skip_by : u.pn; u.e = 0; u.ko = 0; u.ui = i; return true;
    }
    __device__ __forceinline__ unsigned arow(const Unit& u, int h, int R, int, const LAS int*) const { return (unsigned)(u.pm * 256 + h * 128 + R); }
};

template <int FPM  , class Epi, class Sched>
__device__ __forceinline__ void gemm_phase(LAS unsigned char* lds, const void* A, const void* Bt, const int RB  , const Sched& S, const Epi& E, const LAS int* gidx, const int nt_ = 0  ,
        const bool primed = false  , const bool chain = false  ,
        const void* cA = nullptr, const char* cBn = nullptr, const unsigned c00 = 0, const unsigned c01 = 0, const unsigned c10 = 0, const unsigned c11 = 0) {
    constexpr bool FP8 = FPM != 0;
    const int tid = threadIdx.x, wid = __builtin_amdgcn_readfirstlane(tid >> 6), lane = tid & 63, wr = wid >> 2, wc = wid & 3, fr = lane & 15, fq = lane >> 4;
    const int nt = nt_ ? nt_ : RB / (BK * 2);
    unsigned voffB[2];
#pragma unroll
    for (int i = 0; i < 2; ++i) { int R_, C_; stage_rc(tid * 16 + i * 8192, R_, C_); const int Rb = Epi::PERM ? ((R_ & ~31) + perm32(R_ & 31)) : R_; voffB[i] = (unsigned)(Rb * RB + C_ * 2); }
    const size_t kstep = (size_t)(BK * 2);
    const size_t hstep = (size_t)HALF * RB;
    const size_t tstep = 2 * hstep;
    const unsigned ldsw = (unsigned)wid * 1024u;
    const unsigned lds0 = __builtin_amdgcn_readfirstlane((unsigned)(size_t)lds + ldsw);
    const int aoff = lds_byte(wr * 64 + fr, fq * 8), boff = lds_byte(wc * 32 + fr, fq * 8);
#define PG_SA(b, h) (((b) * 2 + (h)) * HTB)
#define PG_SB(b, h) ((4 + (b) * 2 + (h)) * HTB)
#define PG_DMA(voff_, sbase_, ldsoff_) asm volatile("s_mov_b32 m0, %2\n\ts_nop 0\n\tglobal_load_lds_dwordx4 %0, %1" :: "v"(voff_), "s"(sbase_), "s"(ldsoff_) : "memory", "m0")
#define PG_STAGE_B(bufoff, gbase) do { const char* _sb = (const char*)(gbase); _Pragma("unroll") for (int _i = 0; _i < 2; ++_i) \
        PG_DMA(voffB[_i], _sb, lds0 + (unsigned)((bufoff) + _i * 8192)); } while (0)
#define PG_STAGE_A(bufoff, usenext, h, kb) do { const char* _sa = Ab + (size_t)(kb); _Pragma("unroll") for (int _i = 0; _i < 2; ++_i) { const unsigned _o = rac[h][_i]; \
        PG_DMA(_o, _sa, lds0 + (unsigned)((bufoff) + _i * 8192)); } } while (0)
#define PG_LDA(dst, b, h) do { _Pragma("unroll") for (int m = 0; m < 4; ++m) { if constexpr (FP8) { const i32x4 lo_ = *(const LAS i32x4*)(lds + PG_SA(b, h) + aoff + m * 2048), hi_ = *(const LAS i32x4*)(lds + PG_SA(b, h) + aoff + m * 2048 + 1024); dst##8[m] = __builtin_shufflevector(lo_, hi_, 0, 1, 2, 3, 4, 5, 6, 7); } \
        else { _Pragma("unroll") for (int k = 0; k < 2; ++k) dst[m][k] = *(const LAS bf16x8*)(lds + PG_SA(b, h) + aoff + m * 2048 + k * 1024); } } } while (0)
#define PG_LDB(dst, b, h) do { _Pragma("unroll") for (int n = 0; n < 2; ++n) { if constexpr (FP8) { const i32x4 lo_ = *(const LAS i32x4*)(lds + PG_SB(b, h) + boff + n * 2048), hi_ = *(const LAS i32x4*)(lds + PG_SB(b, h) + boff + n * 2048 + 1024); dst##8[n] = __builtin_shufflevector(lo_, hi_, 0, 1, 2, 3, 4, 5, 6, 7); } \
        else { _Pragma("unroll") for (int k = 0; k < 2; ++k) dst[n][k] = *(const LAS bf16x8*)(lds + PG_SB(b, h) + boff + n * 2048 + k * 1024); } } } while (0)
#define PG_MMA(ai, bj, At, Bt_) do { __builtin_amdgcn_s_setprio(1); _Pragma("unroll") for (int m = 0; m < 4; ++m) _Pragma("unroll") for (int n = 0; n < 2; ++n) { \
        if constexpr (FPM == 2) { acc[ai][bj][m][n] = __builtin_amdgcn_mfma_scale_f32_16x16x128_f8f6f4(Bt_##8[n], At##8[m], acc[ai][bj][m][n], 2, 2, 0, Bt_##8[n][6], 0, At##8[m][6]); } \
        else if constexpr (FPM == 1) { acc[ai][bj][m][n] = __builtin_amdgcn_mfma_scale_f32_16x16x128_f8f6f4(Bt_##8[n], At##8[m], acc[ai][bj][m][n], 0, 0, 0, 0x7F7F7F7F, 0, 0x7F7F7F7F); } \
        else { _Pragma("unroll") for (int k = 0; k < 2; ++k) acc[ai][bj][m][n] = __builtin_amdgcn_mfma_f32_16x16x32_bf16(Bt_[n][k], At[m][k], acc[ai][bj][m][n], 0, 0, 0); } } \
        __builtin_amdgcn_s_setprio(0); } while (0)
#define PG_WAIT_V(n) asm volatile("s_waitcnt vmcnt(" #n ")" ::: "memory")
#define PG_WAIT_L(n) asm volatile("s_waitcnt lgkmcnt(" #n ")" ::: "memory")
#define PG_WAIT_VN(n) asm volatile("s_waitcnt vmcnt(%0)" :: "n"(n) : "memory")
#define PG_KPAIR(t, WV_) do { \
            const bool last = (t == nt - 2); \
            const size_t kb1 = (size_t)(t + 1) * kstep; \
            const size_t kb2 = last ? 0 : (size_t)(t + 2) * kstep, kb3 = kb2 + kstep; \
            const char* b2 = last ? nB : cB + (size_t)(t + 2) * kstep; const char* b3 = b2 + kstep; \
            PG_LDB(B0, 0, 0); PG_LDB(B1, 0, 1); PG_SCHED; PG_LDA(At, 0, 0); PG_STAGE_A(PG_SA(1, 1), false, 1, kb1); \
            if (last) { if (has_next) { PG_RA(rac, nxt, ui + 1); } else if (chain) { rac[0][0] = c00; rac[0][1] = c01; rac[1][0] = c10; rac[1][1] = c11; Ab = (const char*)cA; } } \
            PG_WAIT_VN(WV_); PG_WAIT_L(0); PG_BAR; PG_MMA(0, 0, At, B0); PG_MMA(0, 1, At, B1); PG_BAR; PG_SCHED; \
            PG_LDA(At, 0, 1); PG_STAGE_B(PG_SB(0, 0), b2); PG_STAGE_B(PG_SB(0, 1), b2 + hstep); PG_STAGE_A(PG_SA(0, 0), last, 0, kb2); \
            PG_WAIT_VN(WV_); PG_WAIT_L(0); PG_BAR; PG_MMA(1, 0, At, B0); PG_MMA(1, 1, At, B1); PG_BAR; PG_SCHED; \
            PG_LDB(B0, 1, 0); PG_LDB(B1, 1, 1); PG_SCHED; PG_LDA(At, 1, 0); PG_STAGE_A(PG_SA(0, 1), last, 1, kb2); \
            PG_WAIT_V(8); PG_WAIT_L(0); PG_BAR; PG_MMA(0, 0, At, B0); PG_MMA(0, 1, At, B1); PG_BAR; PG_SCHED; \
            PG_LDA(At, 1, 1); PG_STAGE_B(PG_SB(1, 0), b3); PG_STAGE_B(PG_SB(1, 1), b3 + hstep); PG_STAGE_A(PG_SA(1, 0), last, 0, kb3); \
            PG_WAIT_V(8); PG_WAIT_L(0); PG_BAR; PG_MMA(1, 0, At, B0); PG_MMA(1, 1, At, B1); PG_BAR; PG_SCHED; \
        } while (0)
#define PG_BAR __builtin_amdgcn_s_barrier()
#define PG_SCHED __builtin_amdgcn_sched_barrier(0)
#define PG_RA(dst, u, ui_) do { _Pragma("unroll") for (int _i = 0; _i < 2; ++_i) { int R_, C_; stage_rc(tid * 16 + _i * 8192, R_, C_); _Pragma("unroll") for (int _h = 0; _h < 2; ++_h) dst[_h][_i] = S.arow(u, _h, R_, ui_, gidx) * (unsigned)RB + (unsigned)C_ * 2u + (unsigned)u.ko; } } while (0)
    Unit cur, nxt; int ui = 0;
    if (!S.next(0, cur)) return;
    f32x4 acc[2][2][4][2];
#pragma unroll
    for (int a = 0; a < 2; ++a)
#pragma unroll
        for (int b = 0; b < 2; ++b)
#pragma unroll
            for (int m = 0; m < 4; ++m)
#pragma unroll
                for (int n = 0; n < 2; ++n) acc[a][b][m][n] = (f32x4){0.f, 0.f, 0.f, 0.f};
    bf16x8 At[4][2], B0[2][2], B1[2][2]; i32x8 At8[4], B08[2], B18[2];
    unsigned rac[2][2];
    PG_RA(rac, cur, 0);
    const char* Ab = (const char*)A;
    const char* cB = (const char*)Bt + (size_t)cur.pb * tstep + cur.ko;
    if (!primed) {
    PG_STAGE_B(PG_SB(0, 0), cB); PG_STAGE_B(PG_SB(0, 1), cB + hstep); PG_STAGE_A(PG_SA(0, 0), false, 0, 0); PG_STAGE_A(PG_SA(0, 1), false, 1, 0);
    if (wr == 1) PG_BAR;
    PG_WAIT_V(2); PG_BAR;
    PG_STAGE_B(PG_SB(1, 0), cB + kstep); PG_STAGE_A(PG_SA(1, 0), false, 0, kstep); PG_STAGE_B(PG_SB(1, 1), cB + hstep + kstep);
    PG_WAIT_V(6); PG_BAR;
    }
    for (;;) {
        const bool has_next = S.next(ui + 1, nxt);
        const char* nB = has_next ? (const char*)Bt + (size_t)nxt.pb * tstep + nxt.ko : (chain ? cBn : cB);
        int t0 = 0;
        if (Epi::NST > 0 && ui > 0) { PG_KPAIR(0, 8 + Epi::NST); t0 = 2; }
        for (int t = t0; t < nt; t += 2) PG_KPAIR(t, 8);
        E(acc, cur, wr, wc, fr, fq);
        if (!has_next) break;
#pragma unroll
        for (int a = 0; a < 2; ++a)
#pragma unroll
            for (int b = 0; b < 2; ++b)
#pragma unroll
                for (int m = 0; m < 4; ++m)
#pragma unroll
                    for (int n = 0; n < 2; ++n) acc[a][b][m][n] = (f32x4){0.f, 0.f, 0.f, 0.f};
        cur = nxt; cB = nB; ++ui;
    }
    if (!chain) {
    PG_WAIT_V(0);
    if (wr == 0) PG_BAR;
    PG_BAR;
    }
#undef PG_SA
#undef PG_SB
#undef PG_STAGE_A
#undef PG_STAGE_B
#undef PG_DMA
#undef PG_LDA
#undef PG_LDB
#undef PG_MMA
#undef PG_WAIT_V
#undef PG_WAIT_L
#undef PG_WAIT_VN
#undef PG_KPAIR
#undef PG_BAR
#undef PG_SCHED
#undef PG_RA
}

template <class Sched>
__device__ __forceinline__ void first_unit_of(const Sched& S, const void* Bt, const int RB, const char*& cB, unsigned& r00, unsigned& r01, unsigned& r10, unsigned& r11) {
    Unit u; u.pm = 0; u.pn = 0; u.pb = 0; u.e = 0; u.ko = 0; u.ui = 0; S.next(0, u);
    const int tid = threadIdx.x; int R0, C0, R1, C1; stage_rc(tid * 16, R0, C0); stage_rc(tid * 16 + 8192, R1, C1);
    r00 = S.arow(u, 0, R0, 0, nullptr) * (unsigned)RB + (unsigned)C0 * 2u + (unsigned)u.ko; r01 = S.arow(u, 0, R1, 0, nullptr) * (unsigned)RB + (unsigned)C1 * 2u + (unsigned)u.ko;
    r10 = S.arow(u, 1, R0, 0, nullptr) * (unsigned)RB + (unsigned)C0 * 2u + (unsigned)u.ko; r11 = S.arow(u, 1, R1, 0, nullptr) * (unsigned)RB + (unsigned)C1 * 2u + (unsigned)u.ko;
    cB = (const char*)Bt + (size_t)u.pb * (2 * (size_t)HALF * RB) + u.ko;
}
__device__ __forceinline__ u32x4 pack8(const f32x4 a, const f32x4 b, float s) { u32x4 w; w.x = pk2(a[0] * s, a[1] * s); w.y = pk2(a[2] * s, a[3] * s); w.z = pk2(b[0] * s, b[1] * s); w.w = pk2(b[2] * s, b[3] * s); return w; }
typedef f32x4 Acc[2][2][4][2];

__device__ __forceinline__ float rstd_from(const float* ssq8) { const f32x4 a0 = *(const f32x4*)ssq8, a1 = *(const f32x4*)(ssq8 + 4);
    return 1.0f / sqrtf(((a0[0] + a0[1]) + (a0[2] + a0[3]) + (a1[0] + a1[1]) + (a1[2] + a1[3])) * (1.f / 512.f) + EPS); }
struct EpiProjMain {
    static constexpr bool PERM = true; static constexpr int NST = 0; P p;
    __device__ __forceinline__ void operator()(const Acc& acc, const Unit& u, int wr, int wc, int fr, int fq) const {
        const int row0 = u.pm * 256 + wr * 64 + fr;
        if (u.pn < 8) {
            bf16_t* base = WSP(bf16_t, u.pn < 4 ? WS_SBQ : WS_SBK); const float sc = u.pn < 4 ? 0.08838834764831845f * 1.4426950408889634f : 1.f;    const int col0 = (u.pn & 3) * 256 + wc * 32 + 8 * fq;
#pragma unroll
            for (int ai = 0; ai < 2; ++ai)
#pragma unroll
                for (int m = 0; m < 4; ++m) { bf16_t* rp = base + (size_t)(row0 + ai * 128 + m * 16) * 1024 + col0;
#pragma unroll
                    for (int bj = 0; bj < 2; ++bj) *(u32x4*)(rp + bj * 128) = pack8(acc[ai][bj][m][0], acc[ai][bj][m][1], sc); }
        } else {
            const int lat = (u.pn - 8) >> 1, ct = (u.pn - 8) & 1; bf16_t* base = WSP(bf16_t, lat ? WS_KVLAT : WS_QLAT); const int col0 = ct * 256 + wc * 32 + 8 * fq;
            float* ssqp = WSP(float, WS_SSQP);
#pragma unroll
            for (int ai = 0; ai < 2; ++ai)
#pragma unroll
                for (int m = 0; m < 4; ++m) { const int row = row0 + ai * 128 + m * 16; bf16_t* rp = base + (size_t)row * 512 + col0; float s = 0.f;
#pragma unroll
                    for (int bj = 0; bj < 2; ++bj) { *(u32x4*)(rp + bj * 128) = pack8(acc[ai][bj][m][0], acc[ai][bj][m][1], 1.f);
#pragma unroll
                        for (int n = 0; n < 2; ++n) { const f32x4 v = acc[ai][bj][m][n]; s += (v[0] * v[0] + v[1] * v[1]) + (v[2] * v[2] + v[3] * v[3]); } }
                    s += __shfl_xor(s, 16); s += __shfl_xor(s, 32);
                    if (fq == 0) ssqp[(size_t)row * 16 + lat * 8 + ct * 4 + wc] = s; }
        }
    }
};
template <bool SCALE>
__device__ __forceinline__ void epi_vt_r(const Acc& acc, const float* __restrict__ ssqp, bf16_t* __restrict__ dst, int f0, int tokb) {
#pragma unroll
    for (int bj = 0; bj < 2; ++bj) {
        const int tok0 = tokb + bj * 128, b = tok0 / SEQ, s0 = tok0 % SEQ;
        float sc[8];
#pragma unroll
        for (int j = 0; j < 8; ++j) sc[j] = SCALE ? rstd_from(ssqp + (size_t)(tok0 + j) * 16 + 8) : 1.f;
#pragma unroll
        for (int ai = 0; ai < 2; ++ai)
#pragma unroll
            for (int m = 0; m < 4; ++m) { const int f = f0 + ai * 128 + m * 16, h = f >> 7, d = f & 127;
                const f32x4 v0 = acc[ai][bj][m][0], v1 = acc[ai][bj][m][1]; u32x4 w;
                w.x = pk2(v0[0] * sc[0], v0[1] * sc[1]); w.y = pk2(v0[2] * sc[2], v0[3] * sc[3]); w.z = pk2(v1[0] * sc[4], v1[1] * sc[5]); w.w = pk2(v1[2] * sc[6], v1[3] * sc[7]);
                *(u32x4*)(dst + ((size_t)(b * 8 + h) * 128 + d) * SEQ + s0) = w; }
    }
}
template <bool SCALE> struct EpiVt {
    static constexpr bool PERM = true; static constexpr int NST = 0; P p; size_t dst_off;
    __device__ __forceinline__ void operator()(const Acc& acc, const Unit& u, int wr, int wc, int fr, int fq) const {
        epi_vt_r<SCALE>(acc, WSP(float, WS_SSQP), WSP(bf16_t, dst_off), u.pm * 256 + wr * 64 + fr, u.pn * 256 + wc * 32 + 8 * fq);
    }
};
__device__ __forceinline__ void epi_krope_r(const Acc& acc, const float2* __restrict__ cs, bf16_t* __restrict__ dst, int row0, int col0) {
#pragma unroll
    for (int ai = 0; ai < 2; ++ai) {
        f32x4 cv[4][2];
#pragma unroll
        for (int m = 0; m < 4; ++m) { const float2* cr = cs + (size_t)(row0 + ai * 128 + m * 16) * 32 + (col0 >> 1); cv[m][0] = *(const f32x4*)cr; cv[m][1] = *(const f32x4*)(cr + 2); }
        asm volatile("" ::: "memory");
#pragma unroll
        for (int m = 0; m < 4; ++m) { const int row = row0 + ai * 128 + m * 16; const f32x4 v0 = acc[ai][0][m][0], v1 = acc[ai][0][m][1], c0 = cv[m][0], c1 = cv[m][1];
            u32x4 w; w.x = pk2(v0[0] * c0[0] - v0[1] * c0[1], v0[1] * c0[0] + v0[0] * c0[1]); w.y = pk2(v0[2] * c0[2] - v0[3] * c0[3], v0[3] * c0[2] + v0[2] * c0[3]);
            w.z = pk2(v1[0] * c1[0] - v1[1] * c1[1], v1[1] * c1[0] + v1[0] * c1[1]); w.w = pk2(v1[2] * c1[2] - v1[3] * c1[3], v1[3] * c1[2] + v1[2] * c1[3]);
            *(u32x4*)(dst + (size_t)row * 64 + col0) = w; }
        asm volatile("" ::: "memory");
    }
}
struct EpiKrope {
    static constexpr bool PERM = true; static constexpr int NST = 0; P p;
    __device__ __forceinline__ void operator()(const Acc& acc, const Unit& u, int wr, int wc, int fr, int fq) const {
        if (wc >= 2) return;
        epi_krope_r(acc, WSP(float2, WS_CS), WSP(bf16_t, WS_KROPE), u.pm * 256 + wr * 64 + fr, wc * 32 + 8 * fq);
    }
};

__device__ __forceinline__ void epi_q_r(const Acc& acc, const float* __restrict__ ssqp, const float2* __restrict__ cs, bf16_t* __restrict__ dst, int row0, int cbase) {
    const int j0 = cbase % 192, j1 = (cbase + 128) % 192; const bool rp0 = j0 >= 128, rp1 = j1 >= 128; const int i00 = rp0 ? (j0 - 128) >> 1 : 0, i01 = rp1 ? (j1 - 128) >> 1 : 0;
#pragma unroll
    for (int qq = 0; qq < 4; ++qq) {
        f32x4 ca0[2], ca1[2], cb0[2], cb1[2]; float rsv[2];
#pragma unroll
        for (int h = 0; h < 2; ++h) { const int q = 2 * qq + h, ai = q >> 2, m = q & 3, row = row0 + ai * 128 + m * 16; const float2* cr = cs + (size_t)row * 32;
            ca0[h] = *(const f32x4*)(cr + i00); ca1[h] = *(const f32x4*)(cr + i00 + 2); cb0[h] = *(const f32x4*)(cr + i01); cb1[h] = *(const f32x4*)(cr + i01 + 2);
            rsv[h] = rstd_from(ssqp + (size_t)row * 16) * (0.07216878364870322f * 1.4426950408889634f); }
        asm volatile("" ::: "memory");
#pragma unroll
        for (int h = 0; h < 2; ++h) { const int q = 2 * qq + h, ai = q >> 2, m = q & 3, row = row0 + ai * 128 + m * 16;
#pragma unroll
            for (int bj = 0; bj < 2; ++bj) { const bool rp = bj ? rp1 : rp0;
                f32x4 v0 = acc[ai][bj][m][0] * rsv[h], v1 = acc[ai][bj][m][1] * rsv[h];
                if (rp) { const f32x4 c0v = bj ? cb0[h] : ca0[h], c1v = bj ? cb1[h] : ca1[h], t0 = v0, t1 = v1;
                    v0[0] = t0[0] * c0v[0] - t0[1] * c0v[1]; v0[1] = t0[1] * c0v[0] + t0[0] * c0v[1]; v0[2] = t0[2] * c0v[2] - t0[3] * c0v[3]; v0[3] = t0[3] * c0v[2] + t0[2] * c0v[3];
                    v1[0] = t1[0] * c1v[0] - t1[1] * c1v[1]; v1[1] = t1[1] * c1v[0] + t1[0] * c1v[1]; v1[2] = t1[2] * c1v[2] - t1[3] * c1v[3]; v1[3] = t1[3] * c1v[2] + t1[2] * c1v[3]; }
                *(u32x4*)(dst + (size_t)row * 1536 + cbase + bj * 128) = pack8(v0, v1, 1.f); } }
        asm volatile("" ::: "memory");
    }
}
struct EpiQ {
    static constexpr bool PERM = true; static constexpr int NST = 0; P p;
    __device__ __forceinline__ void operator()(const Acc& acc, const Unit& u, int wr, int wc, int fr, int fq) const {
        epi_q_r(acc, WSP(float, WS_SSQP), WSP(float2, WS_CS), WSP(bf16_t, WS_QMLA), u.pm * 256 + wr * 64 + fr, u.pn * 256 + wc * 32 + 8 * fq);
    }
};
__device__ __forceinline__ void epi_knope_r(const Acc& acc, const float* __restrict__ ssqp, bf16_t* __restrict__ dst, int row0, int c0) {
    float rs[2][4];
#pragma unroll
    for (int ai = 0; ai < 2; ++ai)
#pragma unroll
        for (int m = 0; m < 4; ++m) rs[ai][m] = rstd_from(ssqp + (size_t)(row0 + ai * 128 + m * 16) * 16 + 8);
    asm volatile("" ::: "memory");
#pragma unroll
    for (int ai = 0; ai < 2; ++ai)
#pragma unroll
        for (int m = 0; m < 4; ++m) { const int row = row0 + ai * 128 + m * 16;
#pragma unroll
            for (int bj = 0; bj < 2; ++bj) *(u32x4*)(dst + (size_t)row * 1024 + c0 + bj * 128) = pack8(acc[ai][bj][m][0], acc[ai][bj][m][1], rs[ai][m]); }
}
struct EpiKnope {
    static constexpr bool PERM = true; static constexpr int NST = 0; P p;
    __device__ __forceinline__ void operator()(const Acc& acc, const Unit& u, int wr, int wc, int fr, int fq) const {
        epi_knope_r(acc, WSP(float, WS_SSQP), WSP(bf16_t, WS_KNOPE), u.pm * 256 + wr * 64 + fr, u.pn * 256 + wc * 32 + 8 * fq);
    }
};
__device__ __forceinline__ void epi_out_r(const Acc& acc, const float* __restrict__ xin, const float* __restrict__ g1, bf16_t* __restrict__ x1, int row0, int col0) {
    f32x4 gv[2][2];
#pragma unroll
    for (int bj = 0; bj < 2; ++bj)
#pragma unroll
        for (int n = 0; n < 2; ++n) gv[bj][n] = *(const f32x4*)(g1 + col0 + bj * 128 + n * 4);
#pragma unroll
    for (int ai = 0; ai < 2; ++ai) {
        f32x4 xv[4][2][2];
#pragma unroll
        for (int m = 0; m < 4; ++m)
#pragma unroll
            for (int bj = 0; bj < 2; ++bj)
#pragma unroll
                for (int n = 0; n < 2; ++n) xv[m][bj][n] = *(const f32x4*)(xin + (size_t)(row0 + ai * 128 + m * 16) * D + col0 + bj * 128 + n * 4);
        asm volatile("" ::: "memory");
#pragma unroll
        for (int m = 0; m < 4; ++m)
#pragma unroll
            for (int bj = 0; bj < 2; ++bj)
                *(u32x4*)(x1 + (size_t)(row0 + ai * 128 + m * 16) * D + col0 + bj * 128) = pack8(xv[m][bj][0] + gv[bj][0] * acc[ai][bj][m][0], xv[m][bj][1] + gv[bj][1] * acc[ai][bj][m][1], 1.f);
        asm volatile("" ::: "memory");
    }
}
struct EpiOut {
    static constexpr bool PERM = true; static constexpr int NST = 0; P p;
    __device__ __forceinline__ void operator()(const Acc& acc, const Unit& u, int wr, int wc, int fr, int fq) const {
        const int row0 = u.pm * 256 + wr * 64 + fr, b = (u.pm * 256) / SEQ, col0 = u.pn * 256 + wc * 32 + 8 * fq;
        epi_out_r(acc, p.x, WSP(float, WS_MOD) + (size_t)b * NMOD * D + 2 * D, WSP(bf16_t, WS_X1), row0, col0);
    }
};
struct EpiMoe1 {
    static constexpr bool PERM = true; static constexpr int NST = 8; P p; size_t dst_off; const LAS float* bias_lds;
    __device__ __forceinline__ void operator()(const Acc& acc, const Unit& u, int wr, int wc, int fr, int fq) const {
        const int row0 = u.pm * 256 + wr * 64 + fr, a0 = u.pn * 128 + wc * 32 + 8 * fq; const LAS float* b1 = bias_lds + (u.ui < 18 ? u.ui : 0) * 256 + 2 * (wc * 32 + 8 * fq); bf16_t* dst = WSP(bf16_t, dst_off);
        float bg[8], bl[8];
#pragma unroll
        for (int q = 0; q < 4; ++q) { const f32x4 t = *(const LAS f32x4*)(b1 + 4 * q); bg[2 * q] = t[0]; bl[2 * q] = t[1] + 1.f; bg[2 * q + 1] = t[2]; bl[2 * q + 1] = t[3] + 1.f; }
#pragma unroll
        for (int ai = 0; ai < 2; ++ai)
#pragma unroll
            for (int m = 0; m < 4; ++m) { const int row = row0 + ai * 128 + m * 16; float o[8];
#pragma unroll
                for (int j = 0; j < 8; ++j) { float g = acc[ai][0][m][j >> 2][j & 3] * (MOE1_FP6 ? 1.f : W8_INV) + bg[j], l = acc[ai][1][m][j >> 2][j & 3] * (MOE1_FP6 ? 1.f : W8_INV) + bl[j];
                    g = fminf(g, 7.f); l = fminf(fmaxf(l, -6.f), 8.f);
                    o[j] = g * __builtin_amdgcn_rcpf(1.f + __builtin_amdgcn_exp2f(-2.4554669595930156f * g)) * l; }
                if (MOE_FP8) { u32x2 w; w.x = pk4_fp8(o[0], o[1], o[2], o[3]); w.y = pk4_fp8(o[4], o[5], o[6], o[7]); *(u32x2*)((unsigned char*)dst + (size_t)row * DE + a0) = w; }
                else { u32x4 w; w.x = pk2(o[0], o[1]); w.y = pk2(o[2], o[3]); w.z = pk2(o[4], o[5]); w.w = pk2(o[6], o[7]);
                *(u32x4*)(dst + (size_t)row * DE + a0) = w; } }
    }
};
struct EpiMoe2 {
    static constexpr bool PERM = true; static constexpr int NST = 16; P p; const LAS float* bias_lds;
    __device__ __forceinline__ void operator()(const Acc& acc, const Unit& u, int wr, int wc, int fr, int fq) const {
        const int row0 = u.pm * 256 + wr * 64 + fr, c0 = u.pn * 256 + wc * 32 + 8 * fq; const LAS float* b2 = bias_lds + (u.ui < 18 ? u.ui : 0) * 256 + wc * 32 + 8 * fq; bf16_t* dst = WSP(bf16_t, WS_Y);
        f32x4 bv[2][2];
#pragma unroll
        for (int bj = 0; bj < 2; ++bj)
#pragma unroll
            for (int n = 0; n < 2; ++n) bv[bj][n] = *(const LAS f32x4*)(b2 + bj * 128 + 4 * n) * (Y_FP8 ? Y_SCALE : 1.f);
#pragma unroll
        for (int ai = 0; ai < 2; ++ai)
#pragma unroll
            for (int m = 0; m < 4; ++m) { const int row = row0 + ai * 128 + m * 16;
#pragma unroll
                for (int bj = 0; bj < 2; ++bj) {
                    if (Y_FP8) { f32x4 t0 = acc[ai][bj][m][0] * ((MOE_FP8 ? W8_INV : 1.f) * Y_SCALE) + bv[bj][0], t1 = acc[ai][bj][m][1] * ((MOE_FP8 ? W8_INV : 1.f) * Y_SCALE) + bv[bj][1];
#pragma unroll
                        for (int j = 0; j < 4; ++j) { t0[j] = __builtin_amdgcn_fmed3f(t0[j], -448.f, 448.f); t1[j] = __builtin_amdgcn_fmed3f(t1[j], -448.f, 448.f); }
                        u32x2 w; w.x = pk4_fp8(t0[0], t0[1], t0[2], t0[3]); w.y = pk4_fp8(t1[0], t1[1], t1[2], t1[3]);
                        *(u32x2*)((unsigned char*)dst + (size_t)row * D + c0 + bj * 128) = w; }
                    else *(u32x4*)(dst + (size_t)row * D + c0 + bj * 128) = pack8(acc[ai][bj][m][0] * (MOE_FP8 ? W8_INV : 1.f) + bv[bj][0], acc[ai][bj][m][1] * (MOE_FP8 ? W8_INV : 1.f) + bv[bj][1], 1.f); } }
    }
};
template <int NCT, bool GATHER> struct MoeOrder {
    const LAS int* tp; int T, rtr, ctr, rpr, G, c;
    __device__ void init(const LAS int* tp_, int G_, int c_) { tp = tp_; T = tp_[32]; G = G_; c = c_;
        const int x = c_ & 7, a = (c_ >> 3) & 31;
        if (NCT == 16) { rtr = (x >> 2) * 8 + (a >> 2); ctr = (x & 3) * 4 + (a & 3); rpr = 16; } else { rtr = (x >> 1) * 8 + (a >> 2); ctr = (x & 1) * 4 + (a & 3); rpr = 32; } }
    __device__ bool next(int i, Unit& u) const {
        int g, ct;
        if (G == 256) { g = i * rpr + rtr; ct = ctr; } else { const long L = (long)i * G + c; g = (int)(L / NCT); ct = (int)(L % NCT); }
        if (g >= T) return false;
        int e;
        if (G == 256 && i < 20 && tp[63]) { e = tp[40 + i]; }
        else { e = 0; while (e < 31 && tp[e + 1] <= g) ++e; }
        u.pm = g; u.pn = ct; u.pb = e * NCT + ct; u.e = e; u.ko = 0; u.ui = i; return true;
    }
    __device__ __forceinline__ unsigned arow(const Unit& u, int h, int R, int ui, const LAS int* gidx) const { return GATHER ? (unsigned)((const LAS unsigned short*)gidx)[ui * 256 + h * 128 + R] : (unsigned)(u.pm * 256 + h * 128 + R); }
};
struct KropeOrder {
    int G, c;
    __device__ bool next(int i, Unit& u) const { const int L = i * G + c; if (L >= 256) return false; u.pm = L >> 2; u.pn = L & 3; u.pb = 16; u.e = 0; u.ko = (L & 3) * 1024; u.ui = i; return true; }
    __device__ __forceinline__ unsigned arow(const Unit& u, int h, int R, int, const LAS int*) const { return (unsigned)(u.pm * 256 + h * 128 + R); }
};
struct EpiKropeP {
    static constexpr bool PERM = true; static constexpr int NST = 0; P p;
    __device__ __forceinline__ void operator()(const Acc& acc, const Unit& u, int wr, int wc, int fr, int fq) const {
        if (wc >= 2) return;
        float* dst = WSP(float, WS_G_QRAW) + (size_t)u.pn * NTOK * 64; const int row0 = u.pm * 256 + wr * 64 + fr, col0 = wc * 32 + 8 * fq;
#pragma unroll
        for (int ai = 0; ai < 2; ++ai)
#pragma unroll
            for (int m = 0; m < 4; ++m) { float* rp = dst + (size_t)(row0 + ai * 128 + m * 16) * 64 + col0; *(f32x4*)rp = acc[ai][0][m][0]; *(f32x4*)(rp + 4) = acc[ai][0][m][1]; }
    }
};
}

__device__ __forceinline__ void krope_fixup(const float* __restrict__ part, const float2* __restrict__ cs, bf16_t* __restrict__ dst, int G, int bid) {
    for (int r0 = bid * 64; r0 < NTOK; r0 += G * 64) { const int row = r0 + (threadIdx.x >> 3), c8 = (threadIdx.x & 7) * 8;
        f32x4 a = {0.f, 0.f, 0.f, 0.f}, b = {0.f, 0.f, 0.f, 0.f};
#pragma unroll
        for (int q = 0; q < 4; ++q) { const float* pp = part + ((size_t)q * NTOK + row) * 64 + c8; a += *(const f32x4*)pp; b += *(const f32x4*)(pp + 4); }
        const f32x4 c0 = *(const f32x4*)(cs + (size_t)row * 32 + (c8 >> 1)), c1 = *(const f32x4*)(cs + (size_t)row * 32 + (c8 >> 1) + 2);
        u32x4 w; w.x = pk2(a[0] * c0[0] - a[1] * c0[1], a[1] * c0[0] + a[0] * c0[1]); w.y = pk2(a[2] * c0[2] - a[3] * c0[3], a[3] * c0[2] + a[2] * c0[3]);
        w.z = pk2(b[0] * c1[0] - b[1] * c1[1], b[1] * c1[0] + b[0] * c1[1]); w.w = pk2(b[2] * c1[2] - b[3] * c1[3], b[3] * c1[2] + b[2] * c1[3]);
        *(u32x4*)(dst + (size_t)row * 64 + c8) = w; }
}

struct DmIdent { __device__ int operator()(int n) const { return n; } };
struct DmWin { __device__ int operator()(int n) const { if (n < 4096) return n; const int j = n - 4096; return j < 32 ? 4096 + 2 * j : 4096 + 2 * (j - 32) + 1; } };
struct DmWq { __device__ int operator()(int n) const { const int h = n / 192, j = n - h * 192; if (j < 128) return n; return j < 160 ? h * 192 + 128 + 2 * (j - 128) : h * 192 + 128 + 2 * (j - 160) + 1; } };
struct DmWkv { __device__ int operator()(int n) const { const int h = n >> 8, r = n & 255; return r < 128 ? h * 128 + r : 1024 + h * 128 + (r - 128); } };
struct DmW1 { __device__ int operator()(int n) const { const int a = n >> 1; return (a >> 7) * 256 + (n & 1) * 128 + (a & 127); } };
template <class DM>
__device__ __forceinline__ void conv_tile(const float* W, int ldw, int k0, int n0, bf16_t* Bt, int K, DM dm, const float* kscale, LAS unsigned* T) {
    const int tid = threadIdx.x, kp = tid >> 4, nc = tid & 15;
    f32x4 a[2], b[2];
#pragma unroll
    for (int ps = 0; ps < 2; ++ps) { const int k = k0 + 2 * (kp + 32 * ps);
        a[ps] = *(const f32x4*)(W + (size_t)k * ldw + n0 + 4 * nc); b[ps] = *(const f32x4*)(W + (size_t)(k + 1) * ldw + n0 + 4 * nc);
        if (kscale) { a[ps] *= kscale[k]; b[ps] *= kscale[k + 1]; } }
#pragma unroll
    for (int ps = 0; ps < 2; ++ps)
#pragma unroll
        for (int j = 0; j < 4; ++j) T[(4 * nc + j) * 66 + kp + 32 * ps] = pk2(a[ps][j], b[ps][j]);
    __syncthreads();
#pragma unroll
    for (int q = 0; q < 2; ++q) { const int ch = tid + 512 * q, n = ch >> 4, c = ch & 15;
        const u32x2 lo = *(const LAS u32x2*)(T + n * 66 + 4 * c), hi = *(const LAS u32x2*)(T + n * 66 + 4 * c + 2);
        u32x4 w; w.x = lo.x; w.y = lo.y; w.z = hi.x; w.w = hi.y;
        *(u32x4*)(Bt + (size_t)dm(n0 + n) * K + k0 + 8 * c) = w; }
    __syncthreads();
}

template <class DM>
__device__ __forceinline__ void conv_tile8(const float* W, int ldw, int k0, int n0, unsigned char* Bt, int K, DM dm, LAS unsigned* T) {
    const int tid = threadIdx.x, k4 = tid >> 4, nc = tid & 15;
    f32x4 a[4];
#pragma unroll
    for (int r = 0; r < 4; ++r) a[r] = *(const f32x4*)(W + (size_t)(k0 + 4 * k4 + r) * ldw + n0 + 4 * nc) * W8_SCALE;
#pragma unroll
    for (int j = 0; j < 4; ++j) T[(4 * nc + j) * 36 + k4] = pk4_fp8(a[0][j], a[1][j], a[2][j], a[3][j]);
    __syncthreads();
    { const int n = tid >> 3, c = tid & 7; const u32x4 w = *(const LAS u32x4*)(T + n * 36 + 4 * c); *(u32x4*)(Bt + (size_t)dm(n0 + n) * K + k0 + 16 * c) = w; }
    __syncthreads();
}

template <class DM>
__device__ __forceinline__ void conv_tile8x2(const float* Wa, const float* Wb, int ldw, int k0a, int n0a, int k0b, int n0b, unsigned char* Bta, unsigned char* Btb, int K, DM dm, LAS unsigned* T) {
    const int tid = threadIdx.x, k4 = tid >> 4, nc = tid & 15;
    f32x4 a[4], b[4];
#pragma unroll
    for (int r = 0; r < 4; ++r) a[r] = __builtin_nontemporal_load((const f32x4*)(Wa + (size_t)(k0a + 4 * k4 + r) * ldw + n0a + 4 * nc));
#pragma unroll
    for (int r = 0; r < 4; ++r) b[r] = __builtin_nontemporal_load((const f32x4*)(Wb + (size_t)(k0b + 4 * k4 + r) * ldw + n0b + 4 * nc));
#pragma unroll
    for (int j = 0; j < 4; ++j) T[(4 * nc + j) * 36 + k4] = pk4_fp8(a[0][j] * W8_SCALE, a[1][j] * W8_SCALE, a[2][j] * W8_SCALE, a[3][j] * W8_SCALE);
#pragma unroll
    for (int j = 0; j < 4; ++j) T[2304 + (4 * nc + j) * 36 + k4] = pk4_fp8(b[0][j] * W8_SCALE, b[1][j] * W8_SCALE, b[2][j] * W8_SCALE, b[3][j] * W8_SCALE);
    __syncthreads();
    { const int n = tid >> 3, c = tid & 7; const u32x4 wa = *(const LAS u32x4*)(T + n * 36 + 4 * c), wb = *(const LAS u32x4*)(T + 2304 + n * 36 + 4 * c);
      __builtin_nontemporal_store(wa, (u32x4*)(Bta + (size_t)dm(n0a + n) * K + k0a + 16 * c)); __builtin_nontemporal_store(wb, (u32x4*)(Btb + (size_t)dm(n0b + n) * K + k0b + 16 * c)); }
    __syncthreads();
}

template <class DM>
__device__ __forceinline__ void conv_macro8(const float* W, int ldw, int k0, int n0, unsigned char* Bt, int K, DM dm, LAS unsigned char* Tb) {
    const int tid = threadIdx.x, kq = tid >> 6, nc = tid & 63;
    const float* src = W + (size_t)(k0 + 4 * kq) * ldw + n0 + 4 * nc;
    f32x4 a[2][8];
#define CM_LOAD(buf, slab) do { _Pragma("unroll") for (int h_ = 0; h_ < 2; ++h_) _Pragma("unroll") for (int r_ = 0; r_ < 4; ++r_) a[buf][h_ * 4 + r_] = __builtin_nontemporal_load((const f32x4*)(src + (size_t)((slab) * 64 + h_ * 32 + r_) * ldw)); } while (0)
#define CM_PUT(buf, slab) do { _Pragma("unroll") for (int h_ = 0; h_ < 2; ++h_) _Pragma("unroll") for (int j_ = 0; j_ < 4; ++j_) \
        *(LAS unsigned*)(Tb + (4 * nc + j_) * 260 + ((slab) * 64 + h_ * 32 + 4 * kq)) = pk4_fp8(a[buf][h_ * 4][j_] * W8_SCALE, a[buf][h_ * 4 + 1][j_] * W8_SCALE, a[buf][h_ * 4 + 2][j_] * W8_SCALE, a[buf][h_ * 4 + 3][j_] * W8_SCALE); } while (0)
    CM_LOAD(0, 0); CM_LOAD(1, 1);
    CM_PUT(0, 0); CM_LOAD(0, 2);
    CM_PUT(1, 1); CM_LOAD(1, 3);
    CM_PUT(0, 2); CM_PUT(1, 3);
#undef CM_LOAD
#undef CM_PUT
    __syncthreads();
#pragma unroll
    for (int ps = 0; ps < 8; ++ps) { const int n = ps * 32 + (tid >> 4), c = tid & 15; const LAS unsigned* tp_ = (const LAS unsigned*)(Tb + n * 260 + 16 * c);
        u32x4 w; w.x = tp_[0]; w.y = tp_[1]; w.z = tp_[2]; w.w = tp_[3];
        __builtin_nontemporal_store(w, (u32x4*)(Bt + (size_t)dm(n0 + n) * K + k0 + 16 * c)); }
    __syncthreads();
}

__device__ __forceinline__ void phase_prologue(const P& p, LAS unsigned char* lds, int G, int bid) {
    const int tid = threadIdx.x, lane = tid & 63, wid = tid >> 6;
    LAS float* cact = (LAS float*)lds;
    LAS float* red = (LAS float*)(lds + 32768);
    LAS unsigned* T = (LAS unsigned*)(lds + 81920);
    constexpr int U_MOD = 96, U_CS = 64 + 8;
    constexpr int T_WIN = 16 * 65, T_WQ = 4 * 24, T_WKV = 4 * 32, T_WOUT = 16 * 32;
    constexpr int U_REST = U_CS + T_WIN + T_WQ + T_WKV + T_WOUT;
    const bool split = G > 2 * U_MOD;
    if (!split || bid < U_MOD) {
        for (int i = tid; i < 4 * 2048; i += 512) { const int b = i >> 11, k = i & 2047; const float c = p.c[i]; cact[k * 4 + b] = c / (1.f + __expf(-c)); }
        __syncthreads();
        for (int mu = bid; mu < U_MOD; mu += G) {
            f32x4 acc[4] = {{0.f, 0.f, 0.f, 0.f}, {0.f, 0.f, 0.f, 0.f}, {0.f, 0.f, 0.f, 0.f}, {0.f, 0.f, 0.f, 0.f}};
            const int hh = lane >> 5, cl = lane & 31;
            const float* w = p.w_mod + (size_t)(wid * 256 + hh) * (NMOD * D) + mu * 128 + 4 * cl;
#pragma unroll 16
            for (int k = 0; k < 128; ++k) { const f32x4 wv = __builtin_nontemporal_load((const f32x4*)(w + (size_t)(2 * k) * (NMOD * D))); const f32x4 c = *(const LAS f32x4*)(cact + (wid * 256 + 2 * k + hh) * 4);
                acc[0] += wv * c[0]; acc[1] += wv * c[1]; acc[2] += wv * c[2]; acc[3] += wv * c[3]; }
#pragma unroll
            for (int b = 0; b < 4; ++b) *(LAS f32x4*)(red + ((wid * 64 + lane) * 4 + b) * 4) = acc[b];
            __syncthreads();
            if (tid < 128) { const int l = tid >> 2, b = tid & 3; f32x4 sum = *(const f32x4*)(p.b_mod + mu * 128 + 4 * l);
#pragma unroll
                for (int w8 = 0; w8 < 16; ++w8) sum += *(const LAS f32x4*)(red + ((w8 * 32 + l) * 4 + b) * 4);
                *(f32x4*)(WSP(float, WS_MOD) + (size_t)b * NMOD * D + mu * 128 + 4 * l) = sum; }
            __syncthreads();
        }
        if (split) return;
    }
    const int c0 = split ? bid - U_MOD : bid, GS = split ? G - U_MOD : G;
    for (int v = c0; v < U_CS; v += GS) {
        if (v >= 64) {
            for (int j = 0; j < 16; ++j) { const int idx = (v - 64) * 8192 + j * 512 + tid, k = idx >> 5, e = idx & 31; const float w = p.w_router[idx];
                const bf16_t hi = f2bf(w); WSP(bf16_t, WS_WR_HI)[e * 2048 + k] = hi; WSP(bf16_t, WS_WR_LO)[e * 2048 + k] = f2bf(w - bf2f(hi)); }
        } else {
            for (int j = 0; j < 16; ++j) { const int idx = v * 8192 + j * 512 + tid; const int tok = idx >> 5, i = idx & 31;
                double inv = 1.0; for (int q = 0; q < i; ++q) inv *= 0.7498942093324559;
                const double rev = (double)p.pos[tok] * inv * 0.15915494309189535; const float fr = (float)(rev - floor(rev));
                float2 cs; cs.x = __builtin_amdgcn_cosf(fr); cs.y = __builtin_amdgcn_sinf(fr); WSP(float2, WS_CS)[idx] = cs; }
        }
    }
    constexpr int NT = T_WIN + T_WQ + T_WKV + T_WOUT;
    const int kp = tid >> 4, nc = tid & 15;
    f32x4 ra[2][2], rb[2][2];
#define CT_DECL(P_) const float* P_##W = p.w_in; bf16_t* P_##Bt = WSP(bf16_t, WS_WIN_T); const float* P_##ks = nullptr; int P_##ldw = INW, P_##k0 = 0, P_##n0 = 0, P_##K = 2048, P_##dmt = 0
#define CT_SET(P_, vv) do { int v_ = (vv); \
        if (v_ < T_WIN) { P_##W = p.w_in; P_##Bt = WSP(bf16_t, WS_WIN_T); P_##ks = nullptr; P_##ldw = INW; P_##k0 = (v_ / 65) * 128; P_##n0 = (v_ % 65) * 64; P_##K = 2048; P_##dmt = 0; } \
        else if ((v_ -= T_WIN) < T_WQ) { P_##W = p.w_q_up; P_##Bt = WSP(bf16_t, WS_WQ_T); P_##ks = p.g_q; P_##ldw = 1536; P_##k0 = (v_ / 24) * 128; P_##n0 = (v_ % 24) * 64; P_##K = 512; P_##dmt = 1; } \
        else if ((v_ -= T_WQ) < T_WKV) { P_##W = p.w_kv_up; P_##Bt = WSP(bf16_t, WS_WKV_T); P_##ks = p.g_kv; P_##ldw = 2048; P_##k0 = (v_ / 32) * 128; P_##n0 = (v_ % 32) * 64; P_##K = 512; P_##dmt = 2; } \
        else { v_ -= T_WKV; P_##W = p.w_out; P_##Bt = WSP(bf16_t, WS_WOUT_T); P_##ks = nullptr; P_##ldw = 2048; P_##k0 = (v_ / 32) * 128; P_##n0 = (v_ % 32) * 64; P_##K = 2048; P_##dmt = 3; } } while (0)
#define PT_LOAD(buf, P_) do { _Pragma("unroll") for (int ps = 0; ps < 2; ++ps) { const int k = P_##k0 + 2 * (kp + 32 * ps); \
        ra[buf][ps] = *(const f32x4*)(P_##W + (size_t)k * P_##ldw + P_##n0 + 4 * nc); rb[buf][ps] = *(const f32x4*)(P_##W + (size_t)(k + 1) * P_##ldw + P_##n0 + 4 * nc); } } while (0)
#define PT_DO(buf, P_) do { _Pragma("unroll") for (int ps = 0; ps < 2; ++ps) { const int k = P_##k0 + 2 * (kp + 32 * ps); f32x4 x = ra[buf][ps], y = rb[buf][ps]; \
            if (P_##ks) { x *= P_##ks[k]; y *= P_##ks[k + 1]; } \
            _Pragma("unroll") for (int j = 0; j < 4; ++j) T[(4 * nc + j) * 66 + kp + 32 * ps] = pk2(x[j], y[j]); } \
        __syncthreads(); \
        _Pragma("unroll") for (int q = 0; q < 2; ++q) { const int ch = tid + 512 * q, n = ch >> 4, cc = ch & 15; \
            const u32x2 lo = *(const LAS u32x2*)(T + n * 66 + 4 * cc), hi = *(const LAS u32x2*)(T + n * 66 + 4 * cc + 2); \
            u32x4 w; w.x = lo.x; w.y = lo.y; w.z = hi.x; w.w = hi.y; const int nn = P_##n0 + n; \
            const int dn = P_##dmt == 0 ? DmWin{}(nn) : P_##dmt == 1 ? DmWq{}(nn) : P_##dmt == 2 ? DmWkv{}(nn) : nn; \
            *(u32x4*)(P_##Bt + (size_t)dn * P_##K + P_##k0 + 8 * cc) = w; } \
        __syncthreads(); } while (0)
    int v = c0;
    if (v < NT) {
        CT_DECL(c_); CT_DECL(n_);
        CT_SET(c_, v); PT_LOAD(0, c_);
        for (;;) {
            const int vn = v + GS; const bool more = vn < NT;
            if (more) { CT_SET(n_, vn); PT_LOAD(1, n_); }
            PT_DO(0, c_);
            if (!more) break;
            const int vnn = vn + GS; const bool more2 = vnn < NT;
            if (more2) { CT_SET(c_, vnn); PT_LOAD(0, c_); }
            PT_DO(1, n_);
            if (!more2) break;
            v = vnn;
        }
    }
#undef CT_DECL
#undef CT_SET
#undef PT_LOAD
#undef PT_DO
}

__device__ __forceinline__ void phase_normmod_r(const float* __restrict__ mod, const float* __restrict__ x, const float* __restrict__ g, int shift_idx, int scale_idx, bf16_t* __restrict__ out, int G, int bid) {
    const int lane = threadIdx.x & 63, wid = threadIdx.x >> 6;
    for (int row = bid * 8 + wid; row < NTOK; row += G * 8) {
        const int b = row / SEQ; const float* xr = x + (size_t)row * D; f32x4 v[8]; float ss = 0.f;
#pragma unroll
        for (int j = 0; j < 8; ++j) { v[j] = *(const f32x4*)(xr + (j * 64 + lane) * 4); ss += (v[j][0] * v[j][0] + v[j][1] * v[j][1]) + (v[j][2] * v[j][2] + v[j][3] * v[j][3]); }
#pragma unroll
        for (int o = 32; o >= 1; o >>= 1) ss += __shfl_xor(ss, o);
        const float rstd = 1.0f / sqrtf(ss * (1.f / D) + EPS);
        const float* sh = mod + (size_t)b * NMOD * D + shift_idx * D; const float* sc = mod + (size_t)b * NMOD * D + scale_idx * D;
#pragma unroll
        for (int j = 0; j < 8; ++j) { const int k = (j * 64 + lane) * 4; const f32x4 gg = *(const f32x4*)(g + k), s1 = *(const f32x4*)(sc + k), s0 = *(const f32x4*)(sh + k);
            const f32x4 h = v[j] * rstd * gg * (s1 + 1.f) + s0; u32x2 w; w.x = pk2(h[0], h[1]); w.y = pk2(h[2], h[3]); *(u32x2*)(out + (size_t)row * D + k) = w; }
    }
}


__device__ __forceinline__ void phase_cb(const P& p, LAS unsigned char* lds, int bid) {
    if (bid >= NB) return;
    const int tid = threadIdx.x, e = tid & 31, kc = tid >> 5; LAS float* red = (LAS float*)lds;
    const float* sh = WSP(float, WS_MOD) + (size_t)bid * NMOD * D + 3 * D; float s = 0.f;
#pragma unroll 16
    for (int k = kc * 128; k < kc * 128 + 128; ++k) s += sh[k] * p.w_router[k * 32 + e];
    red[tid] = s; __syncthreads();
    if (tid < 32) { float t = p.b_router[tid]; for (int q = 0; q < 16; ++q) t += red[q * 32 + tid]; WSP(float, WS_CB)[bid * 32 + tid] = t; }
    __syncthreads();
}
__device__ __forceinline__ void route_h2_out(const bf16_t* __restrict__ xr, const float* __restrict__ gf, const float* __restrict__ sc, const float* __restrict__ sh, unsigned char* __restrict__ hr8, const float rs, const int kbase) {
#pragma unroll 4
    for (int s = 0; s < 32; ++s) {
        const int k = kbase + 16 * s;
        const f32x4 g0 = *(const f32x4*)(gf + k), g1 = *(const f32x4*)(gf + k + 4), s0 = *(const f32x4*)(sc + k), s1 = *(const f32x4*)(sc + k + 4), h0 = *(const f32x4*)(sh + k), h1 = *(const f32x4*)(sh + k + 4);
        f32x4 xa, xb; { const u32x4 xw = *(const u32x4*)(xr + 16 * s); xa[0] = __uint_as_float(xw.x << 16); xa[1] = __uint_as_float(xw.x & 0xffff0000u); xa[2] = __uint_as_float(xw.y << 16); xa[3] = __uint_as_float(xw.y & 0xffff0000u);
            xb[0] = __uint_as_float(xw.z << 16); xb[1] = __uint_as_float(xw.z & 0xffff0000u); xb[2] = __uint_as_float(xw.w << 16); xb[3] = __uint_as_float(xw.w & 0xffff0000u); }
        const f32x4 y0 = xa * rs * g0 * (s0 + 1.f) + h0, y1 = xb * rs * g1 * (s1 + 1.f) + h1;
        if (MOE_FP8) { u32x2 w; w.x = pk4_fp8(y0[0], y0[1], y0[2], y0[3]); w.y = pk4_fp8(y1[0], y1[1], y1[2], y1[3]); *(u32x2*)(hr8 + 16 * s) = w; }
        else { u32x4 w; w.x = pk2(y0[0], y0[1]); w.y = pk2(y0[2], y0[3]); w.z = pk2(y1[0], y1[1]); w.w = pk2(y1[2], y1[3]); *(u32x4*)(hr8 + 32 * s) = w; }
    }
}
__device__ __forceinline__ void route_h2_fp6(const bf16_t* __restrict__ x1g, const LAS float* gsl, const LAS float* shl, unsigned char* __restrict__ h2g, const LAS float* rsd) {
    const int blk = threadIdx.x & 63, k0 = blk * 32;
    f32x4 gs[8], hs[8];
#pragma unroll
    for (int q = 0; q < 8; ++q) { gs[q] = *(const LAS f32x4*)(gsl + k0 + 4 * q); hs[q] = *(const LAS f32x4*)(shl + k0 + 4 * q); }
#pragma unroll 2
    for (int ps = 0; ps < 8; ++ps) { const int id = threadIdx.x + 512 * ps, r = id >> 6; const float rs = rsd[r];
        float v[32]; const u32x4* xp = (const u32x4*)(x1g + (size_t)r * D + k0);
#pragma unroll
        for (int q = 0; q < 4; ++q) { const u32x4 xw = xp[q]; const f32x4 g0 = gs[2 * q] * rs, g1 = gs[2 * q + 1] * rs, h0 = hs[2 * q], h1 = hs[2 * q + 1];
            v[8 * q + 0] = __uint_as_float(xw.x << 16) * g0[0] + h0[0]; v[8 * q + 1] = __uint_as_float(xw.x & 0xffff0000u) * g0[1] + h0[1];
            v[8 * q + 2] = __uint_as_float(xw.y << 16) * g0[2] + h0[2]; v[8 * q + 3] = __uint_as_float(xw.y & 0xffff0000u) * g0[3] + h0[3];
            v[8 * q + 4] = __uint_as_float(xw.z << 16) * g1[0] + h1[0]; v[8 * q + 5] = __uint_as_float(xw.z & 0xffff0000u) * g1[1] + h1[1];
            v[8 * q + 6] = __uint_as_float(xw.w << 16) * g1[2] + h1[2]; v[8 * q + 7] = __uint_as_float(xw.w & 0xffff0000u) * g1[3] + h1[3]; }
        u32x4 lo, hi; fp6_block(v, lo, hi);
        unsigned char* dst = h2g + (size_t)r * D + (blk >> 2) * 128 + (blk & 3) * 16;
        *(u32x4*)dst = lo; *(u32x4*)(dst + 64) = hi; }
}
__device__ __forceinline__ void phase_route(const P& p, LAS unsigned char* lds, int G, int bid) {
    const int tid = threadIdx.x, lane = tid & 63, wid = __builtin_amdgcn_readfirstlane(tid >> 6), hf = wid >> 2, wq = wid & 3, r32 = lane & 31, kg = lane >> 5;
    LAS float* red = (LAS float*)lds;
    LAS float* ssr = (LAS float*)(lds + 32768);
    LAS float* lg = (LAS float*)(lds + 32768 + 2048);
    LAS float* rsd = (LAS float*)(lds + 32768 + 2048 + 8192);
    LAS int* hist = (LAS int*)(lds + 32768 + 2048 + 8192 + 256);
    LAS int* gbase = hist + 32;
    LAS float* gsl = (LAS float*)(lds + 49152);
    LAS float* shl = (LAS float*)(lds + 57344);
    const bf16_t* wrh = WSP(bf16_t, WS_WR_HI); const bf16_t* wrl = WSP(bf16_t, WS_WR_LO);
    for (int gp = bid; gp < NTOK / 64; gp += G) {
        const int row = gp * 64 + hf * 32 + r32, b = (gp * 64) / SEQ, kb0 = wq * 512 + 8 * kg;
        const float* mod = WSP(float, WS_MOD) + (size_t)b * NMOD * D; const float* sh = mod + 3 * D; const float* sc = mod + 4 * D;
        const bf16_t* xr = WSP(bf16_t, WS_X1) + (size_t)row * D + kb0;
        f32x16 C = {}; float ss = 0.f;
        if (tid < 32) hist[tid] = 0;
        { const int k4 = tid * 4; *(LAS f32x4*)(gsl + k4) = *(const f32x4*)(p.g_ffn + k4) * (*(const f32x4*)(sc + k4) + 1.f); *(LAS f32x4*)(shl + k4) = *(const f32x4*)(sh + k4); }
        __syncthreads();
#pragma unroll 4
        for (int s = 0; s < 32; ++s) {
            const int k = kb0 + 16 * s;
            const f32x4 gs0 = *(const LAS f32x4*)(gsl + k), gs1 = *(const LAS f32x4*)(gsl + k + 4);
            f32x4 x0, x1; { const u32x4 xw = *(const u32x4*)(xr + 16 * s); x0[0] = __uint_as_float(xw.x << 16); x0[1] = __uint_as_float(xw.x & 0xffff0000u); x0[2] = __uint_as_float(xw.y << 16); x0[3] = __uint_as_float(xw.y & 0xffff0000u);
                x1[0] = __uint_as_float(xw.z << 16); x1[1] = __uint_as_float(xw.z & 0xffff0000u); x1[2] = __uint_as_float(xw.w << 16); x1[3] = __uint_as_float(xw.w & 0xffff0000u); }
            ss += (x0[0] * x0[0] + x0[1] * x0[1]) + (x0[2] * x0[2] + x0[3] * x0[3]) + (x1[0] * x1[0] + x1[1] * x1[1]) + (x1[2] * x1[2] + x1[3] * x1[3]);
            const f32x4 y0 = x0 * gs0, y1 = x1 * gs1;
            u32x4 hi; hi.x = pk2(y0[0], y0[1]); hi.y = pk2(y0[2], y0[3]); hi.z = pk2(y1[0], y1[1]); hi.w = pk2(y1[2], y1[3]);
            f32x4 r0, r1;
            r0[0] = y0[0] - __uint_as_float(hi.x << 16); r0[1] = y0[1] - __uint_as_float(hi.x & 0xffff0000u); r0[2] = y0[2] - __uint_as_float(hi.y << 16); r0[3] = y0[3] - __uint_as_float(hi.y & 0xffff0000u);
            r1[0] = y1[0] - __uint_as_float(hi.z << 16); r1[1] = y1[1] - __uint_as_float(hi.z & 0xffff0000u); r1[2] = y1[2] - __uint_as_float(hi.w << 16); r1[3] = y1[3] - __uint_as_float(hi.w & 0xffff0000u);
            u32x4 lo; lo.x = pk2(r0[0], r0[1]); lo.y = pk2(r0[2], r0[3]); lo.z = pk2(r1[0], r1[1]); lo.w = pk2(r1[2], r1[3]);
            const bf16x8 ah = *(const bf16x8*)(wrh + (size_t)r32 * 2048 + k), al = *(const bf16x8*)(wrl + (size_t)r32 * 2048 + k);
            const bf16x8 bh = __builtin_bit_cast(bf16x8, hi), bl = __builtin_bit_cast(bf16x8, lo);
            C = __builtin_amdgcn_mfma_f32_32x32x16_bf16(ah, bh, C, 0, 0, 0);
            C = __builtin_amdgcn_mfma_f32_32x32x16_bf16(al, bh, C, 0, 0, 0);
            C = __builtin_amdgcn_mfma_f32_32x32x16_bf16(ah, bl, C, 0, 0, 0);
        }
#pragma unroll
        for (int r = 0; r < 16; ++r) red[((hf * 4 + wq) * 32 + ((r & 3) + 8 * (r >> 2) + 4 * kg)) * 32 + r32] = C[r];
        ssr[(hf * 8 + wq * 2 + kg) * 32 + r32] = ss;
        __syncthreads();
        { const int h2 = tid >> 8, t2 = tid & 255;
#pragma unroll
          for (int q = 0; q < 4; ++q) { const int e = (t2 >> 5) + 8 * q; float t = 0.f;
#pragma unroll
              for (int w4 = 0; w4 < 4; ++w4) t += red[((h2 * 4 + w4) * 32 + e) * 32 + (t2 & 31)]; lg[(h2 * 32 + e) * 32 + (t2 & 31)] = t; } }
        if (tid < 64) { float t = 0.f;
#pragma unroll
            for (int q = 0; q < 8; ++q) t += ssr[((tid >> 5) * 8 + q) * 32 + (tid & 31)]; rsd[tid] = 1.0f / sqrtf(t * (1.f / D) + EPS); }
        __syncthreads();
        int i0 = 0, i1 = 0, i2 = 0, i3 = 0, l0 = 0, l1 = 0, l2 = 0, l3 = 0; float w0 = 0.f, w1 = 0.f, w2 = 0.f, w3 = 0.f;
        if (tid < 64) {
            const float rs = rsd[tid]; const float* cb = WSP(float, WS_CB) + b * 32; const LAS float* lgr = lg + (tid >> 5) * 1024 + (tid & 31);
            unsigned used = 0; float v0 = 0, v1 = 0, v2 = 0, v3 = 0;
            float xv[32];
#pragma unroll
            for (int e = 0; e < 32; ++e) xv[e] = lgr[e * 32] * rs + cb[e];
#pragma unroll
            for (int k = 0; k < 4; ++k) { float best = -3.0e38f; int bi = 0;
#pragma unroll
                for (int e = 0; e < 32; ++e) { const bool ok = !((used >> e) & 1u) && xv[e] > best; best = ok ? xv[e] : best; bi = ok ? e : bi; }
                used |= 1u << bi;
                if (k == 0) { i0 = bi; v0 = best; } else if (k == 1) { i1 = bi; v1 = best; } else if (k == 2) { i2 = bi; v2 = best; } else { i3 = bi; v3 = best; } }
            const float e1 = __expf(v1 - v0), e2 = __expf(v2 - v0), e3 = __expf(v3 - v0), inv = 1.f / (1.f + e1 + e2 + e3);
            w0 = inv; w1 = e1 * inv; w2 = e2 * inv; w3 = e3 * inv;
            l0 = atomicAdd((int*)(hist + i0), 1); l1 = atomicAdd((int*)(hist + i1), 1); l2 = atomicAdd((int*)(hist + i2), 1); l3 = atomicAdd((int*)(hist + i3), 1);
        }
        __syncthreads();
        if (tid < 32) { const int c = hist[tid]; gbase[tid] = c ? atomicAdd(WSP(int, WS_CNT) + tid, c) : 0; }
        __syncthreads();
        if (tid < 64) { const int rw = gp * 64 + tid;
            const int p0 = gbase[i0] + l0, p1 = gbase[i1] + l1, p2 = gbase[i2] + l2, p3 = gbase[i3] + l3;
            int* te = WSP(int, WS_TOPE) + rw * 4; float* tw = WSP(float, WS_TOPW) + rw * 4; int* tp = WSP(int, WS_TPOS) + rw * 4; int* rt = WSP(int, WS_ROWTOK);
            te[0] = i0; te[1] = i1; te[2] = i2; te[3] = i3; tw[0] = w0; tw[1] = w1; tw[2] = w2; tw[3] = w3; tp[0] = p0; tp[1] = p1; tp[2] = p2; tp[3] = p3;
            rt[(size_t)i0 * NTOK + p0] = rw * 4; rt[(size_t)i1 * NTOK + p1] = rw * 4 + 1; rt[(size_t)i2 * NTOK + p2] = rw * 4 + 2; rt[(size_t)i3 * NTOK + p3] = rw * 4 + 3; }
        if (MOE1_FP6) route_h2_fp6(WSP(bf16_t, WS_X1) + (size_t)(gp * 64) * D, gsl, shl, p.ws + WS_H2 + (size_t)(gp * 64) * D, rsd);
        else route_h2_out(xr, p.g_ffn, sc, sh, p.ws + WS_H2 + (size_t)row * D + kb0, rsd[hf * 32 + r32], kb0);
        __syncthreads();
    }
}
__device__ __forceinline__ void phase_final_r(const bf16_t* __restrict__ Y, const bf16_t* __restrict__ X1, const float* __restrict__ modp, const int* __restrict__ tope, const int* __restrict__ tpos, const float* __restrict__ topw, const float* __restrict__ gfin, float* __restrict__ outp, LAS unsigned char* lds, int G, int bid) {
    const int lane = threadIdx.x & 63, wid = threadIdx.x >> 6; const LAS int* tp = (const LAS int*)(lds + LDS_TP);
    int e_n = 0, ps_n = 0; float wk_n = 0.f;
    { const int r0 = bid * 8 + wid; if (r0 < NTOK && lane < 4) { e_n = tope[r0 * 4 + lane]; ps_n = tpos[r0 * 4 + lane]; wk_n = topw[r0 * 4 + lane]; } }
    for (int row = bid * 8 + wid; row < NTOK; row += G * 8) {
        const int b = row / SEQ; const float* g2 = modp + (size_t)b * NMOD * D + 5 * D;
        int slot = 0; float wk = 0.f;
        if (lane < 4) { slot = tp[e_n] * 256 + ps_n; wk = wk_n; }
        { const int nr = row + G * 8; if (nr < NTOK && lane < 4) { e_n = tope[nr * 4 + lane]; ps_n = tpos[nr * 4 + lane]; wk_n = topw[nr * 4 + lane]; } }
        const int sl0 = __shfl(slot, 0), sl1 = __shfl(slot, 1), sl2 = __shfl(slot, 2), sl3 = __shfl(slot, 3);
        const float ysc = Y_FP8 ? 1.f / Y_SCALE : 1.f, q0 = __shfl(wk, 0) * ysc, q1 = __shfl(wk, 1) * ysc, q2 = __shfl(wk, 2) * ysc, q3 = __shfl(wk, 3) * ysc;
        f32x4 v[8]; float ss = 0.f;
#pragma unroll
        for (int j = 0; j < 8; ++j) { const int k = (j * 64 + lane) * 4;
            f32x4 m;
            if (Y_FP8) { const unsigned char* Y8 = (const unsigned char*)Y;
                const int a0 = *(const int*)(Y8 + (size_t)sl0 * D + k), a1 = *(const int*)(Y8 + (size_t)sl1 * D + k), a2 = *(const int*)(Y8 + (size_t)sl2 * D + k), a3 = *(const int*)(Y8 + (size_t)sl3 * D + k);
                const auto l0 = __builtin_amdgcn_cvt_pk_f32_fp8(a0, false), h0 = __builtin_amdgcn_cvt_pk_f32_fp8(a0, true), l1 = __builtin_amdgcn_cvt_pk_f32_fp8(a1, false), h1 = __builtin_amdgcn_cvt_pk_f32_fp8(a1, true);
                const auto l2 = __builtin_amdgcn_cvt_pk_f32_fp8(a2, false), h2 = __builtin_amdgcn_cvt_pk_f32_fp8(a2, true), l3 = __builtin_amdgcn_cvt_pk_f32_fp8(a3, false), h3 = __builtin_amdgcn_cvt_pk_f32_fp8(a3, true);
                m[0] = q0 * l0[0] + q1 * l1[0] + q2 * l2[0] + q3 * l3[0]; m[1] = q0 * l0[1] + q1 * l1[1] + q2 * l2[1] + q3 * l3[1];
                m[2] = q0 * h0[0] + q1 * h1[0] + q2 * h2[0] + q3 * h3[0]; m[3] = q0 * h0[1] + q1 * h1[1] + q2 * h2[1] + q3 * h3[1];
            } else {
            const u32x2 a0 = *(const u32x2*)(Y + (size_t)sl0 * D + k), a1 = *(const u32x2*)(Y + (size_t)sl1 * D + k), a2 = *(const u32x2*)(Y + (size_t)sl2 * D + k), a3 = *(const u32x2*)(Y + (size_t)sl3 * D + k);
            m[0] = q0 * __uint_as_float(a0.x << 16) + q1 * __uint_as_float(a1.x << 16) + q2 * __uint_as_float(a2.x << 16) + q3 * __uint_as_float(a3.x << 16);
            m[1] = q0 * __uint_as_float(a0.x & 0xffff0000u) + q1 * __uint_as_float(a1.x & 0xffff0000u) + q2 * __uint_as_float(a2.x & 0xffff0000u) + q3 * __uint_as_float(a3.x & 0xffff0000u);
            m[2] = q0 * __uint_as_float(a0.y << 16) + q1 * __uint_as_float(a1.y << 16) + q2 * __uint_as_float(a2.y << 16) + q3 * __uint_as_float(a3.y << 16);
            m[3] = q0 * __uint_as_float(a0.y & 0xffff0000u) + q1 * __uint_as_float(a1.y & 0xffff0000u) + q2 * __uint_as_float(a2.y & 0xffff0000u) + q3 * __uint_as_float(a3.y & 0xffff0000u);
            }
            { const u32x2 xw = *(const u32x2*)(X1 + (size_t)row * D + k); f32x4 xv; xv[0] = __uint_as_float(xw.x << 16); xv[1] = __uint_as_float(xw.x & 0xffff0000u); xv[2] = __uint_as_float(xw.y << 16); xv[3] = __uint_as_float(xw.y & 0xffff0000u);
              v[j] = xv + *(const f32x4*)(g2 + k) * m; }
            ss += (v[j][0] * v[j][0] + v[j][1] * v[j][1]) + (v[j][2] * v[j][2] + v[j][3] * v[j][3]); }
#pragma unroll
        for (int o = 32; o >= 1; o >>= 1) ss += __shfl_xor(ss, o);
        const float rstd = 1.0f / sqrtf(ss * (1.f / D) + EPS);
#pragma unroll
        for (int j = 0; j < 8; ++j) { const int k = (j * 64 + lane) * 4; *(f32x4*)(outp + (size_t)row * D + k) = v[j] * rstd * *(const f32x4*)(gfin + k); }
    }
}
__device__ __forceinline__ void phase_final(const P& p, LAS unsigned char* lds, int G, int bid) { phase_final_r(WSP(bf16_t, WS_Y), WSP(bf16_t, WS_X1), WSP(float, WS_MOD), WSP(int, WS_TOPE), WSP(int, WS_TPOS), WSP(float, WS_TOPW), p.g_final, p.out, lds, G, bid); }

namespace at {
constexpr int VSTR = 144, VT = 128 * VSTR;
constexpr int LDS_AL = 90112, LDS_FLAG = LDS_AL + 1024;
constexpr float LOG2E = 1.4426950408889634f;
__device__ __forceinline__ bf16x8 packf(const f32x16& x, int s) { u32x4 w; w.x = pk2(x[8 * s], x[8 * s + 1]); w.y = pk2(x[8 * s + 2], x[8 * s + 3]); w.z = pk2(x[8 * s + 4], x[8 * s + 5]); w.w = pk2(x[8 * s + 6], x[8 * s + 7]); return __builtin_bit_cast(bf16x8, w); }
#define AT_MFMA(a, b, c) __builtin_amdgcn_mfma_f32_32x32x16_bf16((a), (b), (c), 0, 0, 0)

template <bool MLA>
__device__ __forceinline__ void attn_unit(const P& p, LAS unsigned char* lds, const int b, const int h, const int qb) {
    constexpr int DK = MLA ? 192 : 128, KSTR = MLA ? 400 : 272, KT = 64 * KSTR, BUF = KT + VT, NQF = DK / 16, NKR = MLA ? 3 : 2;
    static_assert(2 * (64 * 400 + VT) <= LDS_AL, "attention LDS map");
    const int tid = threadIdx.x, wid = __builtin_amdgcn_readfirstlane(tid >> 6), lane = tid & 63, r32 = lane & 31, hi = lane >> 5;
    const int q0 = qb * 256, qw = q0 + 32 * wid, qi = qw + r32, nt = (q0 + 256) / 64;
    const bf16_t* Kn = MLA ? WSP(bf16_t, WS_KNOPE) : WSP(bf16_t, WS_SBK);
    const bf16_t* Kr = WSP(bf16_t, WS_KROPE);
    const bf16_t* Vt = WSP(bf16_t, MLA ? WS_VMT : WS_SBVT) + (size_t)(b * 8 + h) * 128 * SEQ;
    LAS float* al = (LAS float*)(lds + LDS_AL) + wid * 32;
    LAS int* flag = (LAS int*)(lds + LDS_FLAG);
    bf16x8 qf[NQF];
    { const char* qb_ = MLA ? (const char*)WSP(bf16_t, WS_QMLA) + ((size_t)(b * SEQ + qw) * 1536 + h * 192) * 2 : (const char*)WSP(bf16_t, WS_SBQ) + ((size_t)(b * SEQ + qw) * 1024 + h * 128) * 2;
      const unsigned qo = (unsigned)((r32 * (MLA ? 1536 : 1024) + 8 * hi) * 2);
#pragma unroll
      for (int s = 0; s < NQF; ++s) qf[s] = *(const bf16x8*)(qb_ + qo + 32 * s); }
    bf16x8 tri0, tri1, ones;
#pragma unroll
    for (int j = 0; j < 8; ++j) { const int k0_ = 8 * (j >> 2) + 4 * hi + (j & 3); tri0[j] = (k0_ > r32) ? (short)0x3F80 : (short)0; tri1[j] = (16 + k0_ > r32) ? (short)0x3F80 : (short)0; ones[j] = (short)0x3F80; }
    u32x4 kreg[NKR], vreg[2];
    const unsigned kofs0 = (unsigned)(((tid >> 4) * 1024 + (tid & 15) * 8) * 2), kofs1 = kofs0 + 32u * 1024u * 2u;
    const unsigned rofs = (unsigned)(((tid >> 3) * 64 + (tid & 7) * 8) * 2);
    const unsigned vofs0 = (unsigned)(((tid >> 3) * SEQ + (tid & 7) * 8) * 2), vofs1 = vofs0 + 64u * SEQ * 2u;
    const unsigned kw0 = (unsigned)((tid >> 4) * KSTR + (tid & 15) * 16), kw1 = kw0 + 32u * KSTR, rw = (unsigned)((tid >> 3) * KSTR + 256 + (tid & 7) * 16);
    const unsigned vw0 = (unsigned)(KT + (tid >> 3) * VSTR + (16 * ((tid & 7) >> 1) + 4 * (tid & 1)) * 2), vw1 = vw0 + 64u * VSTR;
    const char* Knb = (const char*)Kn + ((size_t)b * SEQ * 1024 + h * 128) * 2; const char* Krb = (const char*)Kr + (size_t)b * SEQ * 64 * 2; const char* Vtb = (const char*)Vt;
#define AT_LOAD(tile) do { const int k0_ = (tile) * 64; const char* kp_ = Knb + (size_t)k0_ * 2048; const char* vp_ = Vtb + (size_t)k0_ * 2; \
        kreg[0] = *(const u32x4*)(kp_ + kofs0); kreg[1] = *(const u32x4*)(kp_ + kofs1); if (MLA) kreg[NKR - 1] = *(const u32x4*)(Krb + (size_t)k0_ * 128 + rofs); \
        vreg[0] = *(const u32x4*)(vp_ + vofs0); vreg[1] = *(const u32x4*)(vp_ + vofs1); } while (0)
#define AT_WRITE(buf) do { LAS unsigned char* kb_ = lds + (buf) * BUF; \
        *(LAS u32x4*)(kb_ + kw0) = kreg[0]; *(LAS u32x4*)(kb_ + kw1) = kreg[1]; if (MLA) *(LAS u32x4*)(kb_ + rw) = kreg[NKR - 1]; \
        { u32x2 lo_, hi_; lo_.x = vreg[0].x; lo_.y = vreg[0].y; hi_.x = vreg[0].z; hi_.y = vreg[0].w; *(LAS u32x2*)(kb_ + vw0) = lo_; *(LAS u32x2*)(kb_ + vw0 + 16) = hi_; } \
        { u32x2 lo_, hi_; lo_.x = vreg[1].x; lo_.y = vreg[1].y; hi_.x = vreg[1].z; hi_.y = vreg[1].w; *(LAS u32x2*)(kb_ + vw1) = lo_; *(LAS u32x2*)(kb_ + vw1 + 16) = hi_; } } while (0)
    f32x16 o[4];
#pragma unroll
    for (int d0 = 0; d0 < 4; ++d0)
#pragma unroll
        for (int r = 0; r < 16; ++r) o[d0][r] = 0.f;
    float m_run = -1e30f, l_run = 0.f, R2 = 0.f;
    if (!MLA && tid < 8) flag[tid] = 0;
    AT_LOAD(MLA ? 0 : nt - 1);
    AT_WRITE(0);
    __syncthreads();
    for (int it = 0; it < nt; ++it) {
        const int tile = MLA ? it : nt - 1 - it, cb = it & 1, k0 = tile * 64;
        const bool more = it + 1 < nt;
        if (more) AT_LOAD(MLA ? tile + 1 : tile - 1);
        const bool active = MLA ? (k0 <= qw + 31) : (k0 < qw + 31 && !__all(R2 < -160.f));
        if (active) {
            const LAS unsigned char* kb = lds + cb * BUF;
            f32x16 p0, p1;
#pragma unroll
            for (int r = 0; r < 16; ++r) { p0[r] = 0.f; p1[r] = 0.f; }
#pragma unroll
            for (int s = 0; s < NQF; ++s) { const bf16x8 a0 = *(const LAS bf16x8*)(kb + r32 * KSTR + s * 32 + hi * 16), a1 = *(const LAS bf16x8*)(kb + (32 + r32) * KSTR + s * 32 + hi * 16);
                p0 = AT_MFMA(a0, qf[s], p0); p1 = AT_MFMA(a1, qf[s], p1); if ((s & 3) == 3) __builtin_amdgcn_sched_barrier(0); }
            const int dq = qi - k0 - 4 * hi;
            bf16x8 pf0, pf1, pf2, pf3;
            if (MLA) {
                float pm = -3.0e38f;
                if (k0 + 63 > qw) {
#pragma unroll
                    for (int r = 0; r < 16; ++r) { const int c = (r & 3) + 8 * (r >> 2);
                        if (c > dq) p0[r] = -__builtin_inff(); if (c + 32 > dq) p1[r] = -__builtin_inff(); }
                }
#pragma unroll
                for (int r = 0; r < 16; ++r) pm = fmaxf(pm, fmaxf(p0[r], p1[r]));
                pm = fmaxf(pm, __shfl_xor(pm, 32));
                const float mn = fmaxf(m_run, pm), alpha = __builtin_amdgcn_exp2f(m_run - mn); m_run = mn;
                float ps = 0.f;
#pragma unroll
                for (int r = 0; r < 16; ++r) { p0[r] = __builtin_amdgcn_exp2f(p0[r] - mn); p1[r] = __builtin_amdgcn_exp2f(p1[r] - mn); ps += p0[r] + p1[r]; }
                ps += __shfl_xor(ps, 32);
                l_run = l_run * alpha + ps;
                if (__any(alpha < 1.f)) { if (hi == 0) al[r32] = alpha; asm volatile("s_waitcnt lgkmcnt(0)" ::: "memory");
#pragma unroll
                    for (int r = 0; r < 16; ++r) { const float a = al[(r & 3) + 8 * (r >> 2) + 4 * hi];
#pragma unroll
                        for (int d0 = 0; d0 < 4; ++d0) o[d0][r] *= a; } }
                pf0 = packf(p0, 0); pf1 = packf(p0, 1); pf2 = packf(p1, 0); pf3 = packf(p1, 1);
            } else {
                if (k0 + 63 >= qw) {
#pragma unroll
                    for (int r = 0; r < 16; ++r) { const int c = (r & 3) + 8 * (r >> 2); if (c >= dq) p0[r] = -__builtin_inff(); if (c + 32 >= dq) p1[r] = -__builtin_inff(); } }
                float lsum = 0.f; bf16x8 lf[4];
#pragma unroll
                for (int g = 0; g < 4; ++g) {
                    float Lv[8];
#pragma unroll
                    for (int j = 0; j < 8; ++j) { const int r = 8 * (g & 1) + j;
                        const float z = (g < 2 ? p0[r] : p1[r]);
                        const float t = __builtin_amdgcn_logf(1.f + __builtin_amdgcn_exp2f(-fabsf(z)));
                        const float L = -(fmaxf(z, 0.f) + t);
                        const float ls = fminf(z, 0.f) - t;
                        if (g < 2) p0[r] = ls; else p1[r] = ls;
                        Lv[j] = L; lsum += L; }
                    u32x4 w; w.x = pk2(Lv[0], Lv[1]); w.y = pk2(Lv[2], Lv[3]); w.z = pk2(Lv[4], Lv[5]); w.w = pk2(Lv[6], Lv[7]); lf[g] = __builtin_bit_cast(bf16x8, w);
                }
                p0 = AT_MFMA(tri0, lf[0], p0); p0 = AT_MFMA(tri1, lf[1], p0); p0 = AT_MFMA(ones, lf[2], p0); p0 = AT_MFMA(ones, lf[3], p0);
                p1 = AT_MFMA(tri0, lf[2], p1); p1 = AT_MFMA(tri1, lf[3], p1);
#pragma unroll
                for (int r = 0; r < 16; ++r) { p0[r] = __builtin_amdgcn_exp2f(p0[r] + R2); p1[r] = __builtin_amdgcn_exp2f(p1[r] + R2); }
                lsum += __shfl_xor(lsum, 32);
                R2 += lsum;
                pf0 = packf(p0, 0); pf1 = packf(p0, 1); pf2 = packf(p1, 0); pf3 = packf(p1, 1);
            }
            const LAS unsigned char* vb = kb + KT;
#pragma unroll
            for (int d0 = 0; d0 < 4; ++d0) { const LAS unsigned char* vr = vb + (32 * d0 + r32) * VSTR + hi * 16;
                o[d0] = AT_MFMA(pf0, *(const LAS bf16x8*)(vr), o[d0]); o[d0] = AT_MFMA(pf1, *(const LAS bf16x8*)(vr + 32), o[d0]);
                o[d0] = AT_MFMA(pf2, *(const LAS bf16x8*)(vr + 64), o[d0]); o[d0] = AT_MFMA(pf3, *(const LAS bf16x8*)(vr + 96), o[d0]); __builtin_amdgcn_sched_barrier(0); }
        }
        if (more) AT_WRITE(cb ^ 1);
        if (!MLA) { const bool dn = __all(R2 < -160.f); if (lane == 0) flag[wid] = dn ? 1 : 0; }
        __syncthreads();
        if (!MLA) { int all = 1;
#pragma unroll
            for (int w8 = 0; w8 < 8; ++w8) all &= flag[w8];
            if (all) break; }
    }
    if (!MLA) __syncthreads();
    if (MLA) { if (hi == 0) al[r32] = 1.0f / l_run; asm volatile("s_waitcnt lgkmcnt(0)" ::: "memory"); }
    char* Ob = (char*)(WSP(bf16_t, WS_MIXED) + (size_t)(b * SEQ + qw) * 2048 + (MLA ? 1024 : 0) + h * 128);
    const bool odd = (r32 & 1) != 0;
    const unsigned oo = (unsigned)((4 * hi * 2048 + r32) * 2) + (odd ? 4094u : 0u);
#pragma unroll
    for (int q = 0; q < 8; ++q) { const int ra = 2 * q, c = (ra & 3) + 8 * (ra >> 2); const float iva = MLA ? al[c + 4 * hi] : 1.f, ivb = MLA ? al[c + 1 + 4 * hi] : 1.f;
#pragma unroll
        for (int d0 = 0; d0 < 4; ++d0) { const float A = o[d0][ra] * iva, Bv = o[d0][ra + 1] * ivb;
            const float snd = odd ? A : Bv;
            const float rcv = __int_as_float(__builtin_amdgcn_update_dpp(0, __float_as_int(snd), 0xB1, 0xF, 0xF, true));
            const unsigned w = odd ? pk2(rcv, Bv) : pk2(A, rcv);
            *(unsigned*)(Ob + oo + (unsigned)((c * 2048 + d0 * 32) * 2)) = w; } }
    __syncthreads();
#undef AT_LOAD
#undef AT_WRITE
}
__device__ __forceinline__ void conv_queue(const P& p, LAS unsigned char* lds, int* ctr, int max_tiles) {
    constexpr int NM1 = NE * 16 * 16, NM2 = NE * 16 * 8, NMT = NM1 + NM2;
    LAS int* qs = (LAS int*)(lds + LDS_FLAG + 96); LAS unsigned char* Tb = lds + 16384;
    const int tid = threadIdx.x, kq = tid >> 6, nc = tid & 63;
    int pulled = 0;
#define CQ_CAN (max_tiles < 0 || pulled < max_tiles)
#define CQ_PULL(dst) do { __syncthreads(); if (tid == 0) qs[0] = CQ_CAN ? atomicAdd(ctr, 1) : NMT; __syncthreads(); dst = qs[0]; ++pulled; } while (0)
    int t_cur, t_nxt;
    CQ_PULL(t_cur); if (t_cur >= NMT) { __syncthreads(); return; }
    CQ_PULL(t_nxt);
    f32x4 a[4][4];
#define CQ_SRC(t, src, ldw) const float* src; int ldw; { const bool w1_ = (t) < NM1; const int t2_ = w1_ ? (t) : (t) - NM1, e_ = w1_ ? t2_ >> 8 : t2_ >> 7, r_ = w1_ ? t2_ & 255 : t2_ & 127; \
        ldw = w1_ ? 4096 : 2048; const int k0_ = (w1_ ? r_ >> 4 : r_ >> 3) * 128, n0_ = (w1_ ? r_ & 15 : r_ & 7) * 256; \
        src = (w1_ ? p.w1 + (size_t)e_ * 2048 * 4096 : p.w2 + (size_t)e_ * 2048 * 2048) + (size_t)(k0_ + 4 * kq) * ldw + n0_ + 4 * nc; }
#define CQ_LOAD(buf, slab, src, ldw) do { _Pragma("unroll") for (int r_ = 0; r_ < 4; ++r_) a[buf][r_] = __builtin_nontemporal_load((const f32x4*)(src + (size_t)((slab) * 32 + r_) * ldw)); } while (0)
#define CQ_PUT(buf, slab) do { if (cur_w1) { _Pragma("unroll") for (int j_ = 0; j_ < 4; ++j_) { u32x2 d_; d_.x = pk2(a[buf][0][j_], a[buf][1][j_]); d_.y = pk2(a[buf][2][j_], a[buf][3][j_]); \
            *(LAS u32x2*)(Tb + (4 * nc + j_) * 264 + ((slab) * 32 + 4 * kq) * 2) = d_; } } \
        else { _Pragma("unroll") for (int j_ = 0; j_ < 4; ++j_) *(LAS unsigned*)(Tb + (4 * nc + j_) * 132 + ((slab) * 32 + 4 * kq)) = pk4_fp8(a[buf][0][j_] * W8_SCALE, a[buf][1][j_] * W8_SCALE, a[buf][2][j_] * W8_SCALE, a[buf][3][j_] * W8_SCALE); } } while (0)
    { CQ_SRC(t_cur, s0, l0); CQ_LOAD(0, 0, s0, l0); CQ_LOAD(1, 1, s0, l0); CQ_LOAD(2, 2, s0, l0); CQ_LOAD(3, 3, s0, l0); }
    for (int it = 0;; ++it) {
        const bool more = t_nxt < NMT, cur_w1 = t_cur < NM1;
        if (tid == 0) qs[1 + (it & 1)] = (more && CQ_CAN) ? atomicAdd(ctr, 1) : NMT;
        ++pulled;
        CQ_PUT(0, 0); CQ_PUT(1, 1);
        CQ_SRC(t_nxt < NMT ? t_nxt : 0, s1, l1);
        if (more) { CQ_LOAD(0, 0, s1, l1); CQ_LOAD(1, 1, s1, l1); }
        CQ_PUT(2, 2); CQ_PUT(3, 3);
        __syncthreads();
        { const int t2_ = cur_w1 ? t_cur : t_cur - NM1, e_ = cur_w1 ? t2_ >> 8 : t2_ >> 7, r_ = cur_w1 ? t2_ & 255 : t2_ & 127;
          const int k0 = (cur_w1 ? r_ >> 4 : r_ >> 3) * 128, n0 = (cur_w1 ? r_ & 15 : r_ & 7) * 256;
          if (cur_w1) {
              unsigned char* Bt = p.ws + WS_W1_T + (size_t)e_ * 4096 * 2048;
#pragma unroll 1
              for (int ps = 0; ps < 2; ++ps) { const int id = tid + 512 * ps, n = id >> 2, q = id & 3; const LAS u32x2* tp_ = (const LAS u32x2*)(Tb + n * 264 + q * 64);
                  float v[32];
#pragma unroll
                  for (int i = 0; i < 8; ++i) { const u32x2 w = tp_[i]; v[4 * i] = __uint_as_float(w.x << 16); v[4 * i + 1] = __uint_as_float(w.x & 0xffff0000u); v[4 * i + 2] = __uint_as_float(w.y << 16); v[4 * i + 3] = __uint_as_float(w.y & 0xffff0000u); }
                  u32x4 lo, hi; fp6_block(v, lo, hi);
                  unsigned char* dst = Bt + (size_t)DmW1{}(n0 + n) * 2048 + k0 + 16 * q;
                  __builtin_nontemporal_store(lo, (u32x4*)dst); __builtin_nontemporal_store(hi, (u32x4*)(dst + 64)); }
          } else {
              unsigned char* Bt = p.ws + WS_W2_T + (size_t)e_ * 2048 * 2048;
#pragma unroll
              for (int ps = 0; ps < 4; ++ps) { const int n = ps * 64 + (tid >> 3), c = tid & 7; const LAS unsigned* tp_ = (const LAS unsigned*)(Tb + n * 132 + 16 * c);
                  u32x4 w; w.x = tp_[0]; w.y = tp_[1]; w.z = tp_[2]; w.w = tp_[3];
                  __builtin_nontemporal_store(w, (u32x4*)(Bt + (size_t)(n0 + n) * 2048 + k0 + 16 * c)); }
          } }
        __syncthreads();
        if (!more) break;
        CQ_LOAD(2, 2, s1, l1); CQ_LOAD(3, 3, s1, l1);
        t_cur = t_nxt; t_nxt = qs[1 + (it & 1)];
    }
#undef CQ_PULL
#undef CQ_CAN
#undef CQ_SRC
#undef CQ_LOAD
#undef CQ_PUT
    __syncthreads();
}
__device__ __forceinline__ void attn_queues(const P& p, LAS unsigned char* lds, int* ctr) {
    LAS int* qs = (LAS int*)(lds + LDS_FLAG + 64);
    const int tid = threadIdx.x;
    {   if (tid == 0) qs[0] = atomicAdd(ctr, 1);
        __syncthreads();
        int v = qs[0];
        while (v < NB * 8 * 16) {
            __syncthreads();
            if (tid == 0) qs[0] = atomicAdd(ctr, 1);
            const int bh = v & 31, qb = 15 - (v >> 5);
            attn_unit<true>(p, lds, bh >> 3, bh & 7, qb);
            v = qs[0];
        }
        __syncthreads();
    }
    {   if (tid == 0) qs[0] = atomicAdd(ctr + 64, 1);
        __syncthreads();
        int v = qs[0];
        while (v < NB * 8 * 16) {
            __syncthreads();
            if (tid == 0) qs[0] = atomicAdd(ctr + 64, 1);
            const int bh = v & 31, qb = 15 - (v >> 5);
            attn_unit<false>(p, lds, bh >> 3, bh & 7, qb);
            v = qs[0];
        }
        __syncthreads();
    }
}
__device__ __forceinline__ void phase_attn(const P& p, LAS unsigned char* lds, int G, int bid) {
    int* ctr = (int*)(p.ws + WS_CTL + 61440);
    if (MOE_FP8 && ((bid >> 3) & 7) < 3) { conv_queue(p, lds, ctr + 128, -1); attn_queues(p, lds, ctr); }
    else { attn_queues(p, lds, ctr); if (MOE_FP8) conv_queue(p, lds, ctr + 128, -1); }
}
}

__device__ __forceinline__ void phase_normmod(const P& p, const float* x, const float* g, int shift_idx, int scale_idx, bf16_t* out, int G, int bid) { phase_normmod_r(WSP(float, WS_MOD), x, g, shift_idx, scale_idx, out, G, bid); }
template <class Sched>
__device__ __forceinline__ void moe_tables(const P& p, LAS unsigned char* lds, int G, int bid, bool gather, const float* bias, int bias_ld) {
    LAS int* tp = (LAS int*)(lds + LDS_TP); LAS int* cn = (LAS int*)(lds + LDS_CNT); LAS unsigned short* gidx = (LAS unsigned short*)(lds + LDS_GIDX); LAS float* bl = (LAS float*)(lds + LDS_BIAS);
    const int tid = threadIdx.x;
    if (tid < 32) cn[tid] = WSP(int, WS_CNT)[tid];
    __syncthreads();
    if (tid == 0) { int s = 0; for (int e = 0; e < 32; ++e) { tp[e] = s; s += (cn[e] + 255) >> 8; } tp[32] = s; tp[63] = 0; }
    __syncthreads();
    if (tid < 20) { Sched S; S.init(tp, G, bid); pg::Unit u; tp[40 + tid] = S.next(tid, u) ? u.e : 0; }
    __syncthreads();
    if (tid == 0) tp[63] = 1;
    __syncthreads();
    if (bias) {
        Sched S; S.init(tp, G, bid);
        const int t = tid & 255, i0 = tid >> 8;
        float bv[9]; int rv[9]; bool ok[9];
#pragma unroll
        for (int j = 0; j < 9; ++j) { pg::Unit u; u.e = 0; u.pn = 0; u.pm = 0; ok[j] = S.next(i0 + 2 * j, u);
            const size_t bo = ok[j] ? (size_t)u.e * bias_ld + u.pn * 256 + t : 0;
            bv[j] = bias[bo];
            rv[j] = 0;
            if (gather) { const int e_ = ok[j] ? u.e : 0, r = ok[j] ? (u.pm - tp[e_]) * 256 + t : 0; const bool gk = ok[j] && r < cn[e_];
                const int v = WSP(int, WS_ROWTOK)[gk ? (size_t)e_ * NTOK + r : 0]; rv[j] = gk ? (v >> 2) : 0; } }
#pragma unroll
        for (int j = 0; j < 9; ++j) if (ok[j]) { const int i = i0 + 2 * j; bl[i * 256 + t] = bv[j]; if (gather) gidx[i * 256 + t] = (unsigned short)rv[j]; }
        __syncthreads();
    }
}

__global__ void __launch_bounds__(512, 2) mega(P p, int lo, int hi, int bar_idx) {
    extern __shared__ __attribute__((aligned(16))) unsigned char lds_raw[];
    LAS unsigned char* lds = (LAS unsigned char*)lds_raw;
    const int tid = threadIdx.x, G = gridDim.x, bid = blockIdx.x;
    if (tid < 4) ((LAS unsigned*)(lds + LDS_MISC))[tid] = 0u;
    __syncthreads();
    XcdBarrier bar = xcd_barrier_post((unsigned*)(p.ws + WS_CTL) + bar_idx * XCD_BAR_WORDS, (volatile LAS unsigned*)(lds + LDS_MISC));
#define IN(k) (lo <= (k) && (k) < hi)
#define RUN(k, ...) do { __VA_ARGS__; } while (0)
#define SEAM(k) do { if (IN(k) && IN((k) + 1)) xcd_barrier(bar); } while (0)
    if (IN(0)) RUN(0, phase_prologue(p, lds, G, bid));
    SEAM(0);
    if (IN(1)) RUN(1, { phase_cb(p, lds, bid); phase_normmod(p, p.x, p.g_attn, 0, 1, WSP(bf16_t, WS_H), G, bid); });
    SEAM(1);
    if (IN(2)) RUN(2, {
        const bool ch = (G == 256);
        pg::DenseOrder S1; S1.init(64, 12, G, bid, 8, 4); pg::EpiProjMain E1{p};
        pg::DenseOrder S2; S2.init(4, 64, G, bid); pg::EpiVt<false> E2{p, WS_SBVT};
        pg::KropeOrder S3{G, bid}; pg::EpiKropeP E3{p};
        const bf16_t* A2 = WSP(bf16_t, WS_WIN_T) + (size_t)2048 * 2048;
        const char* b2n = nullptr; unsigned q00 = 0, q01 = 0, q10 = 0, q11 = 0; const char* b3n = nullptr; unsigned k00 = 0, k01 = 0, k10 = 0, k11 = 0;
        if (ch) { pg::first_unit_of(S2, WSP(bf16_t, WS_H), 4096, b2n, q00, q01, q10, q11); pg::first_unit_of(S3, WSP(bf16_t, WS_WIN_T), 4096, b3n, k00, k01, k10, k11); }
        pg::gemm_phase<0>(lds, WSP(bf16_t, WS_H), WSP(bf16_t, WS_WIN_T), 4096, S1, E1, nullptr, 0, false, ch, A2, b2n, q00, q01, q10, q11);
        pg::gemm_phase<0>(lds, A2, WSP(bf16_t, WS_H), 4096, S2, E2, nullptr, 0, ch, ch, WSP(bf16_t, WS_H), b3n, k00, k01, k10, k11);
        pg::gemm_phase<0>(lds, WSP(bf16_t, WS_H), WSP(bf16_t, WS_WIN_T), 4096, S3, E3, nullptr, 8, ch, false);
    });
    SEAM(2);
    if (IN(3)) RUN(3, {
        krope_fixup(WSP(float, WS_G_QRAW), WSP(float2, WS_CS), WSP(bf16_t, WS_KROPE), G, bid);
        const bool ch = (G == 256);
        pg::DenseOrder S1; S1.init(64, 6, G, bid); pg::EpiQ E1{p};
        pg::DenseOrder S2; S2.init(64, 4, G, bid); pg::EpiKnope E2{p};
        pg::DenseOrder S3; S3.init(4, 64, G, bid); pg::EpiVt<true> E3{p, WS_VMT};
        const bf16_t* A3 = WSP(bf16_t, WS_WKV_T) + (size_t)1024 * 512;
        const char* b2n = nullptr; unsigned q00 = 0, q01 = 0, q10 = 0, q11 = 0; const char* b3n = nullptr; unsigned k00 = 0, k01 = 0, k10 = 0, k11 = 0;
        if (ch) { pg::first_unit_of(S2, WSP(bf16_t, WS_WKV_T), 1024, b2n, q00, q01, q10, q11); pg::first_unit_of(S3, WSP(bf16_t, WS_KVLAT), 1024, b3n, k00, k01, k10, k11); }
        pg::gemm_phase<0>(lds, WSP(bf16_t, WS_QLAT), WSP(bf16_t, WS_WQ_T), 1024, S1, E1, nullptr, 0, false, ch, WSP(bf16_t, WS_KVLAT), b2n, q00, q01, q10, q11);
        pg::gemm_phase<0>(lds, WSP(bf16_t, WS_KVLAT), WSP(bf16_t, WS_WKV_T), 1024, S2, E2, nullptr, 0, ch, ch, A3, b3n, k00, k01, k10, k11);
        pg::gemm_phase<0>(lds, A3, WSP(bf16_t, WS_KVLAT), 1024, S3, E3, nullptr, 0, ch, false);
        if (MOE_FP8 && G == 256 && bid >= 128) at::conv_queue(p, lds, (int*)(p.ws + WS_CTL + 61440) + 128, 3);
    });
    SEAM(3);
    if (IN(4)) RUN(4, at::phase_attn(p, lds, G, bid));
    SEAM(4);
    if (IN(5)) RUN(5, { pg::DenseOrder S; S.init(64, 8, G, bid); pg::EpiOut E{p};
        pg::gemm_phase<0>(lds, WSP(bf16_t, WS_MIXED), WSP(bf16_t, WS_WOUT_T), 4096, S, E, nullptr); });
    SEAM(5);
    if (IN(6)) phase_route(p, lds, G, bid);
    SEAM(6);
    if (IN(7)) RUN(7, { typedef pg::MoeOrder<16, true> SO; moe_tables<SO>(p, lds, G, bid, true, p.b1, 4096);
        SO S; S.init((const LAS int*)(lds + LDS_TP), G, bid); pg::EpiMoe1 E{p, WS_ACT, (const LAS float*)(lds + LDS_BIAS)};
        pg::gemm_phase<MOE1_FP6 ? 2 : 1>(lds, p.ws + WS_H2, p.ws + WS_W1_T, 2048, S, E, (const LAS int*)(lds + LDS_GIDX)); });
    SEAM(7);
    if (IN(8)) RUN(8, { typedef pg::MoeOrder<8, false> SO; moe_tables<SO>(p, lds, G, bid, false, p.b2, 2048);
        SO S; S.init((const LAS int*)(lds + LDS_TP), G, bid); pg::EpiMoe2 E{p, (const LAS float*)(lds + LDS_BIAS)};
        pg::gemm_phase<1>(lds, p.ws + WS_ACT, p.ws + WS_W2_T, 2048, S, E, nullptr); });
    SEAM(8);
    if (IN(9)) RUN(9, { moe_tables<pg::MoeOrder<8, false> >(p, lds, G, bid, false, nullptr, 0); phase_final(p, lds, G, bid); });
#undef IN
#undef SEAM
}

extern "C" void kernel_launch(void* const* d_in, const int* in_sizes, int n_in, void* d_out, int out_size, void* d_ws, size_t ws_size, hipStream_t stream) {
    if (n_in != 20 || out_size != NTOK * D || ws_size < WS_END2) { fprintf(stderr, "kernel_launch: unexpected shapes (n_in %d out %d ws %zu need %zu)\n", n_in, out_size, ws_size, (size_t)WS_END2); return; }
    P p{};
    p.x = (const float*)d_in[0]; p.c = (const float*)d_in[1]; p.pos = (const int*)d_in[2]; p.g_attn = (const float*)d_in[3]; p.w_mod = (const float*)d_in[4]; p.b_mod = (const float*)d_in[5];
    p.w_in = (const float*)d_in[6]; p.g_q = (const float*)d_in[7]; p.w_q_up = (const float*)d_in[8]; p.g_kv = (const float*)d_in[9]; p.w_kv_up = (const float*)d_in[10]; p.w_out = (const float*)d_in[11];
    p.g_ffn = (const float*)d_in[12]; p.w_router = (const float*)d_in[13]; p.b_router = (const float*)d_in[14]; p.w1 = (const float*)d_in[15]; p.b1 = (const float*)d_in[16]; p.w2 = (const float*)d_in[17];
    p.b2 = (const float*)d_in[18]; p.g_final = (const float*)d_in[19]; p.out = (float*)d_out; p.ws = (unsigned char*)d_ws;
    static int grid = 0;
    if (grid == 0) {
        int dev = 0, cus = 0, per_cu = 0;
        if (hipGetDevice(&dev) != hipSuccess || hipDeviceGetAttribute(&cus, hipDeviceAttributeMultiprocessorCount, dev) != hipSuccess || cus <= 0) cus = 256;
        if (hipFuncSetAttribute((const void*)mega, hipFuncAttributeMaxDynamicSharedMemorySize, LDS_BYTES) != hipSuccess) fprintf(stderr, "kernel_launch: hipFuncSetAttribute failed\n");
        if (hipOccupancyMaxActiveBlocksPerMultiprocessor(&per_cu, (const void*)mega, 512, LDS_BYTES) != hipSuccess || per_cu < 1) fprintf(stderr, "kernel_launch: occupancy query says %d\n", per_cu);
        (void)hipGetLastError();
        grid = cus;
    }
    (void)hipMemsetAsync((char*)d_ws + WS_CTL, 0, 65536, stream);
    mega<<<grid, 512, LDS_BYTES, stream>>>(p, 0, 10, 0);
}
```

```cpp
#include <hip/hip_runtime.h>
#include <stdint.h>
#include <stdio.h>

constexpr int D = 2048, NB = 4, SEQ = 4096, NTOK = NB * SEQ;
constexpr int SBH = 8, DH = 128, SBW = SBH * DH;
constexpr int MH = 8, NOPE = 128, ROPE = 64, VD = 128, QKD = 192, QR = 512, KVR = 512;
constexpr int INW = 3 * SBW + QR + KVR + ROPE;
constexpr int NE = 32, TOPK = 4, DE = 2048;
constexpr int NMOD = 6;
constexpr float EPS = 1e-6f;
constexpr int MAXSLOT = NTOK * TOPK + NE * 256;

typedef unsigned short bf16_t;
typedef float f32x2_t __attribute__((ext_vector_type(2)));
typedef __bf16 bf16x2_t __attribute__((ext_vector_type(2)));

__device__ __forceinline__ float bf2f(bf16_t v) { return __uint_as_float(((unsigned)v) << 16); }
__device__ __forceinline__ unsigned pk2(float a, float b) { f32x2_t v = {a, b}; bf16x2_t r = __builtin_convertvector(v, bf16x2_t); return __builtin_bit_cast(unsigned, r); }
__device__ __forceinline__ bf16_t f2bf(float a) { return (bf16_t)(pk2(a, 0.f) & 0xffffu); }

constexpr size_t al256(size_t x) { return (x + 255) & ~(size_t)255; }
constexpr size_t WS_CTL   = 0;
constexpr size_t WS_MOD   = 65536;
constexpr size_t WS_CS    = WS_MOD + al256((size_t)NB * NMOD * D * 4);
constexpr size_t WS_H     = WS_CS + (size_t)NTOK * 32 * 8;
constexpr size_t WS_SBQ   = WS_H + (size_t)NTOK * D * 2;
constexpr size_t WS_SBK   = WS_SBQ + (size_t)NTOK * SBW * 2;
constexpr size_t WS_SBVT  = WS_SBK + (size_t)NTOK * SBW * 2;
constexpr size_t WS_QLAT  = WS_SBVT + (size_t)NTOK * SBW * 2;
constexpr size_t WS_KVLAT = WS_QLAT + (size_t)NTOK * QR * 2;
constexpr size_t WS_SSQP  = WS_KVLAT + (size_t)NTOK * KVR * 2;
constexpr size_t WS_KROPE = WS_SSQP + (size_t)NTOK * 16 * 4;
constexpr size_t WS_QMLA  = WS_KROPE + (size_t)NTOK * 64 * 2;
constexpr size_t WS_KNOPE = WS_QMLA + (size_t)NTOK * 1536 * 2;
constexpr size_t WS_VMT   = WS_KNOPE + (size_t)NTOK * 1024 * 2;
constexpr size_t WS_MIXED = WS_VMT + (size_t)NTOK * 1024 * 2;
constexpr size_t WS_X1    = WS_MIXED + (size_t)NTOK * D * 2;
constexpr size_t WS_H2    = WS_X1 + (size_t)NTOK * D * 4;
constexpr size_t WS_TOPE  = WS_H2 + (size_t)NTOK * D * 2;
constexpr size_t WS_TOPW  = WS_TOPE + (size_t)NTOK * 4 * 4;
constexpr size_t WS_TPOS  = WS_TOPW + (size_t)NTOK * 4 * 4;
constexpr size_t WS_CNT   = WS_CTL + 62464;
constexpr size_t WS_ROWTOK= WS_TPOS + (size_t)NTOK * 4 * 4;
constexpr size_t WS_ACT   = WS_ROWTOK + (size_t)NE * NTOK * 4;
constexpr size_t WS_Y     = WS_ACT + (size_t)MAXSLOT * DE * 2;
constexpr size_t WS_GTMP  = WS_Y + (size_t)MAXSLOT * D * 2;
constexpr size_t WS_G_QRAW  = WS_GTMP;
constexpr size_t WS_G_KRRAW = WS_G_QRAW + (size_t)NTOK * 1536 * 4;
constexpr size_t WS_G_SLOTTOK = WS_G_KRRAW + (size_t)NTOK * 64 * 4;
constexpr size_t WS_G_SLOTE   = WS_G_SLOTTOK + (size_t)MAXSLOT * 4;
constexpr size_t WS_END   = WS_G_SLOTE + (size_t)MAXSLOT * 4;

struct P {
    const float *x, *c; const int* pos; const float *g_attn, *w_mod, *b_mod, *w_in, *g_q, *w_q_up, *g_kv, *w_kv_up, *w_out, *g_ffn, *w_router, *b_router, *w1, *b1, *w2, *b2, *g_final;
    float* out; unsigned char* ws;
};
#define WSP(T, off) ((T*)(p.ws + (off)))


#define LAS __attribute__((address_space(3)))
typedef short bf16x8 __attribute__((ext_vector_type(8)));
typedef float f32x4 __attribute__((ext_vector_type(4)));
typedef float f32x16 __attribute__((ext_vector_type(16)));
typedef unsigned u32x4 __attribute__((ext_vector_type(4)));
typedef unsigned u32x2 __attribute__((ext_vector_type(2)));
typedef int i32x8 __attribute__((ext_vector_type(8)));
typedef int i32x4 __attribute__((ext_vector_type(4)));
constexpr bool MOE_FP8 = true;
constexpr float W8_SCALE = 256.f, W8_INV = 1.f / 256.f;
typedef __bf16 bf16x32_t __attribute__((ext_vector_type(32)));
typedef unsigned u32x6 __attribute__((ext_vector_type(6)));
typedef unsigned u32x16 __attribute__((ext_vector_type(16)));
constexpr bool Y_FP8 = true;
constexpr float Y_SCALE = 32.f;
constexpr bool MOE1_FP6 = true;
__device__ __forceinline__ void fp6_block(const float (&v)[32], u32x4& out_lo, u32x4& out_hi) {
    float amax = 0.f;
#pragma unroll
    for (int i = 0; i < 32; ++i) amax = fmaxf(amax, fabsf(v[i]));
    int e = (int)((__float_as_uint(amax) >> 23) & 0xffu) - 127 - 2;
    if (amax * __uint_as_float((unsigned)(127 - e) << 23) > 7.5f) e += 1;
    e = e < -120 ? -120 : e;
    const float inv = __uint_as_float((unsigned)(127 - e) << 23);
    u32x16 w;
#pragma unroll
    for (int i = 0; i < 16; ++i) w[i] = pk2(v[2 * i] * inv, v[2 * i + 1] * inv);
    const u32x6 c = __builtin_amdgcn_cvt_scalef32_pk32_fp6_bf16(__builtin_bit_cast(bf16x32_t, w), 1.0f);
    out_lo.x = c[0]; out_lo.y = c[1]; out_lo.z = c[2]; out_lo.w = c[3];
    out_hi.x = c[4]; out_hi.y = c[5]; out_hi.z = (unsigned)(e + 127); out_hi.w = 0u;
}

__device__ __forceinline__ unsigned pk4_fp8(float a, float b, float c, float d) { int w = 0; w = __builtin_amdgcn_cvt_pk_fp8_f32(a, b, w, false); w = __builtin_amdgcn_cvt_pk_fp8_f32(c, d, w, true); return (unsigned)w; }

constexpr size_t WS_WIN_T  = WS_END;
constexpr size_t WS_WQ_T   = WS_WIN_T + (size_t)4352 * 2048 * 2;
constexpr size_t WS_WKV_T  = WS_WQ_T + (size_t)1536 * 512 * 2;
constexpr size_t WS_WOUT_T = WS_WKV_T + (size_t)2048 * 512 * 2;
constexpr size_t WS_W1_T   = WS_WOUT_T + (size_t)2048 * 2048 * 2;
constexpr size_t WS_W2_T   = WS_W1_T + (size_t)NE * 4096 * 2048 * 2;
constexpr size_t WS_WR_HI  = WS_W2_T + (size_t)NE * 2048 * 2048 * 2;
constexpr size_t WS_WR_LO  = WS_WR_HI + (size_t)32 * 2048 * 2;
constexpr size_t WS_CB     = WS_WR_LO + (size_t)32 * 2048 * 2;
constexpr size_t WS_END2   = WS_CB + 512;

#define XB_TMO      128
#define XB_XCNT(j)  (256  + 64 * (j))
#define XB_XSUB(j)  (1280 + 64 * (j))
#define XB_XGEN(j)  (2304 + 64 * (j))
#define XB_TOP      3328
#define XB_TOPGEN   3392
#define XCD_BAR_WORDS 3456
#define XB_SPIN_CAP (1u << 18)
__device__ __forceinline__ unsigned xb_ld(unsigned* p)              { return __hip_atomic_load(p, __ATOMIC_RELAXED, __HIP_MEMORY_SCOPE_AGENT); }
__device__ __forceinline__ unsigned xb_add(unsigned* p, unsigned v) { return __hip_atomic_fetch_add(p, v, __ATOMIC_RELAXED, __HIP_MEMORY_SCOPE_AGENT); }
__device__ __forceinline__ unsigned xb_xcc_id() { return (unsigned)__builtin_amdgcn_s_getreg((3 << 11) | 20) & 0xFu; }
#define XB_SPIN(cond, bar) do { unsigned _sp = 0; while (cond) { __builtin_amdgcn_s_sleep(1); \
    if ((++_sp & 255u) == 0u) { if (xb_ld(&(bar)[XB_TMO])) break; if (_sp > XB_SPIN_CAP) { atomicAdd(&(bar)[XB_TMO], 1u); break; } } } } while (0)
struct XcdBarrier { unsigned* bar; unsigned x; volatile LAS unsigned* st; };
__device__ __forceinline__ XcdBarrier xcd_barrier_post(unsigned* bar, volatile LAS unsigned* st) {
    XcdBarrier b; b.bar = bar; b.x = xb_xcc_id(); b.st = st;
    if (threadIdx.x == 0) (void)xb_add(&bar[XB_XCNT(b.x)], 1u);
    return b;
}
__device__ __forceinline__ void xcd_barrier_complete(unsigned* bar, unsigned x, unsigned& nloc, unsigned& nx) {
    const unsigned G = gridDim.x * gridDim.y * gridDim.z;
    unsigned sum, cnt, mine, sp = 0u;
    for (;;) {
        sum = 0u; cnt = 0u; mine = 0u;
#pragma unroll
        for (unsigned j = 0; j < 16; ++j) { const unsigned c = xb_ld(&bar[XB_XCNT(j)]); sum += c; cnt += (c > 0u) ? 1u : 0u; mine = (j == x) ? c : mine; }
        if (sum == G) break;
        __builtin_amdgcn_s_sleep(1);
        if ((++sp & 255u) == 0u) { if (xb_ld(&bar[XB_TMO])) break; if (sp > XB_SPIN_CAP) { atomicAdd(&bar[XB_TMO], 1u); break; } }
    }
    nloc = mine > 0u ? mine : 1u; nx = cnt > 0u ? cnt : 1u;
}
__device__ __forceinline__ void xcd_barrier(const XcdBarrier& b) {
    asm volatile("s_waitcnt vmcnt(0)" ::: "memory");
    __syncthreads();
    if (threadIdx.x == 0) {
        unsigned* bar = b.bar;
        __builtin_amdgcn_s_waitcnt(0);
        unsigned nloc = b.st[0], nx = b.st[1];
        if (nloc == 0u) { xcd_barrier_complete(bar, b.x, nloc, nx); b.st[0] = nloc; b.st[1] = nx; }
        const unsigned old = xb_add(&bar[XB_XSUB(b.x)], 1u);
        const unsigned gen = old / nloc;
        if (old + 1u == (gen + 1u) * nloc) {
            __builtin_amdgcn_fence(__ATOMIC_RELEASE, "agent");
            asm volatile("s_waitcnt vmcnt(0)" ::: "memory");
            const unsigned og = xb_add(&bar[XB_TOP], 1u);
            const unsigned tg = og / nx;
            if (og + 1u == (tg + 1u) * nx) xb_add(&bar[XB_TOPGEN], 1u);
            else XB_SPIN(xb_ld(&bar[XB_TOPGEN]) == tg, bar);
            __builtin_amdgcn_fence(__ATOMIC_ACQUIRE, "agent");
            xb_add(&bar[XB_XGEN(b.x)], 1u);
            asm volatile("s_waitcnt vmcnt(0)" ::: "memory");
        } else {
            XB_SPIN(xb_ld(&bar[XB_XGEN(b.x)]) == gen, bar);
            __builtin_amdgcn_fence(__ATOMIC_ACQUIRE, "agent");
            asm volatile("s_waitcnt vmcnt(0)" ::: "memory");
        }
    }
    __syncthreads();
}

constexpr int LDS_STAGE = 0;
constexpr int LDS_GIDX  = 131072;
constexpr int LDS_BIAS  = LDS_GIDX + 9216;
constexpr int LDS_TP    = LDS_BIAS + 18432;
constexpr int LDS_CNT   = LDS_TP + 256;
constexpr int LDS_MISC  = LDS_CNT + 128;
constexpr int LDS_BYTES = LDS_MISC + 128;

namespace pg {
constexpr int BM = 256, BK = 64, HALF = 128, HTB = HALF * BK * 2, STAGE_BYTES = 8 * HTB, NXCD = 8, WGM = 8;
__device__ __forceinline__ int lds_byte(int r, int c) { const int st = (r >> 4) * 2 + (c >> 5), rr = r & 15, cc = c & 31, ob = rr * 64 + cc * 2; return st * 1024 + (ob ^ (((ob >> 9) & 1) << 5)); }
__device__ __forceinline__ void stage_rc(int b, int& R, int& C) { const int st = b / 1024, sb = b % 1024, swz = sb ^ (((sb >> 9) & 1) << 5); R = (st >> 1) * 16 + swz / 64; C = (st & 1) * 32 + (swz % 64) / 2; }
__device__ __forceinline__ int perm32(int rho) { const int n = rho >> 4, i = rho & 15; return 8 * (i >> 2) + 4 * n + (i & 3); }

struct Unit { int pm, pn, pb, e, ko, ui; };
struct DenseOrder {
    int nM, nN, nwg, G, c, skip_from, skip_by;
    __device__ void init(int nM_, int nN_, int G_, int c_, int sf = 1 << 30, int sb = 0) { nM = nM_; nN = nN_; nwg = nM * nN; G = G_; c = c_; skip_from = sf; skip_by = sb; }
    __device__ bool next(int i, Unit& u) const {
        const long L = (long)i * G + c; if (L >= nwg) return false;
        int wgid = (int)L; { const int q = nwg / NXCD, r = nwg % NXCD, xcd = wgid % NXCD, off = wgid / NXCD; wgid = (xcd < r ? xcd * (q + 1) : r * (q + 1) + (xcd - r) * q) + off; }
        const int nig = WGM * nN, gid = wgid / nig, fm = gid * WGM, gsz = (nM - fm) < WGM ? (nM - fm) : WGM;
        u.pm = fm + ((wgid % nig) % gsz); u.pn = (wgid % nig) / gsz; u.pb = u.pn >= skip_from ? u.pn + skip_by : u.pn; u.e = 0; u.ko = 0; u.ui = i; return true;
    }
    __device__ __forceinline__ unsigned arow(const Unit& u, int h, int R, int, const LAS int*) const { return (unsigned)(u.pm * 256 + h * 128 + R); }
};

template <int FPM  , class Epi, class Sched>
__device__ __forceinline__ void gemm_phase(LAS unsigned char* lds, const void* A, const void* Bt, const int RB  , const Sched& S, const Epi& E, const LAS int* gidx, const int nt_ = 0  ,
        const bool primed = false  , const bool chain = false  ,
        const void* cA = nullptr, const char* cBn = nullptr, const unsigned c00 = 0, const unsigned c01 = 0, const unsigned c10 = 0, const unsigned c11 = 0) {
    constexpr bool FP8 = FPM != 0;
    const int tid = threadIdx.x, wid = __builtin_amdgcn_readfirstlane(tid >> 6), lane = tid & 63, wr = wid >> 2, wc = wid & 3, fr = lane & 15, fq = lane >> 4;
    const int nt = nt_ ? nt_ : RB / (BK * 2);
    unsigned voffB[2];
#pragma unroll
    for (int i = 0; i < 2; ++i) { int R_, C_; stage_rc(tid * 16 + i * 8192, R_, C_); const int Rb = Epi::PERM ? ((R_ & ~31) + perm32(R_ & 31)) : R_; voffB[i] = (unsigned)(Rb * RB + C_ * 2); }
    const size_t kstep = (size_t)(BK * 2);
    const size_t hstep = (size_t)HALF * RB;
    const size_t tstep = 2 * hstep;
    const unsigned ldsw = (unsigned)wid * 1024u;
    const unsigned lds0 = __builtin_amdgcn_readfirstlane((unsigned)(size_t)lds + ldsw);
    const int aoff = lds_byte(wr * 64 + fr, fq * 8), boff = lds_byte(wc * 32 + fr, fq * 8);
#define PG_SA(b, h) (((b) * 2 + (h)) * HTB)
#define PG_SB(b, h) ((4 + (b) * 2 + (h)) * HTB)
#define PG_DMA(voff_, sbase_, ldsoff_) asm volatile("s_mov_b32 m0, %2\n\ts_nop 0\n\tglobal_load_lds_dwordx4 %0, %1" :: "v"(voff_), "s"(sbase_), "s"(ldsoff_) : "memory", "m0")
#define PG_STAGE_B(bufoff, gbase) do { const char* _sb = (const char*)(gbase); _Pragma("unroll") for (int _i = 0; _i < 2; ++_i) \
        PG_DMA(voffB[_i], _sb, lds0 + (unsigned)((bufoff) + _i * 8192)); } while (0)
#define PG_STAGE_A(bufoff, usenext, h, kb) do { const char* _sa = Ab + (size_t)(kb); _Pragma("unroll") for (int _i = 0; _i < 2; ++_i) { const unsigned _o = rac[h][_i]; \
        PG_DMA(_o, _sa, lds0 + (unsigned)((bufoff) + _i * 8192)); } } while (0)
#define PG_LDA(dst, b, h) do { _Pragma("unroll") for (int m = 0; m < 4; ++m) { if constexpr (FP8) { const i32x4 lo_ = *(const LAS i32x4*)(lds + PG_SA(b, h) + aoff + m * 2048), hi_ = *(const LAS i32x4*)(lds + PG_SA(b, h) + aoff + m * 2048 + 1024); dst##8[m] = __builtin_shufflevector(lo_, hi_, 0, 1, 2, 3, 4, 5, 6, 7); } \
        else { _Pragma("unroll") for (int k = 0; k < 2; ++k) dst[m][k] = *(const LAS bf16x8*)(lds + PG_SA(b, h) + aoff + m * 2048 + k * 1024); } } } while (0)
#define PG_LDB(dst, b, h) do { _Pragma("unroll") for (int n = 0; n < 2; ++n) { if constexpr (FP8) { const i32x4 lo_ = *(const LAS i32x4*)(lds + PG_SB(b, h) + boff + n * 2048), hi_ = *(const LAS i32x4*)(lds + PG_SB(b, h) + boff + n * 2048 + 1024); dst##8[n] = __builtin_shufflevector(lo_, hi_, 0, 1, 2, 3, 4, 5, 6, 7); } \
        else { _Pragma("unroll") for (int k = 0; k < 2; ++k) dst[n][k] = *(const LAS bf16x8*)(lds + PG_SB(b, h) + boff + n * 2048 + k * 1024); } } } while (0)
#define PG_MMA(ai, bj, At, Bt_) do { __builtin_amdgcn_s_setprio(1); _Pragma("unroll") for (int m = 0; m < 4; ++m) _Pragma("unroll") for (int n = 0; n < 2; ++n) { \
        if constexpr (FPM == 2) { acc[ai][bj][m][n] = __builtin_amdgcn_mfma_scale_f32_16x16x128_f8f6f4(Bt_##8[n], At##8[m], acc[ai][bj][m][n], 2, 2, 0, Bt_##8[n][6], 0, At##8[m][6]); } \
        else if constexpr (FPM == 1) { acc[ai][bj][m][n] = __builtin_amdgcn_mfma_scale_f32_16x16x128_f8f6f4(Bt_##8[n], At##8[m], acc[ai][bj][m][n], 0, 0, 0, 0x7F7F7F7F, 0, 0x7F7F7F7F); } \
        else { _Pragma("unroll") for (int k = 0; k < 2; ++k) acc[ai][bj][m][n] = __builtin_amdgcn_mfma_f32_16x16x32_bf16(Bt_[n][k], At[m][k], acc[ai][bj][m][n], 0, 0, 0); } } \
        __builtin_amdgcn_s_setprio(0); } while (0)
#define PG_WAIT_V(n) asm volatile("s_waitcnt vmcnt(" #n ")" ::: "memory")
#define PG_WAIT_L(n) asm volatile("s_waitcnt lgkmcnt(" #n ")" ::: "memory")
#define PG_WAIT_VN(n) asm volatile("s_waitcnt vmcnt(%0)" :: "n"(n) : "memory")
#define PG_KPAIR(t, WV_) do { \
            const bool last = (t == nt - 2); \
            const size_t kb1 = (size_t)(t + 1) * kstep; \
            const size_t kb2 = last ? 0 : (size_t)(t + 2) * kstep, kb3 = kb2 + kstep; \
            const char* b2 = last ? nB : cB + (size_t)(t + 2) * kstep; const char* b3 = b2 + kstep; \
            PG_LDB(B0, 0, 0); PG_LDB(B1, 0, 1); PG_SCHED; PG_LDA(At, 0, 0); PG_STAGE_A(PG_SA(1, 1), false, 1, kb1); \
            if (last) { if (has_next) { PG_RA(rac, nxt, ui + 1); } else if (chain) { rac[0][0] = c00; rac[0][1] = c01; rac[1][0] = c10; rac[1][1] = c11; Ab = (const char*)cA; } } \
            PG_WAIT_VN(WV_); PG_WAIT_L(0); PG_BAR; PG_MMA(0, 0, At, B0); PG_MMA(0, 1, At, B1); PG_BAR; PG_SCHED; \
            PG_LDA(At, 0, 1); PG_STAGE_B(PG_SB(0, 0), b2); PG_STAGE_B(PG_SB(0, 1), b2 + hstep); PG_STAGE_A(PG_SA(0, 0), last, 0, kb2); \
            PG_WAIT_VN(WV_); PG_WAIT_L(0); PG_BAR; PG_MMA(1, 0, At, B0); PG_MMA(1, 1, At, B1); PG_BAR; PG_SCHED; \
            PG_LDB(B0, 1, 0); PG_LDB(B1, 1, 1); PG_SCHED; PG_LDA(At, 1, 0); PG_STAGE_A(PG_SA(0, 1), last, 1, kb2); \
            PG_WAIT_V(8); PG_WAIT_L(0); PG_BAR; PG_MMA(0, 0, At, B0); PG_MMA(0, 1, At, B1); PG_BAR; PG_SCHED; \
            PG_LDA(At, 1, 1); PG_STAGE_B(PG_SB(1, 0), b3); PG_STAGE_B(PG_SB(1, 1), b3 + hstep); PG_STAGE_A(PG_SA(1, 0), last, 0, kb3); \
            PG_WAIT_V(8); PG_WAIT_L(0); PG_BAR; PG_MMA(1, 0, At, B0); PG_MMA(1, 1, At, B1); PG_BAR; PG_SCHED; \
        } while (0)
#define PG_BAR __builtin_amdgcn_s_barrier()
#define PG_SCHED __builtin_amdgcn_sched_barrier(0)
#define PG_RA(dst, u, ui_) do { _Pragma("unroll") for (int _i = 0; _i < 2; ++_i) { int R_, C_; stage_rc(tid * 16 + _i * 8192, R_, C_); _Pragma("unroll") for (int _h = 0; _h < 2; ++_h) dst[_h][_i] = S.arow(u, _h, R_, ui_, gidx) * (unsigned)RB + (unsigned)C_ * 2u + (unsigned)u.ko; } } while (0)
    Unit cur, nxt; int ui = 0;
    if (!S.next(0, cur)) return;
    f32x4 acc[2][2][4][2];
#pragma unroll
    for (int a = 0; a < 2; ++a)
#pragma unroll
        for (int b = 0; b < 2; ++b)
#pragma unroll
            for (int m = 0; m < 4; ++m)
#pragma unroll
                for (int n = 0; n < 2; ++n) acc[a][b][m][n] = (f32x4){0.f, 0.f, 0.f, 0.f};
    bf16x8 At[4][2], B0[2][2], B1[2][2]; i32x8 At8[4], B08[2], B18[2];
    unsigned rac[2][2];
    PG_RA(rac, cur, 0);
    const char* Ab = (const char*)A;
    const char* cB = (const char*)Bt + (size_t)cur.pb * tstep + cur.ko;
    if (!primed) {
    PG_STAGE_B(PG_SB(0, 0), cB); PG_STAGE_B(PG_SB(0, 1), cB + hstep); PG_STAGE_A(PG_SA(0, 0), false, 0, 0); PG_STAGE_A(PG_SA(0, 1), false, 1, 0);
    if (wr == 1) PG_BAR;
    PG_WAIT_V(2); PG_BAR;
    PG_STAGE_B(PG_SB(1, 0), cB + kstep); PG_STAGE_A(PG_SA(1, 0), false, 0, kstep); PG_STAGE_B(PG_SB(1, 1), cB + hstep + kstep);
    PG_WAIT_V(6); PG_BAR;
    }
    for (;;) {
        const bool has_next = S.next(ui + 1, nxt);
        const char* nB = has_next ? (const char*)Bt + (size_t)nxt.pb * tstep + nxt.ko : (chain ? cBn : cB);
        int t0 = 0;
        if (Epi::NST > 0 && ui > 0) { PG_KPAIR(0, 8 + Epi::NST); t0 = 2; }
        for (int t = t0; t < nt; t += 2) PG_KPAIR(t, 8);
        E(acc, cur, wr, wc, fr, fq);
        if (!has_next) break;
#pragma unroll
        for (int a = 0; a < 2; ++a)
#pragma unroll
            for (int b = 0; b < 2; ++b)
#pragma unroll
                for (int m = 0; m < 4; ++m)
#pragma unroll
                    for (int n = 0; n < 2; ++n) acc[a][b][m][n] = (f32x4){0.f, 0.f, 0.f, 0.f};
        cur = nxt; cB = nB; ++ui;
    }
    if (!chain) {
    PG_WAIT_V(0);
    if (wr == 0) PG_BAR;
    PG_BAR;
    }
#undef PG_SA
#undef PG_SB
#undef PG_STAGE_A
#undef PG_STAGE_B
#undef PG_DMA
#undef PG_LDA
#undef PG_LDB
#undef PG_MMA
#undef PG_WAIT_V
#undef PG_WAIT_L
#undef PG_WAIT_VN
#undef PG_KPAIR
#undef PG_BAR
#undef PG_SCHED
#undef PG_RA
}

template <class Sched>
__device__ __forceinline__ void first_unit_of(const Sched& S, const void* Bt, const int RB, const char*& cB, unsigned& r00, unsigned& r01, unsigned& r10, unsigned& r11) {
    Unit u; u.pm = 0; u.pn = 0; u.pb = 0; u.e = 0; u.ko = 0; u.ui = 0; S.next(0, u);
    const int tid = threadIdx.x; int R0, C0, R1, C1; stage_rc(tid * 16, R0, C0); stage_rc(tid * 16 + 8192, R1, C1);
    r00 = S.arow(u, 0, R0, 0, nullptr) * (unsigned)RB + (unsigned)C0 * 2u + (unsigned)u.ko; r01 = S.arow(u, 0, R1, 0, nullptr) * (unsigned)RB + (unsigned)C1 * 2u + (unsigned)u.ko;
    r10 = S.arow(u, 1, R0, 0, nullptr) * (unsigned)RB + (unsigned)C0 * 2u + (unsigned)u.ko; r11 = S.arow(u, 1, R1, 0, nullptr) * (unsigned)RB + (unsigned)C1 * 2u + (unsigned)u.ko;
    cB = (const char*)Bt + (size_t)u.pb * (2 * (size_t)HALF * RB) + u.ko;
}
__device__ __forceinline__ u32x4 pack8(const f32x4 a, const f32x4 b, float s) { u32x4 w; w.x = pk2(a[0] * s, a[1] * s); w.y = pk2(a[2] * s, a[3] * s); w.z = pk2(b[0] * s, b[1] * s); w.w = pk2(b[2] * s, b[3] * s); return w; }
typedef f32x4 Acc[2][2][4][2];

__device__ __forceinline__ float rstd_from(const float* ssq8) { const f32x4 a0 = *(const f32x4*)ssq8, a1 = *(const f32x4*)(ssq8 + 4);
    return 1.0f / sqrtf(((a0[0] + a0[1]) + (a0[2] + a0[3]) + (a1[0] + a1[1]) + (a1[2] + a1[3])) * (1.f / 512.f) + EPS); }
struct EpiProjMain {
    static constexpr bool PERM = true; static constexpr int NST = 0; P p;
    __device__ __forceinline__ void operator()(const Acc& acc, const Unit& u, int wr, int wc, int fr, int fq) const {
        const int row0 = u.pm * 256 + wr * 64 + fr;
        if (u.pn < 8) {
            bf16_t* base = WSP(bf16_t, u.pn < 4 ? WS_SBQ : WS_SBK); const float sc = u.pn < 4 ? 0.08838834764831845f * 1.4426950408889634f : 1.f;    const int col0 = (u.pn & 3) * 256 + wc * 32 + 8 * fq;
#pragma unroll
            for (int ai = 0; ai < 2; ++ai)
#pragma unroll
                for (int m = 0; m < 4; ++m) { bf16_t* rp = base + (size_t)(row0 + ai * 128 + m * 16) * 1024 + col0;
#pragma unroll
                    for (int bj = 0; bj < 2; ++bj) *(u32x4*)(rp + bj * 128) = pack8(acc[ai][bj][m][0], acc[ai][bj][m][1], sc); }
        } else {
            const int lat = (u.pn - 8) >> 1, ct = (u.pn - 8) & 1; bf16_t* base = WSP(bf16_t, lat ? WS_KVLAT : WS_QLAT); const int col0 = ct * 256 + wc * 32 + 8 * fq;
            float* ssqp = WSP(float, WS_SSQP);
#pragma unroll
            for (int ai = 0; ai < 2; ++ai)
#pragma unroll
                for (int m = 0; m < 4; ++m) { const int row = row0 + ai * 128 + m * 16; bf16_t* rp = base + (size_t)row * 512 + col0; float s = 0.f;
#pragma unroll
                    for (int bj = 0; bj < 2; ++bj) { *(u32x4*)(rp + bj * 128) = pack8(acc[ai][bj][m][0], acc[ai][bj][m][1], 1.f);
#pragma unroll
                        for (int n = 0; n < 2; ++n) { const f32x4 v = acc[ai][bj][m][n]; s += (v[0] * v[0] + v[1] * v[1]) + (v[2] * v[2] + v[3] * v[3]); } }
                    s += __shfl_xor(s, 16); s += __shfl_xor(s, 32);
                    if (fq == 0) ssqp[(size_t)row * 16 + lat * 8 + ct * 4 + wc] = s; }
        }
    }
};
template <bool SCALE>
__device__ __forceinline__ void epi_vt_r(const Acc& acc, const float* __restrict__ ssqp, bf16_t* __restrict__ dst, int f0, int tokb) {
#pragma unroll
    for (int bj = 0; bj < 2; ++bj) {
        const int tok0 = tokb + bj * 128, b = tok0 / SEQ, s0 = tok0 % SEQ;
        float sc[8];
#pragma unroll
        for (int j = 0; j < 8; ++j) sc[j] = SCALE ? rstd_from(ssqp + (size_t)(tok0 + j) * 16 + 8) : 1.f;
#pragma unroll
        for (int ai = 0; ai < 2; ++ai)
#pragma unroll
            for (int m = 0; m < 4; ++m) { const int f = f0 + ai * 128 + m * 16, h = f >> 7, d = f & 127;
                const f32x4 v0 = acc[ai][bj][m][0], v1 = acc[ai][bj][m][1]; u32x4 w;
                w.x = pk2(v0[0] * sc[0], v0[1] * sc[1]); w.y = pk2(v0[2] * sc[2], v0[3] * sc[3]); w.z = pk2(v1[0] * sc[4], v1[1] * sc[5]); w.w = pk2(v1[2] * sc[6], v1[3] * sc[7]);
                *(u32x4*)(dst + ((size_t)(b * 8 + h) * 128 + d) * SEQ + s0) = w; }
    }
}
template <bool SCALE> struct EpiVt {
    static constexpr bool PERM = true; static constexpr int NST = 0; P p; size_t dst_off;
    __device__ __forceinline__ void operator()(const Acc& acc, const Unit& u, int wr, int wc, int fr, int fq) const {
        epi_vt_r<SCALE>(acc, WSP(float, WS_SSQP), WSP(bf16_t, dst_off), u.pm * 256 + wr * 64 + fr, u.pn * 256 + wc * 32 + 8 * fq);
    }
};
__device__ __forceinline__ void epi_krope_r(const Acc& acc, const float2* __restrict__ cs, bf16_t* __restrict__ dst, int row0, int col0) {
#pragma unroll
    for (int ai = 0; ai < 2; ++ai) {
        f32x4 cv[4][2];
#pragma unroll
        for (int m = 0; m < 4; ++m) { const float2* cr = cs + (size_t)(row0 + ai * 128 + m * 16) * 32 + (col0 >> 1); cv[m][0] = *(const f32x4*)cr; cv[m][1] = *(const f32x4*)(cr + 2); }
        asm volatile("" ::: "memory");
#pragma unroll
        for (int m = 0; m < 4; ++m) { const int row = row0 + ai * 128 + m * 16; const f32x4 v0 = acc[ai][0][m][0], v1 = acc[ai][0][m][1], c0 = cv[m][0], c1 = cv[m][1];
            u32x4 w; w.x = pk2(v0[0] * c0[0] - v0[1] * c0[1], v0[1] * c0[0] + v0[0] * c0[1]); w.y = pk2(v0[2] * c0[2] - v0[3] * c0[3], v0[3] * c0[2] + v0[2] * c0[3]);
            w.z = pk2(v1[0] * c1[0] - v1[1] * c1[1], v1[1] * c1[0] + v1[0] * c1[1]); w.w = pk2(v1[2] * c1[2] - v1[3] * c1[3], v1[3] * c1[2] + v1[2] * c1[3]);
            *(u32x4*)(dst + (size_t)row * 64 + col0) = w; }
        asm volatile("" ::: "memory");
    }
}
struct EpiKrope {
    static constexpr bool PERM = true; static constexpr int NST = 0; P p;
    __device__ __forceinline__ void operator()(const Acc& acc, const Unit& u, int wr, int wc, int fr, int fq) const {
        if (wc >= 2) return;
        epi_krope_r(acc, WSP(float2, WS_CS), WSP(bf16_t, WS_KROPE), u.pm * 256 + wr * 64 + fr, wc * 32 + 8 * fq);
    }
};

__device__ __forceinline__ void epi_q_r(const Acc& acc, const float* __restrict__ ssqp, const float2* __restrict__ cs, bf16_t* __restrict__ dst, int row0, int cbase) {
    const int j0 = cbase % 192, j1 = (cbase + 128) % 192; const bool rp0 = j0 >= 128, rp1 = j1 >= 128; const int i00 = rp0 ? (j0 - 128) >> 1 : 0, i01 = rp1 ? (j1 - 128) >> 1 : 0;
#pragma unroll
    for (int qq = 0; qq < 4; ++qq) {
        f32x4 ca0[2], ca1[2], cb0[2], cb1[2]; float rsv[2];
#pragma unroll
        for (int h = 0; h < 2; ++h) { const int q = 2 * qq + h, ai = q >> 2, m = q & 3, row = row0 + ai * 128 + m * 16; const float2* cr = cs + (size_t)row * 32;
            ca0[h] = *(const f32x4*)(cr + i00); ca1[h] = *(const f32x4*)(cr + i00 + 2); cb0[h] = *(const f32x4*)(cr + i01); cb1[h] = *(const f32x4*)(cr + i01 + 2);
            rsv[h] = rstd_from(ssqp + (size_t)row * 16) * (0.07216878364870322f * 1.4426950408889634f); }
        asm volatile("" ::: "memory");
#pragma unroll
        for (int h = 0; h < 2; ++h) { const int q = 2 * qq + h, ai = q >> 2, m = q & 3, row = row0 + ai * 128 + m * 16;
#pragma unroll
            for (int bj = 0; bj < 2; ++bj) { const bool rp = bj ? rp1 : rp0;
                f32x4 v0 = acc[ai][bj][m][0] * rsv[h], v1 = acc[ai][bj][m][1] * rsv[h];
                if (rp) { const f32x4 c0v = bj ? cb0[h] : ca0[h], c1v = bj ? cb1[h] : ca1[h], t0 = v0, t1 = v1;
                    v0[0] = t0[0] * c0v[0] - t0[1] * c0v[1]; v0[1] = t0[1] * c0v[0] + t0[0] * c0v[1]; v0[2] = t0[2] * c0v[2] - t0[3] * c0v[3]; v0[3] = t0[3] * c0v[2] + t0[2] * c0v[3];
                    v1[0] = t1[0] * c1v[0] - t1[1] * c1v[1]; v1[1] = t1[1] * c1v[0] + t1[0] * c1v[1]; v1[2] = t1[2] * c1v[2] - t1[3] * c1v[3]; v1[3] = t1[3] * c1v[2] + t1[2] * c1v[3]; }
                *(u32x4*)(dst + (size_t)row * 1536 + cbase + bj * 128) = pack8(v0, v1, 1.f); } }
        asm volatile("" ::: "memory");
    }
}
struct EpiQ {
    static constexpr bool PERM = true; static constexpr int NST = 0; P p;
    __device__ __forceinline__ void operator()(const Acc& acc, const Unit& u, int wr, int wc, int fr, int fq) const {
        epi_q_r(acc, WSP(float, WS_SSQP), WSP(float2, WS_CS), WSP(bf16_t, WS_QMLA), u.pm * 256 + wr * 64 + fr, u.pn * 256 + wc * 32 + 8 * fq);
    }
};
__device__ __forceinline__ void epi_knope_r(const Acc& acc, const float* __restrict__ ssqp, bf16_t* __restrict__ dst, int row0, int c0) {
    float rs[2][4];
#pragma unroll
    for (int ai = 0; ai < 2; ++ai)
#pragma unroll
        for (int m = 0; m < 4; ++m) rs[ai][m] = rstd_from(ssqp + (size_t)(row0 + ai * 128 + m * 16) * 16 + 8);
    asm volatile("" ::: "memory");
#pragma unroll
    for (int ai = 0; ai < 2; ++ai)
#pragma unroll
        for (int m = 0; m < 4; ++m) { const int row = row0 + ai * 128 + m * 16;
#pragma unroll
            for (int bj = 0; bj < 2; ++bj) *(u32x4*)(dst + (size_t)row * 1024 + c0 + bj * 128) = pack8(acc[ai][bj][m][0], acc[ai][bj][m][1], rs[ai][m]); }
}
struct EpiKnope {
    static constexpr bool PERM = true; static constexpr int NST = 0; P p;
    __device__ __forceinline__ void operator()(const Acc& acc, const Unit& u, int wr, int wc, int fr, int fq) const {
        epi_knope_r(acc, WSP(float, WS_SSQP), WSP(bf16_t, WS_KNOPE), u.pm * 256 + wr * 64 + fr, u.pn * 256 + wc * 32 + 8 * fq);
    }
};
__device__ __forceinline__ void epi_out_r(const Acc& acc, const float* __restrict__ xin, const float* __restrict__ g1, bf16_t* __restrict__ x1, int row0, int col0) {
    f32x4 gv[2][2];
#pragma unroll
    for (int bj = 0; bj < 2; ++bj)
#pragma unroll
        for (int n = 0; n < 2; ++n) gv[bj][n] = *(const f32x4*)(g1 + col0 + bj * 128 + n * 4);
#pragma unroll
    for (int ai = 0; ai < 2; ++ai) {
        f32x4 xv[4][2][2];
#pragma unroll
        for (int m = 0; m < 4; ++m)
#pragma unroll
            for (int bj = 0; bj < 2; ++bj)
#pragma unroll
                for (int n = 0; n < 2; ++n) xv[m][bj][n] = *(const f32x4*)(xin + (size_t)(row0 + ai * 128 + m * 16) * D + col0 + bj * 128 + n * 4);
        asm volatile("" ::: "memory");
#pragma unroll
        for (int m = 0; m < 4; ++m)
#pragma unroll
            for (int bj = 0; bj < 2; ++bj)
                *(u32x4*)(x1 + (size_t)(row0 + ai * 128 + m * 16) * D + col0 + bj * 128) = pack8(xv[m][bj][0] + gv[bj][0] * acc[ai][bj][m][0], xv[m][bj][1] + gv[bj][1] * acc[ai][bj][m][1], 1.f);
        asm volatile("" ::: "memory");
    }
}
struct EpiOut {
    static constexpr bool PERM = true; static constexpr int NST = 0; P p;
    __device__ __forceinline__ void operator()(const Acc& acc, const Unit& u, int wr, int wc, int fr, int fq) const {
        const int row0 = u.pm * 256 + wr * 64 + fr, b = (u.pm * 256) / SEQ, col0 = u.pn * 256 + wc * 32 + 8 * fq;
        epi_out_r(acc, p.x, WSP(float, WS_MOD) + (size_t)b * NMOD * D + 2 * D, WSP(bf16_t, WS_X1), row0, col0);
    }
};
struct EpiMoe1 {
    static constexpr bool PERM = true; static constexpr int NST = 8; P p; size_t dst_off; const LAS float* bias_lds;
    __device__ __forceinline__ void operator()(const Acc& acc, const Unit& u, int wr, int wc, int fr, int fq) const {
        const int row0 = u.pm * 256 + wr * 64 + fr, a0 = u.pn * 128 + wc * 32 + 8 * fq; const LAS float* b1 = bias_lds + (u.ui < 18 ? u.ui : 0) * 256 + 2 * (wc * 32 + 8 * fq); bf16_t* dst = WSP(bf16_t, dst_off);
        float bg[8], bl[8];
#pragma unroll
        for (int q = 0; q < 4; ++q) { const f32x4 t = *(const LAS f32x4*)(b1 + 4 * q); bg[2 * q] = t[0]; bl[2 * q] = t[1] + 1.f; bg[2 * q + 1] = t[2]; bl[2 * q + 1] = t[3] + 1.f; }
#pragma unroll
        for (int ai = 0; ai < 2; ++ai)
#pragma unroll
            for (int m = 0; m < 4; ++m) { const int row = row0 + ai * 128 + m * 16; float o[8];
#pragma unroll
                for (int j = 0; j < 8; ++j) { float g = acc[ai][0][m][j >> 2][j & 3] * (MOE1_FP6 ? 1.f : W8_INV) + bg[j], l = acc[ai][1][m][j >> 2][j & 3] * (MOE1_FP6 ? 1.f : W8_INV) + bl[j];
                    g = fminf(g, 7.f); l = fminf(fmaxf(l, -6.f), 8.f);
                    o[j] = g * __builtin_amdgcn_rcpf(1.f + __builtin_amdgcn_exp2f(-2.4554669595930156f * g)) * l; }
                if (MOE_FP8) { u32x2 w; w.x = pk4_fp8(o[0], o[1], o[2], o[3]); w.y = pk4_fp8(o[4], o[5], o[6], o[7]); *(u32x2*)((unsigned char*)dst + (size_t)row * DE + a0) = w; }
                else { u32x4 w; w.x = pk2(o[0], o[1]); w.y = pk2(o[2], o[3]); w.z = pk2(o[4], o[5]); w.w = pk2(o[6], o[7]);
                *(u32x4*)(dst + (size_t)row * DE + a0) = w; } }
    }
};
struct EpiMoe2 {
    static constexpr bool PERM = true; static constexpr int NST = 16; P p; const LAS float* bias_lds;
    __device__ __forceinline__ void operator()(const Acc& acc, const Unit& u, int wr, int wc, int fr, int fq) const {
        const int row0 = u.pm * 256 + wr * 64 + fr, c0 = u.pn * 256 + wc * 32 + 8 * fq; const LAS float* b2 = bias_lds + (u.ui < 18 ? u.ui : 0) * 256 + wc * 32 + 8 * fq; bf16_t* dst = WSP(bf16_t, WS_Y);
        f32x4 bv[2][2];
#pragma unroll
        for (int bj = 0; bj < 2; ++bj)
#pragma unroll
            for (int n = 0; n < 2; ++n) bv[bj][n] = *(const LAS f32x4*)(b2 + bj * 128 + 4 * n) * (Y_FP8 ? Y_SCALE : 1.f);
#pragma unroll
        for (int ai = 0; ai < 2; ++ai)
#pragma unroll
            for (int m = 0; m < 4; ++m) { const int row = row0 + ai * 128 + m * 16;
#pragma unroll
                for (int bj = 0; bj < 2; ++bj) {
                    if (Y_FP8) { f32x4 t0 = acc[ai][bj][m][0] * ((MOE_FP8 ? W8_INV : 1.f) * Y_SCALE) + bv[bj][0], t1 = acc[ai][bj][m][1] * ((MOE_FP8 ? W8_INV : 1.f) * Y_SCALE) + bv[bj][1];
#pragma unroll
                        for (int j = 0; j < 4; ++j) { t0[j] = __builtin_amdgcn_fmed3f(t0[j], -448.f, 448.f); t1[j] = __builtin_amdgcn_fmed3f(t1[j], -448.f, 448.f); }
                        u32x2 w; w.x = pk4_fp8(t0[0], t0[1], t0[2], t0[3]); w.y = pk4_fp8(t1[0], t1[1], t1[2], t1[3]);
                        *(u32x2*)((unsigned char*)dst + (size_t)row * D + c0 + bj * 128) = w; }
                    else *(u32x4*)(dst + (size_t)row * D + c0 + bj * 128) = pack8(acc[ai][bj][m][0] * (MOE_FP8 ? W8_INV : 1.f) + bv[bj][0], acc[ai][bj][m][1] * (MOE_FP8 ? W8_INV : 1.f) + bv[bj][1], 1.f); } }
    }
};
template <int NCT, bool GATHER> struct MoeOrder {
    const LAS int* tp; int T, rtr, ctr, rpr, G, c;
    __device__ void init(const LAS int* tp_, int G_, int c_) { tp = tp_; T = tp_[32]; G = G_; c = c_;
        const int x = c_ & 7, a = (c_ >> 3) & 31;
        if (NCT == 16) { rtr = (x >> 2) * 8 + (a >> 2); ctr = (x & 3) * 4 + (a & 3); rpr = 16; } else { rtr = (x >> 1) * 8 + (a >> 2); ctr = (x & 1) * 4 + (a & 3); rpr = 32; } }
    __device__ bool next(int i, Unit& u) const {
        int g, ct;
        if (G == 256) { g = i * rpr + rtr; ct = ctr; } else { const long L = (long)i * G + c; g = (int)(L / NCT); ct = (int)(L % NCT); }
        if (g >= T) return false;
        int e;
        if (G == 256 && i < 20 && tp[63]) { e = tp[40 + i]; }
        else { e = 0; while (e < 31 && tp[e + 1] <= g) ++e; }
        u.pm = g; u.pn = ct; u.pb = e * NCT + ct; u.e = e; u.ko = 0; u.ui = i; return true;
    }
    __device__ __forceinline__ unsigned arow(const Unit& u, int h, int R, int ui, const LAS int* gidx) const { return GATHER ? (unsigned)((const LAS unsigned short*)gidx)[ui * 256 + h * 128 + R] : (unsigned)(u.pm * 256 + h * 128 + R); }
};
struct KropeOrder {
    int G, c;
    __device__ bool next(int i, Unit& u) const { const int L = i * G + c; if (L >= 256) return false; u.pm = L >> 2; u.pn = L & 3; u.pb = 16; u.e = 0; u.ko = (L & 3) * 1024; u.ui = i; return true; }
    __device__ __forceinline__ unsigned arow(const Unit& u, int h, int R, int, const LAS int*) const { return (unsigned)(u.pm * 256 + h * 128 + R); }
};
struct EpiKropeP {
    static constexpr bool PERM = true; static constexpr int NST = 0; P p;
    __device__ __forceinline__ void operator()(const Acc& acc, const Unit& u, int wr, int wc, int fr, int fq) const {
        if (wc >= 2) return;
        float* dst = WSP(float, WS_G_QRAW) + (size_t)u.pn * NTOK * 64; const int row0 = u.pm * 256 + wr * 64 + fr, col0 = wc * 32 + 8 * fq;
#pragma unroll
        for (int ai = 0; ai < 2; ++ai)
#pragma unroll
            for (int m = 0; m < 4; ++m) { float* rp = dst + (size_t)(row0 + ai * 128 + m * 16) * 64 + col0; *(f32x4*)rp = acc[ai][0][m][0]; *(f32x4*)(rp + 4) = acc[ai][0][m][1]; }
    }
};
}

__device__ __forceinline__ void krope_fixup(const float* __restrict__ part, const float2* __restrict__ cs, bf16_t* __restrict__ dst, int G, int bid) {
    for (int r0 = bid * 64; r0 < NTOK; r0 += G * 64) { const int row = r0 + (threadIdx.x >> 3), c8 = (threadIdx.x & 7) * 8;
        f32x4 a = {0.f, 0.f, 0.f, 0.f}, b = {0.f, 0.f, 0.f, 0.f};
#pragma unroll
        for (int q = 0; q < 4; ++q) { const float* pp = part + ((size_t)q * NTOK + row) * 64 + c8; a += *(const f32x4*)pp; b += *(const f32x4*)(pp + 4); }
        const f32x4 c0 = *(const f32x4*)(cs + (size_t)row * 32 + (c8 >> 1)), c1 = *(const f32x4*)(cs + (size_t)row * 32 + (c8 >> 1) + 2);
        u32x4 w; w.x = pk2(a[0] * c0[0] - a[1] * c0[1], a[1] * c0[0] + a[0] * c0[1]); w.y = pk2(a[2] * c0[2] - a[3] * c0[3], a[3] * c0[2] + a[2] * c0[3]);
        w.z = pk2(b[0] * c1[0] - b[1] * c1[1], b[1] * c1[0] + b[0] * c1[1]); w.w = pk2(b[2] * c1[2] - b[3] * c1[3], b[3] * c1[2] + b[2] * c1[3]);
        *(u32x4*)(dst + (size_t)row * 64 + c8) = w; }
}

struct DmIdent { __device__ int operator()(int n) const { return n; } };
struct DmWin { __device__ int operator()(int n) const { if (n < 4096) return n; const int j = n - 4096; return j < 32 ? 4096 + 2 * j : 4096 + 2 * (j - 32) + 1; } };
struct DmWq { __device__ int operator()(int n) const { const int h = n / 192, j = n - h * 192; if (j < 128) return n; return j < 160 ? h * 192 + 128 + 2 * (j - 128) : h * 192 + 128 + 2 * (j - 160) + 1; } };
struct DmWkv { __device__ int operator()(int n) const { const int h = n >> 8, r = n & 255; return r < 128 ? h * 128 + r : 1024 + h * 128 + (r - 128); } };
struct DmW1 { __device__ int operator()(int n) const { const int a = n >> 1; return (a >> 7) * 256 + (n & 1) * 128 + (a & 127); } };
template <class DM>
__device__ __forceinline__ void conv_tile(const float* W, int ldw, int k0, int n0, bf16_t* Bt, int K, DM dm, const float* kscale, LAS unsigned* T) {
    const int tid = threadIdx.x, kp = tid >> 4, nc = tid & 15;
    f32x4 a[2], b[2];
#pragma unroll
    for (int ps = 0; ps < 2; ++ps) { const int k = k0 + 2 * (kp + 32 * ps);
        a[ps] = *(const f32x4*)(W + (size_t)k * ldw + n0 + 4 * nc); b[ps] = *(const f32x4*)(W + (size_t)(k + 1) * ldw + n0 + 4 * nc);
        if (kscale) { a[ps] *= kscale[k]; b[ps] *= kscale[k + 1]; } }
#pragma unroll
    for (int ps = 0; ps < 2; ++ps)
#pragma unroll
        for (int j = 0; j < 4; ++j) T[(4 * nc + j) * 66 + kp + 32 * ps] = pk2(a[ps][j], b[ps][j]);
    __syncthreads();
#pragma unroll
    for (int q = 0; q < 2; ++q) { const int ch = tid + 512 * q, n = ch >> 4, c = ch & 15;
        const u32x2 lo = *(const LAS u32x2*)(T + n * 66 + 4 * c), hi = *(const LAS u32x2*)(T + n * 66 + 4 * c + 2);
        u32x4 w; w.x = lo.x; w.y = lo.y; w.z = hi.x; w.w = hi.y;
        *(u32x4*)(Bt + (size_t)dm(n0 + n) * K + k0 + 8 * c) = w; }
    __syncthreads();
}

template <class DM>
__device__ __forceinline__ void conv_tile8(const float* W, int ldw, int k0, int n0, unsigned char* Bt, int K, DM dm, LAS unsigned* T) {
    const int tid = threadIdx.x, k4 = tid >> 4, nc = tid & 15;
    f32x4 a[4];
#pragma unroll
    for (int r = 0; r < 4; ++r) a[r] = *(const f32x4*)(W + (size_t)(k0 + 4 * k4 + r) * ldw + n0 + 4 * nc) * W8_SCALE;
#pragma unroll
    for (int j = 0; j < 4; ++j) T[(4 * nc + j) * 36 + k4] = pk4_fp8(a[0][j], a[1][j], a[2][j], a[3][j]);
    __syncthreads();
    { const int n = tid >> 3, c = tid & 7; const u32x4 w = *(const LAS u32x4*)(T + n * 36 + 4 * c); *(u32x4*)(Bt + (size_t)dm(n0 + n) * K + k0 + 16 * c) = w; }
    __syncthreads();
}

template <class DM>
__device__ __forceinline__ void conv_tile8x2(const float* Wa, const float* Wb, int ldw, int k0a, int n0a, int k0b, int n0b, unsigned char* Bta, unsigned char* Btb, int K, DM dm, LAS unsigned* T) {
    const int tid = threadIdx.x, k4 = tid >> 4, nc = tid & 15;
    f32x4 a[4], b[4];
#pragma unroll
    for (int r = 0; r < 4; ++r) a[r] = __builtin_nontemporal_load((const f32x4*)(Wa + (size_t)(k0a + 4 * k4 + r) * ldw + n0a + 4 * nc));
#pragma unroll
    for (int r = 0; r < 4; ++r) b[r] = __builtin_nontemporal_load((const f32x4*)(Wb + (size_t)(k0b + 4 * k4 + r) * ldw + n0b + 4 * nc));
#pragma unroll
    for (int j = 0; j < 4; ++j) T[(4 * nc + j) * 36 + k4] = pk4_fp8(a[0][j] * W8_SCALE, a[1][j] * W8_SCALE, a[2][j] * W8_SCALE, a[3][j] * W8_SCALE);
#pragma unroll
    for (int j = 0; j < 4; ++j) T[2304 + (4 * nc + j) * 36 + k4] = pk4_fp8(b[0][j] * W8_SCALE, b[1][j] * W8_SCALE, b[2][j] * W8_SCALE, b[3][j] * W8_SCALE);
    __syncthreads();
    { const int n = tid >> 3, c = tid & 7; const u32x4 wa = *(const LAS u32x4*)(T + n * 36 + 4 * c), wb = *(const LAS u32x4*)(T + 2304 + n * 36 + 4 * c);
      __builtin_nontemporal_store(wa, (u32x4*)(Bta + (size_t)dm(n0a + n) * K + k0a + 16 * c)); __builtin_nontemporal_store(wb, (u32x4*)(Btb + (size_t)dm(n0b + n) * K + k0b + 16 * c)); }
    __syncthreads();
}

template <class DM>
__device__ __forceinline__ void conv_macro8(const float* W, int ldw, int k0, int n0, unsigned char* Bt, int K, DM dm, LAS unsigned char* Tb) {
    const int tid = threadIdx.x, kq = tid >> 6, nc = tid & 63;
    const float* src = W + (size_t)(k0 + 4 * kq) * ldw + n0 + 4 * nc;
    f32x4 a[2][8];
#define CM_LOAD(buf, slab) do { _Pragma("unroll") for (int h_ = 0; h_ < 2; ++h_) _Pragma("unroll") for (int r_ = 0; r_ < 4; ++r_) a[buf][h_ * 4 + r_] = __builtin_nontemporal_load((const f32x4*)(src + (size_t)((slab) * 64 + h_ * 32 + r_) * ldw)); } while (0)
#define CM_PUT(buf, slab) do { _Pragma("unroll") for (int h_ = 0; h_ < 2; ++h_) _Pragma("unroll") for (int j_ = 0; j_ < 4; ++j_) \
        *(LAS unsigned*)(Tb + (4 * nc + j_) * 260 + ((slab) * 64 + h_ * 32 + 4 * kq)) = pk4_fp8(a[buf][h_ * 4][j_] * W8_SCALE, a[buf][h_ * 4 + 1][j_] * W8_SCALE, a[buf][h_ * 4 + 2][j_] * W8_SCALE, a[buf][h_ * 4 + 3][j_] * W8_SCALE); } while (0)
    CM_LOAD(0, 0); CM_LOAD(1, 1);
    CM_PUT(0, 0); CM_LOAD(0, 2);
    CM_PUT(1, 1); CM_LOAD(1, 3);
    CM_PUT(0, 2); CM_PUT(1, 3);
#undef CM_LOAD
#undef CM_PUT
    __syncthreads();
#pragma unroll
    for (int ps = 0; ps < 8; ++ps) { const int n = ps * 32 + (tid >> 4), c = tid & 15; const LAS unsigned* tp_ = (const LAS unsigned*)(Tb + n * 260 + 16 * c);
        u32x4 w; w.x = tp_[0]; w.y = tp_[1]; w.z = tp_[2]; w.w = tp_[3];
        __builtin_nontemporal_store(w, (u32x4*)(Bt + (size_t)dm(n0 + n) * K + k0 + 16 * c)); }
    __syncthreads();
}

__device__ __forceinline__ void phase_prologue(const P& p, LAS unsigned char* lds, int G, int bid) {
    const int tid = threadIdx.x, lane = tid & 63, wid = tid >> 6;
    LAS float* cact = (LAS float*)lds;
    LAS float* red = (LAS float*)(lds + 32768);
    LAS unsigned* T = (LAS unsigned*)(lds + 81920);
    constexpr int U_MOD = 96, U_CS = 64 + 8;
    constexpr int T_WIN = 16 * 65, T_WQ = 4 * 24, T_WKV = 4 * 32, T_WOUT = 16 * 32;
    constexpr int U_REST = U_CS + T_WIN + T_WQ + T_WKV + T_WOUT;
    const bool split = G > 2 * U_MOD;
    if (!split || bid < U_MOD) {
        for (int i = tid; i < 4 * 2048; i += 512) { const int b = i >> 11, k = i & 2047; const float c = p.c[i]; cact[k * 4 + b] = c / (1.f + __expf(-c)); }
        __syncthreads();
        for (int mu = bid; mu < U_MOD; mu += G) {
            f32x4 acc[4] = {{0.f, 0.f, 0.f, 0.f}, {0.f, 0.f, 0.f, 0.f}, {0.f, 0.f, 0.f, 0.f}, {0.f, 0.f, 0.f, 0.f}};
            const int hh = lane >> 5, cl = lane & 31;
            const float* w = p.w_mod + (size_t)(wid * 256 + hh) * (NMOD * D) + mu * 128 + 4 * cl;
#pragma unroll 16
            for (int k = 0; k < 128; ++k) { const f32x4 wv = __builtin_nontemporal_load((const f32x4*)(w + (size_t)(2 * k) * (NMOD * D))); const f32x4 c = *(const LAS f32x4*)(cact + (wid * 256 + 2 * k + hh) * 4);
                acc[0] += wv * c[0]; acc[1] += wv * c[1]; acc[2] += wv * c[2]; acc[3] += wv * c[3]; }
#pragma unroll
            for (int b = 0; b < 4; ++b) *(LAS f32x4*)(red + ((wid * 64 + lane) * 4 + b) * 4) = acc[b];
            __syncthreads();
            if (tid < 128) { const int l = tid >> 2, b = tid & 3; f32x4 sum = *(const f32x4*)(p.b_mod + mu * 128 + 4 * l);
#pragma unroll
                for (int w8 = 0; w8 < 16; ++w8) sum += *(const LAS f32x4*)(red + ((w8 * 32 + l) * 4 + b) * 4);
                *(f32x4*)(WSP(float, WS_MOD) + (size_t)b * NMOD * D + mu * 128 + 4 * l) = sum; }
            __syncthreads();
        }
        if (split) return;
    }
    const int c0 = split ? bid - U_MOD : bid, GS = split ? G - U_MOD : G;
    for (int v = c0; v < U_CS; v += GS) {
        if (v >= 64) {
            for (int j = 0; j < 16; ++j) { const int idx = (v - 64) * 8192 + j * 512 + tid, k = idx >> 5, e = idx & 31; const float w = p.w_router[idx];
                const bf16_t hi = f2bf(w); WSP(bf16_t, WS_WR_HI)[e * 2048 + k] = hi; WSP(bf16_t, WS_WR_LO)[e * 2048 + k] = f2bf(w - bf2f(hi)); }
        } else {
            for (int j = 0; j < 16; ++j) { const int idx = v * 8192 + j * 512 + tid; const int tok = idx >> 5, i = idx & 31;
                double inv = 1.0; for (int q = 0; q < i; ++q) inv *= 0.7498942093324559;
                const double rev = (double)p.pos[tok] * inv * 0.15915494309189535; const float fr = (float)(rev - floor(rev));
                float2 cs; cs.x = __builtin_amdgcn_cosf(fr); cs.y = __builtin_amdgcn_sinf(fr); WSP(float2, WS_CS)[idx] = cs; }
        }
    }
    constexpr int NT = T_WIN + T_WQ + T_WKV + T_WOUT;
    const int kp = tid >> 4, nc = tid & 15;
    f32x4 ra[2][2], rb[2][2];
#define CT_DECL(P_) const float* P_##W = p.w_in; bf16_t* P_##Bt = WSP(bf16_t, WS_WIN_T); const float* P_##ks = nullptr; int P_##ldw = INW, P_##k0 = 0, P_##n0 = 0, P_##K = 2048, P_##dmt = 0
#define CT_SET(P_, vv) do { int v_ = (vv); \
        if (v_ < T_WIN) { P_##W = p.w_in; P_##Bt = WSP(bf16_t, WS_WIN_T); P_##ks = nullptr; P_##ldw = INW; P_##k0 = (v_ / 65) * 128; P_##n0 = (v_ % 65) * 64; P_##K = 2048; P_##dmt = 0; } \
        else if ((v_ -= T_WIN) < T_WQ) { P_##W = p.w_q_up; P_##Bt = WSP(bf16_t, WS_WQ_T); P_##ks = p.g_q; P_##ldw = 1536; P_##k0 = (v_ / 24) * 128; P_##n0 = (v_ % 24) * 64; P_##K = 512; P_##dmt = 1; } \
        else if ((v_ -= T_WQ) < T_WKV) { P_##W = p.w_kv_up; P_##Bt = WSP(bf16_t, WS_WKV_T); P_##ks = p.g_kv; P_##ldw = 2048; P_##k0 = (v_ / 32) * 128; P_##n0 = (v_ % 32) * 64; P_##K = 512; P_##dmt = 2; } \
        else { v_ -= T_WKV; P_##W = p.w_out; P_##Bt = WSP(bf16_t, WS_WOUT_T); P_##ks = nullptr; P_##ldw = 2048; P_##k0 = (v_ / 32) * 128; P_##n0 = (v_ % 32) * 64; P_##K = 2048; P_##dmt = 3; } } while (0)
#define PT_LOAD(buf, P_) do { _Pragma("unroll") for (int ps = 0; ps < 2; ++ps) { const int k = P_##k0 + 2 * (kp + 32 * ps); \
        ra[buf][ps] = *(const f32x4*)(P_##W + (size_t)k * P_##ldw + P_##n0 + 4 * nc); rb[buf][ps] = *(const f32x4*)(P_##W + (size_t)(k + 1) * P_##ldw + P_##n0 + 4 * nc); } } while (0)
#define PT_DO(buf, P_) do { _Pragma("unroll") for (int ps = 0; ps < 2; ++ps) { const int k = P_##k0 + 2 * (kp + 32 * ps); f32x4 x = ra[buf][ps], y = rb[buf][ps]; \
            if (P_##ks) { x *= P_##ks[k]; y *= P_##ks[k + 1]; } \
            _Pragma("unroll") for (int j = 0; j < 4; ++j) T[(4 * nc + j) * 66 + kp + 32 * ps] = pk2(x[j], y[j]); } \
        __syncthreads(); \
        _Pragma("unroll") for (int q = 0; q < 2; ++q) { const int ch = tid + 512 * q, n = ch >> 4, cc = ch & 15; \
            const u32x2 lo = *(const LAS u32x2*)(T + n * 66 + 4 * cc), hi = *(const LAS u32x2*)(T + n * 66 + 4 * cc + 2); \
            u32x4 w; w.x = lo.x; w.y = lo.y; w.z = hi.x; w.w = hi.y; const int nn = P_##n0 + n; \
            const int dn = P_##dmt == 0 ? DmWin{}(nn) : P_##dmt == 1 ? DmWq{}(nn) : P_##dmt == 2 ? DmWkv{}(nn) : nn; \
            *(u32x4*)(P_##Bt + (size_t)dn * P_##K + P_##k0 + 8 * cc) = w; } \
        __syncthreads(); } while (0)
    int v = c0;
    if (v < NT) {
        CT_DECL(c_); CT_DECL(n_);
        CT_SET(c_, v); PT_LOAD(0, c_);
        for (;;) {
            const int vn = v + GS; const bool more = vn < NT;
            if (more) { CT_SET(n_, vn); PT_LOAD(1, n_); }
            PT_DO(0, c_);
            if (!more) break;
            const int vnn = vn + GS; const bool more2 = vnn < NT;
            if (more2) { CT_SET(c_, vnn); PT_LOAD(0, c_); }
            PT_DO(1, n_);
            if (!more2) break;
            v = vnn;
        }
    }
#undef CT_DECL
#undef CT_SET
#undef PT_LOAD
#undef PT_DO
}

__device__ __forceinline__ void phase_normmod_r(const float* __restrict__ mod, const float* __restrict__ x, const float* __restrict__ g, int shift_idx, int scale_idx, bf16_t* __restrict__ out, int G, int bid) {
    const int lane = threadIdx.x & 63, wid = threadIdx.x >> 6;
    for (int row = bid * 8 + wid; row < NTOK; row += G * 8) {
        const int b = row / SEQ; const float* xr = x + (size_t)row * D; f32x4 v[8]; float ss = 0.f;
#pragma unroll
        for (int j = 0; j < 8; ++j) { v[j] = *(const f32x4*)(xr + (j * 64 + lane) * 4); ss += (v[j][0] * v[j][0] + v[j][1] * v[j][1]) + (v[j][2] * v[j][2] + v[j][3] * v[j][3]); }
#pragma unroll
        for (int o = 32; o >= 1; o >>= 1) ss += __shfl_xor(ss, o);
        const float rstd = 1.0f / sqrtf(ss * (1.f / D) + EPS);
        const float* sh = mod + (size_t)b * NMOD * D + shift_idx * D; const float* sc = mod + (size_t)b * NMOD * D + scale_idx * D;
#pragma unroll
        for (int j = 0; j < 8; ++j) { const int k = (j * 64 + lane) * 4; const f32x4 gg = *(const f32x4*)(g + k), s1 = *(const f32x4*)(sc + k), s0 = *(const f32x4*)(sh + k);
            const f32x4 h = v[j] * rstd * gg * (s1 + 1.f) + s0; u32x2 w; w.x = pk2(h[0], h[1]); w.y = pk2(h[2], h[3]); *(u32x2*)(out + (size_t)row * D + k) = w; }
    }
}


__device__ __forceinline__ void phase_cb(const P& p, LAS unsigned char* lds, int bid) {
    if (bid >= NB) return;
    const int tid = threadIdx.x, e = tid & 31, kc = tid >> 5; LAS float* red = (LAS float*)lds;
    const float* sh = WSP(float, WS_MOD) + (size_t)bid * NMOD * D + 3 * D; float s = 0.f;
#pragma unroll 16
    for (int k = kc * 128; k < kc * 128 + 128; ++k) s += sh[k] * p.w_router[k * 32 + e];
    red[tid] = s; __syncthreads();
    if (tid < 32) { float t = p.b_router[tid]; for (int q = 0; q < 16; ++q) t += red[q * 32 + tid]; WSP(float, WS_CB)[bid * 32 + tid] = t; }
    __syncthreads();
}
__device__ __forceinline__ void route_h2_out(const bf16_t* __restrict__ xr, const float* __restrict__ gf, const float* __restrict__ sc, const float* __restrict__ sh, unsigned char* __restrict__ hr8, const float rs, const int kbase) {
#pragma unroll 4
    for (int s = 0; s < 32; ++s) {
        const int k = kbase + 16 * s;
        const f32x4 g0 = *(const f32x4*)(gf + k), g1 = *(const f32x4*)(gf + k + 4), s0 = *(const f32x4*)(sc + k), s1 = *(const f32x4*)(sc + k + 4), h0 = *(const f32x4*)(sh + k), h1 = *(const f32x4*)(sh + k + 4);
        f32x4 xa, xb; { const u32x4 xw = *(const u32x4*)(xr + 16 * s); xa[0] = __uint_as_float(xw.x << 16); xa[1] = __uint_as_float(xw.x & 0xffff0000u); xa[2] = __uint_as_float(xw.y << 16); xa[3] = __uint_as_float(xw.y & 0xffff0000u);
            xb[0] = __uint_as_float(xw.z << 16); xb[1] = __uint_as_float(xw.z & 0xffff0000u); xb[2] = __uint_as_float(xw.w << 16); xb[3] = __uint_as_float(xw.w & 0xffff0000u); }
        const f32x4 y0 = xa * rs * g0 * (s0 + 1.f) + h0, y1 = xb * rs * g1 * (s1 + 1.f) + h1;
        if (MOE_FP8) { u32x2 w; w.x = pk4_fp8(y0[0], y0[1], y0[2], y0[3]); w.y = pk4_fp8(y1[0], y1[1], y1[2], y1[3]); *(u32x2*)(hr8 + 16 * s) = w; }
        else { u32x4 w; w.x = pk2(y0[0], y0[1]); w.y = pk2(y0[2], y0[3]); w.z = pk2(y1[0], y1[1]); w.w = pk2(y1[2], y1[3]); *(u32x4*)(hr8 + 32 * s) = w; }
    }
}
__device__ __forceinline__ void route_h2_fp6(const bf16_t* __restrict__ x1g, const LAS float* gsl, const LAS float* shl, unsigned char* __restrict__ h2g, const LAS float* rsd) {
    const int blk = threadIdx.x & 63, k0 = blk * 32;
    f32x4 gs[8], hs[8];
#pragma unroll
    for (int q = 0; q < 8; ++q) { gs[q] = *(const LAS f32x4*)(gsl + k0 + 4 * q); hs[q] = *(const LAS f32x4*)(shl + k0 + 4 * q); }
#pragma unroll 2
    for (int ps = 0; ps < 8; ++ps) { const int id = threadIdx.x + 512 * ps, r = id >> 6; const float rs = rsd[r];
        float v[32]; const u32x4* xp = (const u32x4*)(x1g + (size_t)r * D + k0);
#pragma unroll
        for (int q = 0; q < 4; ++q) { const u32x4 xw = xp[q]; const f32x4 g0 = gs[2 * q] * rs, g1 = gs[2 * q + 1] * rs, h0 = hs[2 * q], h1 = hs[2 * q + 1];
            v[8 * q + 0] = __uint_as_float(xw.x << 16) * g0[0] + h0[0]; v[8 * q + 1] = __uint_as_float(xw.x & 0xffff0000u) * g0[1] + h0[1];
            v[8 * q + 2] = __uint_as_float(xw.y << 16) * g0[2] + h0[2]; v[8 * q + 3] = __uint_as_float(xw.y & 0xffff0000u) * g0[3] + h0[3];
            v[8 * q + 4] = __uint_as_float(xw.z << 16) * g1[0] + h1[0]; v[8 * q + 5] = __uint_as_float(xw.z & 0xffff0000u) * g1[1] + h1[1];
            v[8 * q + 6] = __uint_as_float(xw.w << 16) * g1[2] + h1[2]; v[8 * q + 7] = __uint_as_float(xw.w & 0xffff0000u) * g1[3] + h1[3]; }
        u32x4 lo, hi; fp6_block(v, lo, hi);
        unsigned char* dst = h2g + (size_t)r * D + (blk >> 2) * 128 + (blk & 3) * 16;
        *(u32x4*)dst = lo; *(u32x4*)(dst + 64) = hi; }
}
__device__ __forceinline__ void phase_route(const P& p, LAS unsigned char* lds, int G, int bid) {
    const int tid = threadIdx.x, lane = tid & 63, wid = __builtin_amdgcn_readfirstlane(tid >> 6), hf = wid >> 2, wq = wid & 3, r32 = lane & 31, kg = lane >> 5;
    LAS float* red = (LAS float*)lds;
    LAS float* ssr = (LAS float*)(lds + 32768);
    LAS float* lg = (LAS float*)(lds + 32768 + 2048);
    LAS float* rsd = (LAS float*)(lds + 32768 + 2048 + 8192);
    LAS int* hist = (LAS int*)(lds + 32768 + 2048 + 8192 + 256);
    LAS int* gbase = hist + 32;
    LAS float* gsl = (LAS float*)(lds + 49152);
    LAS float* shl = (LAS float*)(lds + 57344);
    const bf16_t* wrh = WSP(bf16_t, WS_WR_HI); const bf16_t* wrl = WSP(bf16_t, WS_WR_LO);
    for (int gp = bid; gp < NTOK / 64; gp += G) {
        const int row = gp * 64 + hf * 32 + r32, b = (gp * 64) / SEQ, kb0 = wq * 512 + 8 * kg;
        const float* mod = WSP(float, WS_MOD) + (size_t)b * NMOD * D; const float* sh = mod + 3 * D; const float* sc = mod + 4 * D;
        const bf16_t* xr = WSP(bf16_t, WS_X1) + (size_t)row * D + kb0;
        f32x16 C = {}; float ss = 0.f;
        if (tid < 32) hist[tid] = 0;
        { const int k4 = tid * 4; *(LAS f32x4*)(gsl + k4) = *(const f32x4*)(p.g_ffn + k4) * (*(const f32x4*)(sc + k4) + 1.f); *(LAS f32x4*)(shl + k4) = *(const f32x4*)(sh + k4); }
        __syncthreads();
#pragma unroll 4
        for (int s = 0; s < 32; ++s) {
            const int k = kb0 + 16 * s;
            const f32x4 gs0 = *(const LAS f32x4*)(gsl + k), gs1 = *(const LAS f32x4*)(gsl + k + 4);
            f32x4 x0, x1; { const u32x4 xw = *(const u32x4*)(xr + 16 * s); x0[0] = __uint_as_float(xw.x << 16); x0[1] = __uint_as_float(xw.x & 0xffff0000u); x0[2] = __uint_as_float(xw.y << 16); x0[3] = __uint_as_float(xw.y & 0xffff0000u);
                x1[0] = __uint_as_float(xw.z << 16); x1[1] = __uint_as_float(xw.z & 0xffff0000u); x1[2] = __uint_as_float(xw.w << 16); x1[3] = __uint_as_float(xw.w & 0xffff0000u); }
            ss += (x0[0] * x0[0] + x0[1] * x0[1]) + (x0[2] * x0[2] + x0[3] * x0[3]) + (x1[0] * x1[0] + x1[1] * x1[1]) + (x1[2] * x1[2] + x1[3] * x1[3]);
            const f32x4 y0 = x0 * gs0, y1 = x1 * gs1;
            u32x4 hi; hi.x = pk2(y0[0], y0[1]); hi.y = pk2(y0[2], y0[3]); hi.z = pk2(y1[0], y1[1]); hi.w = pk2(y1[2], y1[3]);
            f32x4 r0, r1;
            r0[0] = y0[0] - __uint_as_float(hi.x << 16); r0[1] = y0[1] - __uint_as_float(hi.x & 0xffff0000u); r0[2] = y0[2] - __uint_as_float(hi.y << 16); r0[3] = y0[3] - __uint_as_float(hi.y & 0xffff0000u);
            r1[0] = y1[0] - __uint_as_float(hi.z << 16); r1[1] = y1[1] - __uint_as_float(hi.z & 0xffff0000u); r1[2] = y1[2] - __uint_as_float(hi.w << 16); r1[3] = y1[3] - __uint_as_float(hi.w & 0xffff0000u);
            u32x4 lo; lo.x = pk2(r0[0], r0[1]); lo.y = pk2(r0[2], r0[3]); lo.z = pk2(r1[0], r1[1]); lo.w = pk2(r1[2], r1[3]);
            const bf16x8 ah = *(const bf16x8*)(wrh + (size_t)r32 * 2048 + k), al = *(const bf16x8*)(wrl + (size_t)r32 * 2048 + k);
            const bf16x8 bh = __builtin_bit_cast(bf16x8, hi), bl = __builtin_bit_cast(bf16x8, lo);
            C = __builtin_amdgcn_mfma_f32_32x32x16_bf16(ah, bh, C, 0, 0, 0);
            C = __builtin_amdgcn_mfma_f32_32x32x16_bf16(al, bh, C, 0, 0, 0);
            C = __builtin_amdgcn_mfma_f32_32x32x16_bf16(ah, bl, C, 0, 0, 0);
        }
#pragma unroll
        for (int r = 0; r < 16; ++r) red[((hf * 4 + wq) * 32 + ((r & 3) + 8 * (r >> 2) + 4 * kg)) * 32 + r32] = C[r];
        ssr[(hf * 8 + wq * 2 + kg) * 32 + r32] = ss;
        __syncthreads();
        { const int h2 = tid >> 8, t2 = tid & 255;
#pragma unroll
          for (int q = 0; q < 4; ++q) { const int e = (t2 >> 5) + 8 * q; float t = 0.f;
#pragma unroll
              for (int w4 = 0; w4 < 4; ++w4) t += red[((h2 * 4 + w4) * 32 + e) * 32 + (t2 & 31)]; lg[(h2 * 32 + e) * 32 + (t2 & 31)] = t; } }
        if (tid < 64) { float t = 0.f;
#pragma unroll
            for (int q = 0; q < 8; ++q) t += ssr[((tid >> 5) * 8 + q) * 32 + (tid & 31)]; rsd[tid] = 1.0f / sqrtf(t * (1.f / D) + EPS); }
        __syncthreads();
        int i0 = 0, i1 = 0, i2 = 0, i3 = 0, l0 = 0, l1 = 0, l2 = 0, l3 = 0; float w0 = 0.f, w1 = 0.f, w2 = 0.f, w3 = 0.f;
        if (tid < 64) {
            const float rs = rsd[tid]; const float* cb = WSP(float, WS_CB) + b * 32; const LAS float* lgr = lg + (tid >> 5) * 1024 + (tid & 31);
            unsigned used = 0; float v0 = 0, v1 = 0, v2 = 0, v3 = 0;
            float xv[32];
#pragma unroll
            for (int e = 0; e < 32; ++e) xv[e] = lgr[e * 32] * rs + cb[e];
#pragma unroll
            for (int k = 0; k < 4; ++k) { float best = -3.0e38f; int bi = 0;
#pragma unroll
                for (int e = 0; e < 32; ++e) { const bool ok = !((used >> e) & 1u) && xv[e] > best; best = ok ? xv[e] : best; bi = ok ? e : bi; }
                used |= 1u << bi;
                if (k == 0) { i0 = bi; v0 = best; } else if (k == 1) { i1 = bi; v1 = best; } else if (k == 2) { i2 = bi; v2 = best; } else { i3 = bi; v3 = best; } }
            const float e1 = __expf(v1 - v0), e2 = __expf(v2 - v0), e3 = __expf(v3 - v0), inv = 1.f / (1.f + e1 + e2 + e3);
            w0 = inv; w1 = e1 * inv; w2 = e2 * inv; w3 = e3 * inv;
            l0 = atomicAdd((int*)(hist + i0), 1); l1 = atomicAdd((int*)(hist + i1), 1); l2 = atomicAdd((int*)(hist + i2), 1); l3 = atomicAdd((int*)(hist + i3), 1);
        }
        __syncthreads();
        if (tid < 32) { const int c = hist[tid]; gbase[tid] = c ? atomicAdd(WSP(int, WS_CNT) + tid, c) : 0; }
        __syncthreads();
        if (tid < 64) { const int rw = gp * 64 + tid;
            const int p0 = gbase[i0] + l0, p1 = gbase[i1] + l1, p2 = gbase[i2] + l2, p3 = gbase[i3] + l3;
            int* te = WSP(int, WS_TOPE) + rw * 4; float* tw = WSP(float, WS_TOPW) + rw * 4; int* tp = WSP(int, WS_TPOS) + rw * 4; int* rt = WSP(int, WS_ROWTOK);
            te[0] = i0; te[1] = i1; te[2] = i2; te[3] = i3; tw[0] = w0; tw[1] = w1; tw[2] = w2; tw[3] = w3; tp[0] = p0; tp[1] = p1; tp[2] = p2; tp[3] = p3;
            rt[(size_t)i0 * NTOK + p0] = rw * 4; rt[(size_t)i1 * NTOK + p1] = rw * 4 + 1; rt[(size_t)i2 * NTOK + p2] = rw * 4 + 2; rt[(size_t)i3 * NTOK + p3] = rw * 4 + 3; }
        if (MOE1_FP6) route_h2_fp6(WSP(bf16_t, WS_X1) + (size_t)(gp * 64) * D, gsl, shl, p.ws + WS_H2 + (size_t)(gp * 64) * D, rsd);
        else route_h2_out(xr, p.g_ffn, sc, sh, p.ws + WS_H2 + (size_t)row * D + kb0, rsd[hf * 32 + r32], kb0);
        __syncthreads();
    }
}
__device__ __forceinline__ void phase_final_r(const bf16_t* __restrict__ Y, const bf16_t* __restrict__ X1, const float* __restrict__ modp, const int* __restrict__ tope, const int* __restrict__ tpos, const float* __restrict__ topw, const float* __restrict__ gfin, float* __restrict__ outp, LAS unsigned char* lds, int G, int bid) {
    const int lane = threadIdx.x & 63, wid = threadIdx.x >> 6; const LAS int* tp = (const LAS int*)(lds + LDS_TP);
    int e_n = 0, ps_n = 0; float wk_n = 0.f;
    { const int r0 = bid * 8 + wid; if (r0 < NTOK && lane < 4) { e_n = tope[r0 * 4 + lane]; ps_n = tpos[r0 * 4 + lane]; wk_n = topw[r0 * 4 + lane]; } }
    for (int row = bid * 8 + wid; row < NTOK; row += G * 8) {
        const int b = row / SEQ; const float* g2 = modp + (size_t)b * NMOD * D + 5 * D;
        int slot = 0; float wk = 0.f;
        if (lane < 4) { slot = tp[e_n] * 256 + ps_n; wk = wk_n; }
        { const int nr = row + G * 8; if (nr < NTOK && lane < 4) { e_n = tope[nr * 4 + lane]; ps_n = tpos[nr * 4 + lane]; wk_n = topw[nr * 4 + lane]; } }
        const int sl0 = __shfl(slot, 0), sl1 = __shfl(slot, 1), sl2 = __shfl(slot, 2), sl3 = __shfl(slot, 3);
        const float ysc = Y_FP8 ? 1.f / Y_SCALE : 1.f, q0 = __shfl(wk, 0) * ysc, q1 = __shfl(wk, 1) * ysc, q2 = __shfl(wk, 2) * ysc, q3 = __shfl(wk, 3) * ysc;
        f32x4 v[8]; float ss = 0.f;
#pragma unroll
        for (int j = 0; j < 8; ++j) { const int k = (j * 64 + lane) * 4;
            f32x4 m;
            if (Y_FP8) { const unsigned char* Y8 = (const unsigned char*)Y;
                const int a0 = *(const int*)(Y8 + (size_t)sl0 * D + k), a1 = *(const int*)(Y8 + (size_t)sl1 * D + k), a2 = *(const int*)(Y8 + (size_t)sl2 * D + k), a3 = *(const int*)(Y8 + (size_t)sl3 * D + k);
                const auto l0 = __builtin_amdgcn_cvt_pk_f32_fp8(a0, false), h0 = __builtin_amdgcn_cvt_pk_f32_fp8(a0, true), l1 = __builtin_amdgcn_cvt_pk_f32_fp8(a1, false), h1 = __builtin_amdgcn_cvt_pk_f32_fp8(a1, true);
                const auto l2 = __builtin_amdgcn_cvt_pk_f32_fp8(a2, false), h2 = __builtin_amdgcn_cvt_pk_f32_fp8(a2, true), l3 = __builtin_amdgcn_cvt_pk_f32_fp8(a3, false), h3 = __builtin_amdgcn_cvt_pk_f32_fp8(a3, true);
                m[0] = q0 * l0[0] + q1 * l1[0] + q2 * l2[0] + q3 * l3[0]; m[1] = q0 * l0[1] + q1 * l1[1] + q2 * l2[1] + q3 * l3[1];
                m[2] = q0 * h0[0] + q1 * h1[0] + q2 * h2[0] + q3 * h3[0]; m[3] = q0 * h0[1] + q1 * h1[1] + q2 * h2[1] + q3 * h3[1];
            } else {
            const u32x2 a0 = *(const u32x2*)(Y + (size_t)sl0 * D + k), a1 = *(const u32x2*)(Y + (size_t)sl1 * D + k), a2 = *(const u32x2*)(Y + (size_t)sl2 * D + k), a3 = *(const u32x2*)(Y + (size_t)sl3 * D + k);
            m[0] = q0 * __uint_as_float(a0.x << 16) + q1 * __uint_as_float(a1.x << 16) + q2 * __uint_as_float(a2.x << 16) + q3 * __uint_as_float(a3.x << 16);
            m[1] = q0 * __uint_as_float(a0.x & 0xffff0000u) + q1 * __uint_as_float(a1.x & 0xffff0000u) + q2 * __uint_as_float(a2.x & 0xffff0000u) + q3 * __uint_as_float(a3.x & 0xffff0000u);
            m[2] = q0 * __uint_as_float(a0.y << 16) + q1 * __uint_as_float(a1.y << 16) + q2 * __uint_as_float(a2.y << 16) + q3 * __uint_as_float(a3.y << 16);
            m[3] = q0 * __uint_as_float(a0.y & 0xffff0000u) + q1 * __uint_as_float(a1.y & 0xffff0000u) + q2 * __uint_as_float(a2.y & 0xffff0000u) + q3 * __uint_as_float(a3.y & 0xffff0000u);
            }
            { const u32x2 xw = *(const u32x2*)(X1 + (size_t)row * D + k); f32x4 xv; xv[0] = __uint_as_float(xw.x << 16); xv[1] = __uint_as_float(xw.x & 0xffff0000u); xv[2] = __uint_as_float(xw.y << 16); xv[3] = __uint_as_float(xw.y & 0xffff0000u);
              v[j] = xv + *(const f32x4*)(g2 + k) * m; }
            ss += (v[j][0] * v[j][0] + v[j][1] * v[j][1]) + (v[j][2] * v[j][2] + v[j][3] * v[j][3]); }
#pragma unroll
        for (int o = 32; o >= 1; o >>= 1) ss += __shfl_xor(ss, o);
        const float rstd = 1.0f / sqrtf(ss * (1.f / D) + EPS);
#pragma unroll
        for (int j = 0; j < 8; ++j) { const int k = (j * 64 + lane) * 4; *(f32x4*)(outp + (size_t)row * D + k) = v[j] * rstd * *(const f32x4*)(gfin + k); }
    }
}
__device__ __forceinline__ void phase_final(const P& p, LAS unsigned char* lds, int G, int bid) { phase_final_r(WSP(bf16_t, WS_Y), WSP(bf16_t, WS_X1), WSP(float, WS_MOD), WSP(int, WS_TOPE), WSP(int, WS_TPOS), WSP(float, WS_TOPW), p.g_final, p.out, lds, G, bid); }

namespace at {
constexpr int VSTR = 144, VT = 128 * VSTR;
constexpr int LDS_AL = 90112, LDS_FLAG = LDS_AL + 1024;
constexpr float LOG2E = 1.4426950408889634f;
__device__ __forceinline__ bf16x8 packf(const f32x16& x, int s) { u32x4 w; w.x = pk2(x[8 * s], x[8 * s + 1]); w.y = pk2(x[8 * s + 2], x[8 * s + 3]); w.z = pk2(x[8 * s + 4], x[8 * s + 5]); w.w = pk2(x[8 * s + 6], x[8 * s + 7]); return __builtin_bit_cast(bf16x8, w); }
#define AT_MFMA(a, b, c) __builtin_amdgcn_mfma_f32_32x32x16_bf16((a), (b), (c), 0, 0, 0)

template <bool MLA>
__device__ __forceinline__ void attn_unit(const P& p, LAS unsigned char* lds, const int b, const int h, const int qb) {
    constexpr int DK = MLA ? 192 : 128, KSTR = MLA ? 400 : 272, KT = 64 * KSTR, BUF = KT + VT, NQF = DK / 16, NKR = MLA ? 3 : 2;
    static_assert(2 * (64 * 400 + VT) <= LDS_AL, "attention LDS map");
    const int tid = threadIdx.x, wid = __builtin_amdgcn_readfirstlane(tid >> 6), lane = tid & 63, r32 = lane & 31, hi = lane >> 5;
    const int q0 = qb * 256, qw = q0 + 32 * wid, qi = qw + r32, nt = (q0 + 256) / 64;
    const bf16_t* Kn = MLA ? WSP(bf16_t, WS_KNOPE) : WSP(bf16_t, WS_SBK);
    const bf16_t* Kr = WSP(bf16_t, WS_KROPE);
    const bf16_t* Vt = WSP(bf16_t, MLA ? WS_VMT : WS_SBVT) + (size_t)(b * 8 + h) * 128 * SEQ;
    LAS float* al = (LAS float*)(lds + LDS_AL) + wid * 32;
    LAS int* flag = (LAS int*)(lds + LDS_FLAG);
    bf16x8 qf[NQF];
    { const char* qb_ = MLA ? (const char*)WSP(bf16_t, WS_QMLA) + ((size_t)(b * SEQ + qw) * 1536 + h * 192) * 2 : (const char*)WSP(bf16_t, WS_SBQ) + ((size_t)(b * SEQ + qw) * 1024 + h * 128) * 2;
      const unsigned qo = (unsigned)((r32 * (MLA ? 1536 : 1024) + 8 * hi) * 2);
#pragma unroll
      for (int s = 0; s < NQF; ++s) qf[s] = *(const bf16x8*)(qb_ + qo + 32 * s); }
    bf16x8 tri0, tri1, ones;
#pragma unroll
    for (int j = 0; j < 8; ++j) { const int k0_ = 8 * (j >> 2) + 4 * hi + (j & 3); tri0[j] = (k0_ > r32) ? (short)0x3F80 : (short)0; tri1[j] = (16 + k0_ > r32) ? (short)0x3F80 : (short)0; ones[j] = (short)0x3F80; }
    u32x4 kreg[NKR], vreg[2];
    const unsigned kofs0 = (unsigned)(((tid >> 4) * 1024 + (tid & 15) * 8) * 2), kofs1 = kofs0 + 32u * 1024u * 2u;
    const unsigned rofs = (unsigned)(((tid >> 3) * 64 + (tid & 7) * 8) * 2);
    const unsigned vofs0 = (unsigned)(((tid >> 3) * SEQ + (tid & 7) * 8) * 2), vofs1 = vofs0 + 64u * SEQ * 2u;
    const unsigned kw0 = (unsigned)((tid >> 4) * KSTR + (tid & 15) * 16), kw1 = kw0 + 32u * KSTR, rw = (unsigned)((tid >> 3) * KSTR + 256 + (tid & 7) * 16);
    const unsigned vw0 = (unsigned)(KT + (tid >> 3) * VSTR + (16 * ((tid & 7) >> 1) + 4 * (tid & 1)) * 2), vw1 = vw0 + 64u * VSTR;
    const char* Knb = (const char*)Kn + ((size_t)b * SEQ * 1024 + h * 128) * 2; const char* Krb = (const char*)Kr + (size_t)b * SEQ * 64 * 2; const char* Vtb = (const char*)Vt;
#define AT_LOAD(tile) do { const int k0_ = (tile) * 64; const char* kp_ = Knb + (size_t)k0_ * 2048; const char* vp_ = Vtb + (size_t)k0_ * 2; \
        kreg[0] = *(const u32x4*)(kp_ + kofs0); kreg[1] = *(const u32x4*)(kp_ + kofs1); if (MLA) kreg[NKR - 1] = *(const u32x4*)(Krb + (size_t)k0_ * 128 + rofs); \
        vreg[0] = *(const u32x4*)(vp_ + vofs0); vreg[1] = *(const u32x4*)(vp_ + vofs1); } while (0)
#define AT_WRITE(buf) do { LAS unsigned char* kb_ = lds + (buf) * BUF; \
        *(LAS u32x4*)(kb_ + kw0) = kreg[0]; *(LAS u32x4*)(kb_ + kw1) = kreg[1]; if (MLA) *(LAS u32x4*)(kb_ + rw) = kreg[NKR - 1]; \
        { u32x2 lo_, hi_; lo_.x = vreg[0].x; lo_.y = vreg[0].y; hi_.x = vreg[0].z; hi_.y = vreg[0].w; *(LAS u32x2*)(kb_ + vw0) = lo_; *(LAS u32x2*)(kb_ + vw0 + 16) = hi_; } \
        { u32x2 lo_, hi_; lo_.x = vreg[1].x; lo_.y = vreg[1].y; hi_.x = vreg[1].z; hi_.y = vreg[1].w; *(LAS u32x2*)(kb_ + vw1) = lo_; *(LAS u32x2*)(kb_ + vw1 + 16) = hi_; } } while (0)
    f32x16 o[4];
#pragma unroll
    for (int d0 = 0; d0 < 4; ++d0)
#pragma unroll
        for (int r = 0; r < 16; ++r) o[d0][r] = 0.f;
    float m_run = -1e30f, l_run = 0.f, R2 = 0.f;
    if (!MLA && tid < 8) flag[tid] = 0;
    AT_LOAD(MLA ? 0 : nt - 1);
    AT_WRITE(0);
    __syncthreads();
    for (int it = 0; it < nt; ++it) {
        const int tile = MLA ? it : nt - 1 - it, cb = it & 1, k0 = tile * 64;
        const bool more = it + 1 < nt;
        if (more) AT_LOAD(MLA ? tile + 1 : tile - 1);
        const bool active = MLA ? (k0 <= qw + 31) : (k0 < qw + 31 && !__all(R2 < -160.f));
        if (active) {
            const LAS unsigned char* kb = lds + cb * BUF;
            f32x16 p0, p1;
#pragma unroll
            for (int r = 0; r < 16; ++r) { p0[r] = 0.f; p1[r] = 0.f; }
#pragma unroll
            for (int s = 0; s < NQF; ++s) { const bf16x8 a0 = *(const LAS bf16x8*)(kb + r32 * KSTR + s * 32 + hi * 16), a1 = *(const LAS bf16x8*)(kb + (32 + r32) * KSTR + s * 32 + hi * 16);
                p0 = AT_MFMA(a0, qf[s], p0); p1 = AT_MFMA(a1, qf[s], p1); if ((s & 3) == 3) __builtin_amdgcn_sched_barrier(0); }
            const int dq = qi - k0 - 4 * hi;
            bf16x8 pf0, pf1, pf2, pf3;
            if (MLA) {
                float pm = -3.0e38f;
                if (k0 + 63 > qw) {
#pragma unroll
                    for (int r = 0; r < 16; ++r) { const int c = (r & 3) + 8 * (r >> 2);
                        if (c > dq) p0[r] = -__builtin_inff(); if (c + 32 > dq) p1[r] = -__builtin_inff(); }
                }
#pragma unroll
                for (int r = 0; r < 16; ++r) pm = fmaxf(pm, fmaxf(p0[r], p1[r]));
                pm = fmaxf(pm, __shfl_xor(pm, 32));
                const float mn = fmaxf(m_run, pm), alpha = __builtin_amdgcn_exp2f(m_run - mn); m_run = mn;
                float ps = 0.f;
#pragma unroll
                for (int r = 0; r < 16; ++r) { p0[r] = __builtin_amdgcn_exp2f(p0[r] - mn); p1[r] = __builtin_amdgcn_exp2f(p1[r] - mn); ps += p0[r] + p1[r]; }
                ps += __shfl_xor(ps, 32);
                l_run = l_run * alpha + ps;
                if (__any(alpha < 1.f)) { if (hi == 0) al[r32] = alpha; asm volatile("s_waitcnt lgkmcnt(0)" ::: "memory");
#pragma unroll
                    for (int r = 0; r < 16; ++r) { const float a = al[(r & 3) + 8 * (r >> 2) + 4 * hi];
#pragma unroll
                        for (int d0 = 0; d0 < 4; ++d0) o[d0][r] *= a; } }
                pf0 = packf(p0, 0); pf1 = packf(p0, 1); pf2 = packf(p1, 0); pf3 = packf(p1, 1);
            } else {
                if (k0 + 63 >= qw) {
#pragma unroll
                    for (int r = 0; r < 16; ++r) { const int c = (r & 3) + 8 * (r >> 2); if (c >= dq) p0[r] = -__builtin_inff(); if (c + 32 >= dq) p1[r] = -__builtin_inff(); } }
                float lsum = 0.f; bf16x8 lf[4];
#pragma unroll
                for (int g = 0; g < 4; ++g) {
                    float Lv[8];
#pragma unroll
                    for (int j = 0; j < 8; ++j) { const int r = 8 * (g & 1) + j;
                        const float z = (g < 2 ? p0[r] : p1[r]);
                        const float t = __builtin_amdgcn_logf(1.f + __builtin_amdgcn_exp2f(-fabsf(z)));
                        const float L = -(fmaxf(z, 0.f) + t);
                        const float ls = fminf(z, 0.f) - t;
                        if (g < 2) p0[r] = ls; else p1[r] = ls;
                        Lv[j] = L; lsum += L; }
                    u32x4 w; w.x = pk2(Lv[0], Lv[1]); w.y = pk2(Lv[2], Lv[3]); w.z = pk2(Lv[4], Lv[5]); w.w = pk2(Lv[6], Lv[7]); lf[g] = __builtin_bit_cast(bf16x8, w);
                }
                p0 = AT_MFMA(tri0, lf[0], p0); p0 = AT_MFMA(tri1, lf[1], p0); p0 = AT_MFMA(ones, lf[2], p0); p0 = AT_MFMA(ones, lf[3], p0);
                p1 = AT_MFMA(tri0, lf[2], p1); p1 = AT_MFMA(tri1, lf[3], p1);
#pragma unroll
                for (int r = 0; r < 16; ++r) { p0[r] = __builtin_amdgcn_exp2f(p0[r] + R2); p1[r] = __builtin_amdgcn_exp2f(p1[r] + R2); }
                lsum += __shfl_xor(lsum, 32);
                R2 += lsum;
                pf0 = packf(p0, 0); pf1 = packf(p0, 1); pf2 = packf(p1, 0); pf3 = packf(p1, 1);
            }
            const LAS unsigned char* vb = kb + KT;
#pragma unroll
            for (int d0 = 0; d0 < 4; ++d0) { const LAS unsigned char* vr = vb + (32 * d0 + r32) * VSTR + hi * 16;
                o[d0] = AT_MFMA(pf0, *(const LAS bf16x8*)(vr), o[d0]); o[d0] = AT_MFMA(pf1, *(const LAS bf16x8*)(vr + 32), o[d0]);
                o[d0] = AT_MFMA(pf2, *(const LAS bf16x8*)(vr + 64), o[d0]); o[d0] = AT_MFMA(pf3, *(const LAS bf16x8*)(vr + 96), o[d0]); __builtin_amdgcn_sched_barrier(0); }
        }
        if (more) AT_WRITE(cb ^ 1);
        if (!MLA) { const bool dn = __all(R2 < -160.f); if (lane == 0) flag[wid] = dn ? 1 : 0; }
        __syncthreads();
        if (!MLA) { int all = 1;
#pragma unroll
            for (int w8 = 0; w8 < 8; ++w8) all &= flag[w8];
            if (all) break; }
    }
    if (!MLA) __syncthreads();
    if (MLA) { if (hi == 0) al[r32] = 1.0f / l_run; asm volatile("s_waitcnt lgkmcnt(0)" ::: "memory"); }
    char* Ob = (char*)(WSP(bf16_t, WS_MIXED) + (size_t)(b * SEQ + qw) * 2048 + (MLA ? 1024 : 0) + h * 128);
    const bool odd = (r32 & 1) != 0;
    const unsigned oo = (unsigned)((4 * hi * 2048 + r32) * 2) + (odd ? 4094u : 0u);
#pragma unroll
    for (int q = 0; q < 8; ++q) { const int ra = 2 * q, c = (ra & 3) + 8 * (ra >> 2); const float iva = MLA ? al[c + 4 * hi] : 1.f, ivb = MLA ? al[c + 1 + 4 * hi] : 1.f;
#pragma unroll
        for (int d0 = 0; d0 < 4; ++d0) { const float A = o[d0][ra] * iva, Bv = o[d0][ra + 1] * ivb;
            const float snd = odd ? A : Bv;
            const float rcv = __int_as_float(__builtin_amdgcn_update_dpp(0, __float_as_int(snd), 0xB1, 0xF, 0xF, true));
            const unsigned w = odd ? pk2(rcv, Bv) : pk2(A, rcv);
            *(unsigned*)(Ob + oo + (unsigned)((c * 2048 + d0 * 32) * 2)) = w; } }
    __syncthreads();
#undef AT_LOAD
#undef AT_WRITE
}
__device__ __forceinline__ void conv_queue(const P& p, LAS unsigned char* lds, int* ctr, int max_tiles) {
    constexpr int NM1 = NE * 16 * 16, NM2 = NE * 16 * 8, NMT = NM1 + NM2;
    LAS int* qs = (LAS int*)(lds + LDS_FLAG + 96); LAS unsigned char* Tb = lds + 16384;
    const int tid = threadIdx.x, kq = tid >> 6, nc = tid & 63;
    int pulled = 0;
#define CQ_CAN (max_tiles < 0 || pulled < max_tiles)
#define CQ_PULL(dst) do { __syncthreads(); if (tid == 0) qs[0] = CQ_CAN ? atomicAdd(ctr, 1) : NMT; __syncthreads(); dst = qs[0]; ++pulled; } while (0)
    int t_cur, t_nxt;
    CQ_PULL(t_cur); if (t_cur >= NMT) { __syncthreads(); return; }
    CQ_PULL(t_nxt);
    f32x4 a[4][4];
#define CQ_SRC(t, src, ldw) const float* src; int ldw; { const bool w1_ = (t) < NM1; const int t2_ = w1_ ? (t) : (t) - NM1, e_ = w1_ ? t2_ >> 8 : t2_ >> 7, r_ = w1_ ? t2_ & 255 : t2_ & 127; \
        ldw = w1_ ? 4096 : 2048; const int k0_ = (w1_ ? r_ >> 4 : r_ >> 3) * 128, n0_ = (w1_ ? r_ & 15 : r_ & 7) * 256; \
        src = (w1_ ? p.w1 + (size_t)e_ * 2048 * 4096 : p.w2 + (size_t)e_ * 2048 * 2048) + (size_t)(k0_ + 4 * kq) * ldw + n0_ + 4 * nc; }
#define CQ_LOAD(buf, slab, src, ldw) do { _Pragma("unroll") for (int r_ = 0; r_ < 4; ++r_) a[buf][r_] = __builtin_nontemporal_load((const f32x4*)(src + (size_t)((slab) * 32 + r_) * ldw)); } while (0)
#define CQ_PUT(buf, slab) do { if (cur_w1) { _Pragma("unroll") for (int j_ = 0; j_ < 4; ++j_) { u32x2 d_; d_.x = pk2(a[buf][0][j_], a[buf][1][j_]); d_.y = pk2(a[buf][2][j_], a[buf][3][j_]); \
            *(LAS u32x2*)(Tb + (4 * nc + j_) * 264 + ((slab) * 32 + 4 * kq) * 2) = d_; } } \
        else { _Pragma("unroll") for (int j_ = 0; j_ < 4; ++j_) *(LAS unsigned*)(Tb + (4 * nc + j_) * 132 + ((slab) * 32 + 4 * kq)) = pk4_fp8(a[buf][0][j_] * W8_SCALE, a[buf][1][j_] * W8_SCALE, a[buf][2][j_] * W8_SCALE, a[buf][3][j_] * W8_SCALE); } } while (0)
    { CQ_SRC(t_cur, s0, l0); CQ_LOAD(0, 0, s0, l0); CQ_LOAD(1, 1, s0, l0); CQ_LOAD(2, 2, s0, l0); CQ_LOAD(3, 3, s0, l0); }
    for (int it = 0;; ++it) {
        const bool more = t_nxt < NMT, cur_w1 = t_cur < NM1;
        if (tid == 0) qs[1 + (it & 1)] = (more && CQ_CAN) ? atomicAdd(ctr, 1) : NMT;
        ++pulled;
        CQ_PUT(0, 0); CQ_PUT(1, 1);
        CQ_SRC(t_nxt < NMT ? t_nxt : 0, s1, l1);
        if (more) { CQ_LOAD(0, 0, s1, l1); CQ_LOAD(1, 1, s1, l1); }
        CQ_PUT(2, 2); CQ_PUT(3, 3);
        __syncthreads();
        { const int t2_ = cur_w1 ? t_cur : t_cur - NM1, e_ = cur_w1 ? t2_ >> 8 : t2_ >> 7, r_ = cur_w1 ? t2_ & 255 : t2_ & 127;
          const int k0 = (cur_w1 ? r_ >> 4 : r_ >> 3) * 128, n0 = (cur_w1 ? r_ & 15 : r_ & 7) * 256;
          if (cur_w1) {
              unsigned char* Bt = p.ws + WS_W1_T + (size_t)e_ * 4096 * 2048;
#pragma unroll 1
              for (int ps = 0; ps < 2; ++ps) { const int id = tid + 512 * ps, n = id >> 2, q = id & 3; const LAS u32x2* tp_ = (const LAS u32x2*)(Tb + n * 264 + q * 64);
                  float v[32];
#pragma unroll
                  for (int i = 0; i < 8; ++i) { const u32x2 w = tp_[i]; v[4 * i] = __uint_as_float(w.x << 16); v[4 * i + 1] = __uint_as_float(w.x & 0xffff0000u); v[4 * i + 2] = __uint_as_float(w.y << 16); v[4 * i + 3] = __uint_as_float(w.y & 0xffff0000u); }
                  u32x4 lo, hi; fp6_block(v, lo, hi);
                  unsigned char* dst = Bt + (size_t)DmW1{}(n0 + n) * 2048 + k0 + 16 * q;
                  __builtin_nontemporal_store(lo, (u32x4*)dst); __builtin_nontemporal_store(hi, (u32x4*)(dst + 64)); }
          } else {
              unsigned char* Bt = p.ws + WS_W2_T + (size_t)e_ * 2048 * 2048;
#pragma unroll
              for (int ps = 0; ps < 4; ++ps) { const int n = ps * 64 + (tid >> 3), c = tid & 7; const LAS unsigned* tp_ = (const LAS unsigned*)(Tb + n * 132 + 16 * c);
                  u32x4 w; w.x = tp_[0]; w.y = tp_[1]; w.z = tp_[2]; w.w = tp_[3];
                  __builtin_nontemporal_store(w, (u32x4*)(Bt + (size_t)(n0 + n) * 2048 + k0 + 16 * c)); }
          } }
        __syncthreads();
        if (!more) break;
        CQ_LOAD(2, 2, s1, l1); CQ_LOAD(3, 3, s1, l1);
        t_cur = t_nxt; t_nxt = qs[1 + (it & 1)];
    }
#undef CQ_PULL
#undef CQ_CAN
#undef CQ_SRC
#undef CQ_LOAD
#undef CQ_PUT
    __syncthreads();
}
__device__ __forceinline__ void attn_queues(const P& p, LAS unsigned char* lds, int* ctr, const int xg) {
    LAS int* qs = (LAS int*)(lds + LDS_FLAG + 64);
    const int tid = threadIdx.x, nq = xg >= 0 ? 4 * 16 : NB * 8 * 16;
    int* c0 = ctr + (xg >= 0 ? xg : 0); int* c1 = ctr + 64 + (xg >= 0 ? xg : 0);
    {   if (tid == 0) qs[0] = atomicAdd(c0, 1);
        __syncthreads();
        int v = qs[0];
        while (v < nq) {
            __syncthreads();
            if (tid == 0) qs[0] = atomicAdd(c0, 1);
            const int bh = xg >= 0 ? xg * 4 + (v & 3) : (v & 31), qb = 15 - (xg >= 0 ? (v >> 2) : (v >> 5));
            attn_unit<true>(p, lds, bh >> 3, bh & 7, qb);
            v = qs[0];
        }
        __syncthreads();
    }
    {   if (tid == 0) qs[0] = atomicAdd(c1, 1);
        __syncthreads();
        int v = qs[0];
        while (v < nq) {
            __syncthreads();
            if (tid == 0) qs[0] = atomicAdd(c1, 1);
            const int bh = xg >= 0 ? xg * 4 + (v & 3) : (v & 31), qb = 15 - (xg >= 0 ? (v >> 2) : (v >> 5));
            attn_unit<false>(p, lds, bh >> 3, bh & 7, qb);
            v = qs[0];
        }
        __syncthreads();
    }
}
__device__ __forceinline__ void phase_attn(const P& p, LAS unsigned char* lds, int G, int bid) {
    int* ctr = (int*)(p.ws + WS_CTL + 61440); const int xg = (G == 256) ? (bid & 7) : -1;
    if (MOE_FP8 && ((bid >> 3) & 7) < 3) { conv_queue(p, lds, ctr + 128, -1); attn_queues(p, lds, ctr, xg); }
    else { attn_queues(p, lds, ctr, xg); if (MOE_FP8) conv_queue(p, lds, ctr + 128, -1); }
}
}

__device__ __forceinline__ void phase_normmod(const P& p, const float* x, const float* g, int shift_idx, int scale_idx, bf16_t* out, int G, int bid) { phase_normmod_r(WSP(float, WS_MOD), x, g, shift_idx, scale_idx, out, G, bid); }
template <class Sched>
__device__ __forceinline__ void moe_tables(const P& p, LAS unsigned char* lds, int G, int bid, bool gather, const float* bias, int bias_ld) {
    LAS int* tp = (LAS int*)(lds + LDS_TP); LAS int* cn = (LAS int*)(lds + LDS_CNT); LAS unsigned short* gidx = (LAS unsigned short*)(lds + LDS_GIDX); LAS float* bl = (LAS float*)(lds + LDS_BIAS);
    const int tid = threadIdx.x;
    if (tid < 32) cn[tid] = WSP(int, WS_CNT)[tid];
    __syncthreads();
    if (tid == 0) { int s = 0; for (int e = 0; e < 32; ++e) { tp[e] = s; s += (cn[e] + 255) >> 8; } tp[32] = s; tp[63] = 0; }
    __syncthreads();
    if (tid < 20) { Sched S; S.init(tp, G, bid); pg::Unit u; tp[40 + tid] = S.next(tid, u) ? u.e : 0; }
    __syncthreads();
    if (tid == 0) tp[63] = 1;
    __syncthreads();
    if (bias) {
        Sched S; S.init(tp, G, bid);
        const int t = tid & 255, i0 = tid >> 8;
        float bv[9]; int rv[9]; bool ok[9];
#pragma unroll
        for (int j = 0; j < 9; ++j) { pg::Unit u; u.e = 0; u.pn = 0; u.pm = 0; ok[j] = S.next(i0 + 2 * j, u);
            const size_t bo = ok[j] ? (size_t)u.e * bias_ld + u.pn * 256 + t : 0;
            bv[j] = bias[bo];
            rv[j] = 0;
            if (gather) { const int e_ = ok[j] ? u.e : 0, r = ok[j] ? (u.pm - tp[e_]) * 256 + t : 0; const bool gk = ok[j] && r < cn[e_];
                const int v = WSP(int, WS_ROWTOK)[gk ? (size_t)e_ * NTOK + r : 0]; rv[j] = gk ? (v >> 2) : 0; } }
#pragma unroll
        for (int j = 0; j < 9; ++j) if (ok[j]) { const int i = i0 + 2 * j; bl[i * 256 + t] = bv[j]; if (gather) gidx[i * 256 + t] = (unsigned short)rv[j]; }
        __syncthreads();
    }
}

__global__ void __launch_bounds__(512, 2) mega(P p, int lo, int hi, int bar_idx) {
    extern __shared__ __attribute__((aligned(16))) unsigned char lds_raw[];
    LAS unsigned char* lds = (LAS unsigned char*)lds_raw;
    const int tid = threadIdx.x, G = gridDim.x, bid = blockIdx.x;
    if (tid < 4) ((LAS unsigned*)(lds + LDS_MISC))[tid] = 0u;
    __syncthreads();
    XcdBarrier bar = xcd_barrier_post((unsigned*)(p.ws + WS_CTL) + bar_idx * XCD_BAR_WORDS, (volatile LAS unsigned*)(lds + LDS_MISC));
#define IN(k) (lo <= (k) && (k) < hi)
#define RUN(k, ...) do { __VA_ARGS__; } while (0)
#define SEAM(k) do { if (IN(k) && IN((k) + 1)) xcd_barrier(bar); } while (0)
    if (IN(0)) RUN(0, phase_prologue(p, lds, G, bid));
    SEAM(0);
    if (IN(1)) RUN(1, { phase_cb(p, lds, bid); phase_normmod(p, p.x, p.g_attn, 0, 1, WSP(bf16_t, WS_H), G, bid); });
    SEAM(1);
    if (IN(2)) RUN(2, {
        const bool ch = (G == 256);
        pg::DenseOrder S1; S1.init(64, 12, G, bid, 8, 4); pg::EpiProjMain E1{p};
        pg::DenseOrder S2; S2.init(4, 64, G, bid); pg::EpiVt<false> E2{p, WS_SBVT};
        pg::KropeOrder S3{G, bid}; pg::EpiKropeP E3{p};
        const bf16_t* A2 = WSP(bf16_t, WS_WIN_T) + (size_t)2048 * 2048;
        const char* b2n = nullptr; unsigned q00 = 0, q01 = 0, q10 = 0, q11 = 0; const char* b3n = nullptr; unsigned k00 = 0, k01 = 0, k10 = 0, k11 = 0;
        if (ch) { pg::first_unit_of(S2, WSP(bf16_t, WS_H), 4096, b2n, q00, q01, q10, q11); pg::first_unit_of(S3, WSP(bf16_t, WS_WIN_T), 4096, b3n, k00, k01, k10, k11); }
        pg::gemm_phase<0>(lds, WSP(bf16_t, WS_H), WSP(bf16_t, WS_WIN_T), 4096, S1, E1, nullptr, 0, false, ch, A2, b2n, q00, q01, q10, q11);
        pg::gemm_phase<0>(lds, A2, WSP(bf16_t, WS_H), 4096, S2, E2, nullptr, 0, ch, ch, WSP(bf16_t, WS_H), b3n, k00, k01, k10, k11);
        pg::gemm_phase<0>(lds, WSP(bf16_t, WS_H), WSP(bf16_t, WS_WIN_T), 4096, S3, E3, nullptr, 8, ch, false);
    });
    SEAM(2);
    if (IN(3)) RUN(3, {
        krope_fixup(WSP(float, WS_G_QRAW), WSP(float2, WS_CS), WSP(bf16_t, WS_KROPE), G, bid);
        const bool ch = (G == 256);
        pg::DenseOrder S1; S1.init(64, 6, G, bid); pg::EpiQ E1{p};
        pg::DenseOrder S2; S2.init(64, 4, G, bid); pg::EpiKnope E2{p};
        pg::DenseOrder S3; S3.init(4, 64, G, bid); pg::EpiVt<true> E3{p, WS_VMT};
        const bf16_t* A3 = WSP(bf16_t, WS_WKV_T) + (size_t)1024 * 512;
        const char* b2n = nullptr; unsigned q00 = 0, q01 = 0, q10 = 0, q11 = 0; const char* b3n = nullptr; unsigned k00 = 0, k01 = 0, k10 = 0, k11 = 0;
        if (ch) { pg::first_unit_of(S2, WSP(bf16_t, WS_WKV_T), 1024, b2n, q00, q01, q10, q11); pg::first_unit_of(S3, WSP(bf16_t, WS_KVLAT), 1024, b3n, k00, k01, k10, k11); }
        pg::gemm_phase<0>(lds, WSP(bf16_t, WS_QLAT), WSP(bf16_t, WS_WQ_T), 1024, S1, E1, nullptr, 0, false, ch, WSP(bf16_t, WS_KVLAT), b2n, q00, q01, q10, q11);
        pg::gemm_phase<0>(lds, WSP(bf16_t, WS_KVLAT), WSP(bf16_t, WS_WKV_T), 1024, S2, E2, nullptr, 0, ch, ch, A3, b3n, k00, k01, k10, k11);
        pg::gemm_phase<0>(lds, A3, WSP(bf16_t, WS_KVLAT), 1024, S3, E3, nullptr, 0, ch, false);
        if (MOE_FP8 && G == 256 && bid >= 128) at::conv_queue(p, lds, (int*)(p.ws + WS_CTL + 61440) + 128, 3);
    });
    SEAM(3);
    if (IN(4)) RUN(4, at::phase_attn(p, lds, G, bid));
    SEAM(4);
    if (IN(5)) RUN(5, { pg::DenseOrder S; S.init(64, 8, G, bid); pg::EpiOut E{p};
        pg::gemm_phase<0>(lds, WSP(bf16_t, WS_MIXED), WSP(bf16_t, WS_WOUT_T), 4096, S, E, nullptr); });
    SEAM(5);
    if (IN(6)) phase_route(p, lds, G, bid);
    SEAM(6);
    if (IN(7)) RUN(7, { typedef pg::MoeOrder<16, true> SO; moe_tables<SO>(p, lds, G, bid, true, p.b1, 4096);
        SO S; S.init((const LAS int*)(lds + LDS_TP), G, bid); pg::EpiMoe1 E{p, WS_ACT, (const LAS float*)(lds + LDS_BIAS)};
        pg::gemm_phase<MOE1_FP6 ? 2 : 1>(lds, p.ws + WS_H2, p.ws + WS_W1_T, 2048, S, E, (const LAS int*)(lds + LDS_GIDX)); });
    SEAM(7);
    if (IN(8)) RUN(8, { typedef pg::MoeOrder<8, false> SO; moe_tables<SO>(p, lds, G, bid, false, p.b2, 2048);
        SO S; S.init((const LAS int*)(lds + LDS_TP), G, bid); pg::EpiMoe2 E{p, (const LAS float*)(lds + LDS_BIAS)};
        pg::gemm_phase<1>(lds, p.ws + WS_ACT, p.ws + WS_W2_T, 2048, S, E, nullptr); });
    SEAM(8);
    if (IN(9)) RUN(9, { moe_tables<pg::MoeOrder<8, false> >(p, lds, G, bid, false, nullptr, 0); phase_final(p, lds, G, bid); });
#undef IN
#undef SEAM
}

extern "C" void kernel_launch(void* const* d_in, const int* in_sizes, int n_in, void* d_out, int out_size, void* d_ws, size_t ws_size, hipStream_t stream) {
    if (n_in != 20 || out_size != NTOK * D || ws_size < WS_END2) { fprintf(stderr, "kernel_launch: unexpected shapes (n_in %d out %d ws %zu need %zu)\n", n_in, out_size, ws_size, (size_t)WS_END2); return; }
    P p{};
    p.x = (const float*)d_in[0]; p.c = (const float*)d_in[1]; p.pos = (const int*)d_in[2]; p.g_attn = (const float*)d_in[3]; p.w_mod = (const float*)d_in[4]; p.b_mod = (const float*)d_in[5];
    p.w_in = (const float*)d_in[6]; p.g_q = (const float*)d_in[7]; p.w_q_up = (const float*)d_in[8]; p.g_kv = (const float*)d_in[9]; p.w_kv_up = (const float*)d_in[10]; p.w_out = (const float*)d_in[11];
    p.g_ffn = (const float*)d_in[12]; p.w_router = (const float*)d_in[13]; p.b_router = (const float*)d_in[14]; p.w1 = (const float*)d_in[15]; p.b1 = (const float*)d_in[16]; p.w2 = (const float*)d_in[17];
    p.b2 = (const float*)d_in[18]; p.g_final = (const float*)d_in[19]; p.out = (float*)d_out; p.ws = (unsigned char*)d_ws;
    static int grid = 0;
    if (grid == 0) {
        int dev = 0, cus = 0, per_cu = 0;
        if (hipGetDevice(&dev) != hipSuccess || hipDeviceGetAttribute(&cus, hipDeviceAttributeMultiprocessorCount, dev) != hipSuccess || cus <= 0) cus = 256;
        if (hipFuncSetAttribute((const void*)mega, hipFuncAttributeMaxDynamicSharedMemorySize, LDS_BYTES) != hipSuccess) fprintf(stderr, "kernel_launch: hipFuncSetAttribute failed\n");
        if (hipOccupancyMaxActiveBlocksPerMultiprocessor(&per_cu, (const void*)mega, 512, LDS_BYTES) != hipSuccess || per_cu < 1) fprintf(stderr, "kernel_launch: occupancy query says %d\n", per_cu);
        (void)hipGetLastError();
        grid = cus;
    }
    (void)hipMemsetAsync((char*)d_ws + WS_CTL, 0, 65536, stream);
    mega<<<grid, 512, LDS_BYTES, stream>>>(p, 0, 10, 0);
}
```

```cpp
#include <hip/hip_runtime.h>
#include <stdint.h>
#include <stdio.h>

constexpr int D = 2048, NB = 4, SEQ = 4096, NTOK = NB * SEQ;
constexpr int SBH = 8, DH = 128, SBW = SBH * DH;
constexpr int MH = 8, NOPE = 128, ROPE = 64, VD = 128, QKD = 192, QR = 512, KVR = 512;
constexpr int INW = 3 * SBW + QR + KVR + ROPE;
constexpr int NE = 32, TOPK = 4, DE = 2048;
constexpr int NMOD = 6;
constexpr float EPS = 1e-6f;
constexpr int MAXSLOT = NTOK * TOPK + NE * 256;

typedef unsigned short bf16_t;
typedef float f32x2_t __attribute__((ext_vector_type(2)));
typedef __bf16 bf16x2_t __attribute__((ext_vector_type(2)));

__device__ __forceinline__ float bf2f(bf16_t v) { return __uint_as_float(((unsigned)v) << 16); }
__device__ __forceinline__ unsigned pk2(float a, float b) { f32x2_t v = {a, b}; bf16x2_t r = __builtin_convertvector(v, bf16x2_t); return __builtin_bit_cast(unsigned, r); }
__device__ __forceinline__ bf16_t f2bf(float a) { return (bf16_t)(pk2(a, 0.f) & 0xffffu); }

constexpr size_t al256(size_t x) { return (x + 255) & ~(size_t)255; }
constexpr size_t WS_CTL   = 0;
constexpr size_t WS_MOD   = 65536;
constexpr size_t WS_CS    = WS_MOD + al256((size_t)NB * NMOD * D * 4);
constexpr size_t WS_H     = WS_CS + (size_t)NTOK * 32 * 8;
constexpr size_t WS_SBQ   = WS_H + (size_t)NTOK * D * 2;
constexpr size_t WS_SBK   = WS_SBQ + (size_t)NTOK * SBW * 2;
constexpr size_t WS_SBVT  = WS_SBK + (size_t)NTOK * SBW * 2;
constexpr size_t WS_QLAT  = WS_SBVT + (size_t)NTOK * SBW * 2;
constexpr size_t WS_KVLAT = WS_QLAT + (size_t)NTOK * QR * 2;
constexpr size_t WS_SSQP  = WS_KVLAT + (size_t)NTOK * KVR * 2;
constexpr size_t WS_KROPE = WS_SSQP + (size_t)NTOK * 16 * 4;
constexpr size_t WS_QMLA  = WS_KROPE + (size_t)NTOK * 64 * 2;
constexpr size_t WS_KNOPE = WS_QMLA + (size_t)NTOK * 1536 * 2;
constexpr size_t WS_VMT   = WS_KNOPE + (size_t)NTOK * 1024 * 2;
constexpr size_t WS_MIXED = WS_VMT + (size_t)NTOK * 1024 * 2;
constexpr size_t WS_X1    = WS_MIXED + (size_t)NTOK * D * 2;
constexpr size_t WS_H2    = WS_X1 + (size_t)NTOK * D * 4;
constexpr size_t WS_TOPE  = WS_H2 + (size_t)NTOK * D * 2;
constexpr size_t WS_TOPW  = WS_TOPE + (size_t)NTOK * 4 * 4;
constexpr size_t WS_TPOS  = WS_TOPW + (size_t)NTOK * 4 * 4;
constexpr size_t WS_CNT   = WS_CTL + 62464;
constexpr size_t WS_ROWTOK= WS_TPOS + (size_t)NTOK * 4 * 4;
constexpr size_t WS_ACT   = WS_ROWTOK + (size_t)NE * NTOK * 4;
constexpr size_t WS_Y     = WS_ACT + (size_t)MAXSLOT * DE * 2;
constexpr size_t WS_GTMP  = WS_Y + (size_t)MAXSLOT * D * 2;
constexpr size_t WS_G_QRAW  = WS_GTMP;
constexpr size_t WS_G_KRRAW = WS_G_QRAW + (size_t)NTOK * 1536 * 4;
constexpr size_t WS_G_SLOTTOK = WS_G_KRRAW + (size_t)NTOK * 64 * 4;
constexpr size_t WS_G_SLOTE   = WS_G_SLOTTOK + (size_t)MAXSLOT * 4;
constexpr size_t WS_END   = WS_G_SLOTE + (size_t)MAXSLOT * 4;

struct P {
    const float *x, *c; const int* pos; const float *g_attn, *w_mod, *b_mod, *w_in, *g_q, *w_q_up, *g_kv, *w_kv_up, *w_out, *g_ffn, *w_router, *b_router, *w1, *b1, *w2, *b2, *g_final;
    float* out; unsigned char* ws;
};
#define WSP(T, off) ((T*)(p.ws + (off)))


#define LAS __attribute__((address_space(3)))
typedef short bf16x8 __attribute__((ext_vector_type(8)));
typedef float f32x4 __attribute__((ext_vector_type(4)));
typedef float f32x16 __attribute__((ext_vector_type(16)));
typedef unsigned u32x4 __attribute__((ext_vector_type(4)));
typedef unsigned u32x2 __attribute__((ext_vector_type(2)));
typedef int i32x8 __attribute__((ext_vector_type(8)));
typedef int i32x4 __attribute__((ext_vector_type(4)));
constexpr bool MOE_FP8 = true;
constexpr float W8_SCALE = 256.f, W8_INV = 1.f / 256.f;
typedef __bf16 bf16x32_t __attribute__((ext_vector_type(32)));
typedef unsigned u32x6 __attribute__((ext_vector_type(6)));
typedef unsigned u32x16 __attribute__((ext_vector_type(16)));
constexpr bool Y_FP8 = true;
constexpr float Y_SCALE = 32.f;
constexpr bool MOE1_FP6 = true;
__device__ __forceinline__ void fp6_block(const float (&v)[32], u32x4& out_lo, u32x4& out_hi) {
    float amax = 0.f;
#pragma unroll
    for (int i = 0; i < 32; ++i) amax = fmaxf(amax, fabsf(v[i]));
    int e = (int)((__float_as_uint(amax) >> 23) & 0xffu) - 127 - 2;
    if (amax * __uint_as_float((unsigned)(127 - e) << 23) > 7.5f) e += 1;
    e = e < -120 ? -120 : e;
    const float inv = __uint_as_float((unsigned)(127 - e) << 23);
    u32x16 w;
#pragma unroll
    for (int i = 0; i < 16; ++i) w[i] = pk2(v[2 * i] * inv, v[2 * i + 1] * inv);
    const u32x6 c = __builtin_amdgcn_cvt_scalef32_pk32_fp6_bf16(__builtin_bit_cast(bf16x32_t, w), 1.0f);
    out_lo.x = c[0]; out_lo.y = c[1]; out_lo.z = c[2]; out_lo.w = c[3];
    out_hi.x = c[4]; out_hi.y = c[5]; out_hi.z = (unsigned)(e + 127); out_hi.w = 0u;
}

__device__ __forceinline__ unsigned pk4_fp8(float a, float b, float c, float d) { int w = 0; w = __builtin_amdgcn_cvt_pk_fp8_f32(a, b, w, false); w = __builtin_amdgcn_cvt_pk_fp8_f32(c, d, w, true); return (unsigned)w; }

constexpr size_t WS_WIN_T  = WS_END;
constexpr size_t WS_WQ_T   = WS_WIN_T + (size_t)4352 * 2048 * 2;
constexpr size_t WS_WKV_T  = WS_WQ_T + (size_t)1536 * 512 * 2;
constexpr size_t WS_WOUT_T = WS_WKV_T + (size_t)2048 * 512 * 2;
constexpr size_t WS_W1_T   = WS_WOUT_T + (size_t)2048 * 2048 * 2;
constexpr size_t WS_W2_T   = WS_W1_T + (size_t)NE * 4096 * 2048 * 2;
constexpr size_t WS_WR_HI  = WS_W2_T + (size_t)NE * 2048 * 2048 * 2;
constexpr size_t WS_WR_LO  = WS_WR_HI + (size_t)32 * 2048 * 2;
constexpr size_t WS_CB     = WS_WR_LO + (size_t)32 * 2048 * 2;
constexpr size_t WS_END2   = WS_CB + 512;

#define XB_TMO      128
#define XB_XCNT(j)  (256  + 64 * (j))
#define XB_XSUB(j)  (1280 + 64 * (j))
#define XB_XGEN(j)  (2304 + 64 * (j))
#define XB_TOP      3328
#define XB_TOPGEN   3392
#define XCD_BAR_WORDS 3456
#define XB_SPIN_CAP (1u << 18)
__device__ __forceinline__ unsigned xb_ld(unsigned* p)              { return __hip_atomic_load(p, __ATOMIC_RELAXED, __HIP_MEMORY_SCOPE_AGENT); }
__device__ __forceinline__ unsigned xb_add(unsigned* p, unsigned v) { return __hip_atomic_fetch_add(p, v, __ATOMIC_RELAXED, __HIP_MEMORY_SCOPE_AGENT); }
__device__ __forceinline__ unsigned xb_xcc_id() { return (unsigned)__builtin_amdgcn_s_getreg((3 << 11) | 20) & 0xFu; }
#define XB_SPIN(cond, bar) do { unsigned _sp = 0; while (cond) { __builtin_amdgcn_s_sleep(1); \
    if ((++_sp & 255u) == 0u) { if (xb_ld(&(bar)[XB_TMO])) break; if (_sp > XB_SPIN_CAP) { atomicAdd(&(bar)[XB_TMO], 1u); break; } } } } while (0)
struct XcdBarrier { unsigned* bar; unsigned x; volatile LAS unsigned* st; };
__device__ __forceinline__ XcdBarrier xcd_barrier_post(unsigned* bar, volatile LAS unsigned* st) {
    XcdBarrier b; b.bar = bar; b.x = xb_xcc_id(); b.st = st;
    if (threadIdx.x == 0) (void)xb_add(&bar[XB_XCNT(b.x)], 1u);
    return b;
}
__device__ __forceinline__ void xcd_barrier_complete(unsigned* bar, unsigned x, unsigned& nloc, unsigned& nx) {
    const unsigned G = gridDim.x * gridDim.y * gridDim.z;
    unsigned sum, cnt, mine, sp = 0u;
    for (;;) {
        sum = 0u; cnt = 0u; mine = 0u;
#pragma unroll
        for (unsigned j = 0; j < 16; ++j) { const unsigned c = xb_ld(&bar[XB_XCNT(j)]); sum += c; cnt += (c > 0u) ? 1u : 0u; mine = (j == x) ? c : mine; }
        if (sum == G) break;
        __builtin_amdgcn_s_sleep(1);
        if ((++sp & 255u) == 0u) { if (xb_ld(&bar[XB_TMO])) break; if (sp > XB_SPIN_CAP) { atomicAdd(&bar[XB_TMO], 1u); break; } }
    }
    nloc = mine > 0u ? mine : 1u; nx = cnt > 0u ? cnt : 1u;
}
__device__ __forceinline__ void xcd_barrier(const XcdBarrier& b) {
    asm volatile("s_waitcnt vmcnt(0)" ::: "memory");
    __syncthreads();
    if (threadIdx.x == 0) {
        unsigned* bar = b.bar;
        __builtin_amdgcn_s_waitcnt(0);
        unsigned nloc = b.st[0], nx = b.st[1];
        if (nloc == 0u) { xcd_barrier_complete(bar, b.x, nloc, nx); b.st[0] = nloc; b.st[1] = nx; }
        const unsigned old = xb_add(&bar[XB_XSUB(b.x)], 1u);
        const unsigned gen = old / nloc;
        if (old + 1u == (gen + 1u) * nloc) {
            __builtin_amdgcn_fence(__ATOMIC_RELEASE, "agent");
            asm volatile("s_waitcnt vmcnt(0)" ::: "memory");
            const unsigned og = xb_add(&bar[XB_TOP], 1u);
            const unsigned tg = og / nx;
            if (og + 1u == (tg + 1u) * nx) xb_add(&bar[XB_TOPGEN], 1u);
            else XB_SPIN(xb_ld(&bar[XB_TOPGEN]) == tg, bar);
            __builtin_amdgcn_fence(__ATOMIC_ACQUIRE, "agent");
            xb_add(&bar[XB_XGEN(b.x)], 1u);
            asm volatile("s_waitcnt vmcnt(0)" ::: "memory");
        } else {
            XB_SPIN(xb_ld(&bar[XB_XGEN(b.x)]) == gen, bar);
            __builtin_amdgcn_fence(__ATOMIC_ACQUIRE, "agent");
            asm volatile("s_waitcnt vmcnt(0)" ::: "memory");
        }
    }
    __syncthreads();
}

constexpr int LDS_STAGE = 0;
constexpr int LDS_GIDX  = 131072;
constexpr int LDS_BIAS  = LDS_GIDX + 9216;
constexpr int LDS_TP    = LDS_BIAS + 18432;
constexpr int LDS_CNT   = LDS_TP + 256;
constexpr int LDS_MISC  = LDS_CNT + 128;
constexpr int LDS_BYTES = LDS_MISC + 128;

namespace pg {
constexpr int BM = 256, BK = 64, HALF = 128, HTB = HALF * BK * 2, STAGE_BYTES = 8 * HTB, NXCD = 8, WGM = 8;
__device__ __forceinline__ int lds_byte(int r, int c) { const int st = (r >> 4) * 2 + (c >> 5), rr = r & 15, cc = c & 31, ob = rr * 64 + cc * 2; return st * 1024 + (ob ^ (((ob >> 9) & 1) << 5)); }
__device__ __forceinline__ void stage_rc(int b, int& R, int& C) { const int st = b / 1024, sb = b % 1024, swz = sb ^ (((sb >> 9) & 1) << 5); R = (st >> 1) * 16 + swz / 64; C = (st & 1) * 32 + (swz % 64) / 2; }
__device__ __forceinline__ int perm32(int rho) { const int n = rho >> 4, i = rho & 15; return 8 * (i >> 2) + 4 * n + (i & 3); }

struct Unit { int pm, pn, pb, e, ko, ui; };
struct DenseOrder {
    int nM, nN, nwg, G, c, skip_from, skip_by;
    __device__ void init(int nM_, int nN_, int G_, int c_, int sf = 1 << 30, int sb = 0) { nM = nM_; nN = nN_; nwg = nM * nN; G = G_; c = c_; skip_from = sf; skip_by = sb; }
    __device__ bool next(int i, Unit& u) const {
        const long L = (long)i * G + c; if (L >= nwg) return false;
        int wgid = (int)L; { const int q = nwg / NXCD, r = nwg % NXCD, xcd = wgid % NXCD, off = wgid / NXCD; wgid = (xcd < r ? xcd * (q + 1) : r * (q + 1) + (xcd - r) * q) + off; }
        const int nig = WGM * nN, gid = wgid / nig, fm = gid * WGM, gsz = (nM - fm) < WGM ? (nM - fm) : WGM;
        u.pm = fm + ((wgid % nig) % gsz); u.pn = (wgid % nig) / gsz; u.pb = u.pn >= skip_from ? u.pn + skip_by : u.pn; u.e = 0; u.ko = 0; u.ui = i; return true;
    }
    __device__ __forceinline__ unsigned arow(const Unit& u, int h, int R, int, const LAS int*) const { return (unsigned)(u.pm * 256 + h * 128 + R); }
};

template <int FPM  , class Epi, class Sched>
__device__ __forceinline__ void gemm_phase(LAS unsigned char* lds, const void* A, const void* Bt, const int RB  , const Sched& S, const Epi& E, const LAS int* gidx, const int nt_ = 0  ,
        const bool primed = false  , const bool chain = false  ,
        const void* cA = nullptr, const char* cBn = nullptr, const unsigned c00 = 0, const unsigned c01 = 0, const unsigned c10 = 0, const unsigned c11 = 0) {
    constexpr bool FP8 = FPM != 0;
    const int tid = threadIdx.x, wid = __builtin_amdgcn_readfirstlane(tid >> 6), lane = tid & 63, wr = wid >> 2, wc = wid & 3, fr = lane & 15, fq = lane >> 4;
    const int nt = nt_ ? nt_ : RB / (BK * 2);
    unsigned voffB[2];
#pragma unroll
    for (int i = 0; i < 2; ++i) { int R_, C_; stage_rc(tid * 16 + i * 8192, R_, C_); const int Rb = Epi::PERM ? ((R_ & ~31) + perm32(R_ & 31)) : R_; voffB[i] = (unsigned)(Rb * RB + C_ * 2); }
    const size_t kstep = (size_t)(BK * 2);
    const size_t hstep = (size_t)HALF * RB;
    const size_t tstep = 2 * hstep;
    const unsigned ldsw = (unsigned)wid * 1024u;
    const unsigned lds0 = __builtin_amdgcn_readfirstlane((unsigned)(size_t)lds + ldsw);
    const int aoff = lds_byte(wr * 64 + fr, fq * 8), boff = lds_byte(wc * 32 + fr, fq * 8);
#define PG_SA(b, h) (((b) * 2 + (h)) * HTB)
#define PG_SB(b, h) ((4 + (b) * 2 + (h)) * HTB)
#define PG_DMA(voff_, sbase_, ldsoff_) asm volatile("s_mov_b32 m0, %2\n\ts_nop 0\n\tglobal_load_lds_dwordx4 %0, %1" :: "v"(voff_), "s"(sbase_), "s"(ldsoff_) : "memory", "m0")
#define PG_STAGE_B(bufoff, gbase) do { const char* _sb = (const char*)(gbase); _Pragma("unroll") for (int _i = 0; _i < 2; ++_i) \
        PG_DMA(voffB[_i], _sb, lds0 + (unsigned)((bufoff) + _i * 8192)); } while (0)
#define PG_STAGE_A(bufoff, usenext, h, kb) do { const char* _sa = Ab + (size_t)(kb); _Pragma("unroll") for (int _i = 0; _i < 2; ++_i) { const unsigned _o = rac[h][_i]; \
        PG_DMA(_o, _sa, lds0 + (unsigned)((bufoff) + _i * 8192)); } } while (0)
#define PG_LDA(dst, b, h) do { _Pragma("unroll") for (int m = 0; m < 4; ++m) { if constexpr (FP8) { const i32x4 lo_ = *(const LAS i32x4*)(lds + PG_SA(b, h) + aoff + m * 2048), hi_ = *(const LAS i32x4*)(lds + PG_SA(b, h) + aoff + m * 2048 + 1024); dst##8[m] = __builtin_shufflevector(lo_, hi_, 0, 1, 2, 3, 4, 5, 6, 7); } \
        else { _Pragma("unroll") for (int k = 0; k < 2; ++k) dst[m][k] = *(const LAS bf16x8*)(lds + PG_SA(b, h) + aoff + m * 2048 + k * 1024); } } } while (0)
#define PG_LDB(dst, b, h) do { _Pragma("unroll") for (int n = 0; n < 2; ++n) { if constexpr (FP8) { const i32x4 lo_ = *(const LAS i32x4*)(lds + PG_SB(b, h) + boff + n * 2048), hi_ = *(const LAS i32x4*)(lds + PG_SB(b, h) + boff + n * 2048 + 1024); dst##8[n] = __builtin_shufflevector(lo_, hi_, 0, 1, 2, 3, 4, 5, 6, 7); } \
        else { _Pragma("unroll") for (int k = 0; k < 2; ++k) dst[n][k] = *(const LAS bf16x8*)(lds + PG_SB(b, h) + boff + n * 2048 + k * 1024); } } } while (0)
#define PG_MMA(ai, bj, At, Bt_) do { __builtin_amdgcn_s_setprio(1); _Pragma("unroll") for (int m = 0; m < 4; ++m) _Pragma("unroll") for (int n = 0; n < 2; ++n) { \
        if constexpr (FPM == 2) { acc[ai][bj][m][n] = __builtin_amdgcn_mfma_scale_f32_16x16x128_f8f6f4(Bt_##8[n], At##8[m], acc[ai][bj][m][n], 2, 2, 0, Bt_##8[n][6], 0, At##8[m][6]); } \
        else if constexpr (FPM == 1) { acc[ai][bj][m][n] = __builtin_amdgcn_mfma_scale_f32_16x16x128_f8f6f4(Bt_##8[n], At##8[m], acc[ai][bj][m][n], 0, 0, 0, 0x7F7F7F7F, 0, 0x7F7F7F7F); } \
        else { _Pragma("unroll") for (int k = 0; k < 2; ++k) acc[ai][bj][m][n] = __builtin_amdgcn_mfma_f32_16x16x32_bf16(Bt_[n][k], At[m][k], acc[ai][bj][m][n], 0, 0, 0); } } \
        __builtin_amdgcn_s_setprio(0); } while (0)
#define PG_WAIT_V(n) asm volatile("s_waitcnt vmcnt(" #n ")" ::: "memory")
#define PG_WAIT_L(n) asm volatile("s_waitcnt lgkmcnt(" #n ")" ::: "memory")
#define PG_WAIT_VN(n) asm volatile("s_waitcnt vmcnt(%0)" :: "n"(n) : "memory")
#define PG_KPAIR(t, WV_) do { \
            const bool last = (t == nt - 2); \
            const size_t kb1 = (size_t)(t + 1) * kstep; \
            const size_t kb2 = last ? 0 : (size_t)(t + 2) * kstep, kb3 = kb2 + kstep; \
            const char* b2 = last ? nB : cB + (size_t)(t + 2) * kstep; const char* b3 = b2 + kstep; \
            PG_LDB(B0, 0, 0); PG_LDB(B1, 0, 1); PG_SCHED; PG_LDA(At, 0, 0); PG_STAGE_A(PG_SA(1, 1), false, 1, kb1); \
            if (last) { if (has_next) { PG_RA(rac, nxt, ui + 1); } else if (chain) { rac[0][0] = c00; rac[0][1] = c01; rac[1][0] = c10; rac[1][1] = c11; Ab = (const char*)cA; } } \
            PG_WAIT_VN(WV_); PG_WAIT_L(0); PG_BAR; PG_MMA(0, 0, At, B0); PG_MMA(0, 1, At, B1); PG_BAR; PG_SCHED; \
            PG_LDA(At, 0, 1); PG_STAGE_B(PG_SB(0, 0), b2); PG_STAGE_B(PG_SB(0, 1), b2 + hstep); PG_STAGE_A(PG_SA(0, 0), last, 0, kb2); \
            PG_WAIT_VN(WV_); PG_WAIT_L(0); PG_BAR; PG_MMA(1, 0, At, B0); PG_MMA(1, 1, At, B1); PG_BAR; PG_SCHED; \
            PG_LDB(B0, 1, 0); PG_LDB(B1, 1, 1); PG_SCHED; PG_LDA(At, 1, 0); PG_STAGE_A(PG_SA(0, 1), last, 1, kb2); \
            PG_WAIT_V(8); PG_WAIT_L(0); PG_BAR; PG_MMA(0, 0, At, B0); PG_MMA(0, 1, At, B1); PG_BAR; PG_SCHED; \
            PG_LDA(At, 1, 1); PG_STAGE_B(PG_SB(1, 0), b3); PG_STAGE_B(PG_SB(1, 1), b3 + hstep); PG_STAGE_A(PG_SA(1, 0), last, 0, kb3); \
            PG_WAIT_V(8); PG_WAIT_L(0); PG_BAR; PG_MMA(1, 0, At, B0); PG_MMA(1, 1, At, B1); PG_BAR; PG_SCHED; \
        } while (0)
#define PG_BAR __builtin_amdgcn_s_barrier()
#define PG_SCHED __builtin_amdgcn_sched_barrier(0)
#define PG_RA(dst, u, ui_) do { _Pragma("unroll") for (int _i = 0; _i < 2; ++_i) { int R_, C_; stage_rc(tid * 16 + _i * 8192, R_, C_); _Pragma("unroll") for (int _h = 0; _h < 2; ++_h) dst[_h][_i] = S.arow(u, _h, R_, ui_, gidx) * (unsigned)RB + (unsigned)C_ * 2u + (unsigned)u.ko; } } while (0)
    Unit cur, nxt; int ui = 0;
    if (!S.next(0, cur)) return;
    f32x4 acc[2][2][4][2];
#pragma unroll
    for (int a = 0; a < 2; ++a)
#pragma unroll
        for (int b = 0; b < 2; ++b)
#pragma unroll
            for (int m = 0; m < 4; ++m)
#pragma unroll
                for (int n = 0; n < 2; ++n) acc[a][b][m][n] = (f32x4){0.f, 0.f, 0.f, 0.f};
    bf16x8 At[4][2], B0[2][2], B1[2][2]; i32x8 At8[4], B08[2], B18[2];
    unsigned rac[2][2];
    PG_RA(rac, cur, 0);
    const char* Ab = (const char*)A;
    const char* cB = (const char*)Bt + (size_t)cur.pb * tstep + cur.ko;
    if (!primed) {
    PG_STAGE_B(PG_SB(0, 0), cB); PG_STAGE_B(PG_SB(0, 1), cB + hstep); PG_STAGE_A(PG_SA(0, 0), false, 0, 0); PG_STAGE_A(PG_SA(0, 1), false, 1, 0);
    if (wr == 1) PG_BAR;
    PG_WAIT_V(2); PG_BAR;
    PG_STAGE_B(PG_SB(1, 0), cB + kstep); PG_STAGE_A(PG_SA(1, 0), false, 0, kstep); PG_STAGE_B(PG_SB(1, 1), cB + hstep + kstep);
    PG_WAIT_V(6); PG_BAR;
    }
    for (;;) {
        const bool has_next = S.next(ui + 1, nxt);
        const char* nB = has_next ? (const char*)Bt + (size_t)nxt.pb * tstep + nxt.ko : (chain ? cBn : cB);
        int t0 = 0;
        if (Epi::NST > 0 && ui > 0) { PG_KPAIR(0, 8 + Epi::NST); t0 = 2; }
        for (int t = t0; t < nt; t += 2) PG_KPAIR(t, 8);
        E(acc, cur, wr, wc, fr, fq);
        if (!has_next) break;
#pragma unroll
        for (int a = 0; a < 2; ++a)
#pragma unroll
            for (int b = 0; b < 2; ++b)
#pragma unroll
                for (int m = 0; m < 4; ++m)
#pragma unroll
                    for (int n = 0; n < 2; ++n) acc[a][b][m][n] = (f32x4){0.f, 0.f, 0.f, 0.f};
        cur = nxt; cB = nB; ++ui;
    }
    if (!chain) {
    PG_WAIT_V(0);
    if (wr == 0) PG_BAR;
    PG_BAR;
    }
#undef PG_SA
#undef PG_SB
#undef PG_STAGE_A
#undef PG_STAGE_B
#undef PG_DMA
#undef PG_LDA
#undef PG_LDB
#undef PG_MMA
#undef PG_WAIT_V
#undef PG_WAIT_L
#undef PG_WAIT_VN
#undef PG_KPAIR
#undef PG_BAR
#undef PG_SCHED
#undef PG_RA
}

template <class Sched>
__device__ __forceinline__ void first_unit_of(const Sched& S, const void* Bt, const int RB, const char*& cB, unsigned& r00, unsigned& r01, unsigned& r10, unsigned& r11) {
    Unit u; u.pm = 0; u.pn = 0; u.pb = 0; u.e = 0; u.ko = 0; u.ui = 0; S.next(0, u);
    const int tid = threadIdx.x; int R0, C0, R1, C1; stage_rc(tid * 16, R0, C0); stage_rc(tid * 16 + 8192, R1, C1);
    r00 = S.arow(u, 0, R0, 0, nullptr) * (unsigned)RB + (unsigned)C0 * 2u + (unsigned)u.ko; r01 = S.arow(u, 0, R1, 0, nullptr) * (unsigned)RB + (unsigned)C1 * 2u + (unsigned)u.ko;
    r10 = S.arow(u, 1, R0, 0, nullptr) * (unsigned)RB + (unsigned)C0 * 2u + (unsigned)u.ko; r11 = S.arow(u, 1, R1, 0, nullptr) * (unsigned)RB + (unsigned)C1 * 2u + (unsigned)u.ko;
    cB = (const char*)Bt + (size_t)u.pb * (2 * (size_t)HALF * RB) + u.ko;
}
__device__ __forceinline__ u32x4 pack8(const f32x4 a, const f32x4 b, float s) { u32x4 w; w.x = pk2(a[0] * s, a[1] * s); w.y = pk2(a[2] * s, a[3] * s); w.z = pk2(b[0] * s, b[1] * s); w.w = pk2(b[2] * s, b[3] * s); return w; }
typedef f32x4 Acc[2][2][4][2];

__device__ __forceinline__ float rstd_from(const float* ssq8) { const f32x4 a0 = *(const f32x4*)ssq8, a1 = *(const f32x4*)(ssq8 + 4);
    return 1.0f / sqrtf(((a0[0] + a0[1]) + (a0[2] + a0[3]) + (a1[0] + a1[1]) + (a1[2] + a1[3])) * (1.f / 512.f) + EPS); }
struct EpiProjMain {
    static constexpr bool PERM = true; static constexpr int NST = 0; P p;
    __device__ __forceinline__ void operator()(const Acc& acc, const Unit& u, int wr, int wc, int fr, int fq) const {
        const int row0 = u.pm * 256 + wr * 64 + fr;
        if (u.pn < 8) {
            bf16_t* base = WSP(bf16_t, u.pn < 4 ? WS_SBQ : WS_SBK); const float sc = u.pn < 4 ? 0.08838834764831845f * 1.4426950408889634f : 1.f;    const int col0 = (u.pn & 3) * 256 + wc * 32 + 8 * fq;
#pragma unroll
            for (int ai = 0; ai < 2; ++ai)
#pragma unroll
                for (int m = 0; m < 4; ++m) { bf16_t* rp = base + (size_t)(row0 + ai * 128 + m * 16) * 1024 + col0;
#pragma unroll
                    for (int bj = 0; bj < 2; ++bj) *(u32x4*)(rp + bj * 128) = pack8(acc[ai][bj][m][0], acc[ai][bj][m][1], sc); }
        } else {
            const int lat = (u.pn - 8) >> 1, ct = (u.pn - 8) & 1; bf16_t* base = WSP(bf16_t, lat ? WS_KVLAT : WS_QLAT); const int col0 = ct * 256 + wc * 32 + 8 * fq;
            float* ssqp = WSP(float, WS_SSQP);
#pragma unroll
            for (int ai = 0; ai < 2; ++ai)
#pragma unroll
                for (int m = 0; m < 4; ++m) { const int row = row0 + ai * 128 + m * 16; bf16_t* rp = base + (size_t)row * 512 + col0; float s = 0.f;
#pragma unroll
                    for (int bj = 0; bj < 2; ++bj) { *(u32x4*)(rp + bj * 128) = pack8(acc[ai][bj][m][0], acc[ai][bj][m][1], 1.f);
#pragma unroll
                        for (int n = 0; n < 2; ++n) { const f32x4 v = acc[ai][bj][m][n]; s += (v[0] * v[0] + v[1] * v[1]) + (v[2] * v[2] + v[3] * v[3]); } }
                    s += __shfl_xor(s, 16); s += __shfl_xor(s, 32);
                    if (fq == 0) ssqp[(size_t)row * 16 + lat * 8 + ct * 4 + wc] = s; }
        }
    }
};
template <bool SCALE>
__device__ __forceinline__ void epi_vt_r(const Acc& acc, const float* __restrict__ ssqp, bf16_t* __restrict__ dst, int f0, int tokb) {
#pragma unroll
    for (int bj = 0; bj < 2; ++bj) {
        const int tok0 = tokb + bj * 128, b = tok0 / SEQ, s0 = tok0 % SEQ;
        float sc[8];
#pragma unroll
        for (int j = 0; j < 8; ++j) sc[j] = SCALE ? rstd_from(ssqp + (size_t)(tok0 + j) * 16 + 8) : 1.f;
#pragma unroll
        for (int ai = 0; ai < 2; ++ai)
#pragma unroll
            for (int m = 0; m < 4; ++m) { const int f = f0 + ai * 128 + m * 16, h = f >> 7, d = f & 127;
                const f32x4 v0 = acc[ai][bj][m][0], v1 = acc[ai][bj][m][1]; u32x4 w;
                w.x = pk2(v0[0] * sc[0], v0[1] * sc[1]); w.y = pk2(v0[2] * sc[2], v0[3] * sc[3]); w.z = pk2(v1[0] * sc[4], v1[1] * sc[5]); w.w = pk2(v1[2] * sc[6], v1[3] * sc[7]);
                *(u32x4*)(dst + ((size_t)(b * 8 + h) * 128 + d) * SEQ + s0) = w; }
    }
}
template <bool SCALE> struct EpiVt {
    static constexpr bool PERM = true; static constexpr int NST = 0; P p; size_t dst_off;
    __device__ __forceinline__ void operator()(const Acc& acc, const Unit& u, int wr, int wc, int fr, int fq) const {
        epi_vt_r<SCALE>(acc, WSP(float, WS_SSQP), WSP(bf16_t, dst_off), u.pm * 256 + wr * 64 + fr, u.pn * 256 + wc * 32 + 8 * fq);
    }
};
__device__ __forceinline__ void epi_krope_r(const Acc& acc, const float2* __restrict__ cs, bf16_t* __restrict__ dst, int row0, int col0) {
#pragma unroll
    for (int ai = 0; ai < 2; ++ai) {
        f32x4 cv[4][2];
#pragma unroll
        for (int m = 0; m < 4; ++m) { const float2* cr = cs + (size_t)(row0 + ai * 128 + m * 16) * 32 + (col0 >> 1); cv[m][0] = *(const f32x4*)cr; cv[m][1] = *(const f32x4*)(cr + 2); }
        asm volatile("" ::: "memory");
#pragma unroll
        for (int m = 0; m < 4; ++m) { const int row = row0 + ai * 128 + m * 16; const f32x4 v0 = acc[ai][0][m][0], v1 = acc[ai][0][m][1], c0 = cv[m][0], c1 = cv[m][1];
            u32x4 w; w.x = pk2(v0[0] * c0[0] - v0[1] * c0[1], v0[1] * c0[0] + v0[0] * c0[1]); w.y = pk2(v0[2] * c0[2] - v0[3] * c0[3], v0[3] * c0[2] + v0[2] * c0[3]);
            w.z = pk2(v1[0] * c1[0] - v1[1] * c1[1], v1[1] * c1[0] + v1[0] * c1[1]); w.w = pk2(v1[2] * c1[2] - v1[3] * c1[3], v1[3] * c1[2] + v1[2] * c1[3]);
            *(u32x4*)(dst + (size_t)row * 64 + col0) = w; }
        asm volatile("" ::: "memory");
    }
}
struct EpiKrope {
    static constexpr bool PERM = true; static constexpr int NST = 0; P p;
    __device__ __forceinline__ void operator()(const Acc& acc, const Unit& u, int wr, int wc, int fr, int fq) const {
        if (wc >= 2) return;
        epi_krope_r(acc, WSP(float2, WS_CS), WSP(bf16_t, WS_KROPE), u.pm * 256 + wr * 64 + fr, wc * 32 + 8 * fq);
    }
};

__device__ __forceinline__ void epi_q_r(const Acc& acc, const float* __restrict__ ssqp, const float2* __restrict__ cs, bf16_t* __restrict__ dst, int row0, int cbase) {
    const int j0 = cbase % 192, j1 = (cbase + 128) % 192; const bool rp0 = j0 >= 128, rp1 = j1 >= 128; const int i00 = rp0 ? (j0 - 128) >> 1 : 0, i01 = rp1 ? (j1 - 128) >> 1 : 0;
#pragma unroll
    for (int qq = 0; qq < 4; ++qq) {
        f32x4 ca0[2], ca1[2], cb0[2], cb1[2]; float rsv[2];
#pragma unroll
        for (int h = 0; h < 2; ++h) { const int q = 2 * qq + h, ai = q >> 2, m = q & 3, row = row0 + ai * 128 + m * 16; const float2* cr = cs + (size_t)row * 32;
            ca0[h] = *(const f32x4*)(cr + i00); ca1[h] = *(const f32x4*)(cr + i00 + 2); cb0[h] = *(const f32x4*)(cr + i01); cb1[h] = *(const f32x4*)(cr + i01 + 2);
            rsv[h] = rstd_from(ssqp + (size_t)row * 16) * (0.07216878364870322f * 1.4426950408889634f); }
        asm volatile("" ::: "memory");
#pragma unroll
        for (int h = 0; h < 2; ++h) { const int q = 2 * qq + h, ai = q >> 2, m = q & 3, row = row0 + ai * 128 + m * 16;
#pragma unroll
            for (int bj = 0; bj < 2; ++bj) { const bool rp = bj ? rp1 : rp0;
                f32x4 v0 = acc[ai][bj][m][0] * rsv[h], v1 = acc[ai][bj][m][1] * rsv[h];
                if (rp) { const f32x4 c0v = bj ? cb0[h] : ca0[h], c1v = bj ? cb1[h] : ca1[h], t0 = v0, t1 = v1;
                    v0[0] = t0[0] * c0v[0] - t0[1] * c0v[1]; v0[1] = t0[1] * c0v[0] + t0[0] * c0v[1]; v0[2] = t0[2] * c0v[2] - t0[3] * c0v[3]; v0[3] = t0[3] * c0v[2] + t0[2] * c0v[3];
                    v1[0] = t1[0] * c1v[0] - t1[1] * c1v[1]; v1[1] = t1[1] * c1v[0] + t1[0] * c1v[1]; v1[2] = t1[2] * c1v[2] - t1[3] * c1v[3]; v1[3] = t1[3] * c1v[2] + t1[2] * c1v[3]; }
                *(u32x4*)(dst + (size_t)row * 1536 + cbase + bj * 128) = pack8(v0, v1, 1.f); } }
        asm volatile("" ::: "memory");
    }
}
struct EpiQ {
    static constexpr bool PERM = true; static constexpr int NST = 0; P p;
    __device__ __forceinline__ void operator()(const Acc& acc, const Unit& u, int wr, int wc, int fr, int fq) const {
        epi_q_r(acc, WSP(float, WS_SSQP), WSP(float2, WS_CS), WSP(bf16_t, WS_QMLA), u.pm * 256 + wr * 64 + fr, u.pn * 256 + wc * 32 + 8 * fq);
    }
};
__device__ __forceinline__ void epi_knope_r(const Acc& acc, const float* __restrict__ ssqp, bf16_t* __restrict__ dst, int row0, int c0) {
    float rs[2][4];
#pragma unroll
    for (int ai = 0; ai < 2; ++ai)
#pragma unroll
        for (int m = 0; m < 4; ++m) rs[ai][m] = rstd_from(ssqp + (size_t)(row0 + ai * 128 + m * 16) * 16 + 8);
    asm volatile("" ::: "memory");
#pragma unroll
    for (int ai = 0; ai < 2; ++ai)
#pragma unroll
        for (int m = 0; m < 4; ++m) { const int row = row0 + ai * 128 + m * 16;
#pragma unroll
            for (int bj = 0; bj < 2; ++bj) *(u32x4*)(dst + (size_t)row * 1024 + c0 + bj * 128) = pack8(acc[ai][bj][m][0], acc[ai][bj][m][1], rs[ai][m]); }
}
struct EpiKnope {
    static constexpr bool PERM = true; static constexpr int NST = 0; P p;
    __device__ __forceinline__ void operator()(const Acc& acc, const Unit& u, int wr, int wc, int fr, int fq) const {
        epi_knope_r(acc, WSP(float, WS_SSQP), WSP(bf16_t, WS_KNOPE), u.pm * 256 + wr * 64 + fr, u.pn * 256 + wc * 32 + 8 * fq);
    }
};
__device__ __forceinline__ void epi_out_r(const Acc& acc, const float* __restrict__ xin, const float* __restrict__ g1, bf16_t* __restrict__ x1, int row0, int col0) {
    f32x4 gv[2][2];
#pragma unroll
    for (int bj = 0; bj < 2; ++bj)
#pragma unroll
        for (int n = 0; n < 2; ++n) gv[bj][n] = *(const f32x4*)(g1 + col0 + bj * 128 + n * 4);
#pragma unroll
    for (int ai = 0; ai < 2; ++ai) {
        f32x4 xv[4][2][2];
#pragma unroll
        for (int m = 0; m < 4; ++m)
#pragma unroll
            for (int bj = 0; bj < 2; ++bj)
#pragma unroll
                for (int n = 0; n < 2; ++n) xv[m][bj][n] = *(const f32x4*)(xin + (size_t)(row0 + ai * 128 + m * 16) * D + col0 + bj * 128 + n * 4);
        asm volatile("" ::: "memory");
#pragma unroll
        for (int m = 0; m < 4; ++m)
#pragma unroll
            for (int bj = 0; bj < 2; ++bj)
                *(u32x4*)(x1 + (size_t)(row0 + ai * 128 + m * 16) * D + col0 + bj * 128) = pack8(xv[m][bj][0] + gv[bj][0] * acc[ai][bj][m][0], xv[m][bj][1] + gv[bj][1] * acc[ai][bj][m][1], 1.f);
        asm volatile("" ::: "memory");
    }
}
struct EpiOut {
    static constexpr bool PERM = true; static constexpr int NST = 0; P p;
    __device__ __forceinline__ void operator()(const Acc& acc, const Unit& u, int wr, int wc, int fr, int fq) const {
        const int row0 = u.pm * 256 + wr * 64 + fr, b = (u.pm * 256) / SEQ, col0 = u.pn * 256 + wc * 32 + 8 * fq;
        epi_out_r(acc, p.x, WSP(float, WS_MOD) + (size_t)b * NMOD * D + 2 * D, WSP(bf16_t, WS_X1), row0, col0);
    }
};
struct EpiMoe1 {
    static constexpr bool PERM = true; static constexpr int NST = 8; P p; size_t dst_off; const LAS float* bias_lds;
    __device__ __forceinline__ void operator()(const Acc& acc, const Unit& u, int wr, int wc, int fr, int fq) const {
        const int row0 = u.pm * 256 + wr * 64 + fr, a0 = u.pn * 128 + wc * 32 + 8 * fq; const LAS float* b1 = bias_lds + (u.ui < 18 ? u.ui : 0) * 256 + 2 * (wc * 32 + 8 * fq); bf16_t* dst = WSP(bf16_t, dst_off);
        float bg[8], bl[8];
#pragma unroll
        for (int q = 0; q < 4; ++q) { const f32x4 t = *(const LAS f32x4*)(b1 + 4 * q); bg[2 * q] = t[0]; bl[2 * q] = t[1] + 1.f; bg[2 * q + 1] = t[2]; bl[2 * q + 1] = t[3] + 1.f; }
#pragma unroll
        for (int ai = 0; ai < 2; ++ai)
#pragma unroll
            for (int m = 0; m < 4; ++m) { const int row = row0 + ai * 128 + m * 16; float o[8];
#pragma unroll
                for (int j = 0; j < 8; ++j) { float g = acc[ai][0][m][j >> 2][j & 3] * (MOE1_FP6 ? 1.f : W8_INV) + bg[j], l = acc[ai][1][m][j >> 2][j & 3] * (MOE1_FP6 ? 1.f : W8_INV) + bl[j];
                    g = fminf(g, 7.f); l = fminf(fmaxf(l, -6.f), 8.f);
                    o[j] = g * __builtin_amdgcn_rcpf(1.f + __builtin_amdgcn_exp2f(-2.4554669595930156f * g)) * l; }
                if (MOE_FP8) { u32x2 w; w.x = pk4_fp8(o[0], o[1], o[2], o[3]); w.y = pk4_fp8(o[4], o[5], o[6], o[7]); *(u32x2*)((unsigned char*)dst + (size_t)row * DE + a0) = w; }
                else { u32x4 w; w.x = pk2(o[0], o[1]); w.y = pk2(o[2], o[3]); w.z = pk2(o[4], o[5]); w.w = pk2(o[6], o[7]);
                *(u32x4*)(dst + (size_t)row * DE + a0) = w; } }
    }
};
struct EpiMoe2 {
    static constexpr bool PERM = true; static constexpr int NST = 16; P p; const LAS float* bias_lds;
    __device__ __forceinline__ void operator()(const Acc& acc, const Unit& u, int wr, int wc, int fr, int fq) const {
        const int row0 = u.pm * 256 + wr * 64 + fr, c0 = u.pn * 256 + wc * 32 + 8 * fq; const LAS float* b2 = bias_lds + (u.ui < 18 ? u.ui : 0) * 256 + wc * 32 + 8 * fq; bf16_t* dst = WSP(bf16_t, WS_Y);
        f32x4 bv[2][2];
#pragma unroll
        for (int bj = 0; bj < 2; ++bj)
#pragma unroll
            for (int n = 0; n < 2; ++n) bv[bj][n] = *(const LAS f32x4*)(b2 + bj * 128 + 4 * n) * (Y_FP8 ? Y_SCALE : 1.f);
#pragma unroll
        for (int ai = 0; ai < 2; ++ai)
#pragma unroll
            for (int m = 0; m < 4; ++m) { const int row = row0 + ai * 128 + m * 16;
#pragma unroll
                for (int bj = 0; bj < 2; ++bj) {
                    if (Y_FP8) { f32x4 t0 = acc[ai][bj][m][0] * ((MOE_FP8 ? W8_INV : 1.f) * Y_SCALE) + bv[bj][0], t1 = acc[ai][bj][m][1] * ((MOE_FP8 ? W8_INV : 1.f) * Y_SCALE) + bv[bj][1];
#pragma unroll
                        for (int j = 0; j < 4; ++j) { t0[j] = __builtin_amdgcn_fmed3f(t0[j], -448.f, 448.f); t1[j] = __builtin_amdgcn_fmed3f(t1[j], -448.f, 448.f); }
                        u32x2 w; w.x = pk4_fp8(t0[0], t0[1], t0[2], t0[3]); w.y = pk4_fp8(t1[0], t1[1], t1[2], t1[3]);
                        *(u32x2*)((unsigned char*)dst + (size_t)row * D + c0 + bj * 128) = w; }
                    else *(u32x4*)(dst + (size_t)row * D + c0 + bj * 128) = pack8(acc[ai][bj][m][0] * (MOE_FP8 ? W8_INV : 1.f) + bv[bj][0], acc[ai][bj][m][1] * (MOE_FP8 ? W8_INV : 1.f) + bv[bj][1], 1.f); } }
    }
};
template <int NCT, bool GATHER> struct MoeOrder {
    const LAS int* tp; int T, rtr, ctr, rpr, G, c;
    __device__ void init(const LAS int* tp_, int G_, int c_) { tp = tp_; T = tp_[32]; G = G_; c = c_;
        const int x = c_ & 7, a = (c_ >> 3) & 31;
        if (NCT == 16) { rtr = (x >> 2) * 8 + (a >> 2); ctr = (x & 3) * 4 + (a & 3); rpr = 16; } else { rtr = (x >> 1) * 8 + (a >> 2); ctr = (x & 1) * 4 + (a & 3); rpr = 32; } }
    __device__ bool next(int i, Unit& u) const {
        int g, ct;
        if (G == 256) { g = i * rpr + rtr; ct = ctr; } else { const long L = (long)i * G + c; g = (int)(L / NCT); ct = (int)(L % NCT); }
        if (g >= T) return false;
        int e;
        if (G == 256 && i < 20 && tp[63]) { e = tp[40 + i]; }
        else { e = 0; while (e < 31 && tp[e + 1] <= g) ++e; }
        u.pm = g; u.pn = ct; u.pb = e * NCT + ct; u.e = e; u.ko = 0; u.ui = i; return true;
    }
    __device__ __forceinline__ unsigned arow(const Unit& u, int h, int R, int ui, const LAS int* gidx) const { return GATHER ? (unsigned)((const LAS unsigned short*)gidx)[ui * 256 + h * 128 + R] : (unsigned)(u.pm * 256 + h * 128 + R); }
};
struct KropeOrder {
    int G, c;
    __device__ bool next(int i, Unit& u) const { const int L = i * G + c; if (L >= 256) return false; u.pm = L >> 2; u.pn = L & 3; u.pb = 16; u.e = 0; u.ko = (L & 3) * 1024; u.ui = i; return true; }
    __device__ __forceinline__ unsigned arow(const Unit& u, int h, int R, int, const LAS int*) const { return (unsigned)(u.pm * 256 + h * 128 + R); }
};
struct EpiKropeP {
    static constexpr bool PERM = true; static constexpr int NST = 0; P p;
    __device__ __forceinline__ void operator()(const Acc& acc, const Unit& u, int wr, int wc, int fr, int fq) const {
        if (wc >= 2) return;
        float* dst = WSP(float, WS_G_QRAW) + (size_t)u.pn * NTOK * 64; const int row0 = u.pm * 256 + wr * 64 + fr, col0 = wc * 32 + 8 * fq;
#pragma unroll
        for (int ai = 0; ai < 2; ++ai)
#pragma unroll
            for (int m = 0; m < 4; ++m) { float* rp = dst + (size_t)(row0 + ai * 128 + m * 16) * 64 + col0; *(f32x4*)rp = acc[ai][0][m][0]; *(f32x4*)(rp + 4) = acc[ai][0][m][1]; }
    }
};
}

__device__ __forceinline__ void krope_fixup(const float* __restrict__ part, const float2* __restrict__ cs, bf16_t* __restrict__ dst, int G, int bid) {
    for (int r0 = bid * 64; r0 < NTOK; r0 += G * 64) { const int row = r0 + (threadIdx.x >> 3), c8 = (threadIdx.x & 7) * 8;
        f32x4 a = {0.f, 0.f, 0.f, 0.f}, b = {0.f, 0.f, 0.f, 0.f};
#pragma unroll
        for (int q = 0; q < 4; ++q) { const float* pp = part + ((size_t)q * NTOK + row) * 64 + c8; a += *(const f32x4*)pp; b += *(const f32x4*)(pp + 4); }
        const f32x4 c0 = *(const f32x4*)(cs + (size_t)row * 32 + (c8 >> 1)), c1 = *(const f32x4*)(cs + (size_t)row * 32 + (c8 >> 1) + 2);
        u32x4 w; w.x = pk2(a[0] * c0[0] - a[1] * c0[1], a[1] * c0[0] + a[0] * c0[1]); w.y = pk2(a[2] * c0[2] - a[3] * c0[3], a[3] * c0[2] + a[2] * c0[3]);
        w.z = pk2(b[0] * c1[0] - b[1] * c1[1], b[1] * c1[0] + b[0] * c1[1]); w.w = pk2(b[2] * c1[2] - b[3] * c1[3], b[3] * c1[2] + b[2] * c1[3]);
        *(u32x4*)(dst + (size_t)row * 64 + c8) = w; }
}

struct DmIdent { __device__ int operator()(int n) const { return n; } };
struct DmWin { __device__ int operator()(int n) const { if (n < 4096) return n; const int j = n - 4096; return j < 32 ? 4096 + 2 * j : 4096 + 2 * (j - 32) + 1; } };
struct DmWq { __device__ int operator()(int n) const { const int h = n / 192, j = n - h * 192; if (j < 128) return n; return j < 160 ? h * 192 + 128 + 2 * (j - 128) : h * 192 + 128 + 2 * (j - 160) + 1; } };
struct DmWkv { __device__ int operator()(int n) const { const int h = n >> 8, r = n & 255; return r < 128 ? h * 128 + r : 1024 + h * 128 + (r - 128); } };
struct DmW1 { __device__ int operator()(int n) const { const int a = n >> 1; return (a >> 7) * 256 + (n & 1) * 128 + (a & 127); } };
template <class DM>
__device__ __forceinline__ void conv_tile(const float* W, int ldw, int k0, int n0, bf16_t* Bt, int K, DM dm, const float* kscale, LAS unsigned* T) {
    const int tid = threadIdx.x, kp = tid >> 4, nc = tid & 15;
    f32x4 a[2], b[2];
#pragma unroll
    for (int ps = 0; ps < 2; ++ps) { const int k = k0 + 2 * (kp + 32 * ps);
        a[ps] = *(const f32x4*)(W + (size_t)k * ldw + n0 + 4 * nc); b[ps] = *(const f32x4*)(W + (size_t)(k + 1) * ldw + n0 + 4 * nc);
        if (kscale) { a[ps] *= kscale[k]; b[ps] *= kscale[k + 1]; } }
#pragma unroll
    for (int ps = 0; ps < 2; ++ps)
#pragma unroll
        for (int j = 0; j < 4; ++j) T[(4 * nc + j) * 66 + kp + 32 * ps] = pk2(a[ps][j], b[ps][j]);
    __syncthreads();
#pragma unroll
    for (int q = 0; q < 2; ++q) { const int ch = tid + 512 * q, n = ch >> 4, c = ch & 15;
        const u32x2 lo = *(const LAS u32x2*)(T + n * 66 + 4 * c), hi = *(const LAS u32x2*)(T + n * 66 + 4 * c + 2);
        u32x4 w; w.x = lo.x; w.y = lo.y; w.z = hi.x; w.w = hi.y;
        *(u32x4*)(Bt + (size_t)dm(n0 + n) * K + k0 + 8 * c) = w; }
    __syncthreads();
}

template <class DM>
__device__ __forceinline__ void conv_tile8(const float* W, int ldw, int k0, int n0, unsigned char* Bt, int K, DM dm, LAS unsigned* T) {
    const int tid = threadIdx.x, k4 = tid >> 4, nc = tid & 15;
    f32x4 a[4];
#pragma unroll
    for (int r = 0; r < 4; ++r) a[r] = *(const f32x4*)(W + (size_t)(k0 + 4 * k4 + r) * ldw + n0 + 4 * nc) * W8_SCALE;
#pragma unroll
    for (int j = 0; j < 4; ++j) T[(4 * nc + j) * 36 + k4] = pk4_fp8(a[0][j], a[1][j], a[2][j], a[3][j]);
    __syncthreads();
    { const int n = tid >> 3, c = tid & 7; const u32x4 w = *(const LAS u32x4*)(T + n * 36 + 4 * c); *(u32x4*)(Bt + (size_t)dm(n0 + n) * K + k0 + 16 * c) = w; }
    __syncthreads();
}

template <class DM>
__device__ __forceinline__ void conv_tile8x2(const float* Wa, const float* Wb, int ldw, int k0a, int n0a, int k0b, int n0b, unsigned char* Bta, unsigned char* Btb, int K, DM dm, LAS unsigned* T) {
    const int tid = threadIdx.x, k4 = tid >> 4, nc = tid & 15;
    f32x4 a[4], b[4];
#pragma unroll
    for (int r = 0; r < 4; ++r) a[r] = __builtin_nontemporal_load((const f32x4*)(Wa + (size_t)(k0a + 4 * k4 + r) * ldw + n0a + 4 * nc));
#pragma unroll
    for (int r = 0; r < 4; ++r) b[r] = __builtin_nontemporal_load((const f32x4*)(Wb + (size_t)(k0b + 4 * k4 + r) * ldw + n0b + 4 * nc));
#pragma unroll
    for (int j = 0; j < 4; ++j) T[(4 * nc + j) * 36 + k4] = pk4_fp8(a[0][j] * W8_SCALE, a[1][j] * W8_SCALE, a[2][j] * W8_SCALE, a[3][j] * W8_SCALE);
#pragma unroll
    for (int j = 0; j < 4; ++j) T[2304 + (4 * nc + j) * 36 + k4] = pk4_fp8(b[0][j] * W8_SCALE, b[1][j] * W8_SCALE, b[2][j] * W8_SCALE, b[3][j] * W8_SCALE);
    __syncthreads();
    { const int n = tid >> 3, c = tid & 7; const u32x4 wa = *(const LAS u32x4*)(T + n * 36 + 4 * c), wb = *(const LAS u32x4*)(T + 2304 + n * 36 + 4 * c);
      __builtin_nontemporal_store(wa, (u32x4*)(Bta + (size_t)dm(n0a + n) * K + k0a + 16 * c)); __builtin_nontemporal_store(wb, (u32x4*)(Btb + (size_t)dm(n0b + n) * K + k0b + 16 * c)); }
    __syncthreads();
}

template <class DM>
__device__ __forceinline__ void conv_macro8(const float* W, int ldw, int k0, int n0, unsigned char* Bt, int K, DM dm, LAS unsigned char* Tb) {
    const int tid = threadIdx.x, kq = tid >> 6, nc = tid & 63;
    const float* src = W + (size_t)(k0 + 4 * kq) * ldw + n0 + 4 * nc;
    f32x4 a[2][8];
#define CM_LOAD(buf, slab) do { _Pragma("unroll") for (int h_ = 0; h_ < 2; ++h_) _Pragma("unroll") for (int r_ = 0; r_ < 4; ++r_) a[buf][h_ * 4 + r_] = __builtin_nontemporal_load((const f32x4*)(src + (size_t)((slab) * 64 + h_ * 32 + r_) * ldw)); } while (0)
#define CM_PUT(buf, slab) do { _Pragma("unroll") for (int h_ = 0; h_ < 2; ++h_) _Pragma("unroll") for (int j_ = 0; j_ < 4; ++j_) \
        *(LAS unsigned*)(Tb + (4 * nc + j_) * 260 + ((slab) * 64 + h_ * 32 + 4 * kq)) = pk4_fp8(a[buf][h_ * 4][j_] * W8_SCALE, a[buf][h_ * 4 + 1][j_] * W8_SCALE, a[buf][h_ * 4 + 2][j_] * W8_SCALE, a[buf][h_ * 4 + 3][j_] * W8_SCALE); } while (0)
    CM_LOAD(0, 0); CM_LOAD(1, 1);
    CM_PUT(0, 0); CM_LOAD(0, 2);
    CM_PUT(1, 1); CM_LOAD(1, 3);
    CM_PUT(0, 2); CM_PUT(1, 3);
#undef CM_LOAD
#undef CM_PUT
    __syncthreads();
#pragma unroll
    for (int ps = 0; ps < 8; ++ps) { const int n = ps * 32 + (tid >> 4), c = tid & 15; const LAS unsigned* tp_ = (const LAS unsigned*)(Tb + n * 260 + 16 * c);
        u32x4 w; w.x = tp_[0]; w.y = tp_[1]; w.z = tp_[2]; w.w = tp_[3];
        __builtin_nontemporal_store(w, (u32x4*)(Bt + (size_t)dm(n0 + n) * K + k0 + 16 * c)); }
    __syncthreads();
}

__device__ __forceinline__ void phase_prologue(const P& p, LAS unsigned char* lds, int G, int bid) {
    const int tid = threadIdx.x, lane = tid & 63, wid = tid >> 6;
    LAS float* cact = (LAS float*)lds;
    LAS float* red = (LAS float*)(lds + 32768);
    LAS unsigned* T = (LAS unsigned*)(lds + 81920);
    constexpr int U_MOD = 96, U_CS = 64 + 8;
    constexpr int T_WIN = 16 * 65, T_WQ = 4 * 24, T_WKV = 4 * 32, T_WOUT = 16 * 32;
    constexpr int U_REST = U_CS + T_WIN + T_WQ + T_WKV + T_WOUT;
    const bool split = G > 2 * U_MOD;
    if (!split || bid < U_MOD) {
        for (int i = tid; i < 4 * 2048; i += 512) { const int b = i >> 11, k = i & 2047; const float c = p.c[i]; cact[k * 4 + b] = c / (1.f + __expf(-c)); }
        __syncthreads();
        for (int mu = bid; mu < U_MOD; mu += G) {
            f32x4 acc[4] = {{0.f, 0.f, 0.f, 0.f}, {0.f, 0.f, 0.f, 0.f}, {0.f, 0.f, 0.f, 0.f}, {0.f, 0.f, 0.f, 0.f}};
            const int hh = lane >> 5, cl = lane & 31;
            const float* w = p.w_mod + (size_t)(wid * 256 + hh) * (NMOD * D) + mu * 128 + 4 * cl;
#pragma unroll 16
            for (int k = 0; k < 128; ++k) { const f32x4 wv = __builtin_nontemporal_load((const f32x4*)(w + (size_t)(2 * k) * (NMOD * D))); const f32x4 c = *(const LAS f32x4*)(cact + (wid * 256 + 2 * k + hh) * 4);
                acc[0] += wv * c[0]; acc[1] += wv * c[1]; acc[2] += wv * c[2]; acc[3] += wv * c[3]; }
#pragma unroll
            for (int b = 0; b < 4; ++b) *(LAS f32x4*)(red + ((wid * 64 + lane) * 4 + b) * 4) = acc[b];
            __syncthreads();
            if (tid < 128) { const int l = tid >> 2, b = tid & 3; f32x4 sum = *(const f32x4*)(p.b_mod + mu * 128 + 4 * l);
#pragma unroll
                for (int w8 = 0; w8 < 16; ++w8) sum += *(const LAS f32x4*)(red + ((w8 * 32 + l) * 4 + b) * 4);
                *(f32x4*)(WSP(float, WS_MOD) + (size_t)b * NMOD * D + mu * 128 + 4 * l) = sum; }
            __syncthreads();
        }
        if (split) return;
    }
    const int c0 = split ? bid - U_MOD : bid, GS = split ? G - U_MOD : G;
    for (int v = c0; v < U_CS; v += GS) {
        if (v >= 64) {
            for (int j = 0; j < 16; ++j) { const int idx = (v - 64) * 8192 + j * 512 + tid, k = idx >> 5, e = idx & 31; const float w = p.w_router[idx];
                const bf16_t hi = f2bf(w); WSP(bf16_t, WS_WR_HI)[e * 2048 + k] = hi; WSP(bf16_t, WS_WR_LO)[e * 2048 + k] = f2bf(w - bf2f(hi)); }
        } else {
            for (int j = 0; j < 16; ++j) { const int idx = v * 8192 + j * 512 + tid; const int tok = idx >> 5, i = idx & 31;
                double inv = 1.0; for (int q = 0; q < i; ++q) inv *= 0.7498942093324559;
                const double rev = (double)p.pos[tok] * inv * 0.15915494309189535; const float fr = (float)(rev - floor(rev));
                float2 cs; cs.x = __builtin_amdgcn_cosf(fr); cs.y = __builtin_amdgcn_sinf(fr); WSP(float2, WS_CS)[idx] = cs; }
        }
    }
    constexpr int NT = T_WIN + T_WQ + T_WKV + T_WOUT;
    const int kp = tid >> 4, nc = tid & 15;
    f32x4 ra[2][2], rb[2][2];
#define CT_DECL(P_) const float* P_##W = p.w_in; bf16_t* P_##Bt = WSP(bf16_t, WS_WIN_T); const float* P_##ks = nullptr; int P_##ldw = INW, P_##k0 = 0, P_##n0 = 0, P_##K = 2048, P_##dmt = 0
#define CT_SET(P_, vv) do { int v_ = (vv); \
        if (v_ < T_WIN) { P_##W = p.w_in; P_##Bt = WSP(bf16_t, WS_WIN_T); P_##ks = nullptr; P_##ldw = INW; P_##k0 = (v_ / 65) * 128; P_##n0 = (v_ % 65) * 64; P_##K = 2048; P_##dmt = 0; } \
        else if ((v_ -= T_WIN) < T_WQ) { P_##W = p.w_q_up; P_##Bt = WSP(bf16_t, WS_WQ_T); P_##ks = p.g_q; P_##ldw = 1536; P_##k0 = (v_ / 24) * 128; P_##n0 = (v_ % 24) * 64; P_##K = 512; P_##dmt = 1; } \
        else if ((v_ -= T_WQ) < T_WKV) { P_##W = p.w_kv_up; P_##Bt = WSP(bf16_t, WS_WKV_T); P_##ks = p.g_kv; P_##ldw = 2048; P_##k0 = (v_ / 32) * 128; P_##n0 = (v_ % 32) * 64; P_##K = 512; P_##dmt = 2; } \
        else { v_ -= T_WKV; P_##W = p.w_out; P_##Bt = WSP(bf16_t, WS_WOUT_T); P_##ks = nullptr; P_##ldw = 2048; P_##k0 = (v_ / 32) * 128; P_##n0 = (v_ % 32) * 64; P_##K = 2048; P_##dmt = 3; } } while (0)
#define PT_LOAD(buf, P_) do { _Pragma("unroll") for (int ps = 0; ps < 2; ++ps) { const int k = P_##k0 + 2 * (kp + 32 * ps); \
        ra[buf][ps] = *(const f32x4*)(P_##W + (size_t)k * P_##ldw + P_##n0 + 4 * nc); rb[buf][ps] = *(const f32x4*)(P_##W + (size_t)(k + 1) * P_##ldw + P_##n0 + 4 * nc); } } while (0)
#define PT_DO(buf, P_) do { _Pragma("unroll") for (int ps = 0; ps < 2; ++ps) { const int k = P_##k0 + 2 * (kp + 32 * ps); f32x4 x = ra[buf][ps], y = rb[buf][ps]; \
            if (P_##ks) { x *= P_##ks[k]; y *= P_##ks[k + 1]; } \
            _Pragma("unroll") for (int j = 0; j < 4; ++j) T[(4 * nc + j) * 66 + kp + 32 * ps] = pk2(x[j], y[j]); } \
        __syncthreads(); \
        _Pragma("unroll") for (int q = 0; q < 2; ++q) { const int ch = tid + 512 * q, n = ch >> 4, cc = ch & 15; \
            const u32x2 lo = *(const LAS u32x2*)(T + n * 66 + 4 * cc), hi = *(const LAS u32x2*)(T + n * 66 + 4 * cc + 2); \
            u32x4 w; w.x = lo.x; w.y = lo.y; w.z = hi.x; w.w = hi.y; const int nn = P_##n0 + n; \
            const int dn = P_##dmt == 0 ? DmWin{}(nn) : P_##dmt == 1 ? DmWq{}(nn) : P_##dmt == 2 ? DmWkv{}(nn) : nn; \
            *(u32x4*)(P_##Bt + (size_t)dn * P_##K + P_##k0 + 8 * cc) = w; } \
        __syncthreads(); } while (0)
    int v = c0;
    if (v < NT) {
        CT_DECL(c_); CT_DECL(n_);
        CT_SET(c_, v); PT_LOAD(0, c_);
        for (;;) {
            const int vn = v + GS; const bool more = vn < NT;
            if (more) { CT_SET(n_, vn); PT_LOAD(1, n_); }
            PT_DO(0, c_);
            if (!more) break;
            const int vnn = vn + GS; const bool more2 = vnn < NT;
            if (more2) { CT_SET(c_, vnn); PT_LOAD(0, c_); }
            PT_DO(1, n_);
            if (!more2) break;
            v = vnn;
        }
    }
#undef CT_DECL
#undef CT_SET
#undef PT_LOAD
#undef PT_DO
}

__device__ __forceinline__ void phase_normmod_r(const float* __restrict__ mod, const float* __restrict__ x, const float* __restrict__ g, int shift_idx, int scale_idx, bf16_t* __restrict__ out, int G, int bid) {
    const int lane = threadIdx.x & 63, wid = threadIdx.x >> 6;
    for (int row = bid * 8 + wid; row < NTOK; row += G * 8) {
        const int b = row / SEQ; const float* xr = x + (size_t)row * D; f32x4 v[8]; float ss = 0.f;
#pragma unroll
        for (int j = 0; j < 8; ++j) { v[j] = *(const f32x4*)(xr + (j * 64 + lane) * 4); ss += (v[j][0] * v[j][0] + v[j][1] * v[j][1]) + (v[j][2] * v[j][2] + v[j][3] * v[j][3]); }
#pragma unroll
        for (int o = 32; o >= 1; o >>= 1) ss += __shfl_xor(ss, o);
        const float rstd = 1.0f / sqrtf(ss * (1.f / D) + EPS);
        const float* sh = mod + (size_t)b * NMOD * D + shift_idx * D; const float* sc = mod + (size_t)b * NMOD * D + scale_idx * D;
#pragma unroll
        for (int j = 0; j < 8; ++j) { const int k = (j * 64 + lane) * 4; const f32x4 gg = *(const f32x4*)(g + k), s1 = *(const f32x4*)(sc + k), s0 = *(const f32x4*)(sh + k);
            const f32x4 h = v[j] * rstd * gg * (s1 + 1.f) + s0; u32x2 w; w.x = pk2(h[0], h[1]); w.y = pk2(h[2], h[3]); *(u32x2*)(out + (size_t)row * D + k) = w; }
    }
}


__device__ __forceinline__ void phase_cb(const P& p, LAS unsigned char* lds, int bid) {
    if (bid >= NB) return;
    const int tid = threadIdx.x, e = tid & 31, kc = tid >> 5; LAS float* red = (LAS float*)lds;
    const float* sh = WSP(float, WS_MOD) + (size_t)bid * NMOD * D + 3 * D; float s = 0.f;
#pragma unroll 16
    for (int k = kc * 128; k < kc * 128 + 128; ++k) s += sh[k] * p.w_router[k * 32 + e];
    red[tid] = s; __syncthreads();
    if (tid < 32) { float t = p.b_router[tid]; for (int q = 0; q < 16; ++q) t += red[q * 32 + tid]; WSP(float, WS_CB)[bid * 32 + tid] = t; }
    __syncthreads();
}
__device__ __forceinline__ void route_h2_out(const bf16_t* __restrict__ xr, const float* __restrict__ gf, const float* __restrict__ sc, const float* __restrict__ sh, unsigned char* __restrict__ hr8, const float rs, const int kbase) {
#pragma unroll 4
    for (int s = 0; s < 32; ++s) {
        const int k = kbase + 16 * s;
        const f32x4 g0 = *(const f32x4*)(gf + k), g1 = *(const f32x4*)(gf + k + 4), s0 = *(const f32x4*)(sc + k), s1 = *(const f32x4*)(sc + k + 4), h0 = *(const f32x4*)(sh + k), h1 = *(const f32x4*)(sh + k + 4);
        f32x4 xa, xb; { const u32x4 xw = *(const u32x4*)(xr + 16 * s); xa[0] = __uint_as_float(xw.x << 16); xa[1] = __uint_as_float(xw.x & 0xffff0000u); xa[2] = __uint_as_float(xw.y << 16); xa[3] = __uint_as_float(xw.y & 0xffff0000u);
            xb[0] = __uint_as_float(xw.z << 16); xb[1] = __uint_as_float(xw.z & 0xffff0000u); xb[2] = __uint_as_float(xw.w << 16); xb[3] = __uint_as_float(xw.w & 0xffff0000u); }
        const f32x4 y0 = xa * rs * g0 * (s0 + 1.f) + h0, y1 = xb * rs * g1 * (s1 + 1.f) + h1;
        if (MOE_FP8) { u32x2 w; w.x = pk4_fp8(y0[0], y0[1], y0[2], y0[3]); w.y = pk4_fp8(y1[0], y1[1], y1[2], y1[3]); *(u32x2*)(hr8 + 16 * s) = w; }
        else { u32x4 w; w.x = pk2(y0[0], y0[1]); w.y = pk2(y0[2], y0[3]); w.z = pk2(y1[0], y1[1]); w.w = pk2(y1[2], y1[3]); *(u32x4*)(hr8 + 32 * s) = w; }
    }
}
__device__ __forceinline__ void route_h2_fp6(const bf16_t* __restrict__ x1g, const LAS float* gsl, const LAS float* shl, unsigned char* __restrict__ h2g, const LAS float* rsd) {
    const int blk = threadIdx.x & 63, k0 = blk * 32;
    f32x4 gs[8], hs[8];
#pragma unroll
    for (int q = 0; q < 8; ++q) { gs[q] = *(const LAS f32x4*)(gsl + k0 + 4 * q); hs[q] = *(const LAS f32x4*)(shl + k0 + 4 * q); }
#pragma unroll 2
    for (int ps = 0; ps < 8; ++ps) { const int id = threadIdx.x + 512 * ps, r = id >> 6; const float rs = rsd[r];
        float v[32]; const u32x4* xp = (const u32x4*)(x1g + (size_t)r * D + k0);
#pragma unroll
        for (int q = 0; q < 4; ++q) { const u32x4 xw = xp[q]; const f32x4 g0 = gs[2 * q] * rs, g1 = gs[2 * q + 1] * rs, h0 = hs[2 * q], h1 = hs[2 * q + 1];
            v[8 * q + 0] = __uint_as_float(xw.x << 16) * g0[0] + h0[0]; v[8 * q + 1] = __uint_as_float(xw.x & 0xffff0000u) * g0[1] + h0[1];
            v[8 * q + 2] = __uint_as_float(xw.y << 16) * g0[2] + h0[2]; v[8 * q + 3] = __uint_as_float(xw.y & 0xffff0000u) * g0[3] + h0[3];
            v[8 * q + 4] = __uint_as_float(xw.z << 16) * g1[0] + h1[0]; v[8 * q + 5] = __uint_as_float(xw.z & 0xffff0000u) * g1[1] + h1[1];
            v[8 * q + 6] = __uint_as_float(xw.w << 16) * g1[2] + h1[2]; v[8 * q + 7] = __uint_as_float(xw.w & 0xffff0000u) * g1[3] + h1[3]; }
        u32x4 lo, hi; fp6_block(v, lo, hi);
        unsigned char* dst = h2g + (size_t)r * D + (blk >> 2) * 128 + (blk & 3) * 16;
        *(u32x4*)dst = lo; *(u32x4*)(dst + 64) = hi; }
}
__device__ __forceinline__ void phase_route(const P& p, LAS unsigned char* lds, int G, int bid) {
    const int tid = threadIdx.x, lane = tid & 63, wid = __builtin_amdgcn_readfirstlane(tid >> 6), hf = wid >> 2, wq = wid & 3, r32 = lane & 31, kg = lane >> 5;
    LAS float* red = (LAS float*)lds;
    LAS float* ssr = (LAS float*)(lds + 32768);
    LAS float* lg = (LAS float*)(lds + 32768 + 2048);
    LAS float* rsd = (LAS float*)(lds + 32768 + 2048 + 8192);
    LAS int* hist = (LAS int*)(lds + 32768 + 2048 + 8192 + 256);
    LAS int* gbase = hist + 32;
    LAS float* gsl = (LAS float*)(lds + 49152);
    LAS float* shl = (LAS float*)(lds + 57344);
    const bf16_t* wrh = WSP(bf16_t, WS_WR_HI); const bf16_t* wrl = WSP(bf16_t, WS_WR_LO);
    for (int gp = bid; gp < NTOK / 64; gp += G) {
        const int row = gp * 64 + hf * 32 + r32, b = (gp * 64) / SEQ, kb0 = wq * 512 + 8 * kg;
        const float* mod = WSP(float, WS_MOD) + (size_t)b * NMOD * D; const float* sh = mod + 3 * D; const float* sc = mod + 4 * D;
        const bf16_t* xr = WSP(bf16_t, WS_X1) + (size_t)row * D + kb0;
        f32x16 C = {}; float ss = 0.f;
        if (tid < 32) hist[tid] = 0;
        { const int k4 = tid * 4; *(LAS f32x4*)(gsl + k4) = *(const f32x4*)(p.g_ffn + k4) * (*(const f32x4*)(sc + k4) + 1.f); *(LAS f32x4*)(shl + k4) = *(const f32x4*)(sh + k4); }
        __syncthreads();
#pragma unroll 4
        for (int s = 0; s < 32; ++s) {
            const int k = kb0 + 16 * s;
            const f32x4 gs0 = *(const LAS f32x4*)(gsl + k), gs1 = *(const LAS f32x4*)(gsl + k + 4);
            f32x4 x0, x1; { const u32x4 xw = *(const u32x4*)(xr + 16 * s); x0[0] = __uint_as_float(xw.x << 16); x0[1] = __uint_as_float(xw.x & 0xffff0000u); x0[2] = __uint_as_float(xw.y << 16); x0[3] = __uint_as_float(xw.y & 0xffff0000u);
                x1[0] = __uint_as_float(xw.z << 16); x1[1] = __uint_as_float(xw.z & 0xffff0000u); x1[2] = __uint_as_float(xw.w << 16); x1[3] = __uint_as_float(xw.w & 0xffff0000u); }
            ss += (x0[0] * x0[0] + x0[1] * x0[1]) + (x0[2] * x0[2] + x0[3] * x0[3]) + (x1[0] * x1[0] + x1[1] * x1[1]) + (x1[2] * x1[2] + x1[3] * x1[3]);
            const f32x4 y0 = x0 * gs0, y1 = x1 * gs1;
            u32x4 hi; hi.x = pk2(y0[0], y0[1]); hi.y = pk2(y0[2], y0[3]); hi.z = pk2(y1[0], y1[1]); hi.w = pk2(y1[2], y1[3]);
            f32x4 r0, r1;
            r0[0] = y0[0] - __uint_as_float(hi.x << 16); r0[1] = y0[1] - __uint_as_float(hi.x & 0xffff0000u); r0[2] = y0[2] - __uint_as_float(hi.y << 16); r0[3] = y0[3] - __uint_as_float(hi.y & 0xffff0000u);
            r1[0] = y1[0] - __uint_as_float(hi.z << 16); r1[1] = y1[1] - __uint_as_float(hi.z & 0xffff0000u); r1[2] = y1[2] - __uint_as_float(hi.w << 16); r1[3] = y1[3] - __uint_as_float(hi.w & 0xffff0000u);
            u32x4 lo; lo.x = pk2(r0[0], r0[1]); lo.y = pk2(r0[2], r0[3]); lo.z = pk2(r1[0], r1[1]); lo.w = pk2(r1[2], r1[3]);
            const bf16x8 ah = *(const bf16x8*)(wrh + (size_t)r32 * 2048 + k), al = *(const bf16x8*)(wrl + (size_t)r32 * 2048 + k);
            const bf16x8 bh = __builtin_bit_cast(bf16x8, hi), bl = __builtin_bit_cast(bf16x8, lo);
            C = __builtin_amdgcn_mfma_f32_32x32x16_bf16(ah, bh, C, 0, 0, 0);
            C = __builtin_amdgcn_mfma_f32_32x32x16_bf16(al, bh, C, 0, 0, 0);
            C = __builtin_amdgcn_mfma_f32_32x32x16_bf16(ah, bl, C, 0, 0, 0);
        }
#pragma unroll
        for (int r = 0; r < 16; ++r) red[((hf * 4 + wq) * 32 + ((r & 3) + 8 * (r >> 2) + 4 * kg)) * 32 + r32] = C[r];
        ssr[(hf * 8 + wq * 2 + kg) * 32 + r32] = ss;
        __syncthreads();
        { const int h2 = tid >> 8, t2 = tid & 255;
#pragma unroll
          for (int q = 0; q < 4; ++q) { const int e = (t2 >> 5) + 8 * q; float t = 0.f;
#pragma unroll
              for (int w4 = 0; w4 < 4; ++w4) t += red[((h2 * 4 + w4) * 32 + e) * 32 + (t2 & 31)]; lg[(h2 * 32 + e) * 32 + (t2 & 31)] = t; } }
        if (tid < 64) { float t = 0.f;
#pragma unroll
            for (int q = 0; q < 8; ++q) t += ssr[((tid >> 5) * 8 + q) * 32 + (tid & 31)]; rsd[tid] = 1.0f / sqrtf(t * (1.f / D) + EPS); }
        __syncthreads();
        int i0 = 0, i1 = 0, i2 = 0, i3 = 0, l0 = 0, l1 = 0, l2 = 0, l3 = 0; float w0 = 0.f, w1 = 0.f, w2 = 0.f, w3 = 0.f;
        if (tid < 64) {
            const float rs = rsd[tid]; const float* cb = WSP(float, WS_CB) + b * 32; const LAS float* lgr = lg + (tid >> 5) * 1024 + (tid & 31);
            unsigned used = 0; float v0 = 0, v1 = 0, v2 = 0, v3 = 0;
            float xv[32];
#pragma unroll
            for (int e = 0; e < 32; ++e) xv[e] = lgr[e * 32] * rs + cb[e];
#pragma unroll
            for (int k = 0; k < 4; ++k) { float best = -3.0e38f; int bi = 0;
#pragma unroll
                for (int e = 0; e < 32; ++e) { const bool ok = !((used >> e) & 1u) && xv[e] > best; best = ok ? xv[e] : best; bi = ok ? e : bi; }
                used |= 1u << bi;
                if (k == 0) { i0 = bi; v0 = best; } else if (k == 1) { i1 = bi; v1 = best; } else if (k == 2) { i2 = bi; v2 = best; } else { i3 = bi; v3 = best; } }
            const float e1 = __expf(v1 - v0), e2 = __expf(v2 - v0), e3 = __expf(v3 - v0), inv = 1.f / (1.f + e1 + e2 + e3);
            w0 = inv; w1 = e1 * inv; w2 = e2 * inv; w3 = e3 * inv;
            l0 = atomicAdd((int*)(hist + i0), 1); l1 = atomicAdd((int*)(hist + i1), 1); l2 = atomicAdd((int*)(hist + i2), 1); l3 = atomicAdd((int*)(hist + i3), 1);
        }
        __syncthreads();
        if (tid < 32) { const int c = hist[tid]; gbase[tid] = c ? atomicAdd(WSP(int, WS_CNT) + tid, c) : 0; }
        __syncthreads();
        if (tid < 64) { const int rw = gp * 64 + tid;
            const int p0 = gbase[i0] + l0, p1 = gbase[i1] + l1, p2 = gbase[i2] + l2, p3 = gbase[i3] + l3;
            int* te = WSP(int, WS_TOPE) + rw * 4; float* tw = WSP(float, WS_TOPW) + rw * 4; int* tp = WSP(int, WS_TPOS) + rw * 4; int* rt = WSP(int, WS_ROWTOK);
            te[0] = i0; te[1] = i1; te[2] = i2; te[3] = i3; tw[0] = w0; tw[1] = w1; tw[2] = w2; tw[3] = w3; tp[0] = p0; tp[1] = p1; tp[2] = p2; tp[3] = p3;
            rt[(size_t)i0 * NTOK + p0] = rw * 4; rt[(size_t)i1 * NTOK + p1] = rw * 4 + 1; rt[(size_t)i2 * NTOK + p2] = rw * 4 + 2; rt[(size_t)i3 * NTOK + p3] = rw * 4 + 3; }
        if (MOE1_FP6) route_h2_fp6(WSP(bf16_t, WS_X1) + (size_t)(gp * 64) * D, gsl, shl, p.ws + WS_H2 + (size_t)(gp * 64) * D, rsd);
        else route_h2_out(xr, p.g_ffn, sc, sh, p.ws + WS_H2 + (size_t)row * D + kb0, rsd[hf * 32 + r32], kb0);
        __syncthreads();
    }
}
__device__ __forceinline__ void phase_final_r(const bf16_t* __restrict__ Y, const bf16_t* __restrict__ X1, const float* __restrict__ modp, const int* __restrict__ tope, const int* __restrict__ tpos, const float* __restrict__ topw, const float* __restrict__ gfin, float* __restrict__ outp, LAS unsigned char* lds, int G, int bid) {
    const int lane = threadIdx.x & 63, wid = threadIdx.x >> 6; const LAS int* tp = (const LAS int*)(lds + LDS_TP);
    int e_n = 0, ps_n = 0; float wk_n = 0.f;
    { const int r0 = bid * 8 + wid; if (r0 < NTOK && lane < 4) { e_n = tope[r0 * 4 + lane]; ps_n = tpos[r0 * 4 + lane]; wk_n = topw[r0 * 4 + lane]; } }
    for (int row = bid * 8 + wid; row < NTOK; row += G * 8) {
        const int b = row / SEQ; const float* g2 = modp + (size_t)b * NMOD * D + 5 * D;
        int slot = 0; float wk = 0.f;
        if (lane < 4) { slot = tp[e_n] * 256 + ps_n; wk = wk_n; }
        { const int nr = row + G * 8; if (nr < NTOK && lane < 4) { e_n = tope[nr * 4 + lane]; ps_n = tpos[nr * 4 + lane]; wk_n = topw[nr * 4 + lane]; } }
        const int sl0 = __shfl(slot, 0), sl1 = __shfl(slot, 1), sl2 = __shfl(slot, 2), sl3 = __shfl(slot, 3);
        const float ysc = Y_FP8 ? 1.f / Y_SCALE : 1.f, q0 = __shfl(wk, 0) * ysc, q1 = __shfl(wk, 1) * ysc, q2 = __shfl(wk, 2) * ysc, q3 = __shfl(wk, 3) * ysc;
        f32x4 v[8]; float ss = 0.f;
#pragma unroll
        for (int j = 0; j < 8; ++j) { const int k = (j * 64 + lane) * 4;
            f32x4 m;
            if (Y_FP8) { const unsigned char* Y8 = (const unsigned char*)Y;
                const int a0 = *(const int*)(Y8 + (size_t)sl0 * D + k), a1 = *(const int*)(Y8 + (size_t)sl1 * D + k), a2 = *(const int*)(Y8 + (size_t)sl2 * D + k), a3 = *(const int*)(Y8 + (size_t)sl3 * D + k);
                const auto l0 = __builtin_amdgcn_cvt_pk_f32_fp8(a0, false), h0 = __builtin_amdgcn_cvt_pk_f32_fp8(a0, true), l1 = __builtin_amdgcn_cvt_pk_f32_fp8(a1, false), h1 = __builtin_amdgcn_cvt_pk_f32_fp8(a1, true);
                const auto l2 = __builtin_amdgcn_cvt_pk_f32_fp8(a2, false), h2 = __builtin_amdgcn_cvt_pk_f32_fp8(a2, true), l3 = __builtin_amdgcn_cvt_pk_f32_fp8(a3, false), h3 = __builtin_amdgcn_cvt_pk_f32_fp8(a3, true);
                m[0] = q0 * l0[0] + q1 * l1[0] + q2 * l2[0] + q3 * l3[0]; m[1] = q0 * l0[1] + q1 * l1[1] + q2 * l2[1] + q3 * l3[1];
                m[2] = q0 * h0[0] + q1 * h1[0] + q2 * h2[0] + q3 * h3[0]; m[3] = q0 * h0[1] + q1 * h1[1] + q2 * h2[1] + q3 * h3[1];
            } else {
            const u32x2 a0 = *(const u32x2*)(Y + (size_t)sl0 * D + k), a1 = *(const u32x2*)(Y + (size_t)sl1 * D + k), a2 = *(const u32x2*)(Y + (size_t)sl2 * D + k), a3 = *(const u32x2*)(Y + (size_t)sl3 * D + k);
            m[0] = q0 * __uint_as_float(a0.x << 16) + q1 * __uint_as_float(a1.x << 16) + q2 * __uint_as_float(a2.x << 16) + q3 * __uint_as_float(a3.x << 16);
            m[1] = q0 * __uint_as_float(a0.x & 0xffff0000u) + q1 * __uint_as_float(a1.x & 0xffff0000u) + q2 * __uint_as_float(a2.x & 0xffff0000u) + q3 * __uint_as_float(a3.x & 0xffff0000u);
            m[2] = q0 * __uint_as_float(a0.y << 16) + q1 * __uint_as_float(a1.y << 16) + q2 * __uint_as_float(a2.y << 16) + q3 * __uint_as_float(a3.y << 16);
            m[3] = q0 * __uint_as_float(a0.y & 0xffff0000u) + q1 * __uint_as_float(a1.y & 0xffff0000u) + q2 * __uint_as_float(a2.y & 0xffff0000u) + q3 * __uint_as_float(a3.y & 0xffff0000u);
            }
            { const u32x2 xw = *(const u32x2*)(X1 + (size_t)row * D + k); f32x4 xv; xv[0] = __uint_as_float(xw.x << 16); xv[1] = __uint_as_float(xw.x & 0xffff0000u); xv[2] = __uint_as_float(xw.y << 16); xv[3] = __uint_as_float(xw.y & 0xffff0000u);
              v[j] = xv + *(const f32x4*)(g2 + k) * m; }
            ss += (v[j][0] * v[j][0] + v[j][1] * v[j][1]) + (v[j][2] * v[j][2] + v[j][3] * v[j][3]); }
#pragma unroll
        for (int o = 32; o >= 1; o >>= 1) ss += __shfl_xor(ss, o);
        const float rstd = 1.0f / sqrtf(ss * (1.f / D) + EPS);
#pragma unroll
        for (int j = 0; j < 8; ++j) { const int k = (j * 64 + lane) * 4; *(f32x4*)(outp + (size_t)row * D + k) = v[j] * rstd * *(const f32x4*)(gfin + k); }
    }
}
__device__ __forceinline__ void phase_final(const P& p, LAS unsigned char* lds, int G, int bid) { phase_final_r(WSP(bf16_t, WS_Y), WSP(bf16_t, WS_X1), WSP(float, WS_MOD), WSP(int, WS_TOPE), WSP(int, WS_TPOS), WSP(float, WS_TOPW), p.g_final, p.out, lds, G, bid); }

namespace at {
constexpr int VSTR = 144, VT = 128 * VSTR;
constexpr int LDS_AL = 90112, LDS_FLAG = LDS_AL + 1024;
constexpr float LOG2E = 1.4426950408889634f;
__device__ __forceinline__ bf16x8 packf(const f32x16& x, int s) { u32x4 w; w.x = pk2(x[8 * s], x[8 * s + 1]); w.y = pk2(x[8 * s + 2], x[8 * s + 3]); w.z = pk2(x[8 * s + 4], x[8 * s + 5]); w.w = pk2(x[8 * s + 6], x[8 * s + 7]); return __builtin_bit_cast(bf16x8, w); }
#define AT_MFMA(a, b, c) __builtin_amdgcn_mfma_f32_32x32x16_bf16((a), (b), (c), 0, 0, 0)

template <bool MLA>
__device__ __forceinline__ void attn_unit(const P& p, LAS unsigned char* lds, const int b, const int h, const int qb) {
    constexpr int DK = MLA ? 192 : 128, KSTR = MLA ? 400 : 272, KT = 64 * KSTR, BUF = KT + VT, NQF = DK / 16, NKR = MLA ? 3 : 2;
    static_assert(2 * (64 * 400 + VT) <= LDS_AL, "attention LDS map");
    const int tid = threadIdx.x, wid = __builtin_amdgcn_readfirstlane(tid >> 6), lane = tid & 63, r32 = lane & 31, hi = lane >> 5;
    const int q0 = qb * 256, qw = q0 + 32 * wid, qi = qw + r32, nt = (q0 + 256) / 64;
    const bf16_t* Kn = MLA ? WSP(bf16_t, WS_KNOPE) : WSP(bf16_t, WS_SBK);
    const bf16_t* Kr = WSP(bf16_t, WS_KROPE);
    const bf16_t* Vt = WSP(bf16_t, MLA ? WS_VMT : WS_SBVT) + (size_t)(b * 8 + h) * 128 * SEQ;
    LAS float* al = (LAS float*)(lds + LDS_AL) + wid * 32;
    LAS int* flag = (LAS int*)(lds + LDS_FLAG);
    bf16x8 qf[NQF];
    { const char* qb_ = MLA ? (const char*)WSP(bf16_t, WS_QMLA) + ((size_t)(b * SEQ + qw) * 1536 + h * 192) * 2 : (const char*)WSP(bf16_t, WS_SBQ) + ((size_t)(b * SEQ + qw) * 1024 + h * 128) * 2;
      const unsigned qo = (unsigned)((r32 * (MLA ? 1536 : 1024) + 8 * hi) * 2);
#pragma unroll
      for (int s = 0; s < NQF; ++s) qf[s] = *(const bf16x8*)(qb_ + qo + 32 * s); }
    bf16x8 tri0, tri1, ones;
#pragma unroll
    for (int j = 0; j < 8; ++j) { const int k0_ = 8 * (j >> 2) + 4 * hi + (j & 3); tri0[j] = (k0_ > r32) ? (short)0x3F80 : (short)0; tri1[j] = (16 + k0_ > r32) ? (short)0x3F80 : (short)0; ones[j] = (short)0x3F80; }
    u32x4 kreg[NKR], vreg[2];
    const unsigned kofs0 = (unsigned)(((tid >> 4) * 1024 + (tid & 15) * 8) * 2), kofs1 = kofs0 + 32u * 1024u * 2u;
    const unsigned rofs = (unsigned)(((tid >> 3) * 64 + (tid & 7) * 8) * 2);
    const unsigned vofs0 = (unsigned)(((tid >> 3) * SEQ + (tid & 7) * 8) * 2), vofs1 = vofs0 + 64u * SEQ * 2u;
    const unsigned kw0 = (unsigned)((tid >> 4) * KSTR + (tid & 15) * 16), kw1 = kw0 + 32u * KSTR, rw = (unsigned)((tid >> 3) * KSTR + 256 + (tid & 7) * 16);
    const unsigned vw0 = (unsigned)(KT + (tid >> 3) * VSTR + (16 * ((tid & 7) >> 1) + 4 * (tid & 1)) * 2), vw1 = vw0 + 64u * VSTR;
    const char* Knb = (const char*)Kn + ((size_t)b * SEQ * 1024 + h * 128) * 2; const char* Krb = (const char*)Kr + (size_t)b * SEQ * 64 * 2; const char* Vtb = (const char*)Vt;
#define AT_LOAD(tile) do { const int k0_ = (tile) * 64; const char* kp_ = Knb + (size_t)k0_ * 2048; const char* vp_ = Vtb + (size_t)k0_ * 2; \
        kreg[0] = *(const u32x4*)(kp_ + kofs0); kreg[1] = *(const u32x4*)(kp_ + kofs1); if (MLA) kreg[NKR - 1] = *(const u32x4*)(Krb + (size_t)k0_ * 128 + rofs); \
        vreg[0] = *(const u32x4*)(vp_ + vofs0); vreg[1] = *(const u32x4*)(vp_ + vofs1); } while (0)
#define AT_WRITE(buf) do { LAS unsigned char* kb_ = lds + (buf) * BUF; \
        *(LAS u32x4*)(kb_ + kw0) = kreg[0]; *(LAS u32x4*)(kb_ + kw1) = kreg[1]; if (MLA) *(LAS u32x4*)(kb_ + rw) = kreg[NKR - 1]; \
        { u32x2 lo_, hi_; lo_.x = vreg[0].x; lo_.y = vreg[0].y; hi_.x = vreg[0].z; hi_.y = vreg[0].w; *(LAS u32x2*)(kb_ + vw0) = lo_; *(LAS u32x2*)(kb_ + vw0 + 16) = hi_; } \
        { u32x2 lo_, hi_; lo_.x = vreg[1].x; lo_.y = vreg[1].y; hi_.x = vreg[1].z; hi_.y = vreg[1].w; *(LAS u32x2*)(kb_ + vw1) = lo_; *(LAS u32x2*)(kb_ + vw1 + 16) = hi_; } } while (0)
    f32x16 o[4];
#pragma unroll
    for (int d0 = 0; d0 < 4; ++d0)
#pragma unroll
        for (int r = 0; r < 16; ++r) o[d0][r] = 0.f;
    float m_run = -1e30f, l_run = 0.f, R2 = 0.f;
    if (!MLA && tid < 8) flag[tid] = 0;
    AT_LOAD(MLA ? 0 : nt - 1);
    AT_WRITE(0);
    __syncthreads();
    for (int it = 0; it < nt; ++it) {
        const int tile = MLA ? it : nt - 1 - it, cb = it & 1, k0 = tile * 64;
        const bool more = it + 1 < nt;
        if (more) AT_LOAD(MLA ? tile + 1 : tile - 1);
        const bool active = MLA ? (k0 <= qw + 31) : (k0 < qw + 31 && !__all(R2 < -160.f));
        if (active) {
            const LAS unsigned char* kb = lds + cb * BUF;
            f32x16 p0, p1;
#pragma unroll
            for (int r = 0; r < 16; ++r) { p0[r] = 0.f; p1[r] = 0.f; }
#pragma unroll
            for (int s = 0; s < NQF; ++s) { const bf16x8 a0 = *(const LAS bf16x8*)(kb + r32 * KSTR + s * 32 + hi * 16), a1 = *(const LAS bf16x8*)(kb + (32 + r32) * KSTR + s * 32 + hi * 16);
                p0 = AT_MFMA(a0, qf[s], p0); p1 = AT_MFMA(a1, qf[s], p1); if ((s & 3) == 3) __builtin_amdgcn_sched_barrier(0); }
            const int dq = qi - k0 - 4 * hi;
            bf16x8 pf0, pf1, pf2, pf3;
            if (MLA) {
                float pm = -3.0e38f;
                if (k0 + 63 > qw) {
#pragma unroll
                    for (int r = 0; r < 16; ++r) { const int c = (r & 3) + 8 * (r >> 2);
                        if (c > dq) p0[r] = -__builtin_inff(); if (c + 32 > dq) p1[r] = -__builtin_inff(); }
                }
#pragma unroll
                for (int r = 0; r < 16; ++r) pm = fmaxf(pm, fmaxf(p0[r], p1[r]));
                pm = fmaxf(pm, __shfl_xor(pm, 32));
                const float mn = fmaxf(m_run, pm), alpha = __builtin_amdgcn_exp2f(m_run - mn); m_run = mn;
                float ps = 0.f;
#pragma unroll
                for (int r = 0; r < 16; ++r) { p0[r] = __builtin_amdgcn_exp2f(p0[r] - mn); p1[r] = __builtin_amdgcn_exp2f(p1[r] - mn); ps += p0[r] + p1[r]; }
                ps += __shfl_xor(ps, 32);
                l_run = l_run * alpha + ps;
                if (__any(alpha < 1.f)) { if (hi == 0) al[r32] = alpha; asm volatile("s_waitcnt lgkmcnt(0)" ::: "memory");
#pragma unroll
                    for (int r = 0; r < 16; ++r) { const float a = al[(r & 3) + 8 * (r >> 2) + 4 * hi];
#pragma unroll
                        for (int d0 = 0; d0 < 4; ++d0) o[d0][r] *= a; } }
                pf0 = packf(p0, 0); pf1 = packf(p0, 1); pf2 = packf(p1, 0); pf3 = packf(p1, 1);
            } else {
                if (k0 + 63 >= qw) {
#pragma unroll
                    for (int r = 0; r < 16; ++r) { const int c = (r & 3) + 8 * (r >> 2); if (c >= dq) p0[r] = -__builtin_inff(); if (c + 32 >= dq) p1[r] = -__builtin_inff(); } }
                float lsum = 0.f; bf16x8 lf[4];
#pragma unroll
                for (int g = 0; g < 4; ++g) {
                    float Lv[8];
#pragma unroll
                    for (int j = 0; j < 8; ++j) { const int r = 8 * (g & 1) + j;
                        const float z = (g < 2 ? p0[r] : p1[r]);
                        const float t = __builtin_amdgcn_logf(1.f + __builtin_amdgcn_exp2f(-fabsf(z)));
                        const float L = -(fmaxf(z, 0.f) + t);
                        const float ls = fminf(z, 0.f) - t;
                        if (g < 2) p0[r] = ls; else p1[r] = ls;
                        Lv[j] = L; lsum += L; }
                    u32x4 w; w.x = pk2(Lv[0], Lv[1]); w.y = pk2(Lv[2], Lv[3]); w.z = pk2(Lv[4], Lv[5]); w.w = pk2(Lv[6], Lv[7]); lf[g] = __builtin_bit_cast(bf16x8, w);
                }
                p0 = AT_MFMA(tri0, lf[0], p0); p0 = AT_MFMA(tri1, lf[1], p0); p0 = AT_MFMA(ones, lf[2], p0); p0 = AT_MFMA(ones, lf[3], p0);
                p1 = AT_MFMA(tri0, lf[2], p1); p1 = AT_MFMA(tri1, lf[3], p1);
#pragma unroll
                for (int r = 0; r < 16; ++r) { p0[r] = __builtin_amdgcn_exp2f(p0[r] + R2); p1[r] = __builtin_amdgcn_exp2f(p1[r] + R2); }
                lsum += __shfl_xor(lsum, 32);
                R2 += lsum;
                pf0 = packf(p0, 0); pf1 = packf(p0, 1); pf2 = packf(p1, 0); pf3 = packf(p1, 1);
            }
            const LAS unsigned char* vb = kb + KT;
#pragma unroll
            for (int d0 = 0; d0 < 4; ++d0) { const LAS unsigned char* vr = vb + (32 * d0 + r32) * VSTR + hi * 16;
                o[d0] = AT_MFMA(pf0, *(const LAS bf16x8*)(vr), o[d0]); o[d0] = AT_MFMA(pf1, *(const LAS bf16x8*)(vr + 32), o[d0]);
                o[d0] = AT_MFMA(pf2, *(const LAS bf16x8*)(vr + 64), o[d0]); o[d0] = AT_MFMA(pf3, *(const LAS bf16x8*)(vr + 96), o[d0]); __builtin_amdgcn_sched_barrier(0); }
        }
        if (more) AT_WRITE(cb ^ 1);
        if (!MLA) { const bool dn = __all(R2 < -160.f); if (lane == 0) flag[wid] = dn ? 1 : 0; }
        __syncthreads();
        if (!MLA) { int all = 1;
#pragma unroll
            for (int w8 = 0; w8 < 8; ++w8) all &= flag[w8];
            if (all) break; }
    }
    if (!MLA) __syncthreads();
    if (MLA) { if (hi == 0) al[r32] = 1.0f / l_run; asm volatile("s_waitcnt lgkmcnt(0)" ::: "memory"); }
    char* Ob = (char*)(WSP(bf16_t, WS_MIXED) + (size_t)(b * SEQ + qw) * 2048 + (MLA ? 1024 : 0) + h * 128);
    const bool odd = (r32 & 1) != 0;
    const unsigned oo = (unsigned)((4 * hi * 2048 + r32) * 2) + (odd ? 4094u : 0u);
#pragma unroll
    for (int q = 0; q < 8; ++q) { const int ra = 2 * q, c = (ra & 3) + 8 * (ra >> 2); const float iva = MLA ? al[c + 4 * hi] : 1.f, ivb = MLA ? al[c + 1 + 4 * hi] : 1.f;
#pragma unroll
        for (int d0 = 0; d0 < 4; ++d0) { const float A = o[d0][ra] * iva, Bv = o[d0][ra + 1] * ivb;
            const float snd = odd ? A : Bv;
            const float rcv = __int_as_float(__builtin_amdgcn_update_dpp(0, __float_as_int(snd), 0xB1, 0xF, 0xF, true));
            const unsigned w = odd ? pk2(rcv, Bv) : pk2(A, rcv);
            *(unsigned*)(Ob + oo + (unsigned)((c * 2048 + d0 * 32) * 2)) = w; } }
    __syncthreads();
#undef AT_LOAD
#undef AT_WRITE
}
__device__ __forceinline__ void conv_queue(const P& p, LAS unsigned char* lds, int* ctr, int max_tiles) {
    constexpr int NM1 = NE * 16 * 16, NM2 = NE * 16 * 8, NMT = NM1 + NM2;
    LAS int* qs = (LAS int*)(lds + LDS_FLAG + 96); LAS unsigned char* Tb = lds + 16384;
    const int tid = threadIdx.x, kq = tid >> 6, nc = tid & 63;
    int pulled = 0;
#define CQ_CAN (max_tiles < 0 || pulled < max_tiles)
#define CQ_PULL(dst) do { __syncthreads(); if (tid == 0) qs[0] = CQ_CAN ? atomicAdd(ctr, 1) : NMT; __syncthreads(); dst = qs[0]; ++pulled; } while (0)
    int t_cur, t_nxt;
    CQ_PULL(t_cur); if (t_cur >= NMT) { __syncthreads(); return; }
    CQ_PULL(t_nxt);
    f32x4 a[4][4];
#define CQ_SRC(t, src, ldw) const float* src; int ldw; { const bool w1_ = (t) < NM1; const int t2_ = w1_ ? (t) : (t) - NM1, e_ = w1_ ? t2_ >> 8 : t2_ >> 7, r_ = w1_ ? t2_ & 255 : t2_ & 127; \
        ldw = w1_ ? 4096 : 2048; const int k0_ = (w1_ ? r_ >> 4 : r_ >> 3) * 128, n0_ = (w1_ ? r_ & 15 : r_ & 7) * 256; \
        src = (w1_ ? p.w1 + (size_t)e_ * 2048 * 4096 : p.w2 + (size_t)e_ * 2048 * 2048) + (size_t)(k0_ + 4 * kq) * ldw + n0_ + 4 * nc; }
#define CQ_LOAD(buf, slab, src, ldw) do { _Pragma("unroll") for (int r_ = 0; r_ < 4; ++r_) a[buf][r_] = __builtin_nontemporal_load((const f32x4*)(src + (size_t)((slab) * 32 + r_) * ldw)); } while (0)
#define CQ_PUT(buf, slab) do { if (cur_w1) { _Pragma("unroll") for (int j_ = 0; j_ < 4; ++j_) { u32x2 d_; d_.x = pk2(a[buf][0][j_], a[buf][1][j_]); d_.y = pk2(a[buf][2][j_], a[buf][3][j_]); \
            *(LAS u32x2*)(Tb + (4 * nc + j_) * 264 + ((slab) * 32 + 4 * kq) * 2) = d_; } } \
        else { _Pragma("unroll") for (int j_ = 0; j_ < 4; ++j_) *(LAS unsigned*)(Tb + (4 * nc + j_) * 132 + ((slab) * 32 + 4 * kq)) = pk4_fp8(a[buf][0][j_] * W8_SCALE, a[buf][1][j_] * W8_SCALE, a[buf][2][j_] * W8_SCALE, a[buf][3][j_] * W8_SCALE); } } while (0)
    { CQ_SRC(t_cur, s0, l0); CQ_LOAD(0, 0, s0, l0); CQ_LOAD(1, 1, s0, l0); CQ_LOAD(2, 2, s0, l0); CQ_LOAD(3, 3, s0, l0); }
    for (int it = 0;; ++it) {
        const bool more = t_nxt < NMT, cur_w1 = t_cur < NM1;
        if (tid == 0) qs[1 + (it & 1)] = (more && CQ_CAN) ? atomicAdd(ctr, 1) : NMT;
        ++pulled;
        CQ_PUT(0, 0); CQ_PUT(1, 1);
        CQ_SRC(t_nxt < NMT ? t_nxt : 0, s1, l1);
        if (more) { CQ_LOAD(0, 0, s1, l1); CQ_LOAD(1, 1, s1, l1); }
        CQ_PUT(2, 2); CQ_PUT(3, 3);
        __syncthreads();
        { const int t2_ = cur_w1 ? t_cur : t_cur - NM1, e_ = cur_w1 ? t2_ >> 8 : t2_ >> 7, r_ = cur_w1 ? t2_ & 255 : t2_ & 127;
          const int k0 = (cur_w1 ? r_ >> 4 : r_ >> 3) * 128, n0 = (cur_w1 ? r_ & 15 : r_ & 7) * 256;
          if (cur_w1) {
              unsigned char* Bt = p.ws + WS_W1_T + (size_t)e_ * 4096 * 2048;
#pragma unroll 1
              for (int ps = 0; ps < 2; ++ps) { const int id = tid + 512 * ps, n = id >> 2, q = id & 3; const LAS u32x2* tp_ = (const LAS u32x2*)(Tb + n * 264 + q * 64);
                  float v[32];
#pragma unroll
                  for (int i = 0; i < 8; ++i) { const u32x2 w = tp_[i]; v[4 * i] = __uint_as_float(w.x << 16); v[4 * i + 1] = __uint_as_float(w.x & 0xffff0000u); v[4 * i + 2] = __uint_as_float(w.y << 16); v[4 * i + 3] = __uint_as_float(w.y & 0xffff0000u); }
                  u32x4 lo, hi; fp6_block(v, lo, hi);
                  unsigned char* dst = Bt + (size_t)DmW1{}(n0 + n) * 2048 + k0 + 16 * q;
                  __builtin_nontemporal_store(lo, (u32x4*)dst); __builtin_nontemporal_store(hi, (u32x4*)(dst + 64)); }
          } else {
              unsigned char* Bt = p.ws + WS_W2_T + (size_t)e_ * 2048 * 2048;
#pragma unroll
              for (int ps = 0; ps < 4; ++ps) { const int n = ps * 64 + (tid >> 3), c = tid & 7; const LAS unsigned* tp_ = (const LAS unsigned*)(Tb + n * 132 + 16 * c);
                  u32x4 w; w.x = tp_[0]; w.y = tp_[1]; w.z = tp_[2]; w.w = tp_[3];
                  __builtin_nontemporal_store(w, (u32x4*)(Bt + (size_t)(n0 + n) * 2048 + k0 + 16 * c)); }
          } }
        __syncthreads();
        if (!more) break;
        CQ_LOAD(2, 2, s1, l1); CQ_LOAD(3, 3, s1, l1);
        t_cur = t_nxt; t_nxt = qs[1 + (it & 1)];
    }
#undef CQ_PULL
#undef CQ_CAN
#undef CQ_SRC
#undef CQ_LOAD
#undef CQ_PUT
    __syncthreads();
}
__device__ __forceinline__ void attn_queues(const P& p, LAS unsigned char* lds, int* ctr, const int xg) {
    LAS int* qs = (LAS int*)(lds + LDS_FLAG + 64);
    const int tid = threadIdx.x, nq = xg >= 0 ? 4 * 16 : NB * 8 * 16;
    int* c0 = ctr + (xg >= 0 ? xg : 0); int* c1 = ctr + 64 + (xg >= 0 ? xg : 0);
    {   if (tid == 0) qs[0] = atomicAdd(c0, 1);
        __syncthreads();
        int v = qs[0];
        while (v < nq) {
            __syncthreads();
            if (tid == 0) qs[0] = atomicAdd(c0, 1);
            const int bh = xg >= 0 ? xg * 4 + 2 * (v >> 5) + (v & 1) : (v & 31), qb = 15 - (xg >= 0 ? ((v & 31) >> 1) : (v >> 5));
            attn_unit<true>(p, lds, bh >> 3, bh & 7, qb);
            v = qs[0];
        }
        __syncthreads();
    }
    {   if (tid == 0) qs[0] = atomicAdd(c1, 1);
        __syncthreads();
        int v = qs[0];
        while (v < nq) {
            __syncthreads();
            if (tid == 0) qs[0] = atomicAdd(c1, 1);
            const int bh = xg >= 0 ? xg * 4 + 2 * (v >> 5) + (v & 1) : (v & 31), qb = 15 - (xg >= 0 ? ((v & 31) >> 1) : (v >> 5));
            attn_unit<false>(p, lds, bh >> 3, bh & 7, qb);
            v = qs[0];
        }
        __syncthreads();
    }
}
__device__ __forceinline__ void phase_attn(const P& p, LAS unsigned char* lds, int G, int bid) {
    int* ctr = (int*)(p.ws + WS_CTL + 61440); const int xg = (G == 256) ? (bid & 7) : -1;
    if (MOE_FP8 && ((bid >> 3) & 7) < 3) { conv_queue(p, lds, ctr + 128, -1); attn_queues(p, lds, ctr, xg); }
    else { attn_queues(p, lds, ctr, xg); if (MOE_FP8) conv_queue(p, lds, ctr + 128, -1); }
}
}

__device__ __forceinline__ void phase_normmod(const P& p, const float* x, const float* g, int shift_idx, int scale_idx, bf16_t* out, int G, int bid) { phase_normmod_r(WSP(float, WS_MOD), x, g, shift_idx, scale_idx, out, G, bid); }
template <class Sched>
__device__ __forceinline__ void moe_tables(const P& p, LAS unsigned char* lds, int G, int bid, bool gather, const float* bias, int bias_ld) {
    LAS int* tp = (LAS int*)(lds + LDS_TP); LAS int* cn = (LAS int*)(lds + LDS_CNT); LAS unsigned short* gidx = (LAS unsigned short*)(lds + LDS_GIDX); LAS float* bl = (LAS float*)(lds + LDS_BIAS);
    const int tid = threadIdx.x;
    if (tid < 32) cn[tid] = WSP(int, WS_CNT)[tid];
    __syncthreads();
    if (tid == 0) { int s = 0; for (int e = 0; e < 32; ++e) { tp[e] = s; s += (cn[e] + 255) >> 8; } tp[32] = s; tp[63] = 0; }
    __syncthreads();
    if (tid < 20) { Sched S; S.init(tp, G, bid); pg::Unit u; tp[40 + tid] = S.next(tid, u) ? u.e : 0; }
    __syncthreads();
    if (tid == 0) tp[63] = 1;
    __syncthreads();
    if (bias) {
        Sched S; S.init(tp, G, bid);
        const int t = tid & 255, i0 = tid >> 8;
        float bv[9]; int rv[9]; bool ok[9];
#pragma unroll
        for (int j = 0; j < 9; ++j) { pg::Unit u; u.e = 0; u.pn = 0; u.pm = 0; ok[j] = S.next(i0 + 2 * j, u);
            const size_t bo = ok[j] ? (size_t)u.e * bias_ld + u.pn * 256 + t : 0;
            bv[j] = bias[bo];
            rv[j] = 0;
            if (gather) { const int e_ = ok[j] ? u.e : 0, r = ok[j] ? (u.pm - tp[e_]) * 256 + t : 0; const bool gk = ok[j] && r < cn[e_];
                const int v = WSP(int, WS_ROWTOK)[gk ? (size_t)e_ * NTOK + r : 0]; rv[j] = gk ? (v >> 2) : 0; } }
#pragma unroll
        for (int j = 0; j < 9; ++j) if (ok[j]) { const int i = i0 + 2 * j; bl[i * 256 + t] = bv[j]; if (gather) gidx[i * 256 + t] = (unsigned short)rv[j]; }
        __syncthreads();
    }
}

__global__ void __launch_bounds__(512, 2) mega(P p, int lo, int hi, int bar_idx) {
    extern __shared__ __attribute__((aligned(16))) unsigned char lds_raw[];
    LAS unsigned char* lds = (LAS unsigned char*)lds_raw;
    const int tid = threadIdx.x, G = gridDim.x, bid = blockIdx.x;
    if (tid < 4) ((LAS unsigned*)(lds + LDS_MISC))[tid] = 0u;
    __syncthreads();
    XcdBarrier bar = xcd_barrier_post((unsigned*)(p.ws + WS_CTL) + bar_idx * XCD_BAR_WORDS, (volatile LAS unsigned*)(lds + LDS_MISC));
#define IN(k) (lo <= (k) && (k) < hi)
#define RUN(k, ...) do { __VA_ARGS__; } while (0)
#define SEAM(k) do { if (IN(k) && IN((k) + 1)) xcd_barrier(bar); } while (0)
    if (IN(0)) RUN(0, phase_prologue(p, lds, G, bid));
    SEAM(0);
    if (IN(1)) RUN(1, { phase_cb(p, lds, bid); phase_normmod(p, p.x, p.g_attn, 0, 1, WSP(bf16_t, WS_H), G, bid); });
    SEAM(1);
    if (IN(2)) RUN(2, {
        const bool ch = (G == 256);
        pg::DenseOrder S1; S1.init(64, 12, G, bid, 8, 4); pg::EpiProjMain E1{p};
        pg::DenseOrder S2; S2.init(4, 64, G, bid); pg::EpiVt<false> E2{p, WS_SBVT};
        pg::KropeOrder S3{G, bid}; pg::EpiKropeP E3{p};
        const bf16_t* A2 = WSP(bf16_t, WS_WIN_T) + (size_t)2048 * 2048;
        const char* b2n = nullptr; unsigned q00 = 0, q01 = 0, q10 = 0, q11 = 0; const char* b3n = nullptr; unsigned k00 = 0, k01 = 0, k10 = 0, k11 = 0;
        if (ch) { pg::first_unit_of(S2, WSP(bf16_t, WS_H), 4096, b2n, q00, q01, q10, q11); pg::first_unit_of(S3, WSP(bf16_t, WS_WIN_T), 4096, b3n, k00, k01, k10, k11); }
        pg::gemm_phase<0>(lds, WSP(bf16_t, WS_H), WSP(bf16_t, WS_WIN_T), 4096, S1, E1, nullptr, 0, false, ch, A2, b2n, q00, q01, q10, q11);
        pg::gemm_phase<0>(lds, A2, WSP(bf16_t, WS_H), 4096, S2, E2, nullptr, 0, ch, ch, WSP(bf16_t, WS_H), b3n, k00, k01, k10, k11);
        pg::gemm_phase<0>(lds, WSP(bf16_t, WS_H), WSP(bf16_t, WS_WIN_T), 4096, S3, E3, nullptr, 8, ch, false);
    });
    SEAM(2);
    if (IN(3)) RUN(3, {
        krope_fixup(WSP(float, WS_G_QRAW), WSP(float2, WS_CS), WSP(bf16_t, WS_KROPE), G, bid);
        const bool ch = (G == 256);
        pg::DenseOrder S1; S1.init(64, 6, G, bid); pg::EpiQ E1{p};
        pg::DenseOrder S2; S2.init(64, 4, G, bid); pg::EpiKnope E2{p};
        pg::DenseOrder S3; S3.init(4, 64, G, bid); pg::EpiVt<true> E3{p, WS_VMT};
        const bf16_t* A3 = WSP(bf16_t, WS_WKV_T) + (size_t)1024 * 512;
        const char* b2n = nullptr; unsigned q00 = 0, q01 = 0, q10 = 0, q11 = 0; const char* b3n = nullptr; unsigned k00 = 0, k01 = 0, k10 = 0, k11 = 0;
        if (ch) { pg::first_unit_of(S2, WSP(bf16_t, WS_WKV_T), 1024, b2n, q00, q01, q10, q11); pg::first_unit_of(S3, WSP(bf16_t, WS_KVLAT), 1024, b3n, k00, k01, k10, k11); }
        pg::gemm_phase<0>(lds, WSP(bf16_t, WS_QLAT), WSP(bf16_t, WS_WQ_T), 1024, S1, E1, nullptr, 0, false, ch, WSP(bf16_t, WS_KVLAT), b2n, q00, q01, q10, q11);
        pg::gemm_phase<0>(lds, WSP(bf16_t, WS_KVLAT), WSP(bf16_t, WS_WKV_T), 1024, S2, E2, nullptr, 0, ch, ch, A3, b3n, k00, k01, k10, k11);
        pg::gemm_phase<0>(lds, A3, WSP(bf16_t, WS_KVLAT), 1024, S3, E3, nullptr, 0, ch, false);
        if (MOE_FP8 && G == 256 && bid >= 128) at::conv_queue(p, lds, (int*)(p.ws + WS_CTL + 61440) + 128, 3);
    });
    SEAM(3);
    if (IN(4)) RUN(4, at::phase_attn(p, lds, G, bid));
    SEAM(4);
    if (IN(5)) RUN(5, { pg::DenseOrder S; S.init(64, 8, G, bid); pg::EpiOut E{p};
        pg::gemm_phase<0>(lds, WSP(bf16_t, WS_MIXED), WSP(bf16_t, WS_WOUT_T), 4096, S, E, nullptr); });
    SEAM(5);
    if (IN(6)) phase_route(p, lds, G, bid);
    SEAM(6);
    if (IN(7)) RUN(7, { typedef pg::MoeOrder<16, true> SO; moe_tables<SO>(p, lds, G, bid, true, p.b1, 4096);
        SO S; S.init((const LAS int*)(lds + LDS_TP), G, bid); pg::EpiMoe1 E{p, WS_ACT, (const LAS float*)(lds + LDS_BIAS)};
        pg::gemm_phase<MOE1_FP6 ? 2 : 1>(lds, p.ws + WS_H2, p.ws + WS_W1_T, 2048, S, E, (const LAS int*)(lds + LDS_GIDX)); });
    SEAM(7);
    if (IN(8)) RUN(8, { typedef pg::MoeOrder<8, false> SO; moe_tables<SO>(p, lds, G, bid, false, p.b2, 2048);
        SO S; S.init((const LAS int*)(lds + LDS_TP), G, bid); pg::EpiMoe2 E{p, (const LAS float*)(lds + LDS_BIAS)};
        pg::gemm_phase<1>(lds, p.ws + WS_ACT, p.ws + WS_W2_T, 2048, S, E, nullptr); });
    SEAM(8);
    if (IN(9)) RUN(9, { moe_tables<pg::MoeOrder<8, false> >(p, lds, G, bid, false, nullptr, 0); phase_final(p, lds, G, bid); });
#undef IN
#undef SEAM
}

extern "C" void kernel_launch(void* const* d_in, const int* in_sizes, int n_in, void* d_out, int out_size, void* d_ws, size_t ws_size, hipStream_t stream) {
    if (n_in != 20 || out_size != NTOK * D || ws_size < WS_END2) { fprintf(stderr, "kernel_launch: unexpected shapes (n_in %d out %d ws %zu need %zu)\n", n_in, out_size, ws_size, (size_t)WS_END2); return; }
    P p{};
    p.x = (const float*)d_in[0]; p.c = (const float*)d_in[1]; p.pos = (const int*)d_in[2]; p.g_attn = (const float*)d_in[3]; p.w_mod = (const float*)d_in[4]; p.b_mod = (const float*)d_in[5];
    p.w_in = (const float*)d_in[6]; p.g_q = (const float*)d_in[7]; p.w_q_up = (const float*)d_in[8]; p.g_kv = (const float*)d_in[9]; p.w_kv_up = (const float*)d_in[10]; p.w_out = (const float*)d_in[11];
    p.g_ffn = (const float*)d_in[12]; p.w_router = (const float*)d_in[13]; p.b_router = (const float*)d_in[14]; p.w1 = (const float*)d_in[15]; p.b1 = (const float*)d_in[16]; p.w2 = (const float*)d_in[17];
    p.b2 = (const float*)d_in[18]; p.g_final = (const float*)d_in[19]; p.out = (float*)d_out; p.ws = (unsigned char*)d_ws;
    static int grid = 0;
    if (grid == 0) {
        int dev = 0, cus = 0, per_cu = 0;
        if (hipGetDevice(&dev) != hipSuccess || hipDeviceGetAttribute(&cus, hipDeviceAttributeMultiprocessorCount, dev) != hipSuccess || cus <= 0) cus = 256;
        if (hipFuncSetAttribute((const void*)mega, hipFuncAttributeMaxDynamicSharedMemorySize, LDS_BYTES) != hipSuccess) fprintf(stderr, "kernel_launch: hipFuncSetAttribute failed\n");
        if (hipOccupancyMaxActiveBlocksPerMultiprocessor(&per_cu, (const void*)mega, 512, LDS_BYTES) != hipSuccess || per_cu < 1) fprintf(stderr, "kernel_launch: occupancy query says %d\n", per_cu);
        (void)hipGetLastError();
        grid = cus;
    }
    (void)hipMemsetAsync((char*)d_ws + WS_CTL, 0, 65536, stream);
    mega<<<grid, 512, LDS_BYTES, stream>>>(p, 0, 10, 0);
}
```

```cpp
#include <hip/hip_runtime.h>
#include <stdint.h>
#include <stdio.h>

constexpr int D = 2048, NB = 4, SEQ = 4096, NTOK = NB * SEQ;
constexpr int SBH = 8, DH = 128, SBW = SBH * DH;
constexpr int MH = 8, NOPE = 128, ROPE = 64, VD = 128, QKD = 192, QR = 512, KVR = 512;
constexpr int INW = 3 * SBW + QR + KVR + ROPE;
constexpr int NE = 32, TOPK = 4, DE = 2048;
constexpr int NMOD = 6;
constexpr float EPS = 1e-6f;
constexpr int MAXSLOT = NTOK * TOPK + NE * 256;

typedef unsigned short bf16_t;
typedef float f32x2_t __attribute__((ext_vector_type(2)));
typedef __bf16 bf16x2_t __attribute__((ext_vector_type(2)));

__device__ __forceinline__ float bf2f(bf16_t v) { return __uint_as_float(((unsigned)v) << 16); }
__device__ __forceinline__ unsigned pk2(float a, float b) { f32x2_t v = {a, b}; bf16x2_t r = __builtin_convertvector(v, bf16x2_t); return __builtin_bit_cast(unsigned, r); }
__device__ __forceinline__ bf16_t f2bf(float a) { return (bf16_t)(pk2(a, 0.f) & 0xffffu); }

constexpr size_t al256(size_t x) { return (x + 255) & ~(size_t)255; }
constexpr size_t WS_CTL   = 0;
constexpr size_t WS_MOD   = 65536;
constexpr size_t WS_CS    = WS_MOD + al256((size_t)NB * NMOD * D * 4);
constexpr size_t WS_H     = WS_CS + (size_t)NTOK * 32 * 8;
constexpr size_t WS_SBQ   = WS_H + (size_t)NTOK * D * 2;
constexpr size_t WS_SBK   = WS_SBQ + (size_t)NTOK * SBW * 2;
constexpr size_t WS_SBVT  = WS_SBK + (size_t)NTOK * SBW * 2;
constexpr size_t WS_QLAT  = WS_SBVT + (size_t)NTOK * SBW * 2;
constexpr size_t WS_KVLAT = WS_QLAT + (size_t)NTOK * QR * 2;
constexpr size_t WS_SSQP  = WS_KVLAT + (size_t)NTOK * KVR * 2;
constexpr size_t WS_KROPE = WS_SSQP + (size_t)NTOK * 16 * 4;
constexpr size_t WS_QMLA  = WS_KROPE + (size_t)NTOK * 64 * 2;
constexpr size_t WS_KNOPE = WS_QMLA + (size_t)NTOK * 1536 * 2;
constexpr size_t WS_VMT   = WS_KNOPE + (size_t)NTOK * 1024 * 2;
constexpr size_t WS_MIXED = WS_VMT + (size_t)NTOK * 1024 * 2;
constexpr size_t WS_X1    = WS_MIXED + (size_t)NTOK * D * 2;
constexpr size_t WS_H2    = WS_X1 + (size_t)NTOK * D * 4;
constexpr size_t WS_TOPE  = WS_H2 + (size_t)NTOK * D * 2;
constexpr size_t WS_TOPW  = WS_TOPE + (size_t)NTOK * 4 * 4;
constexpr size_t WS_TPOS  = WS_TOPW + (size_t)NTOK * 4 * 4;
constexpr size_t WS_CNT   = WS_CTL + 62464;
constexpr size_t WS_ROWTOK= WS_TPOS + (size_t)NTOK * 4 * 4;
constexpr size_t WS_ACT   = WS_ROWTOK + (size_t)NE * NTOK * 4;
constexpr size_t WS_Y     = WS_ACT + (size_t)MAXSLOT * DE * 2;
constexpr size_t WS_GTMP  = WS_Y + (size_t)MAXSLOT * D * 2;
constexpr size_t WS_G_QRAW  = WS_GTMP;
constexpr size_t WS_G_KRRAW = WS_G_QRAW + (size_t)NTOK * 1536 * 4;
constexpr size_t WS_G_SLOTTOK = WS_G_KRRAW + (size_t)NTOK * 64 * 4;
constexpr size_t WS_G_SLOTE   = WS_G_SLOTTOK + (size_t)MAXSLOT * 4;
constexpr size_t WS_END   = WS_G_SLOTE + (size_t)MAXSLOT * 4;

struct P {
    const float *x, *c; const int* pos; const float *g_attn, *w_mod, *b_mod, *w_in, *g_q, *w_q_up, *g_kv, *w_kv_up, *w_out, *g_ffn, *w_router, *b_router, *w1, *b1, *w2, *b2, *g_final;
    float* out; unsigned char* ws;
};
#define WSP(T, off) ((T*)(p.ws + (off)))


#define LAS __attribute__((address_space(3)))
typedef short bf16x8 __attribute__((ext_vector_type(8)));
typedef float f32x4 __attribute__((ext_vector_type(4)));
typedef float f32x16 __attribute__((ext_vector_type(16)));
typedef unsigned u32x4 __attribute__((ext_vector_type(4)));
typedef unsigned u32x2 __attribute__((ext_vector_type(2)));
typedef int i32x8 __attribute__((ext_vector_type(8)));
typedef int i32x4 __attribute__((ext_vector_type(4)));
constexpr bool MOE_FP8 = true;
constexpr float W8_SCALE = 256.f, W8_INV = 1.f / 256.f;
typedef __bf16 bf16x32_t __attribute__((ext_vector_type(32)));
typedef unsigned u32x6 __attribute__((ext_vector_type(6)));
typedef unsigned u32x16 __attribute__((ext_vector_type(16)));
constexpr bool Y_FP8 = true;
constexpr float Y_SCALE = 32.f;
constexpr bool MOE1_FP6 = true;
__device__ __forceinline__ void fp6_block(const float (&v)[32], u32x4& out_lo, u32x4& out_hi) {
    float amax = 0.f;
#pragma unroll
    for (int i = 0; i < 32; ++i) amax = fmaxf(amax, fabsf(v[i]));
    int e = (int)((__float_as_uint(amax) >> 23) & 0xffu) - 127 - 2;
    if (amax * __uint_as_float((unsigned)(127 - e) << 23) > 7.5f) e += 1;
    e = e < -120 ? -120 : e;
    const float inv = __uint_as_float((unsigned)(127 - e) << 23);
    u32x16 w;
#pragma unroll
    for (int i = 0; i < 16; ++i) w[i] = pk2(v[2 * i] * inv, v[2 * i + 1] * inv);
    const u32x6 c = __builtin_amdgcn_cvt_scalef32_pk32_fp6_bf16(__builtin_bit_cast(bf16x32_t, w), 1.0f);
    out_lo.x = c[0]; out_lo.y = c[1]; out_lo.z = c[2]; out_lo.w = c[3];
    out_hi.x = c[4]; out_hi.y = c[5]; out_hi.z = (unsigned)(e + 127); out_hi.w = 0u;
}

__device__ __forceinline__ void fp6_block_bf16(const u32x16& w, u32x4& out_lo, u32x4& out_hi) {
    typedef unsigned short u16x2_t __attribute__((ext_vector_type(2))); u16x2_t mx = {0, 0};
#pragma unroll
    for (int i = 0; i < 16; ++i) mx = __builtin_elementwise_max(mx, __builtin_bit_cast(u16x2_t, w[i] & 0x7fff7fffu));
    const unsigned am = mx[0] > mx[1] ? mx[0] : mx[1];
    int sb = (int)((am + 15u) >> 7) - 2; sb = sb < 7 ? 7 : sb;
    const u32x6 c = __builtin_amdgcn_cvt_scalef32_pk32_fp6_bf16(__builtin_bit_cast(bf16x32_t, w), __uint_as_float((unsigned)sb << 23));
    out_lo.x = c[0]; out_lo.y = c[1]; out_lo.z = c[2]; out_lo.w = c[3];
    out_hi.x = c[4]; out_hi.y = c[5]; out_hi.z = (unsigned)sb; out_hi.w = 0u;
}

__device__ __forceinline__ unsigned pk4_fp8(float a, float b, float c, float d) { int w = 0; w = __builtin_amdgcn_cvt_pk_fp8_f32(a, b, w, false); w = __builtin_amdgcn_cvt_pk_fp8_f32(c, d, w, true); return (unsigned)w; }

constexpr size_t WS_WIN_T  = WS_END;
constexpr size_t WS_WQ_T   = WS_WIN_T + (size_t)4352 * 2048 * 2;
constexpr size_t WS_WKV_T  = WS_WQ_T + (size_t)1536 * 512 * 2;
constexpr size_t WS_WOUT_T = WS_WKV_T + (size_t)2048 * 512 * 2;
constexpr size_t WS_W1_T   = WS_WOUT_T + (size_t)2048 * 2048 * 2;
constexpr size_t WS_W2_T   = WS_W1_T + (size_t)NE * 4096 * 2048 * 2;
constexpr size_t WS_WR_HI  = WS_W2_T + (size_t)NE * 2048 * 2048 * 2;
constexpr size_t WS_WR_LO  = WS_WR_HI + (size_t)32 * 2048 * 2;
constexpr size_t WS_CB     = WS_WR_LO + (size_t)32 * 2048 * 2;
constexpr size_t WS_END2   = WS_CB + 512;

#define XB_TMO      128
#define XB_XCNT(j)  (256  + 64 * (j))
#define XB_XSUB(j)  (1280 + 64 * (j))
#define XB_XGEN(j)  (2304 + 64 * (j))
#define XB_TOP      3328
#define XB_TOPGEN   3392
#define XCD_BAR_WORDS 3456
#define XB_SPIN_CAP (1u << 18)
__device__ __forceinline__ unsigned xb_ld(unsigned* p)              { return __hip_atomic_load(p, __ATOMIC_RELAXED, __HIP_MEMORY_SCOPE_AGENT); }
__device__ __forceinline__ unsigned xb_add(unsigned* p, unsigned v) { return __hip_atomic_fetch_add(p, v, __ATOMIC_RELAXED, __HIP_MEMORY_SCOPE_AGENT); }
__device__ __forceinline__ unsigned xb_xcc_id() { return (unsigned)__builtin_amdgcn_s_getreg((3 << 11) | 20) & 0xFu; }
#define XB_SPIN(cond, bar) do { unsigned _sp = 0; while (cond) { __builtin_amdgcn_s_sleep(1); \
    if ((++_sp & 255u) == 0u) { if (xb_ld(&(bar)[XB_TMO])) break; if (_sp > XB_SPIN_CAP) { atomicAdd(&(bar)[XB_TMO], 1u); break; } } } } while (0)
struct XcdBarrier { unsigned* bar; unsigned x; volatile LAS unsigned* st; };
__device__ __forceinline__ XcdBarrier xcd_barrier_post(unsigned* bar, volatile LAS unsigned* st) {
    XcdBarrier b; b.bar = bar; b.x = xb_xcc_id(); b.st = st;
    if (threadIdx.x == 0) (void)xb_add(&bar[XB_XCNT(b.x)], 1u);
    return b;
}
__device__ __forceinline__ void xcd_barrier_complete(unsigned* bar, unsigned x, unsigned& nloc, unsigned& nx) {
    const unsigned G = gridDim.x * gridDim.y * gridDim.z;
    unsigned sum, cnt, mine, sp = 0u;
    for (;;) {
        sum = 0u; cnt = 0u; mine = 0u;
#pragma unroll
        for (unsigned j = 0; j < 16; ++j) { const unsigned c = xb_ld(&bar[XB_XCNT(j)]); sum += c; cnt += (c > 0u) ? 1u : 0u; mine = (j == x) ? c : mine; }
        if (sum == G) break;
        __builtin_amdgcn_s_sleep(1);
        if ((++sp & 255u) == 0u) { if (xb_ld(&bar[XB_TMO])) break; if (sp > XB_SPIN_CAP) { atomicAdd(&bar[XB_TMO], 1u); break; } }
    }
    nloc = mine > 0u ? mine : 1u; nx = cnt > 0u ? cnt : 1u;
}
__device__ __forceinline__ void xcd_barrier(const XcdBarrier& b) {
    asm volatile("s_waitcnt vmcnt(0)" ::: "memory");
    __syncthreads();
    if (threadIdx.x == 0) {
        unsigned* bar = b.bar;
        __builtin_amdgcn_s_waitcnt(0);
        unsigned nloc = b.st[0], nx = b.st[1];
        if (nloc == 0u) { xcd_barrier_complete(bar, b.x, nloc, nx); b.st[0] = nloc; b.st[1] = nx; }
        const unsigned old = xb_add(&bar[XB_XSUB(b.x)], 1u);
        const unsigned gen = old / nloc;
        if (old + 1u == (gen + 1u) * nloc) {
            __builtin_amdgcn_fence(__ATOMIC_RELEASE, "agent");
            asm volatile("s_waitcnt vmcnt(0)" ::: "memory");
            const unsigned og = xb_add(&bar[XB_TOP], 1u);
            const unsigned tg = og / nx;
            if (og + 1u == (tg + 1u) * nx) xb_add(&bar[XB_TOPGEN], 1u);
            else XB_SPIN(xb_ld(&bar[XB_TOPGEN]) == tg, bar);
            __builtin_amdgcn_fence(__ATOMIC_ACQUIRE, "agent");
            xb_add(&bar[XB_XGEN(b.x)], 1u);
            asm volatile("s_waitcnt vmcnt(0)" ::: "memory");
        } else {
            XB_SPIN(xb_ld(&bar[XB_XGEN(b.x)]) == gen, bar);
            __builtin_amdgcn_fence(__ATOMIC_ACQUIRE, "agent");
            asm volatile("s_waitcnt vmcnt(0)" ::: "memory");
        }
    }
    __syncthreads();
}

constexpr int LDS_STAGE = 0;
constexpr int LDS_GIDX  = 131072;
constexpr int LDS_BIAS  = LDS_GIDX + 9216;
constexpr int LDS_TP    = LDS_BIAS + 18432;
constexpr int LDS_CNT   = LDS_TP + 256;
constexpr int LDS_MISC  = LDS_CNT + 128;
constexpr int LDS_BYTES = LDS_MISC + 128;

namespace pg {
constexpr int BM = 256, BK = 64, HALF = 128, HTB = HALF * BK * 2, STAGE_BYTES = 8 * HTB, NXCD = 8, WGM = 8;
__device__ __forceinline__ int lds_byte(int r, int c) { const int st = (r >> 4) * 2 + (c >> 5), rr = r & 15, cc = c & 31, ob = rr * 64 + cc * 2; return st * 1024 + (ob ^ (((ob >> 9) & 1) << 5)); }
__device__ __forceinline__ void stage_rc(int b, int& R, int& C) { const int st = b / 1024, sb = b % 1024, swz = sb ^ (((sb >> 9) & 1) << 5); R = (st >> 1) * 16 + swz / 64; C = (st & 1) * 32 + (swz % 64) / 2; }
__device__ __forceinline__ int perm32(int rho) { const int n = rho >> 4, i = rho & 15; return 8 * (i >> 2) + 4 * n + (i & 3); }

struct Unit { int pm, pn, pb, e, ko, ui; };
struct DenseOrder {
    int nM, nN, nwg, G, c, skip_from, skip_by;
    __device__ void init(int nM_, int nN_, int G_, int c_, int sf = 1 << 30, int sb = 0) { nM = nM_; nN = nN_; nwg = nM * nN; G = G_; c = c_; skip_from = sf; skip_by = sb; }
    __device__ bool next(int i, Unit& u) const {
        const long L = (long)i * G + c; if (L >= nwg) return false;
        int wgid = (int)L; { const int q = nwg / NXCD, r = nwg % NXCD, xcd = wgid % NXCD, off = wgid / NXCD; wgid = (xcd < r ? xcd * (q + 1) : r * (q + 1) + (xcd - r) * q) + off; }
        const int nig = WGM * nN, gid = wgid / nig, fm = gid * WGM, gsz = (nM - fm) < WGM ? (nM - fm) : WGM;
        u.pm = fm + ((wgid % nig) % gsz); u.pn = (wgid % nig) / gsz; u.pb = u.pn >= skip_from ? u.pn + skip_by : u.pn; u.e = 0; u.ko = 0; u.ui = i; return true;
    }
    __device__ __forceinline__ unsigned arow(const Unit& u, int h, int R, int, const LAS int*) const { return (unsigned)(u.pm * 256 + h * 128 + R); }
};

template <int FPM  , class Epi, class Sched>
__device__ __forceinline__ void gemm_phase(LAS unsigned char* lds, const void* A, const void* Bt, const int RB  , const Sched& S, const Epi& E, const LAS int* gidx, const int nt_ = 0  ,
        const bool primed = false  , const bool chain = false  ,
        const void* cA = nullptr, const char* cBn = nullptr, const unsigned c00 = 0, const unsigned c01 = 0, const unsigned c10 = 0, const unsigned c11 = 0) {
    constexpr bool FP8 = FPM != 0;
    const int tid = threadIdx.x, wid = __builtin_amdgcn_readfirstlane(tid >> 6), lane = tid & 63, wr = wid >> 2, wc = wid & 3, fr = lane & 15, fq = lane >> 4;
    const int nt = nt_ ? nt_ : RB / (BK * 2);
    unsigned voffB[2];
#pragma unroll
    for (int i = 0; i < 2; ++i) { int R_, C_; stage_rc(tid * 16 + i * 8192, R_, C_); const int Rb = Epi::PERM ? ((R_ & ~31) + perm32(R_ & 31)) : R_; voffB[i] = (unsigned)(Rb * RB + C_ * 2); }
    const size_t kstep = (size_t)(BK * 2);
    const size_t hstep = (size_t)HALF * RB;
    const size_t tstep = 2 * hstep;
    const unsigned ldsw = (unsigned)wid * 1024u;
    const unsigned lds0 = __builtin_amdgcn_readfirstlane((unsigned)(size_t)lds + ldsw);
    const int aoff = lds_byte(wr * 64 + fr, fq * 8), boff = lds_byte(wc * 32 + fr, fq * 8);
#define PG_SA(b, h) (((b) * 2 + (h)) * HTB)
#define PG_SB(b, h) ((4 + (b) * 2 + (h)) * HTB)
#define PG_DMA(voff_, sbase_, ldsoff_) asm volatile("s_mov_b32 m0, %2\n\ts_nop 0\n\tglobal_load_lds_dwordx4 %0, %1" :: "v"(voff_), "s"(sbase_), "s"(ldsoff_) : "memory", "m0")
#define PG_STAGE_B(bufoff, gbase) do { const char* _sb = (const char*)(gbase); _Pragma("unroll") for (int _i = 0; _i < 2; ++_i) \
        PG_DMA(voffB[_i], _sb, lds0 + (unsigned)((bufoff) + _i * 8192)); } while (0)
#define PG_STAGE_A(bufoff, usenext, h, kb) do { const char* _sa = Ab + (size_t)(kb); _Pragma("unroll") for (int _i = 0; _i < 2; ++_i) { const unsigned _o = rac[h][_i]; \
        PG_DMA(_o, _sa, lds0 + (unsigned)((bufoff) + _i * 8192)); } } while (0)
#define PG_LDA(dst, b, h) do { _Pragma("unroll") for (int m = 0; m < 4; ++m) { if constexpr (FP8) { const i32x4 lo_ = *(const LAS i32x4*)(lds + PG_SA(b, h) + aoff + m * 2048), hi_ = *(const LAS i32x4*)(lds + PG_SA(b, h) + aoff + m * 2048 + 1024); dst##8[m] = __builtin_shufflevector(lo_, hi_, 0, 1, 2, 3, 4, 5, 6, 7); } \
        else { _Pragma("unroll") for (int k = 0; k < 2; ++k) dst[m][k] = *(const LAS bf16x8*)(lds + PG_SA(b, h) + aoff + m * 2048 + k * 1024); } } } while (0)
#define PG_LDB(dst, b, h) do { _Pragma("unroll") for (int n = 0; n < 2; ++n) { if constexpr (FP8) { const i32x4 lo_ = *(const LAS i32x4*)(lds + PG_SB(b, h) + boff + n * 2048), hi_ = *(const LAS i32x4*)(lds + PG_SB(b, h) + boff + n * 2048 + 1024); dst##8[n] = __builtin_shufflevector(lo_, hi_, 0, 1, 2, 3, 4, 5, 6, 7); } \
        else { _Pragma("unroll") for (int k = 0; k < 2; ++k) dst[n][k] = *(const LAS bf16x8*)(lds + PG_SB(b, h) + boff + n * 2048 + k * 1024); } } } while (0)
#define PG_MMA(ai, bj, At, Bt_) do { __builtin_amdgcn_s_setprio(1); _Pragma("unroll") for (int m = 0; m < 4; ++m) _Pragma("unroll") for (int n = 0; n < 2; ++n) { \
        if constexpr (FPM == 2) { acc[ai][bj][m][n] = __builtin_amdgcn_mfma_scale_f32_16x16x128_f8f6f4(Bt_##8[n], At##8[m], acc[ai][bj][m][n], 2, 2, 0, Bt_##8[n][6], 0, At##8[m][6]); } \
        else if constexpr (FPM == 1) { acc[ai][bj][m][n] = __builtin_amdgcn_mfma_scale_f32_16x16x128_f8f6f4(Bt_##8[n], At##8[m], acc[ai][bj][m][n], 0, 0, 0, 0x7F7F7F7F, 0, 0x7F7F7F7F); } \
        else { _Pragma("unroll") for (int k = 0; k < 2; ++k) acc[ai][bj][m][n] = __builtin_amdgcn_mfma_f32_16x16x32_bf16(Bt_[n][k], At[m][k], acc[ai][bj][m][n], 0, 0, 0); } } \
        __builtin_amdgcn_s_setprio(0); } while (0)
#define PG_WAIT_V(n) asm volatile("s_waitcnt vmcnt(" #n ")" ::: "memory")
#define PG_WAIT_L(n) asm volatile("s_waitcnt lgkmcnt(" #n ")" ::: "memory")
#define PG_WAIT_VN(n) asm volatile("s_waitcnt vmcnt(%0)" :: "n"(n) : "memory")
#define PG_KPAIR(t, WV_) do { \
            const bool last = (t == nt - 2); \
            const size_t kb1 = (size_t)(t + 1) * kstep; \
            const size_t kb2 = last ? 0 : (size_t)(t + 2) * kstep, kb3 = kb2 + kstep; \
            const char* b2 = last ? nB : cB + (size_t)(t + 2) * kstep; const char* b3 = b2 + kstep; \
            PG_LDB(B0, 0, 0); PG_LDB(B1, 0, 1); PG_SCHED; PG_LDA(At, 0, 0); PG_STAGE_A(PG_SA(1, 1), false, 1, kb1); \
            if (last) { if (has_next) { PG_RA(rac, nxt, ui + 1); } else if (chain) { rac[0][0] = c00; rac[0][1] = c01; rac[1][0] = c10; rac[1][1] = c11; Ab = (const char*)cA; } } \
            PG_WAIT_VN(WV_); PG_WAIT_L(0); PG_BAR; PG_MMA(0, 0, At, B0); PG_MMA(0, 1, At, B1); PG_BAR; PG_SCHED; \
            PG_LDA(At, 0, 1); PG_STAGE_B(PG_SB(0, 0), b2); PG_STAGE_B(PG_SB(0, 1), b2 + hstep); PG_STAGE_A(PG_SA(0, 0), last, 0, kb2); \
            PG_WAIT_VN(WV_); PG_WAIT_L(0); PG_BAR; PG_MMA(1, 0, At, B0); PG_MMA(1, 1, At, B1); PG_BAR; PG_SCHED; \
            PG_LDB(B0, 1, 0); PG_LDB(B1, 1, 1); PG_SCHED; PG_LDA(At, 1, 0); PG_STAGE_A(PG_SA(0, 1), last, 1, kb2); \
            PG_WAIT_V(8); PG_WAIT_L(0); PG_BAR; PG_MMA(0, 0, At, B0); PG_MMA(0, 1, At, B1); PG_BAR; PG_SCHED; \
            PG_LDA(At, 1, 1); PG_STAGE_B(PG_SB(1, 0), b3); PG_STAGE_B(PG_SB(1, 1), b3 + hstep); PG_STAGE_A(PG_SA(1, 0), last, 0, kb3); \
            PG_WAIT_V(8); PG_WAIT_L(0); PG_BAR; PG_MMA(1, 0, At, B0); PG_MMA(1, 1, At, B1); PG_BAR; PG_SCHED; \
        } while (0)
#define PG_BAR __builtin_amdgcn_s_barrier()
#define PG_SCHED __builtin_amdgcn_sched_barrier(0)
#define PG_RA(dst, u, ui_) do { _Pragma("unroll") for (int _i = 0; _i < 2; ++_i) { int R_, C_; stage_rc(tid * 16 + _i * 8192, R_, C_); _Pragma("unroll") for (int _h = 0; _h < 2; ++_h) dst[_h][_i] = S.arow(u, _h, R_, ui_, gidx) * (unsigned)RB + (unsigned)C_ * 2u + (unsigned)u.ko; } } while (0)
    Unit cur, nxt; int ui = 0;
    if (!S.next(0, cur)) return;
    f32x4 acc[2][2][4][2];
#pragma unroll
    for (int a = 0; a < 2; ++a)
#pragma unroll
        for (int b = 0; b < 2; ++b)
#pragma unroll
            for (int m = 0; m < 4; ++m)
#pragma unroll
                for (int n = 0; n < 2; ++n) acc[a][b][m][n] = (f32x4){0.f, 0.f, 0.f, 0.f};
    bf16x8 At[4][2], B0[2][2], B1[2][2]; i32x8 At8[4], B08[2], B18[2];
    unsigned rac[2][2];
    PG_RA(rac, cur, 0);
    const char* Ab = (const char*)A;
    const char* cB = (const char*)Bt + (size_t)cur.pb * tstep + cur.ko;
    if (!primed) {
    PG_STAGE_B(PG_SB(0, 0), cB); PG_STAGE_B(PG_SB(0, 1), cB + hstep); PG_STAGE_A(PG_SA(0, 0), false, 0, 0); PG_STAGE_A(PG_SA(0, 1), false, 1, 0);
    if (wr == 1) PG_BAR;
    PG_WAIT_V(2); PG_BAR;
    PG_STAGE_B(PG_SB(1, 0), cB + kstep); PG_STAGE_A(PG_SA(1, 0), false, 0, kstep); PG_STAGE_B(PG_SB(1, 1), cB + hstep + kstep);
    PG_WAIT_V(6); PG_BAR;
    }
    for (;;) {
        const bool has_next = S.next(ui + 1, nxt);
        const char* nB = has_next ? (const char*)Bt + (size_t)nxt.pb * tstep + nxt.ko : (chain ? cBn : cB);
        int t0 = 0;
        if (Epi::NST > 0 && ui > 0) { PG_KPAIR(0, 8 + Epi::NST); t0 = 2; }
        for (int t = t0; t < nt; t += 2) PG_KPAIR(t, 8);
        E(acc, cur, wr, wc, fr, fq);
        if (!has_next) break;
#pragma unroll
        for (int a = 0; a < 2; ++a)
#pragma unroll
            for (int b = 0; b < 2; ++b)
#pragma unroll
                for (int m = 0; m < 4; ++m)
#pragma unroll
                    for (int n = 0; n < 2; ++n) acc[a][b][m][n] = (f32x4){0.f, 0.f, 0.f, 0.f};
        cur = nxt; cB = nB; ++ui;
    }
    if (!chain) {
    PG_WAIT_V(0);
    if (wr == 0) PG_BAR;
    PG_BAR;
    }
#undef PG_SA
#undef PG_SB
#undef PG_STAGE_A
#undef PG_STAGE_B
#undef PG_DMA
#undef PG_LDA
#undef PG_LDB
#undef PG_MMA
#undef PG_WAIT_V
#undef PG_WAIT_L
#undef PG_WAIT_VN
#undef PG_KPAIR
#undef PG_BAR
#undef PG_SCHED
#undef PG_RA
}

template <class Sched>
__device__ __forceinline__ void first_unit_of(const Sched& S, const void* Bt, const int RB, const char*& cB, unsigned& r00, unsigned& r01, unsigned& r10, unsigned& r11) {
    Unit u; u.pm = 0; u.pn = 0; u.pb = 0; u.e = 0; u.ko = 0; u.ui = 0; S.next(0, u);
    const int tid = threadIdx.x; int R0, C0, R1, C1; stage_rc(tid * 16, R0, C0); stage_rc(tid * 16 + 8192, R1, C1);
    r00 = S.arow(u, 0, R0, 0, nullptr) * (unsigned)RB + (unsigned)C0 * 2u + (unsigned)u.ko; r01 = S.arow(u, 0, R1, 0, nullptr) * (unsigned)RB + (unsigned)C1 * 2u + (unsigned)u.ko;
    r10 = S.arow(u, 1, R0, 0, nullptr) * (unsigned)RB + (unsigned)C0 * 2u + (unsigned)u.ko; r11 = S.arow(u, 1, R1, 0, nullptr) * (unsigned)RB + (unsigned)C1 * 2u + (unsigned)u.ko;
    cB = (const char*)Bt + (size_t)u.pb * (2 * (size_t)HALF * RB) + u.ko;
}
__device__ __forceinline__ u32x4 pack8(const f32x4 a, const f32x4 b, float s) { u32x4 w; w.x = pk2(a[0] * s, a[1] * s); w.y = pk2(a[2] * s, a[3] * s); w.z = pk2(b[0] * s, b[1] * s); w.w = pk2(b[2] * s, b[3] * s); return w; }
typedef f32x4 Acc[2][2][4][2];

__device__ __forceinline__ float rstd_from(const float* ssq8) { const f32x4 a0 = *(const f32x4*)ssq8, a1 = *(const f32x4*)(ssq8 + 4);
    return 1.0f / sqrtf(((a0[0] + a0[1]) + (a0[2] + a0[3]) + (a1[0] + a1[1]) + (a1[2] + a1[3])) * (1.f / 512.f) + EPS); }
struct EpiProjMain {
    static constexpr bool PERM = true; static constexpr int NST = 0; P p;
    __device__ __forceinline__ void operator()(const Acc& acc, const Unit& u, int wr, int wc, int fr, int fq) const {
        const int row0 = u.pm * 256 + wr * 64 + fr;
        if (u.pn < 8) {
            bf16_t* base = WSP(bf16_t, u.pn < 4 ? WS_SBQ : WS_SBK); const float sc = u.pn < 4 ? 0.08838834764831845f * 1.4426950408889634f : 1.f;    const int col0 = (u.pn & 3) * 256 + wc * 32 + 8 * fq;
#pragma unroll
            for (int ai = 0; ai < 2; ++ai)
#pragma unroll
                for (int m = 0; m < 4; ++m) { bf16_t* rp = base + (size_t)(row0 + ai * 128 + m * 16) * 1024 + col0;
#pragma unroll
                    for (int bj = 0; bj < 2; ++bj) *(u32x4*)(rp + bj * 128) = pack8(acc[ai][bj][m][0], acc[ai][bj][m][1], sc); }
        } else {
            const int lat = (u.pn - 8) >> 1, ct = (u.pn - 8) & 1; bf16_t* base = WSP(bf16_t, lat ? WS_KVLAT : WS_QLAT); const int col0 = ct * 256 + wc * 32 + 8 * fq;
            float* ssqp = WSP(float, WS_SSQP);
#pragma unroll
            for (int ai = 0; ai < 2; ++ai)
#pragma unroll
                for (int m = 0; m < 4; ++m) { const int row = row0 + ai * 128 + m * 16; bf16_t* rp = base + (size_t)row * 512 + col0; float s = 0.f;
#pragma unroll
                    for (int bj = 0; bj < 2; ++bj) { *(u32x4*)(rp + bj * 128) = pack8(acc[ai][bj][m][0], acc[ai][bj][m][1], 1.f);
#pragma unroll
                        for (int n = 0; n < 2; ++n) { const f32x4 v = acc[ai][bj][m][n]; s += (v[0] * v[0] + v[1] * v[1]) + (v[2] * v[2] + v[3] * v[3]); } }
                    s += __shfl_xor(s, 16); s += __shfl_xor(s, 32);
                    if (fq == 0) ssqp[(size_t)row * 16 + lat * 8 + ct * 4 + wc] = s; }
        }
    }
};
template <bool SCALE>
__device__ __forceinline__ void epi_vt_r(const Acc& acc, const float* __restrict__ ssqp, bf16_t* __restrict__ dst, int f0, int tokb) {
#pragma unroll
    for (int bj = 0; bj < 2; ++bj) {
        const int tok0 = tokb + bj * 128, b = tok0 / SEQ, s0 = tok0 % SEQ;
        float sc[8];
#pragma unroll
        for (int j = 0; j < 8; ++j) sc[j] = SCALE ? rstd_from(ssqp + (size_t)(tok0 + j) * 16 + 8) : 1.f;
#pragma unroll
        for (int ai = 0; ai < 2; ++ai)
#pragma unroll
            for (int m = 0; m < 4; ++m) { const int f = f0 + ai * 128 + m * 16, h = f >> 7, d = f & 127;
                const f32x4 v0 = acc[ai][bj][m][0], v1 = acc[ai][bj][m][1]; u32x4 w;
                w.x = pk2(v0[0] * sc[0], v0[1] * sc[1]); w.y = pk2(v0[2] * sc[2], v0[3] * sc[3]); w.z = pk2(v1[0] * sc[4], v1[1] * sc[5]); w.w = pk2(v1[2] * sc[6], v1[3] * sc[7]);
                *(u32x4*)(dst + ((size_t)(b * 8 + h) * 128 + d) * SEQ + s0) = w; }
    }
}
template <bool SCALE> struct EpiVt {
    static constexpr bool PERM = true; static constexpr int NST = 0; P p; size_t dst_off;
    __device__ __forceinline__ void operator()(const Acc& acc, const Unit& u, int wr, int wc, int fr, int fq) const {
        epi_vt_r<SCALE>(acc, WSP(float, WS_SSQP), WSP(bf16_t, dst_off), u.pm * 256 + wr * 64 + fr, u.pn * 256 + wc * 32 + 8 * fq);
    }
};
__device__ __forceinline__ void epi_krope_r(const Acc& acc, const float2* __restrict__ cs, bf16_t* __restrict__ dst, int row0, int col0) {
#pragma unroll
    for (int ai = 0; ai < 2; ++ai) {
        f32x4 cv[4][2];
#pragma unroll
        for (int m = 0; m < 4; ++m) { const float2* cr = cs + (size_t)(row0 + ai * 128 + m * 16) * 32 + (col0 >> 1); cv[m][0] = *(const f32x4*)cr; cv[m][1] = *(const f32x4*)(cr + 2); }
        asm volatile("" ::: "memory");
#pragma unroll
        for (int m = 0; m < 4; ++m) { const int row = row0 + ai * 128 + m * 16; const f32x4 v0 = acc[ai][0][m][0], v1 = acc[ai][0][m][1], c0 = cv[m][0], c1 = cv[m][1];
            u32x4 w; w.x = pk2(v0[0] * c0[0] - v0[1] * c0[1], v0[1] * c0[0] + v0[0] * c0[1]); w.y = pk2(v0[2] * c0[2] - v0[3] * c0[3], v0[3] * c0[2] + v0[2] * c0[3]);
            w.z = pk2(v1[0] * c1[0] - v1[1] * c1[1], v1[1] * c1[0] + v1[0] * c1[1]); w.w = pk2(v1[2] * c1[2] - v1[3] * c1[3], v1[3] * c1[2] + v1[2] * c1[3]);
            *(u32x4*)(dst + (size_t)row * 64 + col0) = w; }
        asm volatile("" ::: "memory");
    }
}
struct EpiKrope {
    static constexpr bool PERM = true; static constexpr int NST = 0; P p;
    __device__ __forceinline__ void operator()(const Acc& acc, const Unit& u, int wr, int wc, int fr, int fq) const {
        if (wc >= 2) return;
        epi_krope_r(acc, WSP(float2, WS_CS), WSP(bf16_t, WS_KROPE), u.pm * 256 + wr * 64 + fr, wc * 32 + 8 * fq);
    }
};

__device__ __forceinline__ void epi_q_r(const Acc& acc, const float* __restrict__ ssqp, const float2* __restrict__ cs, bf16_t* __restrict__ dst, int row0, int cbase) {
    const int j0 = cbase % 192, j1 = (cbase + 128) % 192; const bool rp0 = j0 >= 128, rp1 = j1 >= 128; const int i00 = rp0 ? (j0 - 128) >> 1 : 0, i01 = rp1 ? (j1 - 128) >> 1 : 0;
#pragma unroll
    for (int qq = 0; qq < 4; ++qq) {
        f32x4 ca0[2], ca1[2], cb0[2], cb1[2]; float rsv[2];
#pragma unroll
        for (int h = 0; h < 2; ++h) { const int q = 2 * qq + h, ai = q >> 2, m = q & 3, row = row0 + ai * 128 + m * 16; const float2* cr = cs + (size_t)row * 32;
            ca0[h] = *(const f32x4*)(cr + i00); ca1[h] = *(const f32x4*)(cr + i00 + 2); cb0[h] = *(const f32x4*)(cr + i01); cb1[h] = *(const f32x4*)(cr + i01 + 2);
            rsv[h] = rstd_from(ssqp + (size_t)row * 16) * (0.07216878364870322f * 1.4426950408889634f); }
        asm volatile("" ::: "memory");
#pragma unroll
        for (int h = 0; h < 2; ++h) { const int q = 2 * qq + h, ai = q >> 2, m = q & 3, row = row0 + ai * 128 + m * 16;
#pragma unroll
            for (int bj = 0; bj < 2; ++bj) { const bool rp = bj ? rp1 : rp0;
                f32x4 v0 = acc[ai][bj][m][0] * rsv[h], v1 = acc[ai][bj][m][1] * rsv[h];
                if (rp) { const f32x4 c0v = bj ? cb0[h] : ca0[h], c1v = bj ? cb1[h] : ca1[h], t0 = v0, t1 = v1;
                    v0[0] = t0[0] * c0v[0] - t0[1] * c0v[1]; v0[1] = t0[1] * c0v[0] + t0[0] * c0v[1]; v0[2] = t0[2] * c0v[2] - t0[3] * c0v[3]; v0[3] = t0[3] * c0v[2] + t0[2] * c0v[3];
                    v1[0] = t1[0] * c1v[0] - t1[1] * c1v[1]; v1[1] = t1[1] * c1v[0] + t1[0] * c1v[1]; v1[2] = t1[2] * c1v[2] - t1[3] * c1v[3]; v1[3] = t1[3] * c1v[2] + t1[2] * c1v[3]; }
                *(u32x4*)(dst + (size_t)row * 1536 + cbase + bj * 128) = pack8(v0, v1, 1.f); } }
        asm volatile("" ::: "memory");
    }
}
struct EpiQ {
    static constexpr bool PERM = true; static constexpr int NST = 0; P p;
    __device__ __forceinline__ void operator()(const Acc& acc, const Unit& u, int wr, int wc, int fr, int fq) const {
        epi_q_r(acc, WSP(float, WS_SSQP), WSP(float2, WS_CS), WSP(bf16_t, WS_QMLA), u.pm * 256 + wr * 64 + fr, u.pn * 256 + wc * 32 + 8 * fq);
    }
};
__device__ __forceinline__ void epi_knope_r(const Acc& acc, const float* __restrict__ ssqp, bf16_t* __restrict__ dst, int row0, int c0) {
    float rs[2][4];
#pragma unroll
    for (int ai = 0; ai < 2; ++ai)
#pragma unroll
        for (int m = 0; m < 4; ++m) rs[ai][m] = rstd_from(ssqp + (size_t)(row0 + ai * 128 + m * 16) * 16 + 8);
    asm volatile("" ::: "memory");
#pragma unroll
    for (int ai = 0; ai < 2; ++ai)
#pragma unroll
        for (int m = 0; m < 4; ++m) { const int row = row0 + ai * 128 + m * 16;
#pragma unroll
            for (int bj = 0; bj < 2; ++bj) *(u32x4*)(dst + (size_t)row * 1024 + c0 + bj * 128) = pack8(acc[ai][bj][m][0], acc[ai][bj][m][1], rs[ai][m]); }
}
struct EpiKnope {
    static constexpr bool PERM = true; static constexpr int NST = 0; P p;
    __device__ __forceinline__ void operator()(const Acc& acc, const Unit& u, int wr, int wc, int fr, int fq) const {
        epi_knope_r(acc, WSP(float, WS_SSQP), WSP(bf16_t, WS_KNOPE), u.pm * 256 + wr * 64 + fr, u.pn * 256 + wc * 32 + 8 * fq);
    }
};
__device__ __forceinline__ void epi_out_r(const Acc& acc, const float* __restrict__ xin, const float* __restrict__ g1, bf16_t* __restrict__ x1, int row0, int col0) {
    f32x4 gv[2][2];
#pragma unroll
    for (int bj = 0; bj < 2; ++bj)
#pragma unroll
        for (int n = 0; n < 2; ++n) gv[bj][n] = *(const f32x4*)(g1 + col0 + bj * 128 + n * 4);
#pragma unroll
    for (int ai = 0; ai < 2; ++ai) {
        f32x4 xv[4][2][2];
#pragma unroll
        for (int m = 0; m < 4; ++m)
#pragma unroll
            for (int bj = 0; bj < 2; ++bj)
#pragma unroll
                for (int n = 0; n < 2; ++n) xv[m][bj][n] = *(const f32x4*)(xin + (size_t)(row0 + ai * 128 + m * 16) * D + col0 + bj * 128 + n * 4);
        asm volatile("" ::: "memory");
#pragma unroll
        for (int m = 0; m < 4; ++m)
#pragma unroll
            for (int bj = 0; bj < 2; ++bj)
                *(u32x4*)(x1 + (size_t)(row0 + ai * 128 + m * 16) * D + col0 + bj * 128) = pack8(xv[m][bj][0] + gv[bj][0] * acc[ai][bj][m][0], xv[m][bj][1] + gv[bj][1] * acc[ai][bj][m][1], 1.f);
        asm volatile("" ::: "memory");
    }
}
struct EpiOut {
    static constexpr bool PERM = true; static constexpr int NST = 0; P p;
    __device__ __forceinline__ void operator()(const Acc& acc, const Unit& u, int wr, int wc, int fr, int fq) const {
        const int row0 = u.pm * 256 + wr * 64 + fr, b = (u.pm * 256) / SEQ, col0 = u.pn * 256 + wc * 32 + 8 * fq;
        epi_out_r(acc, p.x, WSP(float, WS_MOD) + (size_t)b * NMOD * D + 2 * D, WSP(bf16_t, WS_X1), row0, col0);
    }
};
struct EpiMoe1 {
    static constexpr bool PERM = true; static constexpr int NST = 8; P p; size_t dst_off; const LAS float* bias_lds;
    __device__ __forceinline__ void operator()(const Acc& acc, const Unit& u, int wr, int wc, int fr, int fq) const {
        const int row0 = u.pm * 256 + wr * 64 + fr, a0 = u.pn * 128 + wc * 32 + 8 * fq; const LAS float* b1 = bias_lds + (u.ui < 18 ? u.ui : 0) * 256 + 2 * (wc * 32 + 8 * fq); bf16_t* dst = WSP(bf16_t, dst_off);
        float bg[8], bl[8];
#pragma unroll
        for (int q = 0; q < 4; ++q) { const f32x4 t = *(const LAS f32x4*)(b1 + 4 * q); bg[2 * q] = t[0]; bl[2 * q] = t[1] + 1.f; bg[2 * q + 1] = t[2]; bl[2 * q + 1] = t[3] + 1.f; }
#pragma unroll
        for (int ai = 0; ai < 2; ++ai)
#pragma unroll
            for (int m = 0; m < 4; ++m) { const int row = row0 + ai * 128 + m * 16; float o[8];
#pragma unroll
                for (int j = 0; j < 8; ++j) { float g = acc[ai][0][m][j >> 2][j & 3] * (MOE1_FP6 ? 1.f : W8_INV) + bg[j], l = acc[ai][1][m][j >> 2][j & 3] * (MOE1_FP6 ? 1.f : W8_INV) + bl[j];
                    g = fminf(g, 7.f); l = fminf(fmaxf(l, -6.f), 8.f);
                    o[j] = g * __builtin_amdgcn_rcpf(1.f + __builtin_amdgcn_exp2f(-2.4554669595930156f * g)) * l; }
                if (MOE_FP8) { u32x2 w; w.x = pk4_fp8(o[0], o[1], o[2], o[3]); w.y = pk4_fp8(o[4], o[5], o[6], o[7]); *(u32x2*)((unsigned char*)dst + (size_t)row * DE + a0) = w; }
                else { u32x4 w; w.x = pk2(o[0], o[1]); w.y = pk2(o[2], o[3]); w.z = pk2(o[4], o[5]); w.w = pk2(o[6], o[7]);
                *(u32x4*)(dst + (size_t)row * DE + a0) = w; } }
    }
};
struct EpiMoe2 {
    static constexpr bool PERM = true; static constexpr int NST = 16; P p; const LAS float* bias_lds;
    __device__ __forceinline__ void operator()(const Acc& acc, const Unit& u, int wr, int wc, int fr, int fq) const {
        const int row0 = u.pm * 256 + wr * 64 + fr, c0 = u.pn * 256 + wc * 32 + 8 * fq; const LAS float* b2 = bias_lds + (u.ui < 18 ? u.ui : 0) * 256 + wc * 32 + 8 * fq; bf16_t* dst = WSP(bf16_t, WS_Y);
        f32x4 bv[2][2];
#pragma unroll
        for (int bj = 0; bj < 2; ++bj)
#pragma unroll
            for (int n = 0; n < 2; ++n) bv[bj][n] = *(const LAS f32x4*)(b2 + bj * 128 + 4 * n) * (Y_FP8 ? Y_SCALE : 1.f);
#pragma unroll
        for (int ai = 0; ai < 2; ++ai)
#pragma unroll
            for (int m = 0; m < 4; ++m) { const int row = row0 + ai * 128 + m * 16;
#pragma unroll
                for (int bj = 0; bj < 2; ++bj) {
                    if (Y_FP8) { f32x4 t0 = acc[ai][bj][m][0] * ((MOE_FP8 ? W8_INV : 1.f) * Y_SCALE) + bv[bj][0], t1 = acc[ai][bj][m][1] * ((MOE_FP8 ? W8_INV : 1.f) * Y_SCALE) + bv[bj][1];
#pragma unroll
                        for (int j = 0; j < 4; ++j) { t0[j] = __builtin_amdgcn_fmed3f(t0[j], -448.f, 448.f); t1[j] = __builtin_amdgcn_fmed3f(t1[j], -448.f, 448.f); }
                        u32x2 w; w.x = pk4_fp8(t0[0], t0[1], t0[2], t0[3]); w.y = pk4_fp8(t1[0], t1[1], t1[2], t1[3]);
                        *(u32x2*)((unsigned char*)dst + (size_t)row * D + c0 + bj * 128) = w; }
                    else *(u32x4*)(dst + (size_t)row * D + c0 + bj * 128) = pack8(acc[ai][bj][m][0] * (MOE_FP8 ? W8_INV : 1.f) + bv[bj][0], acc[ai][bj][m][1] * (MOE_FP8 ? W8_INV : 1.f) + bv[bj][1], 1.f); } }
    }
};
template <int NCT, bool GATHER> struct MoeOrder {
    const LAS int* tp; int T, rtr, ctr, rpr, G, c;
    __device__ void init(const LAS int* tp_, int G_, int c_) { tp = tp_; T = tp_[32]; G = G_; c = c_;
        const int x = c_ & 7, a = (c_ >> 3) & 31;
        if (NCT == 16) { rtr = (x >> 2) * 8 + (a >> 2); ctr = (x & 3) * 4 + (a & 3); rpr = 16; } else { rtr = (x >> 1) * 8 + (a >> 2); ctr = (x & 1) * 4 + (a & 3); rpr = 32; } }
    __device__ bool next(int i, Unit& u) const {
        int g, ct;
        if (G == 256) { g = i * rpr + rtr; ct = ctr; } else { const long L = (long)i * G + c; g = (int)(L / NCT); ct = (int)(L % NCT); }
        if (g >= T) return false;
        int e;
        if (G == 256 && i < 20 && tp[63]) { e = tp[40 + i]; }
        else { e = 0; while (e < 31 && tp[e + 1] <= g) ++e; }
        u.pm = g; u.pn = ct; u.pb = e * NCT + ct; u.e = e; u.ko = 0; u.ui = i; return true;
    }
    __device__ __forceinline__ unsigned arow(const Unit& u, int h, int R, int ui, const LAS int* gidx) const { return GATHER ? (unsigned)((const LAS unsigned short*)gidx)[ui * 256 + h * 128 + R] : (unsigned)(u.pm * 256 + h * 128 + R); }
};
struct KropeOrder {
    int G, c;
    __device__ bool next(int i, Unit& u) const { const int L = i * G + c; if (L >= 256) return false; u.pm = L >> 2; u.pn = L & 3; u.pb = 16; u.e = 0; u.ko = (L & 3) * 1024; u.ui = i; return true; }
    __device__ __forceinline__ unsigned arow(const Unit& u, int h, int R, int, const LAS int*) const { return (unsigned)(u.pm * 256 + h * 128 + R); }
};
struct EpiKropeP {
    static constexpr bool PERM = true; static constexpr int NST = 0; P p;
    __device__ __forceinline__ void operator()(const Acc& acc, const Unit& u, int wr, int wc, int fr, int fq) const {
        if (wc >= 2) return;
        float* dst = WSP(float, WS_G_QRAW) + (size_t)u.pn * NTOK * 64; const int row0 = u.pm * 256 + wr * 64 + fr, col0 = wc * 32 + 8 * fq;
#pragma unroll
        for (int ai = 0; ai < 2; ++ai)
#pragma unroll
            for (int m = 0; m < 4; ++m) { float* rp = dst + (size_t)(row0 + ai * 128 + m * 16) * 64 + col0; *(f32x4*)rp = acc[ai][0][m][0]; *(f32x4*)(rp + 4) = acc[ai][0][m][1]; }
    }
};
}

__device__ __forceinline__ void krope_fixup(const float* __restrict__ part, const float2* __restrict__ cs, bf16_t* __restrict__ dst, int G, int bid) {
    for (int r0 = bid * 64; r0 < NTOK; r0 += G * 64) { const int row = r0 + (threadIdx.x >> 3), c8 = (threadIdx.x & 7) * 8;
        f32x4 a = {0.f, 0.f, 0.f, 0.f}, b = {0.f, 0.f, 0.f, 0.f};
#pragma unroll
        for (int q = 0; q < 4; ++q) { const float* pp = part + ((size_t)q * NTOK + row) * 64 + c8; a += *(const f32x4*)pp; b += *(const f32x4*)(pp + 4); }
        const f32x4 c0 = *(const f32x4*)(cs + (size_t)row * 32 + (c8 >> 1)), c1 = *(const f32x4*)(cs + (size_t)row * 32 + (c8 >> 1) + 2);
        u32x4 w; w.x = pk2(a[0] * c0[0] - a[1] * c0[1], a[1] * c0[0] + a[0] * c0[1]); w.y = pk2(a[2] * c0[2] - a[3] * c0[3], a[3] * c0[2] + a[2] * c0[3]);
        w.z = pk2(b[0] * c1[0] - b[1] * c1[1], b[1] * c1[0] + b[0] * c1[1]); w.w = pk2(b[2] * c1[2] - b[3] * c1[3], b[3] * c1[2] + b[2] * c1[3]);
        *(u32x4*)(dst + (size_t)row * 64 + c8) = w; }
}

struct DmIdent { __device__ int operator()(int n) const { return n; } };
struct DmWin { __device__ int operator()(int n) const { if (n < 4096) return n; const int j = n - 4096; return j < 32 ? 4096 + 2 * j : 4096 + 2 * (j - 32) + 1; } };
struct DmWq { __device__ int operator()(int n) const { const int h = n / 192, j = n - h * 192; if (j < 128) return n; return j < 160 ? h * 192 + 128 + 2 * (j - 128) : h * 192 + 128 + 2 * (j - 160) + 1; } };
struct DmWkv { __device__ int operator()(int n) const { const int h = n >> 8, r = n & 255; return r < 128 ? h * 128 + r : 1024 + h * 128 + (r - 128); } };
struct DmW1 { __device__ int operator()(int n) const { const int a = n >> 1; return (a >> 7) * 256 + (n & 1) * 128 + (a & 127); } };
template <class DM>
__device__ __forceinline__ void conv_tile(const float* W, int ldw, int k0, int n0, bf16_t* Bt, int K, DM dm, const float* kscale, LAS unsigned* T) {
    const int tid = threadIdx.x, kp = tid >> 4, nc = tid & 15;
    f32x4 a[2], b[2];
#pragma unroll
    for (int ps = 0; ps < 2; ++ps) { const int k = k0 + 2 * (kp + 32 * ps);
        a[ps] = *(const f32x4*)(W + (size_t)k * ldw + n0 + 4 * nc); b[ps] = *(const f32x4*)(W + (size_t)(k + 1) * ldw + n0 + 4 * nc);
        if (kscale) { a[ps] *= kscale[k]; b[ps] *= kscale[k + 1]; } }
#pragma unroll
    for (int ps = 0; ps < 2; ++ps)
#pragma unroll
        for (int j = 0; j < 4; ++j) T[(4 * nc + j) * 66 + kp + 32 * ps] = pk2(a[ps][j], b[ps][j]);
    __syncthreads();
#pragma unroll
    for (int q = 0; q < 2; ++q) { const int ch = tid + 512 * q, n = ch >> 4, c = ch & 15;
        const u32x2 lo = *(const LAS u32x2*)(T + n * 66 + 4 * c), hi = *(const LAS u32x2*)(T + n * 66 + 4 * c + 2);
        u32x4 w; w.x = lo.x; w.y = lo.y; w.z = hi.x; w.w = hi.y;
        *(u32x4*)(Bt + (size_t)dm(n0 + n) * K + k0 + 8 * c) = w; }
    __syncthreads();
}

template <class DM>
__device__ __forceinline__ void conv_tile8(const float* W, int ldw, int k0, int n0, unsigned char* Bt, int K, DM dm, LAS unsigned* T) {
    const int tid = threadIdx.x, k4 = tid >> 4, nc = tid & 15;
    f32x4 a[4];
#pragma unroll
    for (int r = 0; r < 4; ++r) a[r] = *(const f32x4*)(W + (size_t)(k0 + 4 * k4 + r) * ldw + n0 + 4 * nc) * W8_SCALE;
#pragma unroll
    for (int j = 0; j < 4; ++j) T[(4 * nc + j) * 36 + k4] = pk4_fp8(a[0][j], a[1][j], a[2][j], a[3][j]);
    __syncthreads();
    { const int n = tid >> 3, c = tid & 7; const u32x4 w = *(const LAS u32x4*)(T + n * 36 + 4 * c); *(u32x4*)(Bt + (size_t)dm(n0 + n) * K + k0 + 16 * c) = w; }
    __syncthreads();
}

template <class DM>
__device__ __forceinline__ void conv_tile8x2(const float* Wa, const float* Wb, int ldw, int k0a, int n0a, int k0b, int n0b, unsigned char* Bta, unsigned char* Btb, int K, DM dm, LAS unsigned* T) {
    const int tid = threadIdx.x, k4 = tid >> 4, nc = tid & 15;
    f32x4 a[4], b[4];
#pragma unroll
    for (int r = 0; r < 4; ++r) a[r] = __builtin_nontemporal_load((const f32x4*)(Wa + (size_t)(k0a + 4 * k4 + r) * ldw + n0a + 4 * nc));
#pragma unroll
    for (int r = 0; r < 4; ++r) b[r] = __builtin_nontemporal_load((const f32x4*)(Wb + (size_t)(k0b + 4 * k4 + r) * ldw + n0b + 4 * nc));
#pragma unroll
    for (int j = 0; j < 4; ++j) T[(4 * nc + j) * 36 + k4] = pk4_fp8(a[0][j] * W8_SCALE, a[1][j] * W8_SCALE, a[2][j] * W8_SCALE, a[3][j] * W8_SCALE);
#pragma unroll
    for (int j = 0; j < 4; ++j) T[2304 + (4 * nc + j) * 36 + k4] = pk4_fp8(b[0][j] * W8_SCALE, b[1][j] * W8_SCALE, b[2][j] * W8_SCALE, b[3][j] * W8_SCALE);
    __syncthreads();
    { const int n = tid >> 3, c = tid & 7; const u32x4 wa = *(const LAS u32x4*)(T + n * 36 + 4 * c), wb = *(const LAS u32x4*)(T + 2304 + n * 36 + 4 * c);
      __builtin_nontemporal_store(wa, (u32x4*)(Bta + (size_t)dm(n0a + n) * K + k0a + 16 * c)); __builtin_nontemporal_store(wb, (u32x4*)(Btb + (size_t)dm(n0b + n) * K + k0b + 16 * c)); }
    __syncthreads();
}

template <class DM>
__device__ __forceinline__ void conv_macro8(const float* W, int ldw, int k0, int n0, unsigned char* Bt, int K, DM dm, LAS unsigned char* Tb) {
    const int tid = threadIdx.x, kq = tid >> 6, nc = tid & 63;
    const float* src = W + (size_t)(k0 + 4 * kq) * ldw + n0 + 4 * nc;
    f32x4 a[2][8];
#define CM_LOAD(buf, slab) do { _Pragma("unroll") for (int h_ = 0; h_ < 2; ++h_) _Pragma("unroll") for (int r_ = 0; r_ < 4; ++r_) a[buf][h_ * 4 + r_] = __builtin_nontemporal_load((const f32x4*)(src + (size_t)((slab) * 64 + h_ * 32 + r_) * ldw)); } while (0)
#define CM_PUT(buf, slab) do { _Pragma("unroll") for (int h_ = 0; h_ < 2; ++h_) _Pragma("unroll") for (int j_ = 0; j_ < 4; ++j_) \
        *(LAS unsigned*)(Tb + (4 * nc + j_) * 260 + ((slab) * 64 + h_ * 32 + 4 * kq)) = pk4_fp8(a[buf][h_ * 4][j_] * W8_SCALE, a[buf][h_ * 4 + 1][j_] * W8_SCALE, a[buf][h_ * 4 + 2][j_] * W8_SCALE, a[buf][h_ * 4 + 3][j_] * W8_SCALE); } while (0)
    CM_LOAD(0, 0); CM_LOAD(1, 1);
    CM_PUT(0, 0); CM_LOAD(0, 2);
    CM_PUT(1, 1); CM_LOAD(1, 3);
    CM_PUT(0, 2); CM_PUT(1, 3);
#undef CM_LOAD
#undef CM_PUT
    __syncthreads();
#pragma unroll
    for (int ps = 0; ps < 8; ++ps) { const int n = ps * 32 + (tid >> 4), c = tid & 15; const LAS unsigned* tp_ = (const LAS unsigned*)(Tb + n * 260 + 16 * c);
        u32x4 w; w.x = tp_[0]; w.y = tp_[1]; w.z = tp_[2]; w.w = tp_[3];
        __builtin_nontemporal_store(w, (u32x4*)(Bt + (size_t)dm(n0 + n) * K + k0 + 16 * c)); }
    __syncthreads();
}

__device__ __forceinline__ void phase_prologue(const P& p, LAS unsigned char* lds, int G, int bid) {
    const int tid = threadIdx.x, lane = tid & 63, wid = tid >> 6;
    LAS float* cact = (LAS float*)lds;
    LAS float* red = (LAS float*)(lds + 32768);
    LAS unsigned* T = (LAS unsigned*)(lds + 81920);
    constexpr int U_MOD = 96, U_CS = 64 + 8;
    constexpr int T_WIN = 16 * 65, T_WQ = 4 * 24, T_WKV = 4 * 32, T_WOUT = 16 * 32;
    constexpr int U_REST = U_CS + T_WIN + T_WQ + T_WKV + T_WOUT;
    const bool split = G > 2 * U_MOD;
    if (!split || bid < U_MOD) {
        for (int i = tid; i < 4 * 2048; i += 512) { const int b = i >> 11, k = i & 2047; const float c = p.c[i]; cact[k * 4 + b] = c / (1.f + __expf(-c)); }
        __syncthreads();
        for (int mu = bid; mu < U_MOD; mu += G) {
            f32x4 acc[4] = {{0.f, 0.f, 0.f, 0.f}, {0.f, 0.f, 0.f, 0.f}, {0.f, 0.f, 0.f, 0.f}, {0.f, 0.f, 0.f, 0.f}};
            const int hh = lane >> 5, cl = lane & 31;
            const float* w = p.w_mod + (size_t)(wid * 256 + hh) * (NMOD * D) + mu * 128 + 4 * cl;
#pragma unroll 16
            for (int k = 0; k < 128; ++k) { const f32x4 wv = __builtin_nontemporal_load((const f32x4*)(w + (size_t)(2 * k) * (NMOD * D))); const f32x4 c = *(const LAS f32x4*)(cact + (wid * 256 + 2 * k + hh) * 4);
                acc[0] += wv * c[0]; acc[1] += wv * c[1]; acc[2] += wv * c[2]; acc[3] += wv * c[3]; }
#pragma unroll
            for (int b = 0; b < 4; ++b) *(LAS f32x4*)(red + ((wid * 64 + lane) * 4 + b) * 4) = acc[b];
            __syncthreads();
            if (tid < 128) { const int l = tid >> 2, b = tid & 3; f32x4 sum = *(const f32x4*)(p.b_mod + mu * 128 + 4 * l);
#pragma unroll
                for (int w8 = 0; w8 < 16; ++w8) sum += *(const LAS f32x4*)(red + ((w8 * 32 + l) * 4 + b) * 4);
                *(f32x4*)(WSP(float, WS_MOD) + (size_t)b * NMOD * D + mu * 128 + 4 * l) = sum; }
            __syncthreads();
        }
        if (split) return;
    }
    const int c0 = split ? bid - U_MOD : bid, GS = split ? G - U_MOD : G;
    for (int v = c0; v < U_CS; v += GS) {
        if (v >= 64) {
            for (int j = 0; j < 16; ++j) { const int idx = (v - 64) * 8192 + j * 512 + tid, k = idx >> 5, e = idx & 31; const float w = p.w_router[idx];
                const bf16_t hi = f2bf(w); WSP(bf16_t, WS_WR_HI)[e * 2048 + k] = hi; WSP(bf16_t, WS_WR_LO)[e * 2048 + k] = f2bf(w - bf2f(hi)); }
        } else {
            for (int j = 0; j < 16; ++j) { const int idx = v * 8192 + j * 512 + tid; const int tok = idx >> 5, i = idx & 31;
                double inv = 1.0; for (int q = 0; q < i; ++q) inv *= 0.7498942093324559;
                const double rev = (double)p.pos[tok] * inv * 0.15915494309189535; const float fr = (float)(rev - floor(rev));
                float2 cs; cs.x = __builtin_amdgcn_cosf(fr); cs.y = __builtin_amdgcn_sinf(fr); WSP(float2, WS_CS)[idx] = cs; }
        }
    }
    constexpr int NT = T_WIN + T_WQ + T_WKV + T_WOUT;
    const int kp = tid >> 4, nc = tid & 15;
    f32x4 ra[2][2], rb[2][2];
#define CT_DECL(P_) const float* P_##W = p.w_in; bf16_t* P_##Bt = WSP(bf16_t, WS_WIN_T); const float* P_##ks = nullptr; int P_##ldw = INW, P_##k0 = 0, P_##n0 = 0, P_##K = 2048, P_##dmt = 0
#define CT_SET(P_, vv) do { int v_ = (vv); \
        if (v_ < T_WIN) { P_##W = p.w_in; P_##Bt = WSP(bf16_t, WS_WIN_T); P_##ks = nullptr; P_##ldw = INW; P_##k0 = (v_ / 65) * 128; P_##n0 = (v_ % 65) * 64; P_##K = 2048; P_##dmt = 0; } \
        else if ((v_ -= T_WIN) < T_WQ) { P_##W = p.w_q_up; P_##Bt = WSP(bf16_t, WS_WQ_T); P_##ks = p.g_q; P_##ldw = 1536; P_##k0 = (v_ / 24) * 128; P_##n0 = (v_ % 24) * 64; P_##K = 512; P_##dmt = 1; } \
        else if ((v_ -= T_WQ) < T_WKV) { P_##W = p.w_kv_up; P_##Bt = WSP(bf16_t, WS_WKV_T); P_##ks = p.g_kv; P_##ldw = 2048; P_##k0 = (v_ / 32) * 128; P_##n0 = (v_ % 32) * 64; P_##K = 512; P_##dmt = 2; } \
        else { v_ -= T_WKV; P_##W = p.w_out; P_##Bt = WSP(bf16_t, WS_WOUT_T); P_##ks = nullptr; P_##ldw = 2048; P_##k0 = (v_ / 32) * 128; P_##n0 = (v_ % 32) * 64; P_##K = 2048; P_##dmt = 3; } } while (0)
#define PT_LOAD(buf, P_) do { _Pragma("unroll") for (int ps = 0; ps < 2; ++ps) { const int k = P_##k0 + 2 * (kp + 32 * ps); \
        ra[buf][ps] = *(const f32x4*)(P_##W + (size_t)k * P_##ldw + P_##n0 + 4 * nc); rb[buf][ps] = *(const f32x4*)(P_##W + (size_t)(k + 1) * P_##ldw + P_##n0 + 4 * nc); } } while (0)
#define PT_DO(buf, P_) do { _Pragma("unroll") for (int ps = 0; ps < 2; ++ps) { const int k = P_##k0 + 2 * (kp + 32 * ps); f32x4 x = ra[buf][ps], y = rb[buf][ps]; \
            if (P_##ks) { x *= P_##ks[k]; y *= P_##ks[k + 1]; } \
            _Pragma("unroll") for (int j = 0; j < 4; ++j) T[(4 * nc + j) * 66 + kp + 32 * ps] = pk2(x[j], y[j]); } \
        __syncthreads(); \
        _Pragma("unroll") for (int q = 0; q < 2; ++q) { const int ch = tid + 512 * q, n = ch >> 4, cc = ch & 15; \
            const u32x2 lo = *(const LAS u32x2*)(T + n * 66 + 4 * cc), hi = *(const LAS u32x2*)(T + n * 66 + 4 * cc + 2); \
            u32x4 w; w.x = lo.x; w.y = lo.y; w.z = hi.x; w.w = hi.y; const int nn = P_##n0 + n; \
            const int dn = P_##dmt == 0 ? DmWin{}(nn) : P_##dmt == 1 ? DmWq{}(nn) : P_##dmt == 2 ? DmWkv{}(nn) : nn; \
            *(u32x4*)(P_##Bt + (size_t)dn * P_##K + P_##k0 + 8 * cc) = w; } \
        __syncthreads(); } while (0)
    int v = c0;
    if (v < NT) {
        CT_DECL(c_); CT_DECL(n_);
        CT_SET(c_, v); PT_LOAD(0, c_);
        for (;;) {
            const int vn = v + GS; const bool more = vn < NT;
            if (more) { CT_SET(n_, vn); PT_LOAD(1, n_); }
            PT_DO(0, c_);
            if (!more) break;
            const int vnn = vn + GS; const bool more2 = vnn < NT;
            if (more2) { CT_SET(c_, vnn); PT_LOAD(0, c_); }
            PT_DO(1, n_);
            if (!more2) break;
            v = vnn;
        }
    }
#undef CT_DECL
#undef CT_SET
#undef PT_LOAD
#undef PT_DO
}

__device__ __forceinline__ void phase_normmod_r(const float* __restrict__ mod, const float* __restrict__ x, const float* __restrict__ g, int shift_idx, int scale_idx, bf16_t* __restrict__ out, int G, int bid) {
    const int lane = threadIdx.x & 63, wid = threadIdx.x >> 6;
    for (int row = bid * 8 + wid; row < NTOK; row += G * 8) {
        const int b = row / SEQ; const float* xr = x + (size_t)row * D; f32x4 v[8]; float ss = 0.f;
#pragma unroll
        for (int j = 0; j < 8; ++j) { v[j] = *(const f32x4*)(xr + (j * 64 + lane) * 4); ss += (v[j][0] * v[j][0] + v[j][1] * v[j][1]) + (v[j][2] * v[j][2] + v[j][3] * v[j][3]); }
#pragma unroll
        for (int o = 32; o >= 1; o >>= 1) ss += __shfl_xor(ss, o);
        const float rstd = 1.0f / sqrtf(ss * (1.f / D) + EPS);
        const float* sh = mod + (size_t)b * NMOD * D + shift_idx * D; const float* sc = mod + (size_t)b * NMOD * D + scale_idx * D;
#pragma unroll
        for (int j = 0; j < 8; ++j) { const int k = (j * 64 + lane) * 4; const f32x4 gg = *(const f32x4*)(g + k), s1 = *(const f32x4*)(sc + k), s0 = *(const f32x4*)(sh + k);
            const f32x4 h = v[j] * rstd * gg * (s1 + 1.f) + s0; u32x2 w; w.x = pk2(h[0], h[1]); w.y = pk2(h[2], h[3]); *(u32x2*)(out + (size_t)row * D + k) = w; }
    }
}


__device__ __forceinline__ void phase_cb(const P& p, LAS unsigned char* lds, int bid) {
    if (bid >= NB) return;
    const int tid = threadIdx.x, e = tid & 31, kc = tid >> 5; LAS float* red = (LAS float*)lds;
    const float* sh = WSP(float, WS_MOD) + (size_t)bid * NMOD * D + 3 * D; float s = 0.f;
#pragma unroll 16
    for (int k = kc * 128; k < kc * 128 + 128; ++k) s += sh[k] * p.w_router[k * 32 + e];
    red[tid] = s; __syncthreads();
    if (tid < 32) { float t = p.b_router[tid]; for (int q = 0; q < 16; ++q) t += red[q * 32 + tid]; WSP(float, WS_CB)[bid * 32 + tid] = t; }
    __syncthreads();
}
__device__ __forceinline__ void route_h2_out(const bf16_t* __restrict__ xr, const float* __restrict__ gf, const float* __restrict__ sc, const float* __restrict__ sh, unsigned char* __restrict__ hr8, const float rs, const int kbase) {
#pragma unroll 4
    for (int s = 0; s < 32; ++s) {
        const int k = kbase + 16 * s;
        const f32x4 g0 = *(const f32x4*)(gf + k), g1 = *(const f32x4*)(gf + k + 4), s0 = *(const f32x4*)(sc + k), s1 = *(const f32x4*)(sc + k + 4), h0 = *(const f32x4*)(sh + k), h1 = *(const f32x4*)(sh + k + 4);
        f32x4 xa, xb; { const u32x4 xw = *(const u32x4*)(xr + 16 * s); xa[0] = __uint_as_float(xw.x << 16); xa[1] = __uint_as_float(xw.x & 0xffff0000u); xa[2] = __uint_as_float(xw.y << 16); xa[3] = __uint_as_float(xw.y & 0xffff0000u);
            xb[0] = __uint_as_float(xw.z << 16); xb[1] = __uint_as_float(xw.z & 0xffff0000u); xb[2] = __uint_as_float(xw.w << 16); xb[3] = __uint_as_float(xw.w & 0xffff0000u); }
        const f32x4 y0 = xa * rs * g0 * (s0 + 1.f) + h0, y1 = xb * rs * g1 * (s1 + 1.f) + h1;
        if (MOE_FP8) { u32x2 w; w.x = pk4_fp8(y0[0], y0[1], y0[2], y0[3]); w.y = pk4_fp8(y1[0], y1[1], y1[2], y1[3]); *(u32x2*)(hr8 + 16 * s) = w; }
        else { u32x4 w; w.x = pk2(y0[0], y0[1]); w.y = pk2(y0[2], y0[3]); w.z = pk2(y1[0], y1[1]); w.w = pk2(y1[2], y1[3]); *(u32x4*)(hr8 + 32 * s) = w; }
    }
}
__device__ __forceinline__ void route_h2_fp6(const bf16_t* __restrict__ x1g, const LAS float* gsl, const LAS float* shl, unsigned char* __restrict__ h2g, const LAS float* rsd) {
    const int blk = threadIdx.x & 63, k0 = blk * 32;
    f32x4 gs[8], hs[8];
#pragma unroll
    for (int q = 0; q < 8; ++q) { gs[q] = *(const LAS f32x4*)(gsl + k0 + 4 * q); hs[q] = *(const LAS f32x4*)(shl + k0 + 4 * q); }
#pragma unroll 2
    for (int ps = 0; ps < 8; ++ps) { const int id = threadIdx.x + 512 * ps, r = id >> 6; const float rs = rsd[r];
        float v[32]; const u32x4* xp = (const u32x4*)(x1g + (size_t)r * D + k0);
#pragma unroll
        for (int q = 0; q < 4; ++q) { const u32x4 xw = xp[q]; const f32x4 g0 = gs[2 * q] * rs, g1 = gs[2 * q + 1] * rs, h0 = hs[2 * q], h1 = hs[2 * q + 1];
            v[8 * q + 0] = __uint_as_float(xw.x << 16) * g0[0] + h0[0]; v[8 * q + 1] = __uint_as_float(xw.x & 0xffff0000u) * g0[1] + h0[1];
            v[8 * q + 2] = __uint_as_float(xw.y << 16) * g0[2] + h0[2]; v[8 * q + 3] = __uint_as_float(xw.y & 0xffff0000u) * g0[3] + h0[3];
            v[8 * q + 4] = __uint_as_float(xw.z << 16) * g1[0] + h1[0]; v[8 * q + 5] = __uint_as_float(xw.z & 0xffff0000u) * g1[1] + h1[1];
            v[8 * q + 6] = __uint_as_float(xw.w << 16) * g1[2] + h1[2]; v[8 * q + 7] = __uint_as_float(xw.w & 0xffff0000u) * g1[3] + h1[3]; }
        u32x4 lo, hi; fp6_block(v, lo, hi);
        unsigned char* dst = h2g + (size_t)r * D + (blk >> 2) * 128 + (blk & 3) * 16;
        *(u32x4*)dst = lo; *(u32x4*)(dst + 64) = hi; }
}
__device__ __forceinline__ void phase_route(const P& p, LAS unsigned char* lds, int G, int bid) {
    const int tid = threadIdx.x, lane = tid & 63, wid = __builtin_amdgcn_readfirstlane(tid >> 6), hf = wid >> 2, wq = wid & 3, r32 = lane & 31, kg = lane >> 5;
    LAS float* red = (LAS float*)lds;
    LAS float* ssr = (LAS float*)(lds + 32768);
    LAS float* lg = (LAS float*)(lds + 32768 + 2048);
    LAS float* rsd = (LAS float*)(lds + 32768 + 2048 + 8192);
    LAS int* hist = (LAS int*)(lds + 32768 + 2048 + 8192 + 256);
    LAS int* gbase = hist + 32;
    LAS float* gsl = (LAS float*)(lds + 49152);
    LAS float* shl = (LAS float*)(lds + 57344);
    const bf16_t* wrh = WSP(bf16_t, WS_WR_HI); const bf16_t* wrl = WSP(bf16_t, WS_WR_LO);
    for (int gp = bid; gp < NTOK / 64; gp += G) {
        const int row = gp * 64 + hf * 32 + r32, b = (gp * 64) / SEQ, kb0 = wq * 512 + 8 * kg;
        const float* mod = WSP(float, WS_MOD) + (size_t)b * NMOD * D; const float* sh = mod + 3 * D; const float* sc = mod + 4 * D;
        const bf16_t* xr = WSP(bf16_t, WS_X1) + (size_t)row * D + kb0;
        f32x16 C = {}; float ss = 0.f;
        if (tid < 32) hist[tid] = 0;
        { const int k4 = tid * 4; *(LAS f32x4*)(gsl + k4) = *(const f32x4*)(p.g_ffn + k4) * (*(const f32x4*)(sc + k4) + 1.f); *(LAS f32x4*)(shl + k4) = *(const f32x4*)(sh + k4); }
        __syncthreads();
#pragma unroll 4
        for (int s = 0; s < 32; ++s) {
            const int k = kb0 + 16 * s;
            const f32x4 gs0 = *(const LAS f32x4*)(gsl + k), gs1 = *(const LAS f32x4*)(gsl + k + 4);
            f32x4 x0, x1; { const u32x4 xw = *(const u32x4*)(xr + 16 * s); x0[0] = __uint_as_float(xw.x << 16); x0[1] = __uint_as_float(xw.x & 0xffff0000u); x0[2] = __uint_as_float(xw.y << 16); x0[3] = __uint_as_float(xw.y & 0xffff0000u);
                x1[0] = __uint_as_float(xw.z << 16); x1[1] = __uint_as_float(xw.z & 0xffff0000u); x1[2] = __uint_as_float(xw.w << 16); x1[3] = __uint_as_float(xw.w & 0xffff0000u); }
            ss += (x0[0] * x0[0] + x0[1] * x0[1]) + (x0[2] * x0[2] + x0[3] * x0[3]) + (x1[0] * x1[0] + x1[1] * x1[1]) + (x1[2] * x1[2] + x1[3] * x1[3]);
            const f32x4 y0 = x0 * gs0, y1 = x1 * gs1;
            u32x4 hi; hi.x = pk2(y0[0], y0[1]); hi.y = pk2(y0[2], y0[3]); hi.z = pk2(y1[0], y1[1]); hi.w = pk2(y1[2], y1[3]);
            f32x4 r0, r1;
            r0[0] = y0[0] - __uint_as_float(hi.x << 16); r0[1] = y0[1] - __uint_as_float(hi.x & 0xffff0000u); r0[2] = y0[2] - __uint_as_float(hi.y << 16); r0[3] = y0[3] - __uint_as_float(hi.y & 0xffff0000u);
            r1[0] = y1[0] - __uint_as_float(hi.z << 16); r1[1] = y1[1] - __uint_as_float(hi.z & 0xffff0000u); r1[2] = y1[2] - __uint_as_float(hi.w << 16); r1[3] = y1[3] - __uint_as_float(hi.w & 0xffff0000u);
            u32x4 lo; lo.x = pk2(r0[0], r0[1]); lo.y = pk2(r0[2], r0[3]); lo.z = pk2(r1[0], r1[1]); lo.w = pk2(r1[2], r1[3]);
            const bf16x8 ah = *(const bf16x8*)(wrh + (size_t)r32 * 2048 + k), al = *(const bf16x8*)(wrl + (size_t)r32 * 2048 + k);
            const bf16x8 bh = __builtin_bit_cast(bf16x8, hi), bl = __builtin_bit_cast(bf16x8, lo);
            C = __builtin_amdgcn_mfma_f32_32x32x16_bf16(ah, bh, C, 0, 0, 0);
            C = __builtin_amdgcn_mfma_f32_32x32x16_bf16(al, bh, C, 0, 0, 0);
            C = __builtin_amdgcn_mfma_f32_32x32x16_bf16(ah, bl, C, 0, 0, 0);
        }
#pragma unroll
        for (int r = 0; r < 16; ++r) red[((hf * 4 + wq) * 32 + ((r & 3) + 8 * (r >> 2) + 4 * kg)) * 32 + r32] = C[r];
        ssr[(hf * 8 + wq * 2 + kg) * 32 + r32] = ss;
        __syncthreads();
        { const int h2 = tid >> 8, t2 = tid & 255;
#pragma unroll
          for (int q = 0; q < 4; ++q) { const int e = (t2 >> 5) + 8 * q; float t = 0.f;
#pragma unroll
              for (int w4 = 0; w4 < 4; ++w4) t += red[((h2 * 4 + w4) * 32 + e) * 32 + (t2 & 31)]; lg[(h2 * 32 + e) * 32 + (t2 & 31)] = t; } }
        if (tid < 64) { float t = 0.f;
#pragma unroll
            for (int q = 0; q < 8; ++q) t += ssr[((tid >> 5) * 8 + q) * 32 + (tid & 31)]; rsd[tid] = 1.0f / sqrtf(t * (1.f / D) + EPS); }
        __syncthreads();
        int i0 = 0, i1 = 0, i2 = 0, i3 = 0, l0 = 0, l1 = 0, l2 = 0, l3 = 0; float w0 = 0.f, w1 = 0.f, w2 = 0.f, w3 = 0.f;
        if (tid < 64) {
            const float rs = rsd[tid]; const float* cb = WSP(float, WS_CB) + b * 32; const LAS float* lgr = lg + (tid >> 5) * 1024 + (tid & 31);
            unsigned used = 0; float v0 = 0, v1 = 0, v2 = 0, v3 = 0;
            float xv[32];
#pragma unroll
            for (int e = 0; e < 32; ++e) xv[e] = lgr[e * 32] * rs + cb[e];
#pragma unroll
            for (int k = 0; k < 4; ++k) { float best = -3.0e38f; int bi = 0;
#pragma unroll
                for (int e = 0; e < 32; ++e) { const bool ok = !((used >> e) & 1u) && xv[e] > best; best = ok ? xv[e] : best; bi = ok ? e : bi; }
                used |= 1u << bi;
                if (k == 0) { i0 = bi; v0 = best; } else if (k == 1) { i1 = bi; v1 = best; } else if (k == 2) { i2 = bi; v2 = best; } else { i3 = bi; v3 = best; } }
            const float e1 = __expf(v1 - v0), e2 = __expf(v2 - v0), e3 = __expf(v3 - v0), inv = 1.f / (1.f + e1 + e2 + e3);
            w0 = inv; w1 = e1 * inv; w2 = e2 * inv; w3 = e3 * inv;
            l0 = atomicAdd((int*)(hist + i0), 1); l1 = atomicAdd((int*)(hist + i1), 1); l2 = atomicAdd((int*)(hist + i2), 1); l3 = atomicAdd((int*)(hist + i3), 1);
        }
        __syncthreads();
        if (tid < 32) { const int c = hist[tid]; gbase[tid] = c ? atomicAdd(WSP(int, WS_CNT) + tid, c) : 0; }
        __syncthreads();
        if (tid < 64) { const int rw = gp * 64 + tid;
            const int p0 = gbase[i0] + l0, p1 = gbase[i1] + l1, p2 = gbase[i2] + l2, p3 = gbase[i3] + l3;
            int* te = WSP(int, WS_TOPE) + rw * 4; float* tw = WSP(float, WS_TOPW) + rw * 4; int* tp = WSP(int, WS_TPOS) + rw * 4; int* rt = WSP(int, WS_ROWTOK);
            te[0] = i0; te[1] = i1; te[2] = i2; te[3] = i3; tw[0] = w0; tw[1] = w1; tw[2] = w2; tw[3] = w3; tp[0] = p0; tp[1] = p1; tp[2] = p2; tp[3] = p3;
            rt[(size_t)i0 * NTOK + p0] = rw * 4; rt[(size_t)i1 * NTOK + p1] = rw * 4 + 1; rt[(size_t)i2 * NTOK + p2] = rw * 4 + 2; rt[(size_t)i3 * NTOK + p3] = rw * 4 + 3; }
        if (MOE1_FP6) route_h2_fp6(WSP(bf16_t, WS_X1) + (size_t)(gp * 64) * D, gsl, shl, p.ws + WS_H2 + (size_t)(gp * 64) * D, rsd);
        else route_h2_out(xr, p.g_ffn, sc, sh, p.ws + WS_H2 + (size_t)row * D + kb0, rsd[hf * 32 + r32], kb0);
        __syncthreads();
    }
}
__device__ __forceinline__ void phase_final_r(const bf16_t* __restrict__ Y, const bf16_t* __restrict__ X1, const float* __restrict__ modp, const int* __restrict__ tope, const int* __restrict__ tpos, const float* __restrict__ topw, const float* __restrict__ gfin, float* __restrict__ outp, LAS unsigned char* lds, int G, int bid) {
    const int lane = threadIdx.x & 63, wid = threadIdx.x >> 6; const LAS int* tp = (const LAS int*)(lds + LDS_TP);
    int e_n = 0, ps_n = 0; float wk_n = 0.f;
    { const int r0 = bid * 8 + wid; if (r0 < NTOK && lane < 4) { e_n = tope[r0 * 4 + lane]; ps_n = tpos[r0 * 4 + lane]; wk_n = topw[r0 * 4 + lane]; } }
    for (int row = bid * 8 + wid; row < NTOK; row += G * 8) {
        const int b = row / SEQ; const float* g2 = modp + (size_t)b * NMOD * D + 5 * D;
        int slot = 0; float wk = 0.f;
        if (lane < 4) { slot = tp[e_n] * 256 + ps_n; wk = wk_n; }
        { const int nr = row + G * 8; if (nr < NTOK && lane < 4) { e_n = tope[nr * 4 + lane]; ps_n = tpos[nr * 4 + lane]; wk_n = topw[nr * 4 + lane]; } }
        const int sl0 = __shfl(slot, 0), sl1 = __shfl(slot, 1), sl2 = __shfl(slot, 2), sl3 = __shfl(slot, 3);
        const float ysc = Y_FP8 ? 1.f / Y_SCALE : 1.f, q0 = __shfl(wk, 0) * ysc, q1 = __shfl(wk, 1) * ysc, q2 = __shfl(wk, 2) * ysc, q3 = __shfl(wk, 3) * ysc;
        f32x4 v[8]; float ss = 0.f;
#pragma unroll
        for (int j = 0; j < 8; ++j) { const int k = (j * 64 + lane) * 4;
            f32x4 m;
            if (Y_FP8) { const unsigned char* Y8 = (const unsigned char*)Y;
                const int a0 = *(const int*)(Y8 + (size_t)sl0 * D + k), a1 = *(const int*)(Y8 + (size_t)sl1 * D + k), a2 = *(const int*)(Y8 + (size_t)sl2 * D + k), a3 = *(const int*)(Y8 + (size_t)sl3 * D + k);
                const auto l0 = __builtin_amdgcn_cvt_pk_f32_fp8(a0, false), h0 = __builtin_amdgcn_cvt_pk_f32_fp8(a0, true), l1 = __builtin_amdgcn_cvt_pk_f32_fp8(a1, false), h1 = __builtin_amdgcn_cvt_pk_f32_fp8(a1, true);
                const auto l2 = __builtin_amdgcn_cvt_pk_f32_fp8(a2, false), h2 = __builtin_amdgcn_cvt_pk_f32_fp8(a2, true), l3 = __builtin_amdgcn_cvt_pk_f32_fp8(a3, false), h3 = __builtin_amdgcn_cvt_pk_f32_fp8(a3, true);
                m[0] = q0 * l0[0] + q1 * l1[0] + q2 * l2[0] + q3 * l3[0]; m[1] = q0 * l0[1] + q1 * l1[1] + q2 * l2[1] + q3 * l3[1];
                m[2] = q0 * h0[0] + q1 * h1[0] + q2 * h2[0] + q3 * h3[0]; m[3] = q0 * h0[1] + q1 * h1[1] + q2 * h2[1] + q3 * h3[1];
            } else {
            const u32x2 a0 = *(const u32x2*)(Y + (size_t)sl0 * D + k), a1 = *(const u32x2*)(Y + (size_t)sl1 * D + k), a2 = *(const u32x2*)(Y + (size_t)sl2 * D + k), a3 = *(const u32x2*)(Y + (size_t)sl3 * D + k);
            m[0] = q0 * __uint_as_float(a0.x << 16) + q1 * __uint_as_float(a1.x << 16) + q2 * __uint_as_float(a2.x << 16) + q3 * __uint_as_float(a3.x << 16);
            m[1] = q0 * __uint_as_float(a0.x & 0xffff0000u) + q1 * __uint_as_float(a1.x & 0xffff0000u) + q2 * __uint_as_float(a2.x & 0xffff0000u) + q3 * __uint_as_float(a3.x & 0xffff0000u);
            m[2] = q0 * __uint_as_float(a0.y << 16) + q1 * __uint_as_float(a1.y << 16) + q2 * __uint_as_float(a2.y << 16) + q3 * __uint_as_float(a3.y << 16);
            m[3] = q0 * __uint_as_float(a0.y & 0xffff0000u) + q1 * __uint_as_float(a1.y & 0xffff0000u) + q2 * __uint_as_float(a2.y & 0xffff0000u) + q3 * __uint_as_float(a3.y & 0xffff0000u);
            }
            { const u32x2 xw = *(const u32x2*)(X1 + (size_t)row * D + k); f32x4 xv; xv[0] = __uint_as_float(xw.x << 16); xv[1] = __uint_as_float(xw.x & 0xffff0000u); xv[2] = __uint_as_float(xw.y << 16); xv[3] = __uint_as_float(xw.y & 0xffff0000u);
              v[j] = xv + *(const f32x4*)(g2 + k) * m; }
            ss += (v[j][0] * v[j][0] + v[j][1] * v[j][1]) + (v[j][2] * v[j][2] + v[j][3] * v[j][3]); }
#pragma unroll
        for (int o = 32; o >= 1; o >>= 1) ss += __shfl_xor(ss, o);
        const float rstd = 1.0f / sqrtf(ss * (1.f / D) + EPS);
#pragma unroll
        for (int j = 0; j < 8; ++j) { const int k = (j * 64 + lane) * 4; *(f32x4*)(outp + (size_t)row * D + k) = v[j] * rstd * *(const f32x4*)(gfin + k); }
    }
}
__device__ __forceinline__ void phase_final(const P& p, LAS unsigned char* lds, int G, int bid) { phase_final_r(WSP(bf16_t, WS_Y), WSP(bf16_t, WS_X1), WSP(float, WS_MOD), WSP(int, WS_TOPE), WSP(int, WS_TPOS), WSP(float, WS_TOPW), p.g_final, p.out, lds, G, bid); }

namespace at {
constexpr int VSTR = 144, VT = 128 * VSTR;
constexpr int LDS_AL = 90112, LDS_FLAG = LDS_AL + 1024;
constexpr float LOG2E = 1.4426950408889634f;
__device__ __forceinline__ bf16x8 packf(const f32x16& x, int s) { u32x4 w; w.x = pk2(x[8 * s], x[8 * s + 1]); w.y = pk2(x[8 * s + 2], x[8 * s + 3]); w.z = pk2(x[8 * s + 4], x[8 * s + 5]); w.w = pk2(x[8 * s + 6], x[8 * s + 7]); return __builtin_bit_cast(bf16x8, w); }
#define AT_MFMA(a, b, c) __builtin_amdgcn_mfma_f32_32x32x16_bf16((a), (b), (c), 0, 0, 0)

template <bool MLA>
__device__ __forceinline__ void attn_unit(const P& p, LAS unsigned char* lds, const int b, const int h, const int qb) {
    constexpr int DK = MLA ? 192 : 128, KSTR = MLA ? 400 : 272, KT = 64 * KSTR, BUF = KT + VT, NQF = DK / 16, NKR = MLA ? 3 : 2;
    static_assert(2 * (64 * 400 + VT) <= LDS_AL, "attention LDS map");
    const int tid = threadIdx.x, wid = __builtin_amdgcn_readfirstlane(tid >> 6), lane = tid & 63, r32 = lane & 31, hi = lane >> 5;
    const int q0 = qb * 256, qw = q0 + 32 * wid, qi = qw + r32, nt = (q0 + 256) / 64;
    const bf16_t* Kn = MLA ? WSP(bf16_t, WS_KNOPE) : WSP(bf16_t, WS_SBK);
    const bf16_t* Kr = WSP(bf16_t, WS_KROPE);
    const bf16_t* Vt = WSP(bf16_t, MLA ? WS_VMT : WS_SBVT) + (size_t)(b * 8 + h) * 128 * SEQ;
    LAS float* al = (LAS float*)(lds + LDS_AL) + wid * 32;
    LAS int* flag = (LAS int*)(lds + LDS_FLAG);
    bf16x8 qf[NQF];
    { const char* qb_ = MLA ? (const char*)WSP(bf16_t, WS_QMLA) + ((size_t)(b * SEQ + qw) * 1536 + h * 192) * 2 : (const char*)WSP(bf16_t, WS_SBQ) + ((size_t)(b * SEQ + qw) * 1024 + h * 128) * 2;
      const unsigned qo = (unsigned)((r32 * (MLA ? 1536 : 1024) + 8 * hi) * 2);
#pragma unroll
      for (int s = 0; s < NQF; ++s) qf[s] = *(const bf16x8*)(qb_ + qo + 32 * s); }
    bf16x8 tri0, tri1, ones;
#pragma unroll
    for (int j = 0; j < 8; ++j) { const int k0_ = 8 * (j >> 2) + 4 * hi + (j & 3); tri0[j] = (k0_ > r32) ? (short)0x3F80 : (short)0; tri1[j] = (16 + k0_ > r32) ? (short)0x3F80 : (short)0; ones[j] = (short)0x3F80; }
    u32x4 kreg[NKR], vreg[2];
    const unsigned kofs0 = (unsigned)(((tid >> 4) * 1024 + (tid & 15) * 8) * 2), kofs1 = kofs0 + 32u * 1024u * 2u;
    const unsigned rofs = (unsigned)(((tid >> 3) * 64 + (tid & 7) * 8) * 2);
    const unsigned vofs0 = (unsigned)(((tid >> 3) * SEQ + (tid & 7) * 8) * 2), vofs1 = vofs0 + 64u * SEQ * 2u;
    const unsigned kw0 = (unsigned)((tid >> 4) * KSTR + (tid & 15) * 16), kw1 = kw0 + 32u * KSTR, rw = (unsigned)((tid >> 3) * KSTR + 256 + (tid & 7) * 16);
    const unsigned vw0 = (unsigned)(KT + (tid >> 3) * VSTR + (16 * ((tid & 7) >> 1) + 4 * (tid & 1)) * 2), vw1 = vw0 + 64u * VSTR;
    const char* Knb = (const char*)Kn + ((size_t)b * SEQ * 1024 + h * 128) * 2; const char* Krb = (const char*)Kr + (size_t)b * SEQ * 64 * 2; const char* Vtb = (const char*)Vt;
#define AT_LOAD(tile) do { const int k0_ = (tile) * 64; const char* kp_ = Knb + (size_t)k0_ * 2048; const char* vp_ = Vtb + (size_t)k0_ * 2; \
        kreg[0] = *(const u32x4*)(kp_ + kofs0); kreg[1] = *(const u32x4*)(kp_ + kofs1); if (MLA) kreg[NKR - 1] = *(const u32x4*)(Krb + (size_t)k0_ * 128 + rofs); \
        vreg[0] = *(const u32x4*)(vp_ + vofs0); vreg[1] = *(const u32x4*)(vp_ + vofs1); } while (0)
#define AT_WRITE(buf) do { LAS unsigned char* kb_ = lds + (buf) * BUF; \
        *(LAS u32x4*)(kb_ + kw0) = kreg[0]; *(LAS u32x4*)(kb_ + kw1) = kreg[1]; if (MLA) *(LAS u32x4*)(kb_ + rw) = kreg[NKR - 1]; \
        { u32x2 lo_, hi_; lo_.x = vreg[0].x; lo_.y = vreg[0].y; hi_.x = vreg[0].z; hi_.y = vreg[0].w; *(LAS u32x2*)(kb_ + vw0) = lo_; *(LAS u32x2*)(kb_ + vw0 + 16) = hi_; } \
        { u32x2 lo_, hi_; lo_.x = vreg[1].x; lo_.y = vreg[1].y; hi_.x = vreg[1].z; hi_.y = vreg[1].w; *(LAS u32x2*)(kb_ + vw1) = lo_; *(LAS u32x2*)(kb_ + vw1 + 16) = hi_; } } while (0)
    f32x16 o[4];
#pragma unroll
    for (int d0 = 0; d0 < 4; ++d0)
#pragma unroll
        for (int r = 0; r < 16; ++r) o[d0][r] = 0.f;
    float m_run = -1e30f, l_run = 0.f, R2 = 0.f;
    if (!MLA && tid < 8) flag[tid] = 0;
    AT_LOAD(MLA ? 0 : nt - 1);
    AT_WRITE(0);
    __syncthreads();
    for (int it = 0; it < nt; ++it) {
        const int tile = MLA ? it : nt - 1 - it, cb = it & 1, k0 = tile * 64;
        const bool more = it + 1 < nt;
        if (more) AT_LOAD(MLA ? tile + 1 : tile - 1);
        const bool active = MLA ? (k0 <= qw + 31) : (k0 < qw + 31 && !__all(R2 < -160.f));
        if (active) {
            const LAS unsigned char* kb = lds + cb * BUF;
            f32x16 p0, p1;
#pragma unroll
            for (int r = 0; r < 16; ++r) { p0[r] = 0.f; p1[r] = 0.f; }
#pragma unroll
            for (int s = 0; s < NQF; ++s) { const bf16x8 a0 = *(const LAS bf16x8*)(kb + r32 * KSTR + s * 32 + hi * 16), a1 = *(const LAS bf16x8*)(kb + (32 + r32) * KSTR + s * 32 + hi * 16);
                p0 = AT_MFMA(a0, qf[s], p0); p1 = AT_MFMA(a1, qf[s], p1); if ((s & 3) == 3) __builtin_amdgcn_sched_barrier(0); }
            const int dq = qi - k0 - 4 * hi;
            bf16x8 pf0, pf1, pf2, pf3;
            if (MLA) {
                float pm = -3.0e38f;
                if (k0 + 63 > qw) {
#pragma unroll
                    for (int r = 0; r < 16; ++r) { const int c = (r & 3) + 8 * (r >> 2);
                        if (c > dq) p0[r] = -__builtin_inff(); if (c + 32 > dq) p1[r] = -__builtin_inff(); }
                }
#pragma unroll
                for (int r = 0; r < 16; ++r) pm = fmaxf(pm, fmaxf(p0[r], p1[r]));
                pm = fmaxf(pm, __shfl_xor(pm, 32));
                const float mn = fmaxf(m_run, pm), alpha = __builtin_amdgcn_exp2f(m_run - mn); m_run = mn;
                float ps = 0.f;
#pragma unroll
                for (int r = 0; r < 16; ++r) { p0[r] = __builtin_amdgcn_exp2f(p0[r] - mn); p1[r] = __builtin_amdgcn_exp2f(p1[r] - mn); ps += p0[r] + p1[r]; }
                ps += __shfl_xor(ps, 32);
                l_run = l_run * alpha + ps;
                if (__any(alpha < 1.f)) { if (hi == 0) al[r32] = alpha; asm volatile("s_waitcnt lgkmcnt(0)" ::: "memory");
#pragma unroll
                    for (int r = 0; r < 16; ++r) { const float a = al[(r & 3) + 8 * (r >> 2) + 4 * hi];
#pragma unroll
                        for (int d0 = 0; d0 < 4; ++d0) o[d0][r] *= a; } }
                pf0 = packf(p0, 0); pf1 = packf(p0, 1); pf2 = packf(p1, 0); pf3 = packf(p1, 1);
            } else {
                if (k0 + 63 >= qw) {
#pragma unroll
                    for (int r = 0; r < 16; ++r) { const int c = (r & 3) + 8 * (r >> 2); if (c >= dq) p0[r] = -__builtin_inff(); if (c + 32 >= dq) p1[r] = -__builtin_inff(); } }
                float lsum = 0.f; bf16x8 lf[4];
#pragma unroll
                for (int g = 0; g < 4; ++g) {
                    float Lv[8];
#pragma unroll
                    for (int j = 0; j < 8; ++j) { const int r = 8 * (g & 1) + j;
                        const float z = (g < 2 ? p0[r] : p1[r]);
                        const float t = __builtin_amdgcn_logf(1.f + __builtin_amdgcn_exp2f(-fabsf(z)));
                        const float L = -(fmaxf(z, 0.f) + t);
                        const float ls = fminf(z, 0.f) - t;
                        if (g < 2) p0[r] = ls; else p1[r] = ls;
                        Lv[j] = L; lsum += L; }
                    u32x4 w; w.x = pk2(Lv[0], Lv[1]); w.y = pk2(Lv[2], Lv[3]); w.z = pk2(Lv[4], Lv[5]); w.w = pk2(Lv[6], Lv[7]); lf[g] = __builtin_bit_cast(bf16x8, w);
                }
                p0 = AT_MFMA(tri0, lf[0], p0); p0 = AT_MFMA(tri1, lf[1], p0); p0 = AT_MFMA(ones, lf[2], p0); p0 = AT_MFMA(ones, lf[3], p0);
                p1 = AT_MFMA(tri0, lf[2], p1); p1 = AT_MFMA(tri1, lf[3], p1);
#pragma unroll
                for (int r = 0; r < 16; ++r) { p0[r] = __builtin_amdgcn_exp2f(p0[r] + R2); p1[r] = __builtin_amdgcn_exp2f(p1[r] + R2); }
                lsum += __shfl_xor(lsum, 32);
                R2 += lsum;
                pf0 = packf(p0, 0); pf1 = packf(p0, 1); pf2 = packf(p1, 0); pf3 = packf(p1, 1);
            }
            const LAS unsigned char* vb = kb + KT;
#pragma unroll
            for (int d0 = 0; d0 < 4; ++d0) { const LAS unsigned char* vr = vb + (32 * d0 + r32) * VSTR + hi * 16;
                o[d0] = AT_MFMA(pf0, *(const LAS bf16x8*)(vr), o[d0]); o[d0] = AT_MFMA(pf1, *(const LAS bf16x8*)(vr + 32), o[d0]);
                o[d0] = AT_MFMA(pf2, *(const LAS bf16x8*)(vr + 64), o[d0]); o[d0] = AT_MFMA(pf3, *(const LAS bf16x8*)(vr + 96), o[d0]); __builtin_amdgcn_sched_barrier(0); }
        }
        if (more) AT_WRITE(cb ^ 1);
        if (!MLA) { const bool dn = __all(R2 < -160.f); if (lane == 0) flag[wid] = dn ? 1 : 0; }
        __syncthreads();
        if (!MLA) { int all = 1;
#pragma unroll
            for (int w8 = 0; w8 < 8; ++w8) all &= flag[w8];
            if (all) break; }
    }
    if (!MLA) __syncthreads();
    if (MLA) { if (hi == 0) al[r32] = 1.0f / l_run; asm volatile("s_waitcnt lgkmcnt(0)" ::: "memory"); }
    char* Ob = (char*)(WSP(bf16_t, WS_MIXED) + (size_t)(b * SEQ + qw) * 2048 + (MLA ? 1024 : 0) + h * 128);
    const bool odd = (r32 & 1) != 0;
    const unsigned oo = (unsigned)((4 * hi * 2048 + r32) * 2) + (odd ? 4094u : 0u);
#pragma unroll
    for (int q = 0; q < 8; ++q) { const int ra = 2 * q, c = (ra & 3) + 8 * (ra >> 2); const float iva = MLA ? al[c + 4 * hi] : 1.f, ivb = MLA ? al[c + 1 + 4 * hi] : 1.f;
#pragma unroll
        for (int d0 = 0; d0 < 4; ++d0) { const float A = o[d0][ra] * iva, Bv = o[d0][ra + 1] * ivb;
            const float snd = odd ? A : Bv;
            const float rcv = __int_as_float(__builtin_amdgcn_update_dpp(0, __float_as_int(snd), 0xB1, 0xF, 0xF, true));
            const unsigned w = odd ? pk2(rcv, Bv) : pk2(A, rcv);
            *(unsigned*)(Ob + oo + (unsigned)((c * 2048 + d0 * 32) * 2)) = w; } }
    __syncthreads();
#undef AT_LOAD
#undef AT_WRITE
}
__device__ __forceinline__ void conv_queue(const P& p, LAS unsigned char* lds, int* ctr, int max_tiles) {
    constexpr int NM1 = NE * 16 * 16, NM2 = NE * 16 * 8, NMT = NM1 + NM2;
    LAS int* qs = (LAS int*)(lds + LDS_FLAG + 96); LAS unsigned char* Tb = lds + 16384;
    const int tid = threadIdx.x, kq = tid >> 6, nc = tid & 63;
    int pulled = 0;
#define CQ_CAN (max_tiles < 0 || pulled < max_tiles)
#define CQ_PULL(dst) do { __syncthreads(); if (tid == 0) qs[0] = CQ_CAN ? atomicAdd(ctr, 1) : NMT; __syncthreads(); dst = qs[0]; ++pulled; } while (0)
    int t_cur, t_nxt;
    CQ_PULL(t_cur); if (t_cur >= NMT) { __syncthreads(); return; }
    CQ_PULL(t_nxt);
    f32x4 a[4][4];
#define CQ_SRC(t, src, ldw) const float* src; int ldw; { const bool w1_ = (t) < NM1; const int t2_ = w1_ ? (t) : (t) - NM1, e_ = w1_ ? t2_ >> 8 : t2_ >> 7, r_ = w1_ ? t2_ & 255 : t2_ & 127; \
        ldw = w1_ ? 4096 : 2048; const int k0_ = (w1_ ? r_ >> 4 : r_ >> 3) * 128, n0_ = (w1_ ? r_ & 15 : r_ & 7) * 256; \
        src = (w1_ ? p.w1 + (size_t)e_ * 2048 * 4096 : p.w2 + (size_t)e_ * 2048 * 2048) + (size_t)(k0_ + 4 * kq) * ldw + n0_ + 4 * nc; }
#define CQ_LOAD(buf, slab, src, ldw) do { _Pragma("unroll") for (int r_ = 0; r_ < 4; ++r_) a[buf][r_] = __builtin_nontemporal_load((const f32x4*)(src + (size_t)((slab) * 32 + r_) * ldw)); } while (0)
#define CQ_PUT(buf, slab) do { if (cur_w1) { _Pragma("unroll") for (int j_ = 0; j_ < 4; ++j_) { u32x2 d_; d_.x = pk2(a[buf][0][j_], a[buf][1][j_]); d_.y = pk2(a[buf][2][j_], a[buf][3][j_]); \
            *(LAS u32x2*)(Tb + (4 * nc + j_) * 264 + ((slab) * 32 + 4 * kq) * 2) = d_; } } \
        else { _Pragma("unroll") for (int j_ = 0; j_ < 4; ++j_) *(LAS unsigned*)(Tb + (4 * nc + j_) * 132 + ((slab) * 32 + 4 * kq)) = pk4_fp8(a[buf][0][j_] * W8_SCALE, a[buf][1][j_] * W8_SCALE, a[buf][2][j_] * W8_SCALE, a[buf][3][j_] * W8_SCALE); } } while (0)
    { CQ_SRC(t_cur, s0, l0); CQ_LOAD(0, 0, s0, l0); CQ_LOAD(1, 1, s0, l0); CQ_LOAD(2, 2, s0, l0); CQ_LOAD(3, 3, s0, l0); }
    for (int it = 0;; ++it) {
        const bool more = t_nxt < NMT, cur_w1 = t_cur < NM1;
        if (tid == 0) qs[1 + (it & 1)] = (more && CQ_CAN) ? atomicAdd(ctr, 1) : NMT;
        ++pulled;
        CQ_PUT(0, 0); CQ_PUT(1, 1);
        CQ_SRC(t_nxt < NMT ? t_nxt : 0, s1, l1);
        if (more) { CQ_LOAD(0, 0, s1, l1); CQ_LOAD(1, 1, s1, l1); }
        CQ_PUT(2, 2); CQ_PUT(3, 3);
        __syncthreads();
        { const int t2_ = cur_w1 ? t_cur : t_cur - NM1, e_ = cur_w1 ? t2_ >> 8 : t2_ >> 7, r_ = cur_w1 ? t2_ & 255 : t2_ & 127;
          const int k0 = (cur_w1 ? r_ >> 4 : r_ >> 3) * 128, n0 = (cur_w1 ? r_ & 15 : r_ & 7) * 256;
          if (cur_w1) {
              unsigned char* Bt = p.ws + WS_W1_T + (size_t)e_ * 4096 * 2048;
#pragma unroll 1
              for (int ps = 0; ps < 2; ++ps) { const int id = tid + 512 * ps, n = id >> 2, q = id & 3; const LAS u32x2* tp_ = (const LAS u32x2*)(Tb + n * 264 + q * 64);
                  u32x16 wv;
#pragma unroll
                  for (int i = 0; i < 8; ++i) { const u32x2 w = tp_[i]; wv[2 * i] = w.x; wv[2 * i + 1] = w.y; }
                  u32x4 lo, hi; fp6_block_bf16(wv, lo, hi);
                  unsigned char* dst = Bt + (size_t)DmW1{}(n0 + n) * 2048 + k0 + 16 * q;
                  __builtin_nontemporal_store(lo, (u32x4*)dst); __builtin_nontemporal_store(hi, (u32x4*)(dst + 64)); }
          } else {
              unsigned char* Bt = p.ws + WS_W2_T + (size_t)e_ * 2048 * 2048;
#pragma unroll
              for (int ps = 0; ps < 4; ++ps) { const int n = ps * 64 + (tid >> 3), c = tid & 7; const LAS unsigned* tp_ = (const LAS unsigned*)(Tb + n * 132 + 16 * c);
                  u32x4 w; w.x = tp_[0]; w.y = tp_[1]; w.z = tp_[2]; w.w = tp_[3];
                  __builtin_nontemporal_store(w, (u32x4*)(Bt + (size_t)(n0 + n) * 2048 + k0 + 16 * c)); }
          } }
        __syncthreads();
        if (!more) break;
        CQ_LOAD(2, 2, s1, l1); CQ_LOAD(3, 3, s1, l1);
        t_cur = t_nxt; t_nxt = qs[1 + (it & 1)];
    }
#undef CQ_PULL
#undef CQ_CAN
#undef CQ_SRC
#undef CQ_LOAD
#undef CQ_PUT
    __syncthreads();
}
__device__ __forceinline__ void attn_queues(const P& p, LAS unsigned char* lds, int* ctr, const int xg) {
    LAS int* qs = (LAS int*)(lds + LDS_FLAG + 64);
    const int tid = threadIdx.x, nq = xg >= 0 ? 4 * 16 : NB * 8 * 16;
    int* c0 = ctr + (xg >= 0 ? xg : 0); int* c1 = ctr + 64 + (xg >= 0 ? xg : 0);
    {   if (tid == 0) qs[0] = atomicAdd(c0, 1);
        __syncthreads();
        int v = qs[0];
        while (v < nq) {
            __syncthreads();
            if (tid == 0) qs[0] = atomicAdd(c0, 1);
            const int bh = xg >= 0 ? xg * 4 + 2 * (v >> 5) + (v & 1) : (v & 31), qb = 15 - (xg >= 0 ? ((v & 31) >> 1) : (v >> 5));
            attn_unit<true>(p, lds, bh >> 3, bh & 7, qb);
            v = qs[0];
        }
        __syncthreads();
    }
    {   if (tid == 0) qs[0] = atomicAdd(c1, 1);
        __syncthreads();
        int v = qs[0];
        while (v < nq) {
            __syncthreads();
            if (tid == 0) qs[0] = atomicAdd(c1, 1);
            const int bh = xg >= 0 ? xg * 4 + 2 * (v >> 5) + (v & 1) : (v & 31), qb = 15 - (xg >= 0 ? ((v & 31) >> 1) : (v >> 5));
            attn_unit<false>(p, lds, bh >> 3, bh & 7, qb);
            v = qs[0];
        }
        __syncthreads();
    }
}
__device__ __forceinline__ void phase_attn(const P& p, LAS unsigned char* lds, int G, int bid) {
    int* ctr = (int*)(p.ws + WS_CTL + 61440); const int xg = (G == 256) ? (bid & 7) : -1;
    if (MOE_FP8 && ((bid >> 3) & 7) < 3) { conv_queue(p, lds, ctr + 128, -1); attn_queues(p, lds, ctr, xg); }
    else { attn_queues(p, lds, ctr, xg); if (MOE_FP8) conv_queue(p, lds, ctr + 128, -1); }
}
}

__device__ __forceinline__ void phase_normmod(const P& p, const float* x, const float* g, int shift_idx, int scale_idx, bf16_t* out, int G, int bid) { phase_normmod_r(WSP(float, WS_MOD), x, g, shift_idx, scale_idx, out, G, bid); }
template <class Sched>
__device__ __forceinline__ void moe_tables(const P& p, LAS unsigned char* lds, int G, int bid, bool gather, const float* bias, int bias_ld) {
    LAS int* tp = (LAS int*)(lds + LDS_TP); LAS int* cn = (LAS int*)(lds + LDS_CNT); LAS unsigned short* gidx = (LAS unsigned short*)(lds + LDS_GIDX); LAS float* bl = (LAS float*)(lds + LDS_BIAS);
    const int tid = threadIdx.x;
    if (tid < 32) cn[tid] = WSP(int, WS_CNT)[tid];
    __syncthreads();
    if (tid == 0) { int s = 0; for (int e = 0; e < 32; ++e) { tp[e] = s; s += (cn[e] + 255) >> 8; } tp[32] = s; tp[63] = 0; }
    __syncthreads();
    if (tid < 20) { Sched S; S.init(tp, G, bid); pg::Unit u; tp[40 + tid] = S.next(tid, u) ? u.e : 0; }
    __syncthreads();
    if (tid == 0) tp[63] = 1;
    __syncthreads();
    if (bias) {
        Sched S; S.init(tp, G, bid);
        const int t = tid & 255, i0 = tid >> 8;
        float bv[9]; int rv[9]; bool ok[9];
#pragma unroll
        for (int j = 0; j < 9; ++j) { pg::Unit u; u.e = 0; u.pn = 0; u.pm = 0; ok[j] = S.next(i0 + 2 * j, u);
            const size_t bo = ok[j] ? (size_t)u.e * bias_ld + u.pn * 256 + t : 0;
            bv[j] = bias[bo];
            rv[j] = 0;
            if (gather) { const int e_ = ok[j] ? u.e : 0, r = ok[j] ? (u.pm - tp[e_]) * 256 + t : 0; const bool gk = ok[j] && r < cn[e_];
                const int v = WSP(int, WS_ROWTOK)[gk ? (size_t)e_ * NTOK + r : 0]; rv[j] = gk ? (v >> 2) : 0; } }
#pragma unroll
        for (int j = 0; j < 9; ++j) if (ok[j]) { const int i = i0 + 2 * j; bl[i * 256 + t] = bv[j]; if (gather) gidx[i * 256 + t] = (unsigned short)rv[j]; }
        __syncthreads();
    }
}

__global__ void __launch_bounds__(512, 2) mega(P p, int lo, int hi, int bar_idx) {
    extern __shared__ __attribute__((aligned(16))) unsigned char lds_raw[];
    LAS unsigned char* lds = (LAS unsigned char*)lds_raw;
    const int tid = threadIdx.x, G = gridDim.x, bid = blockIdx.x;
    if (tid < 4) ((LAS unsigned*)(lds + LDS_MISC))[tid] = 0u;
    __syncthreads();
    XcdBarrier bar = xcd_barrier_post((unsigned*)(p.ws + WS_CTL) + bar_idx * XCD_BAR_WORDS, (volatile LAS unsigned*)(lds + LDS_MISC));
#define IN(k) (lo <= (k) && (k) < hi)
#define RUN(k, ...) do { __VA_ARGS__; } while (0)
#define SEAM(k) do { if (IN(k) && IN((k) + 1)) xcd_barrier(bar); } while (0)
    if (IN(0)) RUN(0, phase_prologue(p, lds, G, bid));
    SEAM(0);
    if (IN(1)) RUN(1, { phase_cb(p, lds, bid); phase_normmod(p, p.x, p.g_attn, 0, 1, WSP(bf16_t, WS_H), G, bid); });
    SEAM(1);
    if (IN(2)) RUN(2, {
        const bool ch = (G == 256);
        pg::DenseOrder S1; S1.init(64, 12, G, bid, 8, 4); pg::EpiProjMain E1{p};
        pg::DenseOrder S2; S2.init(4, 64, G, bid); pg::EpiVt<false> E2{p, WS_SBVT};
        pg::KropeOrder S3{G, bid}; pg::EpiKropeP E3{p};
        const bf16_t* A2 = WSP(bf16_t, WS_WIN_T) + (size_t)2048 * 2048;
        const char* b2n = nullptr; unsigned q00 = 0, q01 = 0, q10 = 0, q11 = 0; const char* b3n = nullptr; unsigned k00 = 0, k01 = 0, k10 = 0, k11 = 0;
        if (ch) { pg::first_unit_of(S2, WSP(bf16_t, WS_H), 4096, b2n, q00, q01, q10, q11); pg::first_unit_of(S3, WSP(bf16_t, WS_WIN_T), 4096, b3n, k00, k01, k10, k11); }
        pg::gemm_phase<0>(lds, WSP(bf16_t, WS_H), WSP(bf16_t, WS_WIN_T), 4096, S1, E1, nullptr, 0, false, ch, A2, b2n, q00, q01, q10, q11);
        pg::gemm_phase<0>(lds, A2, WSP(bf16_t, WS_H), 4096, S2, E2, nullptr, 0, ch, ch, WSP(bf16_t, WS_H), b3n, k00, k01, k10, k11);
        pg::gemm_phase<0>(lds, WSP(bf16_t, WS_H), WSP(bf16_t, WS_WIN_T), 4096, S3, E3, nullptr, 8, ch, false);
    });
    SEAM(2);
    if (IN(3)) RUN(3, {
        krope_fixup(WSP(float, WS_G_QRAW), WSP(float2, WS_CS), WSP(bf16_t, WS_KROPE), G, bid);
        const bool ch = (G == 256);
        pg::DenseOrder S1; S1.init(64, 6, G, bid); pg::EpiQ E1{p};
        pg::DenseOrder S2; S2.init(64, 4, G, bid); pg::EpiKnope E2{p};
        pg::DenseOrder S3; S3.init(4, 64, G, bid); pg::EpiVt<true> E3{p, WS_VMT};
        const bf16_t* A3 = WSP(bf16_t, WS_WKV_T) + (size_t)1024 * 512;
        const char* b2n = nullptr; unsigned q00 = 0, q01 = 0, q10 = 0, q11 = 0; const char* b3n = nullptr; unsigned k00 = 0, k01 = 0, k10 = 0, k11 = 0;
        if (ch) { pg::first_unit_of(S2, WSP(bf16_t, WS_WKV_T), 1024, b2n, q00, q01, q10, q11); pg::first_unit_of(S3, WSP(bf16_t, WS_KVLAT), 1024, b3n, k00, k01, k10, k11); }
        pg::gemm_phase<0>(lds, WSP(bf16_t, WS_QLAT), WSP(bf16_t, WS_WQ_T), 1024, S1, E1, nullptr, 0, false, ch, WSP(bf16_t, WS_KVLAT), b2n, q00, q01, q10, q11);
        pg::gemm_phase<0>(lds, WSP(bf16_t, WS_KVLAT), WSP(bf16_t, WS_WKV_T), 1024, S2, E2, nullptr, 0, ch, ch, A3, b3n, k00, k01, k10, k11);
        pg::gemm_phase<0>(lds, A3, WSP(bf16_t, WS_KVLAT), 1024, S3, E3, nullptr, 0, ch, false);
        if (MOE_FP8 && G == 256 && bid >= 128) at::conv_queue(p, lds, (int*)(p.ws + WS_CTL + 61440) + 128, 3);
    });
    SEAM(3);
    if (IN(4)) RUN(4, at::phase_attn(p, lds, G, bid));
    SEAM(4);
    if (IN(5)) RUN(5, { pg::DenseOrder S; S.init(64, 8, G, bid); pg::EpiOut E{p};
        pg::gemm_phase<0>(lds, WSP(bf16_t, WS_MIXED), WSP(bf16_t, WS_WOUT_T), 4096, S, E, nullptr); });
    SEAM(5);
    if (IN(6)) phase_route(p, lds, G, bid);
    SEAM(6);
    if (IN(7)) RUN(7, { typedef pg::MoeOrder<16, true> SO; moe_tables<SO>(p, lds, G, bid, true, p.b1, 4096);
        SO S; S.init((const LAS int*)(lds + LDS_TP), G, bid); pg::EpiMoe1 E{p, WS_ACT, (const LAS float*)(lds + LDS_BIAS)};
        pg::gemm_phase<MOE1_FP6 ? 2 : 1>(lds, p.ws + WS_H2, p.ws + WS_W1_T, 2048, S, E, (const LAS int*)(lds + LDS_GIDX)); });
    SEAM(7);
    if (IN(8)) RUN(8, { typedef pg::MoeOrder<8, false> SO; moe_tables<SO>(p, lds, G, bid, false, p.b2, 2048);
        SO S; S.init((const LAS int*)(lds + LDS_TP), G, bid); pg::EpiMoe2 E{p, (const LAS float*)(lds + LDS_BIAS)};
        pg::gemm_phase<1>(lds, p.ws + WS_ACT, p.ws + WS_W2_T, 2048, S, E, nullptr); });
    SEAM(8);
    if (IN(9)) RUN(9, { moe_tables<pg::MoeOrder<8, false> >(p, lds, G, bid, false, nullptr, 0); phase_final(p, lds, G, bid); });
#undef IN
#undef SEAM
}

extern "C" void kernel_launch(void* const* d_in, const int* in_sizes, int n_in, void* d_out, int out_size, void* d_ws, size_t ws_size, hipStream_t stream) {
    if (n_in != 20 || out_size != NTOK * D || ws_size < WS_END2) { fprintf(stderr, "kernel_launch: unexpected shapes (n_in %d out %d ws %zu need %zu)\n", n_in, out_size, ws_size, (size_t)WS_END2); return; }
    P p{};
    p.x = (const float*)d_in[0]; p.c = (const float*)d_in[1]; p.pos = (const int*)d_in[2]; p.g_attn = (const float*)d_in[3]; p.w_mod = (const float*)d_in[4]; p.b_mod = (const float*)d_in[5];
    p.w_in = (const float*)d_in[6]; p.g_q = (const float*)d_in[7]; p.w_q_up = (const float*)d_in[8]; p.g_kv = (const float*)d_in[9]; p.w_kv_up = (const float*)d_in[10]; p.w_out = (const float*)d_in[11];
    p.g_ffn = (const float*)d_in[12]; p.w_router = (const float*)d_in[13]; p.b_router = (const float*)d_in[14]; p.w1 = (const float*)d_in[15]; p.b1 = (const float*)d_in[16]; p.w2 = (const float*)d_in[17];
    p.b2 = (const float*)d_in[18]; p.g_final = (const float*)d_in[19]; p.out = (float*)d_out; p.ws = (unsigned char*)d_ws;
    static int grid = 0;
    if (grid == 0) {
        int dev = 0, cus = 0, per_cu = 0;
        if (hipGetDevice(&dev) != hipSuccess || hipDeviceGetAttribute(&cus, hipDeviceAttributeMultiprocessorCount, dev) != hipSuccess || cus <= 0) cus = 256;
        if (hipFuncSetAttribute((const void*)mega, hipFuncAttributeMaxDynamicSharedMemorySize, LDS_BYTES) != hipSuccess) fprintf(stderr, "kernel_launch: hipFuncSetAttribute failed\n");
        if (hipOccupancyMaxActiveBlocksPerMultiprocessor(&per_cu, (const void*)mega, 512, LDS_BYTES) != hipSuccess || per_cu < 1) fprintf(stderr, "kernel_launch: occupancy query says %d\n", per_cu);
        (void)hipGetLastError();
        grid = cus;
    }
    (void)hipMemsetAsync((char*)d_ws + WS_CTL, 0, 65536, stream);
    mega<<<grid, 512, LDS_BYTES, stream>>>(p, 0, 10, 0);
}
```

```cpp
#include <hip/hip_runtime.h>
#include <stdint.h>
#include <stdio.h>

constexpr int D = 2048, NB = 4, SEQ = 4096, NTOK = NB * SEQ;
constexpr int SBH = 8, DH = 128, SBW = SBH * DH;
constexpr int MH = 8, NOPE = 128, ROPE = 64, VD = 128, QKD = 192, QR = 512, KVR = 512;
constexpr int INW = 3 * SBW + QR + KVR + ROPE;
constexpr int NE = 32, TOPK = 4, DE = 2048;
constexpr int NMOD = 6;
constexpr float EPS = 1e-6f;
constexpr int MAXSLOT = NTOK * TOPK + NE * 256;

typedef unsigned short bf16_t;
typedef float f32x2_t __attribute__((ext_vector_type(2)));
typedef __bf16 bf16x2_t __attribute__((ext_vector_type(2)));

__device__ __forceinline__ float bf2f(bf16_t v) { return __uint_as_float(((unsigned)v) << 16); }
__device__ __forceinline__ unsigned pk2(float a, float b) { f32x2_t v = {a, b}; bf16x2_t r = __builtin_convertvector(v, bf16x2_t); return __builtin_bit_cast(unsigned, r); }
__device__ __forceinline__ bf16_t f2bf(float a) { return (bf16_t)(pk2(a, 0.f) & 0xffffu); }

constexpr size_t al256(size_t x) { return (x + 255) & ~(size_t)255; }
constexpr size_t WS_CTL   = 0;
constexpr size_t WS_MOD   = 65536;
constexpr size_t WS_CS    = WS_MOD + al256((size_t)NB * NMOD * D * 4);
constexpr size_t WS_H     = WS_CS + (size_t)NTOK * 32 * 8;
constexpr size_t WS_SBQ   = WS_H + (size_t)NTOK * D * 2;
constexpr size_t WS_SBK   = WS_SBQ + (size_t)NTOK * SBW * 2;
constexpr size_t WS_SBVT  = WS_SBK + (size_t)NTOK * SBW * 2;
constexpr size_t WS_QLAT  = WS_SBVT + (size_t)NTOK * SBW * 2;
constexpr size_t WS_KVLAT = WS_QLAT + (size_t)NTOK * QR * 2;
constexpr size_t WS_SSQP  = WS_KVLAT + (size_t)NTOK * KVR * 2;
constexpr size_t WS_KROPE = WS_SSQP + (size_t)NTOK * 16 * 4;
constexpr size_t WS_QMLA  = WS_KROPE + (size_t)NTOK * 64 * 2;
constexpr size_t WS_KNOPE = WS_QMLA + (size_t)NTOK * 1536 * 2;
constexpr size_t WS_VMT   = WS_KNOPE + (size_t)NTOK * 1024 * 2;
constexpr size_t WS_MIXED = WS_VMT + (size_t)NTOK * 1024 * 2;
constexpr size_t WS_X1    = WS_MIXED + (size_t)NTOK * D * 2;
constexpr size_t WS_H2    = WS_X1 + (size_t)NTOK * D * 4;
constexpr size_t WS_TOPE  = WS_H2 + (size_t)NTOK * D * 2;
constexpr size_t WS_TOPW  = WS_TOPE + (size_t)NTOK * 4 * 4;
constexpr size_t WS_TPOS  = WS_TOPW + (size_t)NTOK * 4 * 4;
constexpr size_t WS_CNT   = WS_CTL + 62464;
constexpr size_t WS_ROWTOK= WS_TPOS + (size_t)NTOK * 4 * 4;
constexpr size_t WS_ACT   = WS_ROWTOK + (size_t)NE * NTOK * 4;
constexpr size_t WS_Y     = WS_ACT + (size_t)MAXSLOT * DE * 2;
constexpr size_t WS_GTMP  = WS_Y + (size_t)MAXSLOT * D * 2;
constexpr size_t WS_G_QRAW  = WS_GTMP;
constexpr size_t WS_G_KRRAW = WS_G_QRAW + (size_t)NTOK * 1536 * 4;
constexpr size_t WS_G_SLOTTOK = WS_G_KRRAW + (size_t)NTOK * 64 * 4;
constexpr size_t WS_G_SLOTE   = WS_G_SLOTTOK + (size_t)MAXSLOT * 4;
constexpr size_t WS_END   = WS_G_SLOTE + (size_t)MAXSLOT * 4;

struct P {
    const float *x, *c; const int* pos; const float *g_attn, *w_mod, *b_mod, *w_in, *g_q, *w_q_up, *g_kv, *w_kv_up, *w_out, *g_ffn, *w_router, *b_router, *w1, *b1, *w2, *b2, *g_final;
    float* out; unsigned char* ws;
};
#define WSP(T, off) ((T*)(p.ws + (off)))


#define LAS __attribute__((address_space(3)))
typedef short bf16x8 __attribute__((ext_vector_type(8)));
typedef float f32x4 __attribute__((ext_vector_type(4)));
typedef float f32x16 __attribute__((ext_vector_type(16)));
typedef unsigned u32x4 __attribute__((ext_vector_type(4)));
typedef unsigned u32x2 __attribute__((ext_vector_type(2)));
typedef int i32x8 __attribute__((ext_vector_type(8)));
typedef int i32x4 __attribute__((ext_vector_type(4)));
constexpr bool MOE_FP8 = true;
constexpr float W8_SCALE = 256.f, W8_INV = 1.f / 256.f;
typedef __bf16 bf16x32_t __attribute__((ext_vector_type(32)));
typedef unsigned u32x6 __attribute__((ext_vector_type(6)));
typedef unsigned u32x16 __attribute__((ext_vector_type(16)));
constexpr bool Y_FP8 = true;
constexpr float Y_SCALE = 32.f;
constexpr bool MOE1_FP6 = true;
__device__ __forceinline__ void fp6_block(const float (&v)[32], u32x4& out_lo, u32x4& out_hi) {
    float amax = 0.f;
#pragma unroll
    for (int i = 0; i < 32; ++i) amax = fmaxf(amax, fabsf(v[i]));
    int e = (int)((__float_as_uint(amax) >> 23) & 0xffu) - 127 - 2;
    if (amax * __uint_as_float((unsigned)(127 - e) << 23) > 7.5f) e += 1;
    e = e < -120 ? -120 : e;
    const float inv = __uint_as_float((unsigned)(127 - e) << 23);
    u32x16 w;
#pragma unroll
    for (int i = 0; i < 16; ++i) w[i] = pk2(v[2 * i] * inv, v[2 * i + 1] * inv);
    const u32x6 c = __builtin_amdgcn_cvt_scalef32_pk32_fp6_bf16(__builtin_bit_cast(bf16x32_t, w), 1.0f);
    out_lo.x = c[0]; out_lo.y = c[1]; out_lo.z = c[2]; out_lo.w = c[3];
    out_hi.x = c[4]; out_hi.y = c[5]; out_hi.z = (unsigned)(e + 127); out_hi.w = 0u;
}

__device__ __forceinline__ void fp6_block_bf16(const u32x16& w, u32x4& out_lo, u32x4& out_hi) {
    typedef unsigned short u16x2_t __attribute__((ext_vector_type(2))); u16x2_t mx = {0, 0};
#pragma unroll
    for (int i = 0; i < 16; ++i) mx = __builtin_elementwise_max(mx, __builtin_bit_cast(u16x2_t, w[i] & 0x7fff7fffu));
    const unsigned am = mx[0] > mx[1] ? mx[0] : mx[1];
    int sb = (int)((am + 15u) >> 7) - 2; sb = sb < 7 ? 7 : sb;
    const u32x6 c = __builtin_amdgcn_cvt_scalef32_pk32_fp6_bf16(__builtin_bit_cast(bf16x32_t, w), __uint_as_float((unsigned)sb << 23));
    out_lo.x = c[0]; out_lo.y = c[1]; out_lo.z = c[2]; out_lo.w = c[3];
    out_hi.x = c[4]; out_hi.y = c[5]; out_hi.z = (unsigned)sb; out_hi.w = 0u;
}

__device__ __forceinline__ unsigned pk4_fp8(float a, float b, float c, float d) { int w = 0; w = __builtin_amdgcn_cvt_pk_fp8_f32(a, b, w, false); w = __builtin_amdgcn_cvt_pk_fp8_f32(c, d, w, true); return (unsigned)w; }

__device__ __forceinline__ unsigned pk4_fp8_sc(float a, float b, float c, float d, float scale) {
    typedef short s16x2_t __attribute__((ext_vector_type(2))); s16x2_t o = {0, 0};
    o = __builtin_amdgcn_cvt_scalef32_pk_fp8_f32(o, a, b, scale, false); o = __builtin_amdgcn_cvt_scalef32_pk_fp8_f32(o, c, d, scale, true);
    return __builtin_bit_cast(unsigned, o);
}
constexpr size_t WS_WIN_T  = WS_END;
constexpr size_t WS_WQ_T   = WS_WIN_T + (size_t)4352 * 2048 * 2;
constexpr size_t WS_WKV_T  = WS_WQ_T + (size_t)1536 * 512 * 2;
constexpr size_t WS_WOUT_T = WS_WKV_T + (size_t)2048 * 512 * 2;
constexpr size_t WS_W1_T   = WS_WOUT_T + (size_t)2048 * 2048 * 2;
constexpr size_t WS_W2_T   = WS_W1_T + (size_t)NE * 4096 * 2048 * 2;
constexpr size_t WS_WR_HI  = WS_W2_T + (size_t)NE * 2048 * 2048 * 2;
constexpr size_t WS_WR_LO  = WS_WR_HI + (size_t)32 * 2048 * 2;
constexpr size_t WS_CB     = WS_WR_LO + (size_t)32 * 2048 * 2;
constexpr size_t WS_END2   = WS_CB + 512;

#define XB_TMO      128
#define XB_XCNT(j)  (256  + 64 * (j))
#define XB_XSUB(j)  (1280 + 64 * (j))
#define XB_XGEN(j)  (2304 + 64 * (j))
#define XB_TOP      3328
#define XB_TOPGEN   3392
#define XCD_BAR_WORDS 3456
#define XB_SPIN_CAP (1u << 18)
__device__ __forceinline__ unsigned xb_ld(unsigned* p)              { return __hip_atomic_load(p, __ATOMIC_RELAXED, __HIP_MEMORY_SCOPE_AGENT); }
__device__ __forceinline__ unsigned xb_add(unsigned* p, unsigned v) { return __hip_atomic_fetch_add(p, v, __ATOMIC_RELAXED, __HIP_MEMORY_SCOPE_AGENT); }
__device__ __forceinline__ unsigned xb_xcc_id() { return (unsigned)__builtin_amdgcn_s_getreg((3 << 11) | 20) & 0xFu; }
#define XB_SPIN(cond, bar) do { unsigned _sp = 0; while (cond) { __builtin_amdgcn_s_sleep(1); \
    if ((++_sp & 255u) == 0u) { if (xb_ld(&(bar)[XB_TMO])) break; if (_sp > XB_SPIN_CAP) { atomicAdd(&(bar)[XB_TMO], 1u); break; } } } } while (0)
struct XcdBarrier { unsigned* bar; unsigned x; volatile LAS unsigned* st; };
__device__ __forceinline__ XcdBarrier xcd_barrier_post(unsigned* bar, volatile LAS unsigned* st) {
    XcdBarrier b; b.bar = bar; b.x = xb_xcc_id(); b.st = st;
    if (threadIdx.x == 0) (void)xb_add(&bar[XB_XCNT(b.x)], 1u);
    return b;
}
__device__ __forceinline__ void xcd_barrier_complete(unsigned* bar, unsigned x, unsigned& nloc, unsigned& nx) {
    const unsigned G = gridDim.x * gridDim.y * gridDim.z;
    unsigned sum, cnt, mine, sp = 0u;
    for (;;) {
        sum = 0u; cnt = 0u; mine = 0u;
#pragma unroll
        for (unsigned j = 0; j < 16; ++j) { const unsigned c = xb_ld(&bar[XB_XCNT(j)]); sum += c; cnt += (c > 0u) ? 1u : 0u; mine = (j == x) ? c : mine; }
        if (sum == G) break;
        __builtin_amdgcn_s_sleep(1);
        if ((++sp & 255u) == 0u) { if (xb_ld(&bar[XB_TMO])) break; if (sp > XB_SPIN_CAP) { atomicAdd(&bar[XB_TMO], 1u); break; } }
    }
    nloc = mine > 0u ? mine : 1u; nx = cnt > 0u ? cnt : 1u;
}
__device__ __forceinline__ void xcd_barrier(const XcdBarrier& b) {
    asm volatile("s_waitcnt vmcnt(0)" ::: "memory");
    __syncthreads();
    if (threadIdx.x == 0) {
        unsigned* bar = b.bar;
        __builtin_amdgcn_s_waitcnt(0);
        unsigned nloc = b.st[0], nx = b.st[1];
        if (nloc == 0u) { xcd_barrier_complete(bar, b.x, nloc, nx); b.st[0] = nloc; b.st[1] = nx; }
        const unsigned old = xb_add(&bar[XB_XSUB(b.x)], 1u);
        const unsigned gen = old / nloc;
        if (old + 1u == (gen + 1u) * nloc) {
            __builtin_amdgcn_fence(__ATOMIC_RELEASE, "agent");
            asm volatile("s_waitcnt vmcnt(0)" ::: "memory");
            const unsigned og = xb_add(&bar[XB_TOP], 1u);
            const unsigned tg = og / nx;
            if (og + 1u == (tg + 1u) * nx) xb_add(&bar[XB_TOPGEN], 1u);
            else XB_SPIN(xb_ld(&bar[XB_TOPGEN]) == tg, bar);
            __builtin_amdgcn_fence(__ATOMIC_ACQUIRE, "agent");
            xb_add(&bar[XB_XGEN(b.x)], 1u);
            asm volatile("s_waitcnt vmcnt(0)" ::: "memory");
        } else {
            XB_SPIN(xb_ld(&bar[XB_XGEN(b.x)]) == gen, bar);
            __builtin_amdgcn_fence(__ATOMIC_ACQUIRE, "agent");
            asm volatile("s_waitcnt vmcnt(0)" ::: "memory");
        }
    }
    __syncthreads();
}

constexpr int LDS_STAGE = 0;
constexpr int LDS_GIDX  = 131072;
constexpr int LDS_BIAS  = LDS_GIDX + 9216;
constexpr int LDS_TP    = LDS_BIAS + 18432;
constexpr int LDS_CNT   = LDS_TP + 256;
constexpr int LDS_MISC  = LDS_CNT + 128;
constexpr int LDS_BYTES = LDS_MISC + 128;

namespace pg {
constexpr int BM = 256, BK = 64, HALF = 128, HTB = HALF * BK * 2, STAGE_BYTES = 8 * HTB, NXCD = 8, WGM = 8;
__device__ __forceinline__ int lds_byte(int r, int c) { const int st = (r >> 4) * 2 + (c >> 5), rr = r & 15, cc = c & 31, ob = rr * 64 + cc * 2; return st * 1024 + (ob ^ (((ob >> 9) & 1) << 5)); }
__device__ __forceinline__ void stage_rc(int b, int& R, int& C) { const int st = b / 1024, sb = b % 1024, swz = sb ^ (((sb >> 9) & 1) << 5); R = (st >> 1) * 16 + swz / 64; C = (st & 1) * 32 + (swz % 64) / 2; }
__device__ __forceinline__ int perm32(int rho) { const int n = rho >> 4, i = rho & 15; return 8 * (i >> 2) + 4 * n + (i & 3); }

struct Unit { int pm, pn, pb, e, ko, ui; };
struct DenseOrder {
    int nM, nN, nwg, G, c, skip_from, skip_by;
    __device__ void init(int nM_, int nN_, int G_, int c_, int sf = 1 << 30, int sb = 0) { nM = nM_; nN = nN_; nwg = nM * nN; G = G_; c = c_; skip_from = sf; skip_by = sb; }
    __device__ bool next(int i, Unit& u) const {
        const long L = (long)i * G + c; if (L >= nwg) return false;
        int wgid = (int)L; { const int q = nwg / NXCD, r = nwg % NXCD, xcd = wgid % NXCD, off = wgid / NXCD; wgid = (xcd < r ? xcd * (q + 1) : r * (q + 1) + (xcd - r) * q) + off; }
        const int nig = WGM * nN, gid = wgid / nig, fm = gid * WGM, gsz = (nM - fm) < WGM ? (nM - fm) : WGM;
        u.pm = fm + ((wgid % nig) % gsz); u.pn = (wgid % nig) / gsz; u.pb = u.pn >= skip_from ? u.pn + skip_by : u.pn; u.e = 0; u.ko = 0; u.ui = i; return true;
    }
    __device__ __forceinline__ unsigned arow(const Unit& u, int h, int R, int, const LAS int*) const { return (unsigned)(u.pm * 256 + h * 128 + R); }
};

template <int FPM  , class Epi, class Sched>
__device__ __forceinline__ void gemm_phase(LAS unsigned char* lds, const void* A, const void* Bt, const int RB  , const Sched& S, const Epi& E, const LAS int* gidx, const int nt_ = 0  ,
        const bool primed = false  , const bool chain = false  ,
        const void* cA = nullptr, const char* cBn = nullptr, const unsigned c00 = 0, const unsigned c01 = 0, const unsigned c10 = 0, const unsigned c11 = 0) {
    constexpr bool FP8 = FPM != 0;
    const int tid = threadIdx.x, wid = __builtin_amdgcn_readfirstlane(tid >> 6), lane = tid & 63, wr = wid >> 2, wc = wid & 3, fr = lane & 15, fq = lane >> 4;
    const int nt = nt_ ? nt_ : RB / (BK * 2);
    unsigned voffB[2];
#pragma unroll
    for (int i = 0; i < 2; ++i) { int R_, C_; stage_rc(tid * 16 + i * 8192, R_, C_); const int Rb = Epi::PERM ? ((R_ & ~31) + perm32(R_ & 31)) : R_; voffB[i] = (unsigned)(Rb * RB + C_ * 2); }
    const size_t kstep = (size_t)(BK * 2);
    const size_t hstep = (size_t)HALF * RB;
    const size_t tstep = 2 * hstep;
    const unsigned ldsw = (unsigned)wid * 1024u;
    const unsigned lds0 = __builtin_amdgcn_readfirstlane((unsigned)(size_t)lds + ldsw);
    const int aoff = lds_byte(wr * 64 + fr, fq * 8), boff = lds_byte(wc * 32 + fr, fq * 8);
#define PG_SA(b, h) (((b) * 2 + (h)) * HTB)
#define PG_SB(b, h) ((4 + (b) * 2 + (h)) * HTB)
#define PG_DMA(voff_, sbase_, ldsoff_) asm volatile("s_mov_b32 m0, %2\n\ts_nop 0\n\tglobal_load_lds_dwordx4 %0, %1" :: "v"(voff_), "s"(sbase_), "s"(ldsoff_) : "memory", "m0")
#define PG_STAGE_B(bufoff, gbase) do { const char* _sb = (const char*)(gbase); _Pragma("unroll") for (int _i = 0; _i < 2; ++_i) \
        PG_DMA(voffB[_i], _sb, lds0 + (unsigned)((bufoff) + _i * 8192)); } while (0)
#define PG_STAGE_A(bufoff, usenext, h, kb) do { const char* _sa = Ab + (size_t)(kb); _Pragma("unroll") for (int _i = 0; _i < 2; ++_i) { const unsigned _o = rac[h][_i]; \
        PG_DMA(_o, _sa, lds0 + (unsigned)((bufoff) + _i * 8192)); } } while (0)
#define PG_LDA(dst, b, h) do { _Pragma("unroll") for (int m = 0; m < 4; ++m) { if constexpr (FP8) { const i32x4 lo_ = *(const LAS i32x4*)(lds + PG_SA(b, h) + aoff + m * 2048), hi_ = *(const LAS i32x4*)(lds + PG_SA(b, h) + aoff + m * 2048 + 1024); dst##8[m] = __builtin_shufflevector(lo_, hi_, 0, 1, 2, 3, 4, 5, 6, 7); } \
        else { _Pragma("unroll") for (int k = 0; k < 2; ++k) dst[m][k] = *(const LAS bf16x8*)(lds + PG_SA(b, h) + aoff + m * 2048 + k * 1024); } } } while (0)
#define PG_LDB(dst, b, h) do { _Pragma("unroll") for (int n = 0; n < 2; ++n) { if constexpr (FP8) { const i32x4 lo_ = *(const LAS i32x4*)(lds + PG_SB(b, h) + boff + n * 2048), hi_ = *(const LAS i32x4*)(lds + PG_SB(b, h) + boff + n * 2048 + 1024); dst##8[n] = __builtin_shufflevector(lo_, hi_, 0, 1, 2, 3, 4, 5, 6, 7); } \
        else { _Pragma("unroll") for (int k = 0; k < 2; ++k) dst[n][k] = *(const LAS bf16x8*)(lds + PG_SB(b, h) + boff + n * 2048 + k * 1024); } } } while (0)
#define PG_MMA(ai, bj, At, Bt_) do { __builtin_amdgcn_s_setprio(1); _Pragma("unroll") for (int m = 0; m < 4; ++m) _Pragma("unroll") for (int n = 0; n < 2; ++n) { \
        if constexpr (FPM == 2) { acc[ai][bj][m][n] = __builtin_amdgcn_mfma_scale_f32_16x16x128_f8f6f4(Bt_##8[n], At##8[m], acc[ai][bj][m][n], 2, 2, 0, Bt_##8[n][6], 0, At##8[m][6]); } \
        else if constexpr (FPM == 1) { acc[ai][bj][m][n] = __builtin_amdgcn_mfma_scale_f32_16x16x128_f8f6f4(Bt_##8[n], At##8[m], acc[ai][bj][m][n], 0, 0, 0, 0x7F7F7F7F, 0, 0x7F7F7F7F); } \
        else { _Pragma("unroll") for (int k = 0; k < 2; ++k) acc[ai][bj][m][n] = __builtin_amdgcn_mfma_f32_16x16x32_bf16(Bt_[n][k], At[m][k], acc[ai][bj][m][n], 0, 0, 0); } } \
        __builtin_amdgcn_s_setprio(0); } while (0)
#define PG_WAIT_V(n) asm volatile("s_waitcnt vmcnt(" #n ")" ::: "memory")
#define PG_WAIT_L(n) asm volatile("s_waitcnt lgkmcnt(" #n ")" ::: "memory")
#define PG_WAIT_VN(n) asm volatile("s_waitcnt vmcnt(%0)" :: "n"(n) : "memory")
#define PG_KPAIR(t, WV_) do { \
            const bool last = (t == nt - 2); \
            const size_t kb1 = (size_t)(t + 1) * kstep; \
            const size_t kb2 = last ? 0 : (size_t)(t + 2) * kstep, kb3 = kb2 + kstep; \
            const char* b2 = last ? nB : cB + (size_t)(t + 2) * kstep; const char* b3 = b2 + kstep; \
            PG_LDB(B0, 0, 0); PG_LDB(B1, 0, 1); PG_SCHED; PG_LDA(At, 0, 0); PG_STAGE_A(PG_SA(1, 1), false, 1, kb1); \
            if (last) { if (has_next) { PG_RA(rac, nxt, ui + 1); } else if (chain) { rac[0][0] = c00; rac[0][1] = c01; rac[1][0] = c10; rac[1][1] = c11; Ab = (const char*)cA; } } \
            PG_WAIT_VN(WV_); PG_WAIT_L(0); PG_BAR; PG_MMA(0, 0, At, B0); PG_MMA(0, 1, At, B1); PG_BAR; PG_SCHED; \
            PG_LDA(At, 0, 1); PG_STAGE_B(PG_SB(0, 0), b2); PG_STAGE_B(PG_SB(0, 1), b2 + hstep); PG_STAGE_A(PG_SA(0, 0), last, 0, kb2); \
            PG_WAIT_VN(WV_); PG_WAIT_L(0); PG_BAR; PG_MMA(1, 0, At, B0); PG_MMA(1, 1, At, B1); PG_BAR; PG_SCHED; \
            PG_LDB(B0, 1, 0); PG_LDB(B1, 1, 1); PG_SCHED; PG_LDA(At, 1, 0); PG_STAGE_A(PG_SA(0, 1), last, 1, kb2); \
            PG_WAIT_V(8); PG_WAIT_L(0); PG_BAR; PG_MMA(0, 0, At, B0); PG_MMA(0, 1, At, B1); PG_BAR; PG_SCHED; \
            PG_LDA(At, 1, 1); PG_STAGE_B(PG_SB(1, 0), b3); PG_STAGE_B(PG_SB(1, 1), b3 + hstep); PG_STAGE_A(PG_SA(1, 0), last, 0, kb3); \
            PG_WAIT_V(8); PG_WAIT_L(0); PG_BAR; PG_MMA(1, 0, At, B0); PG_MMA(1, 1, At, B1); PG_BAR; PG_SCHED; \
        } while (0)
#define PG_BAR __builtin_amdgcn_s_barrier()
#define PG_SCHED __builtin_amdgcn_sched_barrier(0)
#define PG_RA(dst, u, ui_) do { _Pragma("unroll") for (int _i = 0; _i < 2; ++_i) { int R_, C_; stage_rc(tid * 16 + _i * 8192, R_, C_); _Pragma("unroll") for (int _h = 0; _h < 2; ++_h) dst[_h][_i] = S.arow(u, _h, R_, ui_, gidx) * (unsigned)RB + (unsigned)C_ * 2u + (unsigned)u.ko; } } while (0)
    Unit cur, nxt; int ui = 0;
    if (!S.next(0, cur)) return;
    f32x4 acc[2][2][4][2];
#pragma unroll
    for (int a = 0; a < 2; ++a)
#pragma unroll
        for (int b = 0; b < 2; ++b)
#pragma unroll
            for (int m = 0; m < 4; ++m)
#pragma unroll
                for (int n = 0; n < 2; ++n) acc[a][b][m][n] = (f32x4){0.f, 0.f, 0.f, 0.f};
    bf16x8 At[4][2], B0[2][2], B1[2][2]; i32x8 At8[4], B08[2], B18[2];
    unsigned rac[2][2];
    PG_RA(rac, cur, 0);
    const char* Ab = (const char*)A;
    const char* cB = (const char*)Bt + (size_t)cur.pb * tstep + cur.ko;
    if (!primed) {
    PG_STAGE_B(PG_SB(0, 0), cB); PG_STAGE_B(PG_SB(0, 1), cB + hstep); PG_STAGE_A(PG_SA(0, 0), false, 0, 0); PG_STAGE_A(PG_SA(0, 1), false, 1, 0);
    if (wr == 1) PG_BAR;
    PG_WAIT_V(2); PG_BAR;
    PG_STAGE_B(PG_SB(1, 0), cB + kstep); PG_STAGE_A(PG_SA(1, 0), false, 0, kstep); PG_STAGE_B(PG_SB(1, 1), cB + hstep + kstep);
    PG_WAIT_V(6); PG_BAR;
    }
    for (;;) {
        const bool has_next = S.next(ui + 1, nxt);
        const char* nB = has_next ? (const char*)Bt + (size_t)nxt.pb * tstep + nxt.ko : (chain ? cBn : cB);
        int t0 = 0;
        if (Epi::NST > 0 && ui > 0) { PG_KPAIR(0, 8 + Epi::NST); t0 = 2; }
        for (int t = t0; t < nt; t += 2) PG_KPAIR(t, 8);
        E(acc, cur, wr, wc, fr, fq);
        if (!has_next) break;
#pragma unroll
        for (int a = 0; a < 2; ++a)
#pragma unroll
            for (int b = 0; b < 2; ++b)
#pragma unroll
                for (int m = 0; m < 4; ++m)
#pragma unroll
                    for (int n = 0; n < 2; ++n) acc[a][b][m][n] = (f32x4){0.f, 0.f, 0.f, 0.f};
        cur = nxt; cB = nB; ++ui;
    }
    if (!chain) {
    PG_WAIT_V(0);
    if (wr == 0) PG_BAR;
    PG_BAR;
    }
#undef PG_SA
#undef PG_SB
#undef PG_STAGE_A
#undef PG_STAGE_B
#undef PG_DMA
#undef PG_LDA
#undef PG_LDB
#undef PG_MMA
#undef PG_WAIT_V
#undef PG_WAIT_L
#undef PG_WAIT_VN
#undef PG_KPAIR
#undef PG_BAR
#undef PG_SCHED
#undef PG_RA
}

template <class Sched>
__device__ __forceinline__ void first_unit_of(const Sched& S, const void* Bt, const int RB, const char*& cB, unsigned& r00, unsigned& r01, unsigned& r10, unsigned& r11) {
    Unit u; u.pm = 0; u.pn = 0; u.pb = 0; u.e = 0; u.ko = 0; u.ui = 0; S.next(0, u);
    const int tid = threadIdx.x; int R0, C0, R1, C1; stage_rc(tid * 16, R0, C0); stage_rc(tid * 16 + 8192, R1, C1);
    r00 = S.arow(u, 0, R0, 0, nullptr) * (unsigned)RB + (unsigned)C0 * 2u + (unsigned)u.ko; r01 = S.arow(u, 0, R1, 0, nullptr) * (unsigned)RB + (unsigned)C1 * 2u + (unsigned)u.ko;
    r10 = S.arow(u, 1, R0, 0, nullptr) * (unsigned)RB + (unsigned)C0 * 2u + (unsigned)u.ko; r11 = S.arow(u, 1, R1, 0, nullptr) * (unsigned)RB + (unsigned)C1 * 2u + (unsigned)u.ko;
    cB = (const char*)Bt + (size_t)u.pb * (2 * (size_t)HALF * RB) + u.ko;
}
__device__ __forceinline__ u32x4 pack8(const f32x4 a, const f32x4 b, float s) { u32x4 w; w.x = pk2(a[0] * s, a[1] * s); w.y = pk2(a[2] * s, a[3] * s); w.z = pk2(b[0] * s, b[1] * s); w.w = pk2(b[2] * s, b[3] * s); return w; }
typedef f32x4 Acc[2][2][4][2];

__device__ __forceinline__ float rstd_from(const float* ssq8) { const f32x4 a0 = *(const f32x4*)ssq8, a1 = *(const f32x4*)(ssq8 + 4);
    return 1.0f / sqrtf(((a0[0] + a0[1]) + (a0[2] + a0[3]) + (a1[0] + a1[1]) + (a1[2] + a1[3])) * (1.f / 512.f) + EPS); }
struct EpiProjMain {
    static constexpr bool PERM = true; static constexpr int NST = 0; P p;
    __device__ __forceinline__ void operator()(const Acc& acc, const Unit& u, int wr, int wc, int fr, int fq) const {
        const int row0 = u.pm * 256 + wr * 64 + fr;
        if (u.pn < 8) {
            bf16_t* base = WSP(bf16_t, u.pn < 4 ? WS_SBQ : WS_SBK); const float sc = u.pn < 4 ? 0.08838834764831845f * 1.4426950408889634f : 1.f;    const int col0 = (u.pn & 3) * 256 + wc * 32 + 8 * fq;
#pragma unroll
            for (int ai = 0; ai < 2; ++ai)
#pragma unroll
                for (int m = 0; m < 4; ++m) { bf16_t* rp = base + (size_t)(row0 + ai * 128 + m * 16) * 1024 + col0;
#pragma unroll
                    for (int bj = 0; bj < 2; ++bj) *(u32x4*)(rp + bj * 128) = pack8(acc[ai][bj][m][0], acc[ai][bj][m][1], sc); }
        } else {
            const int lat = (u.pn - 8) >> 1, ct = (u.pn - 8) & 1; bf16_t* base = WSP(bf16_t, lat ? WS_KVLAT : WS_QLAT); const int col0 = ct * 256 + wc * 32 + 8 * fq;
            float* ssqp = WSP(float, WS_SSQP);
#pragma unroll
            for (int ai = 0; ai < 2; ++ai)
#pragma unroll
                for (int m = 0; m < 4; ++m) { const int row = row0 + ai * 128 + m * 16; bf16_t* rp = base + (size_t)row * 512 + col0; float s = 0.f;
#pragma unroll
                    for (int bj = 0; bj < 2; ++bj) { *(u32x4*)(rp + bj * 128) = pack8(acc[ai][bj][m][0], acc[ai][bj][m][1], 1.f);
#pragma unroll
                        for (int n = 0; n < 2; ++n) { const f32x4 v = acc[ai][bj][m][n]; s += (v[0] * v[0] + v[1] * v[1]) + (v[2] * v[2] + v[3] * v[3]); } }
                    s += __shfl_xor(s, 16); s += __shfl_xor(s, 32);
                    if (fq == 0) ssqp[(size_t)row * 16 + lat * 8 + ct * 4 + wc] = s; }
        }
    }
};
template <bool SCALE>
__device__ __forceinline__ void epi_vt_r(const Acc& acc, const float* __restrict__ ssqp, bf16_t* __restrict__ dst, int f0, int tokb) {
#pragma unroll
    for (int bj = 0; bj < 2; ++bj) {
        const int tok0 = tokb + bj * 128, b = tok0 / SEQ, s0 = tok0 % SEQ;
        float sc[8];
#pragma unroll
        for (int j = 0; j < 8; ++j) sc[j] = SCALE ? rstd_from(ssqp + (size_t)(tok0 + j) * 16 + 8) : 1.f;
#pragma unroll
        for (int ai = 0; ai < 2; ++ai)
#pragma unroll
            for (int m = 0; m < 4; ++m) { const int f = f0 + ai * 128 + m * 16, h = f >> 7, d = f & 127;
                const f32x4 v0 = acc[ai][bj][m][0], v1 = acc[ai][bj][m][1]; u32x4 w;
                w.x = pk2(v0[0] * sc[0], v0[1] * sc[1]); w.y = pk2(v0[2] * sc[2], v0[3] * sc[3]); w.z = pk2(v1[0] * sc[4], v1[1] * sc[5]); w.w = pk2(v1[2] * sc[6], v1[3] * sc[7]);
                *(u32x4*)(dst + ((size_t)(b * 8 + h) * 128 + d) * SEQ + s0) = w; }
    }
}
template <bool SCALE> struct EpiVt {
    static constexpr bool PERM = true; static constexpr int NST = 0; P p; size_t dst_off;
    __device__ __forceinline__ void operator()(const Acc& acc, const Unit& u, int wr, int wc, int fr, int fq) const {
        epi_vt_r<SCALE>(acc, WSP(float, WS_SSQP), WSP(bf16_t, dst_off), u.pm * 256 + wr * 64 + fr, u.pn * 256 + wc * 32 + 8 * fq);
    }
};
__device__ __forceinline__ void epi_krope_r(const Acc& acc, const float2* __restrict__ cs, bf16_t* __restrict__ dst, int row0, int col0) {
#pragma unroll
    for (int ai = 0; ai < 2; ++ai) {
        f32x4 cv[4][2];
#pragma unroll
        for (int m = 0; m < 4; ++m) { const float2* cr = cs + (size_t)(row0 + ai * 128 + m * 16) * 32 + (col0 >> 1); cv[m][0] = *(const f32x4*)cr; cv[m][1] = *(const f32x4*)(cr + 2); }
        asm volatile("" ::: "memory");
#pragma unroll
        for (int m = 0; m < 4; ++m) { const int row = row0 + ai * 128 + m * 16; const f32x4 v0 = acc[ai][0][m][0], v1 = acc[ai][0][m][1], c0 = cv[m][0], c1 = cv[m][1];
            u32x4 w; w.x = pk2(v0[0] * c0[0] - v0[1] * c0[1], v0[1] * c0[0] + v0[0] * c0[1]); w.y = pk2(v0[2] * c0[2] - v0[3] * c0[3], v0[3] * c0[2] + v0[2] * c0[3]);
            w.z = pk2(v1[0] * c1[0] - v1[1] * c1[1], v1[1] * c1[0] + v1[0] * c1[1]); w.w = pk2(v1[2] * c1[2] - v1[3] * c1[3], v1[3] * c1[2] + v1[2] * c1[3]);
            *(u32x4*)(dst + (size_t)row * 64 + col0) = w; }
        asm volatile("" ::: "memory");
    }
}
struct EpiKrope {
    static constexpr bool PERM = true; static constexpr int NST = 0; P p;
    __device__ __forceinline__ void operator()(const Acc& acc, const Unit& u, int wr, int wc, int fr, int fq) const {
        if (wc >= 2) return;
        epi_krope_r(acc, WSP(float2, WS_CS), WSP(bf16_t, WS_KROPE), u.pm * 256 + wr * 64 + fr, wc * 32 + 8 * fq);
    }
};

__device__ __forceinline__ void epi_q_r(const Acc& acc, const float* __restrict__ ssqp, const float2* __restrict__ cs, bf16_t* __restrict__ dst, int row0, int cbase) {
    const int j0 = cbase % 192, j1 = (cbase + 128) % 192; const bool rp0 = j0 >= 128, rp1 = j1 >= 128; const int i00 = rp0 ? (j0 - 128) >> 1 : 0, i01 = rp1 ? (j1 - 128) >> 1 : 0;
#pragma unroll
    for (int qq = 0; qq < 4; ++qq) {
        f32x4 ca0[2], ca1[2], cb0[2], cb1[2]; float rsv[2];
#pragma unroll
        for (int h = 0; h < 2; ++h) { const int q = 2 * qq + h, ai = q >> 2, m = q & 3, row = row0 + ai * 128 + m * 16; const float2* cr = cs + (size_t)row * 32;
            ca0[h] = *(const f32x4*)(cr + i00); ca1[h] = *(const f32x4*)(cr + i00 + 2); cb0[h] = *(const f32x4*)(cr + i01); cb1[h] = *(const f32x4*)(cr + i01 + 2);
            rsv[h] = rstd_from(ssqp + (size_t)row * 16) * (0.07216878364870322f * 1.4426950408889634f); }
        asm volatile("" ::: "memory");
#pragma unroll
        for (int h = 0; h < 2; ++h) { const int q = 2 * qq + h, ai = q >> 2, m = q & 3, row = row0 + ai * 128 + m * 16;
#pragma unroll
            for (int bj = 0; bj < 2; ++bj) { const bool rp = bj ? rp1 : rp0;
                f32x4 v0 = acc[ai][bj][m][0] * rsv[h], v1 = acc[ai][bj][m][1] * rsv[h];
                if (rp) { const f32x4 c0v = bj ? cb0[h] : ca0[h], c1v = bj ? cb1[h] : ca1[h], t0 = v0, t1 = v1;
                    v0[0] = t0[0] * c0v[0] - t0[1] * c0v[1]; v0[1] = t0[1] * c0v[0] + t0[0] * c0v[1]; v0[2] = t0[2] * c0v[2] - t0[3] * c0v[3]; v0[3] = t0[3] * c0v[2] + t0[2] * c0v[3];
                    v1[0] = t1[0] * c1v[0] - t1[1] * c1v[1]; v1[1] = t1[1] * c1v[0] + t1[0] * c1v[1]; v1[2] = t1[2] * c1v[2] - t1[3] * c1v[3]; v1[3] = t1[3] * c1v[2] + t1[2] * c1v[3]; }
                *(u32x4*)(dst + (size_t)row * 1536 + cbase + bj * 128) = pack8(v0, v1, 1.f); } }
        asm volatile("" ::: "memory");
    }
}
struct EpiQ {
    static constexpr bool PERM = true; static constexpr int NST = 0; P p;
    __device__ __forceinline__ void operator()(const Acc& acc, const Unit& u, int wr, int wc, int fr, int fq) const {
        epi_q_r(acc, WSP(float, WS_SSQP), WSP(float2, WS_CS), WSP(bf16_t, WS_QMLA), u.pm * 256 + wr * 64 + fr, u.pn * 256 + wc * 32 + 8 * fq);
    }
};
__device__ __forceinline__ void epi_knope_r(const Acc& acc, const float* __restrict__ ssqp, bf16_t* __restrict__ dst, int row0, int c0) {
    float rs[2][4];
#pragma unroll
    for (int ai = 0; ai < 2; ++ai)
#pragma unroll
        for (int m = 0; m < 4; ++m) rs[ai][m] = rstd_from(ssqp + (size_t)(row0 + ai * 128 + m * 16) * 16 + 8);
    asm volatile("" ::: "memory");
#pragma unroll
    for (int ai = 0; ai < 2; ++ai)
#pragma unroll
        for (int m = 0; m < 4; ++m) { const int row = row0 + ai * 128 + m * 16;
#pragma unroll
            for (int bj = 0; bj < 2; ++bj) *(u32x4*)(dst + (size_t)row * 1024 + c0 + bj * 128) = pack8(acc[ai][bj][m][0], acc[ai][bj][m][1], rs[ai][m]); }
}
struct EpiKnope {
    static constexpr bool PERM = true; static constexpr int NST = 0; P p;
    __device__ __forceinline__ void operator()(const Acc& acc, const Unit& u, int wr, int wc, int fr, int fq) const {
        epi_knope_r(acc, WSP(float, WS_SSQP), WSP(bf16_t, WS_KNOPE), u.pm * 256 + wr * 64 + fr, u.pn * 256 + wc * 32 + 8 * fq);
    }
};
__device__ __forceinline__ void epi_out_r(const Acc& acc, const float* __restrict__ xin, const float* __restrict__ g1, bf16_t* __restrict__ x1, int row0, int col0) {
    f32x4 gv[2][2];
#pragma unroll
    for (int bj = 0; bj < 2; ++bj)
#pragma unroll
        for (int n = 0; n < 2; ++n) gv[bj][n] = *(const f32x4*)(g1 + col0 + bj * 128 + n * 4);
#pragma unroll
    for (int ai = 0; ai < 2; ++ai) {
        f32x4 xv[4][2][2];
#pragma unroll
        for (int m = 0; m < 4; ++m)
#pragma unroll
            for (int bj = 0; bj < 2; ++bj)
#pragma unroll
                for (int n = 0; n < 2; ++n) xv[m][bj][n] = *(const f32x4*)(xin + (size_t)(row0 + ai * 128 + m * 16) * D + col0 + bj * 128 + n * 4);
        asm volatile("" ::: "memory");
#pragma unroll
        for (int m = 0; m < 4; ++m)
#pragma unroll
            for (int bj = 0; bj < 2; ++bj)
                *(u32x4*)(x1 + (size_t)(row0 + ai * 128 + m * 16) * D + col0 + bj * 128) = pack8(xv[m][bj][0] + gv[bj][0] * acc[ai][bj][m][0], xv[m][bj][1] + gv[bj][1] * acc[ai][bj][m][1], 1.f);
        asm volatile("" ::: "memory");
    }
}
struct EpiOut {
    static constexpr bool PERM = true; static constexpr int NST = 0; P p;
    __device__ __forceinline__ void operator()(const Acc& acc, const Unit& u, int wr, int wc, int fr, int fq) const {
        const int row0 = u.pm * 256 + wr * 64 + fr, b = (u.pm * 256) / SEQ, col0 = u.pn * 256 + wc * 32 + 8 * fq;
        epi_out_r(acc, p.x, WSP(float, WS_MOD) + (size_t)b * NMOD * D + 2 * D, WSP(bf16_t, WS_X1), row0, col0);
    }
};
struct EpiMoe1 {
    static constexpr bool PERM = true; static constexpr int NST = 8; P p; size_t dst_off; const LAS float* bias_lds;
    __device__ __forceinline__ void operator()(const Acc& acc, const Unit& u, int wr, int wc, int fr, int fq) const {
        const int row0 = u.pm * 256 + wr * 64 + fr, a0 = u.pn * 128 + wc * 32 + 8 * fq; const LAS float* b1 = bias_lds + (u.ui < 18 ? u.ui : 0) * 256 + 2 * (wc * 32 + 8 * fq); bf16_t* dst = WSP(bf16_t, dst_off);
        float bg[8], bl[8];
#pragma unroll
        for (int q = 0; q < 4; ++q) { const f32x4 t = *(const LAS f32x4*)(b1 + 4 * q); bg[2 * q] = t[0]; bl[2 * q] = t[1] + 1.f; bg[2 * q + 1] = t[2]; bl[2 * q + 1] = t[3] + 1.f; }
#pragma unroll
        for (int ai = 0; ai < 2; ++ai)
#pragma unroll
            for (int m = 0; m < 4; ++m) { const int row = row0 + ai * 128 + m * 16; float o[8];
#pragma unroll
                for (int j = 0; j < 8; ++j) { float g = acc[ai][0][m][j >> 2][j & 3] * (MOE1_FP6 ? 1.f : W8_INV) + bg[j], l = acc[ai][1][m][j >> 2][j & 3] * (MOE1_FP6 ? 1.f : W8_INV) + bl[j];
                    g = fminf(g, 7.f); l = fminf(fmaxf(l, -6.f), 8.f);
                    o[j] = g * __builtin_amdgcn_rcpf(1.f + __builtin_amdgcn_exp2f(-2.4554669595930156f * g)) * l; }
                if (MOE_FP8) { u32x2 w; w.x = pk4_fp8(o[0], o[1], o[2], o[3]); w.y = pk4_fp8(o[4], o[5], o[6], o[7]); *(u32x2*)((unsigned char*)dst + (size_t)row * DE + a0) = w; }
                else { u32x4 w; w.x = pk2(o[0], o[1]); w.y = pk2(o[2], o[3]); w.z = pk2(o[4], o[5]); w.w = pk2(o[6], o[7]);
                *(u32x4*)(dst + (size_t)row * DE + a0) = w; } }
    }
};
struct EpiMoe2 {
    static constexpr bool PERM = true; static constexpr int NST = 16; P p; const LAS float* bias_lds;
    __device__ __forceinline__ void operator()(const Acc& acc, const Unit& u, int wr, int wc, int fr, int fq) const {
        const int row0 = u.pm * 256 + wr * 64 + fr, c0 = u.pn * 256 + wc * 32 + 8 * fq; const LAS float* b2 = bias_lds + (u.ui < 18 ? u.ui : 0) * 256 + wc * 32 + 8 * fq; bf16_t* dst = WSP(bf16_t, WS_Y);
        f32x4 bv[2][2];
#pragma unroll
        for (int bj = 0; bj < 2; ++bj)
#pragma unroll
            for (int n = 0; n < 2; ++n) bv[bj][n] = *(const LAS f32x4*)(b2 + bj * 128 + 4 * n) * (Y_FP8 ? Y_SCALE : 1.f);
#pragma unroll
        for (int ai = 0; ai < 2; ++ai)
#pragma unroll
            for (int m = 0; m < 4; ++m) { const int row = row0 + ai * 128 + m * 16;
#pragma unroll
                for (int bj = 0; bj < 2; ++bj) {
                    if (Y_FP8) { f32x4 t0 = acc[ai][bj][m][0] * ((MOE_FP8 ? W8_INV : 1.f) * Y_SCALE) + bv[bj][0], t1 = acc[ai][bj][m][1] * ((MOE_FP8 ? W8_INV : 1.f) * Y_SCALE) + bv[bj][1];
#pragma unroll
                        for (int j = 0; j < 4; ++j) { t0[j] = __builtin_amdgcn_fmed3f(t0[j], -448.f, 448.f); t1[j] = __builtin_amdgcn_fmed3f(t1[j], -448.f, 448.f); }
                        u32x2 w; w.x = pk4_fp8(t0[0], t0[1], t0[2], t0[3]); w.y = pk4_fp8(t1[0], t1[1], t1[2], t1[3]);
                        *(u32x2*)((unsigned char*)dst + (size_t)row * D + c0 + bj * 128) = w; }
                    else *(u32x4*)(dst + (size_t)row * D + c0 + bj * 128) = pack8(acc[ai][bj][m][0] * (MOE_FP8 ? W8_INV : 1.f) + bv[bj][0], acc[ai][bj][m][1] * (MOE_FP8 ? W8_INV : 1.f) + bv[bj][1], 1.f); } }
    }
};
template <int NCT, bool GATHER> struct MoeOrder {
    const LAS int* tp; int T, rtr, ctr, rpr, G, c;
    __device__ void init(const LAS int* tp_, int G_, int c_) { tp = tp_; T = tp_[32]; G = G_; c = c_;
        const int x = c_ & 7, a = (c_ >> 3) & 31;
        if (NCT == 16) { rtr = (x >> 2) * 8 + (a >> 2); ctr = (x & 3) * 4 + (a & 3); rpr = 16; } else { rtr = (x >> 1) * 8 + (a >> 2); ctr = (x & 1) * 4 + (a & 3); rpr = 32; } }
    __device__ bool next(int i, Unit& u) const {
        int g, ct;
        if (G == 256) { g = i * rpr + rtr; ct = ctr; } else { const long L = (long)i * G + c; g = (int)(L / NCT); ct = (int)(L % NCT); }
        if (g >= T) return false;
        int e;
        if (G == 256 && i < 20 && tp[63]) { e = tp[40 + i]; }
        else { e = 0; while (e < 31 && tp[e + 1] <= g) ++e; }
        u.pm = g; u.pn = ct; u.pb = e * NCT + ct; u.e = e; u.ko = 0; u.ui = i; return true;
    }
    __device__ __forceinline__ unsigned arow(const Unit& u, int h, int R, int ui, const LAS int* gidx) const { return GATHER ? (unsigned)((const LAS unsigned short*)gidx)[ui * 256 + h * 128 + R] : (unsigned)(u.pm * 256 + h * 128 + R); }
};
struct KropeOrder {
    int G, c;
    __device__ bool next(int i, Unit& u) const { const int L = i * G + c; if (L >= 256) return false; u.pm = L >> 2; u.pn = L & 3; u.pb = 16; u.e = 0; u.ko = (L & 3) * 1024; u.ui = i; return true; }
    __device__ __forceinline__ unsigned arow(const Unit& u, int h, int R, int, const LAS int*) const { return (unsigned)(u.pm * 256 + h * 128 + R); }
};
struct EpiKropeP {
    static constexpr bool PERM = true; static constexpr int NST = 0; P p;
    __device__ __forceinline__ void operator()(const Acc& acc, const Unit& u, int wr, int wc, int fr, int fq) const {
        if (wc >= 2) return;
        float* dst = WSP(float, WS_G_QRAW) + (size_t)u.pn * NTOK * 64; const int row0 = u.pm * 256 + wr * 64 + fr, col0 = wc * 32 + 8 * fq;
#pragma unroll
        for (int ai = 0; ai < 2; ++ai)
#pragma unroll
            for (int m = 0; m < 4; ++m) { float* rp = dst + (size_t)(row0 + ai * 128 + m * 16) * 64 + col0; *(f32x4*)rp = acc[ai][0][m][0]; *(f32x4*)(rp + 4) = acc[ai][0][m][1]; }
    }
};
}

__device__ __forceinline__ void krope_fixup(const float* __restrict__ part, const float2* __restrict__ cs, bf16_t* __restrict__ dst, int G, int bid) {
    for (int r0 = bid * 64; r0 < NTOK; r0 += G * 64) { const int row = r0 + (threadIdx.x >> 3), c8 = (threadIdx.x & 7) * 8;
        f32x4 a = {0.f, 0.f, 0.f, 0.f}, b = {0.f, 0.f, 0.f, 0.f};
#pragma unroll
        for (int q = 0; q < 4; ++q) { const float* pp = part + ((size_t)q * NTOK + row) * 64 + c8; a += *(const f32x4*)pp; b += *(const f32x4*)(pp + 4); }
        const f32x4 c0 = *(const f32x4*)(cs + (size_t)row * 32 + (c8 >> 1)), c1 = *(const f32x4*)(cs + (size_t)row * 32 + (c8 >> 1) + 2);
        u32x4 w; w.x = pk2(a[0] * c0[0] - a[1] * c0[1], a[1] * c0[0] + a[0] * c0[1]); w.y = pk2(a[2] * c0[2] - a[3] * c0[3], a[3] * c0[2] + a[2] * c0[3]);
        w.z = pk2(b[0] * c1[0] - b[1] * c1[1], b[1] * c1[0] + b[0] * c1[1]); w.w = pk2(b[2] * c1[2] - b[3] * c1[3], b[3] * c1[2] + b[2] * c1[3]);
        *(u32x4*)(dst + (size_t)row * 64 + c8) = w; }
}

struct DmIdent { __device__ int operator()(int n) const { return n; } };
struct DmWin { __device__ int operator()(int n) const { if (n < 4096) return n; const int j = n - 4096; return j < 32 ? 4096 + 2 * j : 4096 + 2 * (j - 32) + 1; } };
struct DmWq { __device__ int operator()(int n) const { const int h = n / 192, j = n - h * 192; if (j < 128) return n; return j < 160 ? h * 192 + 128 + 2 * (j - 128) : h * 192 + 128 + 2 * (j - 160) + 1; } };
struct DmWkv { __device__ int operator()(int n) const { const int h = n >> 8, r = n & 255; return r < 128 ? h * 128 + r : 1024 + h * 128 + (r - 128); } };
struct DmW1 { __device__ int operator()(int n) const { const int a = n >> 1; return (a >> 7) * 256 + (n & 1) * 128 + (a & 127); } };
template <class DM>
__device__ __forceinline__ void conv_tile(const float* W, int ldw, int k0, int n0, bf16_t* Bt, int K, DM dm, const float* kscale, LAS unsigned* T) {
    const int tid = threadIdx.x, kp = tid >> 4, nc = tid & 15;
    f32x4 a[2], b[2];
#pragma unroll
    for (int ps = 0; ps < 2; ++ps) { const int k = k0 + 2 * (kp + 32 * ps);
        a[ps] = *(const f32x4*)(W + (size_t)k * ldw + n0 + 4 * nc); b[ps] = *(const f32x4*)(W + (size_t)(k + 1) * ldw + n0 + 4 * nc);
        if (kscale) { a[ps] *= kscale[k]; b[ps] *= kscale[k + 1]; } }
#pragma unroll
    for (int ps = 0; ps < 2; ++ps)
#pragma unroll
        for (int j = 0; j < 4; ++j) T[(4 * nc + j) * 66 + kp + 32 * ps] = pk2(a[ps][j], b[ps][j]);
    __syncthreads();
#pragma unroll
    for (int q = 0; q < 2; ++q) { const int ch = tid + 512 * q, n = ch >> 4, c = ch & 15;
        const u32x2 lo = *(const LAS u32x2*)(T + n * 66 + 4 * c), hi = *(const LAS u32x2*)(T + n * 66 + 4 * c + 2);
        u32x4 w; w.x = lo.x; w.y = lo.y; w.z = hi.x; w.w = hi.y;
        *(u32x4*)(Bt + (size_t)dm(n0 + n) * K + k0 + 8 * c) = w; }
    __syncthreads();
}

template <class DM>
__device__ __forceinline__ void conv_tile8(const float* W, int ldw, int k0, int n0, unsigned char* Bt, int K, DM dm, LAS unsigned* T) {
    const int tid = threadIdx.x, k4 = tid >> 4, nc = tid & 15;
    f32x4 a[4];
#pragma unroll
    for (int r = 0; r < 4; ++r) a[r] = *(const f32x4*)(W + (size_t)(k0 + 4 * k4 + r) * ldw + n0 + 4 * nc) * W8_SCALE;
#pragma unroll
    for (int j = 0; j < 4; ++j) T[(4 * nc + j) * 36 + k4] = pk4_fp8(a[0][j], a[1][j], a[2][j], a[3][j]);
    __syncthreads();
    { const int n = tid >> 3, c = tid & 7; const u32x4 w = *(const LAS u32x4*)(T + n * 36 + 4 * c); *(u32x4*)(Bt + (size_t)dm(n0 + n) * K + k0 + 16 * c) = w; }
    __syncthreads();
}

template <class DM>
__device__ __forceinline__ void conv_tile8x2(const float* Wa, const float* Wb, int ldw, int k0a, int n0a, int k0b, int n0b, unsigned char* Bta, unsigned char* Btb, int K, DM dm, LAS unsigned* T) {
    const int tid = threadIdx.x, k4 = tid >> 4, nc = tid & 15;
    f32x4 a[4], b[4];
#pragma unroll
    for (int r = 0; r < 4; ++r) a[r] = __builtin_nontemporal_load((const f32x4*)(Wa + (size_t)(k0a + 4 * k4 + r) * ldw + n0a + 4 * nc));
#pragma unroll
    for (int r = 0; r < 4; ++r) b[r] = __builtin_nontemporal_load((const f32x4*)(Wb + (size_t)(k0b + 4 * k4 + r) * ldw + n0b + 4 * nc));
#pragma unroll
    for (int j = 0; j < 4; ++j) T[(4 * nc + j) * 36 + k4] = pk4_fp8(a[0][j] * W8_SCALE, a[1][j] * W8_SCALE, a[2][j] * W8_SCALE, a[3][j] * W8_SCALE);
#pragma unroll
    for (int j = 0; j < 4; ++j) T[2304 + (4 * nc + j) * 36 + k4] = pk4_fp8(b[0][j] * W8_SCALE, b[1][j] * W8_SCALE, b[2][j] * W8_SCALE, b[3][j] * W8_SCALE);
    __syncthreads();
    { const int n = tid >> 3, c = tid & 7; const u32x4 wa = *(const LAS u32x4*)(T + n * 36 + 4 * c), wb = *(const LAS u32x4*)(T + 2304 + n * 36 + 4 * c);
      __builtin_nontemporal_store(wa, (u32x4*)(Bta + (size_t)dm(n0a + n) * K + k0a + 16 * c)); __builtin_nontemporal_store(wb, (u32x4*)(Btb + (size_t)dm(n0b + n) * K + k0b + 16 * c)); }
    __syncthreads();
}

template <class DM>
__device__ __forceinline__ void conv_macro8(const float* W, int ldw, int k0, int n0, unsigned char* Bt, int K, DM dm, LAS unsigned char* Tb) {
    const int tid = threadIdx.x, kq = tid >> 6, nc = tid & 63;
    const float* src = W + (size_t)(k0 + 4 * kq) * ldw + n0 + 4 * nc;
    f32x4 a[2][8];
#define CM_LOAD(buf, slab) do { _Pragma("unroll") for (int h_ = 0; h_ < 2; ++h_) _Pragma("unroll") for (int r_ = 0; r_ < 4; ++r_) a[buf][h_ * 4 + r_] = __builtin_nontemporal_load((const f32x4*)(src + (size_t)((slab) * 64 + h_ * 32 + r_) * ldw)); } while (0)
#define CM_PUT(buf, slab) do { _Pragma("unroll") for (int h_ = 0; h_ < 2; ++h_) _Pragma("unroll") for (int j_ = 0; j_ < 4; ++j_) \
        *(LAS unsigned*)(Tb + (4 * nc + j_) * 260 + ((slab) * 64 + h_ * 32 + 4 * kq)) = pk4_fp8(a[buf][h_ * 4][j_] * W8_SCALE, a[buf][h_ * 4 + 1][j_] * W8_SCALE, a[buf][h_ * 4 + 2][j_] * W8_SCALE, a[buf][h_ * 4 + 3][j_] * W8_SCALE); } while (0)
    CM_LOAD(0, 0); CM_LOAD(1, 1);
    CM_PUT(0, 0); CM_LOAD(0, 2);
    CM_PUT(1, 1); CM_LOAD(1, 3);
    CM_PUT(0, 2); CM_PUT(1, 3);
#undef CM_LOAD
#undef CM_PUT
    __syncthreads();
#pragma unroll
    for (int ps = 0; ps < 8; ++ps) { const int n = ps * 32 + (tid >> 4), c = tid & 15; const LAS unsigned* tp_ = (const LAS unsigned*)(Tb + n * 260 + 16 * c);
        u32x4 w; w.x = tp_[0]; w.y = tp_[1]; w.z = tp_[2]; w.w = tp_[3];
        __builtin_nontemporal_store(w, (u32x4*)(Bt + (size_t)dm(n0 + n) * K + k0 + 16 * c)); }
    __syncthreads();
}

__device__ __forceinline__ void phase_prologue(const P& p, LAS unsigned char* lds, int G, int bid) {
    const int tid = threadIdx.x, lane = tid & 63, wid = tid >> 6;
    LAS float* cact = (LAS float*)lds;
    LAS float* red = (LAS float*)(lds + 32768);
    LAS unsigned* T = (LAS unsigned*)(lds + 81920);
    constexpr int U_MOD = 96, U_CS = 64 + 8;
    constexpr int T_WIN = 16 * 65, T_WQ = 4 * 24, T_WKV = 4 * 32, T_WOUT = 16 * 32;
    constexpr int U_REST = U_CS + T_WIN + T_WQ + T_WKV + T_WOUT;
    const bool split = G > 2 * U_MOD;
    if (!split || bid < U_MOD) {
        for (int i = tid; i < 4 * 2048; i += 512) { const int b = i >> 11, k = i & 2047; const float c = p.c[i]; cact[k * 4 + b] = c / (1.f + __expf(-c)); }
        __syncthreads();
        for (int mu = bid; mu < U_MOD; mu += G) {
            f32x4 acc[4] = {{0.f, 0.f, 0.f, 0.f}, {0.f, 0.f, 0.f, 0.f}, {0.f, 0.f, 0.f, 0.f}, {0.f, 0.f, 0.f, 0.f}};
            const int hh = lane >> 5, cl = lane & 31;
            const float* w = p.w_mod + (size_t)(wid * 256 + hh) * (NMOD * D) + mu * 128 + 4 * cl;
#pragma unroll 16
            for (int k = 0; k < 128; ++k) { const f32x4 wv = __builtin_nontemporal_load((const f32x4*)(w + (size_t)(2 * k) * (NMOD * D))); const f32x4 c = *(const LAS f32x4*)(cact + (wid * 256 + 2 * k + hh) * 4);
                acc[0] += wv * c[0]; acc[1] += wv * c[1]; acc[2] += wv * c[2]; acc[3] += wv * c[3]; }
#pragma unroll
            for (int b = 0; b < 4; ++b) *(LAS f32x4*)(red + ((wid * 64 + lane) * 4 + b) * 4) = acc[b];
            __syncthreads();
            if (tid < 128) { const int l = tid >> 2, b = tid & 3; f32x4 sum = *(const f32x4*)(p.b_mod + mu * 128 + 4 * l);
#pragma unroll
                for (int w8 = 0; w8 < 16; ++w8) sum += *(const LAS f32x4*)(red + ((w8 * 32 + l) * 4 + b) * 4);
                *(f32x4*)(WSP(float, WS_MOD) + (size_t)b * NMOD * D + mu * 128 + 4 * l) = sum; }
            __syncthreads();
        }
        if (split) return;
    }
    const int c0 = split ? bid - U_MOD : bid, GS = split ? G - U_MOD : G;
    for (int v = c0; v < U_CS; v += GS) {
        if (v >= 64) {
            for (int j = 0; j < 16; ++j) { const int idx = (v - 64) * 8192 + j * 512 + tid, k = idx >> 5, e = idx & 31; const float w = p.w_router[idx];
                const bf16_t hi = f2bf(w); WSP(bf16_t, WS_WR_HI)[e * 2048 + k] = hi; WSP(bf16_t, WS_WR_LO)[e * 2048 + k] = f2bf(w - bf2f(hi)); }
        } else {
            for (int j = 0; j < 16; ++j) { const int idx = v * 8192 + j * 512 + tid; const int tok = idx >> 5, i = idx & 31;
                double inv = 1.0; for (int q = 0; q < i; ++q) inv *= 0.7498942093324559;
                const double rev = (double)p.pos[tok] * inv * 0.15915494309189535; const float fr = (float)(rev - floor(rev));
                float2 cs; cs.x = __builtin_amdgcn_cosf(fr); cs.y = __builtin_amdgcn_sinf(fr); WSP(float2, WS_CS)[idx] = cs; }
        }
    }
    constexpr int NT = T_WIN + T_WQ + T_WKV + T_WOUT;
    const int kp = tid >> 4, nc = tid & 15;
    f32x4 ra[2][2], rb[2][2];
#define CT_DECL(P_) const float* P_##W = p.w_in; bf16_t* P_##Bt = WSP(bf16_t, WS_WIN_T); const float* P_##ks = nullptr; int P_##ldw = INW, P_##k0 = 0, P_##n0 = 0, P_##K = 2048, P_##dmt = 0
#define CT_SET(P_, vv) do { int v_ = (vv); \
        if (v_ < T_WIN) { P_##W = p.w_in; P_##Bt = WSP(bf16_t, WS_WIN_T); P_##ks = nullptr; P_##ldw = INW; P_##k0 = (v_ / 65) * 128; P_##n0 = (v_ % 65) * 64; P_##K = 2048; P_##dmt = 0; } \
        else if ((v_ -= T_WIN) < T_WQ) { P_##W = p.w_q_up; P_##Bt = WSP(bf16_t, WS_WQ_T); P_##ks = p.g_q; P_##ldw = 1536; P_##k0 = (v_ / 24) * 128; P_##n0 = (v_ % 24) * 64; P_##K = 512; P_##dmt = 1; } \
        else if ((v_ -= T_WQ) < T_WKV) { P_##W = p.w_kv_up; P_##Bt = WSP(bf16_t, WS_WKV_T); P_##ks = p.g_kv; P_##ldw = 2048; P_##k0 = (v_ / 32) * 128; P_##n0 = (v_ % 32) * 64; P_##K = 512; P_##dmt = 2; } \
        else { v_ -= T_WKV; P_##W = p.w_out; P_##Bt = WSP(bf16_t, WS_WOUT_T); P_##ks = nullptr; P_##ldw = 2048; P_##k0 = (v_ / 32) * 128; P_##n0 = (v_ % 32) * 64; P_##K = 2048; P_##dmt = 3; } } while (0)
#define PT_LOAD(buf, P_) do { _Pragma("unroll") for (int ps = 0; ps < 2; ++ps) { const int k = P_##k0 + 2 * (kp + 32 * ps); \
        ra[buf][ps] = *(const f32x4*)(P_##W + (size_t)k * P_##ldw + P_##n0 + 4 * nc); rb[buf][ps] = *(const f32x4*)(P_##W + (size_t)(k + 1) * P_##ldw + P_##n0 + 4 * nc); } } while (0)
#define PT_DO(buf, P_) do { _Pragma("unroll") for (int ps = 0; ps < 2; ++ps) { const int k = P_##k0 + 2 * (kp + 32 * ps); f32x4 x = ra[buf][ps], y = rb[buf][ps]; \
            if (P_##ks) { x *= P_##ks[k]; y *= P_##ks[k + 1]; } \
            _Pragma("unroll") for (int j = 0; j < 4; ++j) T[(4 * nc + j) * 66 + kp + 32 * ps] = pk2(x[j], y[j]); } \
        __syncthreads(); \
        _Pragma("unroll") for (int q = 0; q < 2; ++q) { const int ch = tid + 512 * q, n = ch >> 4, cc = ch & 15; \
            const u32x2 lo = *(const LAS u32x2*)(T + n * 66 + 4 * cc), hi = *(const LAS u32x2*)(T + n * 66 + 4 * cc + 2); \
            u32x4 w; w.x = lo.x; w.y = lo.y; w.z = hi.x; w.w = hi.y; const int nn = P_##n0 + n; \
            const int dn = P_##dmt == 0 ? DmWin{}(nn) : P_##dmt == 1 ? DmWq{}(nn) : P_##dmt == 2 ? DmWkv{}(nn) : nn; \
            *(u32x4*)(P_##Bt + (size_t)dn * P_##K + P_##k0 + 8 * cc) = w; } \
        __syncthreads(); } while (0)
    int v = c0;
    if (v < NT) {
        CT_DECL(c_); CT_DECL(n_);
        CT_SET(c_, v); PT_LOAD(0, c_);
        for (;;) {
            const int vn = v + GS; const bool more = vn < NT;
            if (more) { CT_SET(n_, vn); PT_LOAD(1, n_); }
            PT_DO(0, c_);
            if (!more) break;
            const int vnn = vn + GS; const bool more2 = vnn < NT;
            if (more2) { CT_SET(c_, vnn); PT_LOAD(0, c_); }
            PT_DO(1, n_);
            if (!more2) break;
            v = vnn;
        }
    }
#undef CT_DECL
#undef CT_SET
#undef PT_LOAD
#undef PT_DO
}

__device__ __forceinline__ void phase_normmod_r(const float* __restrict__ mod, const float* __restrict__ x, const float* __restrict__ g, int shift_idx, int scale_idx, bf16_t* __restrict__ out, int G, int bid) {
    const int lane = threadIdx.x & 63, wid = threadIdx.x >> 6;
    for (int row = bid * 8 + wid; row < NTOK; row += G * 8) {
        const int b = row / SEQ; const float* xr = x + (size_t)row * D; f32x4 v[8]; float ss = 0.f;
#pragma unroll
        for (int j = 0; j < 8; ++j) { v[j] = *(const f32x4*)(xr + (j * 64 + lane) * 4); ss += (v[j][0] * v[j][0] + v[j][1] * v[j][1]) + (v[j][2] * v[j][2] + v[j][3] * v[j][3]); }
#pragma unroll
        for (int o = 32; o >= 1; o >>= 1) ss += __shfl_xor(ss, o);
        const float rstd = 1.0f / sqrtf(ss * (1.f / D) + EPS);
        const float* sh = mod + (size_t)b * NMOD * D + shift_idx * D; const float* sc = mod + (size_t)b * NMOD * D + scale_idx * D;
#pragma unroll
        for (int j = 0; j < 8; ++j) { const int k = (j * 64 + lane) * 4; const f32x4 gg = *(const f32x4*)(g + k), s1 = *(const f32x4*)(sc + k), s0 = *(const f32x4*)(sh + k);
            const f32x4 h = v[j] * rstd * gg * (s1 + 1.f) + s0; u32x2 w; w.x = pk2(h[0], h[1]); w.y = pk2(h[2], h[3]); *(u32x2*)(out + (size_t)row * D + k) = w; }
    }
}


__device__ __forceinline__ void phase_cb(const P& p, LAS unsigned char* lds, int bid) {
    if (bid >= NB) return;
    const int tid = threadIdx.x, e = tid & 31, kc = tid >> 5; LAS float* red = (LAS float*)lds;
    const float* sh = WSP(float, WS_MOD) + (size_t)bid * NMOD * D + 3 * D; float s = 0.f;
#pragma unroll 16
    for (int k = kc * 128; k < kc * 128 + 128; ++k) s += sh[k] * p.w_router[k * 32 + e];
    red[tid] = s; __syncthreads();
    if (tid < 32) { float t = p.b_router[tid]; for (int q = 0; q < 16; ++q) t += red[q * 32 + tid]; WSP(float, WS_CB)[bid * 32 + tid] = t; }
    __syncthreads();
}
__device__ __forceinline__ void route_h2_out(const bf16_t* __restrict__ xr, const float* __restrict__ gf, const float* __restrict__ sc, const float* __restrict__ sh, unsigned char* __restrict__ hr8, const float rs, const int kbase) {
#pragma unroll 4
    for (int s = 0; s < 32; ++s) {
        const int k = kbase + 16 * s;
        const f32x4 g0 = *(const f32x4*)(gf + k), g1 = *(const f32x4*)(gf + k + 4), s0 = *(const f32x4*)(sc + k), s1 = *(const f32x4*)(sc + k + 4), h0 = *(const f32x4*)(sh + k), h1 = *(const f32x4*)(sh + k + 4);
        f32x4 xa, xb; { const u32x4 xw = *(const u32x4*)(xr + 16 * s); xa[0] = __uint_as_float(xw.x << 16); xa[1] = __uint_as_float(xw.x & 0xffff0000u); xa[2] = __uint_as_float(xw.y << 16); xa[3] = __uint_as_float(xw.y & 0xffff0000u);
            xb[0] = __uint_as_float(xw.z << 16); xb[1] = __uint_as_float(xw.z & 0xffff0000u); xb[2] = __uint_as_float(xw.w << 16); xb[3] = __uint_as_float(xw.w & 0xffff0000u); }
        const f32x4 y0 = xa * rs * g0 * (s0 + 1.f) + h0, y1 = xb * rs * g1 * (s1 + 1.f) + h1;
        if (MOE_FP8) { u32x2 w; w.x = pk4_fp8(y0[0], y0[1], y0[2], y0[3]); w.y = pk4_fp8(y1[0], y1[1], y1[2], y1[3]); *(u32x2*)(hr8 + 16 * s) = w; }
        else { u32x4 w; w.x = pk2(y0[0], y0[1]); w.y = pk2(y0[2], y0[3]); w.z = pk2(y1[0], y1[1]); w.w = pk2(y1[2], y1[3]); *(u32x4*)(hr8 + 32 * s) = w; }
    }
}
__device__ __forceinline__ void route_h2_fp6(const bf16_t* __restrict__ x1g, const LAS float* gsl, const LAS float* shl, unsigned char* __restrict__ h2g, const LAS float* rsd) {
    const int blk = threadIdx.x & 63, k0 = blk * 32;
    f32x4 gs[8], hs[8];
#pragma unroll
    for (int q = 0; q < 8; ++q) { gs[q] = *(const LAS f32x4*)(gsl + k0 + 4 * q); hs[q] = *(const LAS f32x4*)(shl + k0 + 4 * q); }
#pragma unroll 2
    for (int ps = 0; ps < 8; ++ps) { const int id = threadIdx.x + 512 * ps, r = id >> 6; const float rs = rsd[r];
        float v[32]; const u32x4* xp = (const u32x4*)(x1g + (size_t)r * D + k0);
#pragma unroll
        for (int q = 0; q < 4; ++q) { const u32x4 xw = xp[q]; const f32x4 g0 = gs[2 * q] * rs, g1 = gs[2 * q + 1] * rs, h0 = hs[2 * q], h1 = hs[2 * q + 1];
            v[8 * q + 0] = __uint_as_float(xw.x << 16) * g0[0] + h0[0]; v[8 * q + 1] = __uint_as_float(xw.x & 0xffff0000u) * g0[1] + h0[1];
            v[8 * q + 2] = __uint_as_float(xw.y << 16) * g0[2] + h0[2]; v[8 * q + 3] = __uint_as_float(xw.y & 0xffff0000u) * g0[3] + h0[3];
            v[8 * q + 4] = __uint_as_float(xw.z << 16) * g1[0] + h1[0]; v[8 * q + 5] = __uint_as_float(xw.z & 0xffff0000u) * g1[1] + h1[1];
            v[8 * q + 6] = __uint_as_float(xw.w << 16) * g1[2] + h1[2]; v[8 * q + 7] = __uint_as_float(xw.w & 0xffff0000u) * g1[3] + h1[3]; }
        u32x4 lo, hi; fp6_block(v, lo, hi);
        unsigned char* dst = h2g + (size_t)r * D + (blk >> 2) * 128 + (blk & 3) * 16;
        *(u32x4*)dst = lo; *(u32x4*)(dst + 64) = hi; }
}
__device__ __forceinline__ void phase_route(const P& p, LAS unsigned char* lds, int G, int bid) {
    const int tid = threadIdx.x, lane = tid & 63, wid = __builtin_amdgcn_readfirstlane(tid >> 6), hf = wid >> 2, wq = wid & 3, r32 = lane & 31, kg = lane >> 5;
    LAS float* red = (LAS float*)lds;
    LAS float* ssr = (LAS float*)(lds + 32768);
    LAS float* lg = (LAS float*)(lds + 32768 + 2048);
    LAS float* rsd = (LAS float*)(lds + 32768 + 2048 + 8192);
    LAS int* hist = (LAS int*)(lds + 32768 + 2048 + 8192 + 256);
    LAS int* gbase = hist + 32;
    LAS float* gsl = (LAS float*)(lds + 49152);
    LAS float* shl = (LAS float*)(lds + 57344);
    const bf16_t* wrh = WSP(bf16_t, WS_WR_HI); const bf16_t* wrl = WSP(bf16_t, WS_WR_LO);
    for (int gp = bid; gp < NTOK / 64; gp += G) {
        const int row = gp * 64 + hf * 32 + r32, b = (gp * 64) / SEQ, kb0 = wq * 512 + 8 * kg;
        const float* mod = WSP(float, WS_MOD) + (size_t)b * NMOD * D; const float* sh = mod + 3 * D; const float* sc = mod + 4 * D;
        const bf16_t* xr = WSP(bf16_t, WS_X1) + (size_t)row * D + kb0;
        f32x16 C = {}; float ss = 0.f;
        if (tid < 32) hist[tid] = 0;
        { const int k4 = tid * 4; *(LAS f32x4*)(gsl + k4) = *(const f32x4*)(p.g_ffn + k4) * (*(const f32x4*)(sc + k4) + 1.f); *(LAS f32x4*)(shl + k4) = *(const f32x4*)(sh + k4); }
        __syncthreads();
#pragma unroll 4
        for (int s = 0; s < 32; ++s) {
            const int k = kb0 + 16 * s;
            const f32x4 gs0 = *(const LAS f32x4*)(gsl + k), gs1 = *(const LAS f32x4*)(gsl + k + 4);
            f32x4 x0, x1; { const u32x4 xw = *(const u32x4*)(xr + 16 * s); x0[0] = __uint_as_float(xw.x << 16); x0[1] = __uint_as_float(xw.x & 0xffff0000u); x0[2] = __uint_as_float(xw.y << 16); x0[3] = __uint_as_float(xw.y & 0xffff0000u);
                x1[0] = __uint_as_float(xw.z << 16); x1[1] = __uint_as_float(xw.z & 0xffff0000u); x1[2] = __uint_as_float(xw.w << 16); x1[3] = __uint_as_float(xw.w & 0xffff0000u); }
            ss += (x0[0] * x0[0] + x0[1] * x0[1]) + (x0[2] * x0[2] + x0[3] * x0[3]) + (x1[0] * x1[0] + x1[1] * x1[1]) + (x1[2] * x1[2] + x1[3] * x1[3]);
            const f32x4 y0 = x0 * gs0, y1 = x1 * gs1;
            u32x4 hi; hi.x = pk2(y0[0], y0[1]); hi.y = pk2(y0[2], y0[3]); hi.z = pk2(y1[0], y1[1]); hi.w = pk2(y1[2], y1[3]);
            f32x4 r0, r1;
            r0[0] = y0[0] - __uint_as_float(hi.x << 16); r0[1] = y0[1] - __uint_as_float(hi.x & 0xffff0000u); r0[2] = y0[2] - __uint_as_float(hi.y << 16); r0[3] = y0[3] - __uint_as_float(hi.y & 0xffff0000u);
            r1[0] = y1[0] - __uint_as_float(hi.z << 16); r1[1] = y1[1] - __uint_as_float(hi.z & 0xffff0000u); r1[2] = y1[2] - __uint_as_float(hi.w << 16); r1[3] = y1[3] - __uint_as_float(hi.w & 0xffff0000u);
            u32x4 lo; lo.x = pk2(r0[0], r0[1]); lo.y = pk2(r0[2], r0[3]); lo.z = pk2(r1[0], r1[1]); lo.w = pk2(r1[2], r1[3]);
            const bf16x8 ah = *(const bf16x8*)(wrh + (size_t)r32 * 2048 + k), al = *(const bf16x8*)(wrl + (size_t)r32 * 2048 + k);
            const bf16x8 bh = __builtin_bit_cast(bf16x8, hi), bl = __builtin_bit_cast(bf16x8, lo);
            C = __builtin_amdgcn_mfma_f32_32x32x16_bf16(ah, bh, C, 0, 0, 0);
            C = __builtin_amdgcn_mfma_f32_32x32x16_bf16(al, bh, C, 0, 0, 0);
            C = __builtin_amdgcn_mfma_f32_32x32x16_bf16(ah, bl, C, 0, 0, 0);
        }
#pragma unroll
        for (int r = 0; r < 16; ++r) red[((hf * 4 + wq) * 32 + ((r & 3) + 8 * (r >> 2) + 4 * kg)) * 32 + r32] = C[r];
        ssr[(hf * 8 + wq * 2 + kg) * 32 + r32] = ss;
        __syncthreads();
        { const int h2 = tid >> 8, t2 = tid & 255;
#pragma unroll
          for (int q = 0; q < 4; ++q) { const int e = (t2 >> 5) + 8 * q; float t = 0.f;
#pragma unroll
              for (int w4 = 0; w4 < 4; ++w4) t += red[((h2 * 4 + w4) * 32 + e) * 32 + (t2 & 31)]; lg[(h2 * 32 + e) * 32 + (t2 & 31)] = t; } }
        if (tid < 64) { float t = 0.f;
#pragma unroll
            for (int q = 0; q < 8; ++q) t += ssr[((tid >> 5) * 8 + q) * 32 + (tid & 31)]; rsd[tid] = 1.0f / sqrtf(t * (1.f / D) + EPS); }
        __syncthreads();
        int i0 = 0, i1 = 0, i2 = 0, i3 = 0, l0 = 0, l1 = 0, l2 = 0, l3 = 0; float w0 = 0.f, w1 = 0.f, w2 = 0.f, w3 = 0.f;
        if (tid < 64) {
            const float rs = rsd[tid]; const float* cb = WSP(float, WS_CB) + b * 32; const LAS float* lgr = lg + (tid >> 5) * 1024 + (tid & 31);
            unsigned used = 0; float v0 = 0, v1 = 0, v2 = 0, v3 = 0;
            float xv[32];
#pragma unroll
            for (int e = 0; e < 32; ++e) xv[e] = lgr[e * 32] * rs + cb[e];
#pragma unroll
            for (int k = 0; k < 4; ++k) { float best = -3.0e38f; int bi = 0;
#pragma unroll
                for (int e = 0; e < 32; ++e) { const bool ok = !((used >> e) & 1u) && xv[e] > best; best = ok ? xv[e] : best; bi = ok ? e : bi; }
                used |= 1u << bi;
                if (k == 0) { i0 = bi; v0 = best; } else if (k == 1) { i1 = bi; v1 = best; } else if (k == 2) { i2 = bi; v2 = best; } else { i3 = bi; v3 = best; } }
            const float e1 = __expf(v1 - v0), e2 = __expf(v2 - v0), e3 = __expf(v3 - v0), inv = 1.f / (1.f + e1 + e2 + e3);
            w0 = inv; w1 = e1 * inv; w2 = e2 * inv; w3 = e3 * inv;
            l0 = atomicAdd((int*)(hist + i0), 1); l1 = atomicAdd((int*)(hist + i1), 1); l2 = atomicAdd((int*)(hist + i2), 1); l3 = atomicAdd((int*)(hist + i3), 1);
        }
        __syncthreads();
        if (tid < 32) { const int c = hist[tid]; gbase[tid] = c ? atomicAdd(WSP(int, WS_CNT) + tid, c) : 0; }
        __syncthreads();
        if (tid < 64) { const int rw = gp * 64 + tid;
            const int p0 = gbase[i0] + l0, p1 = gbase[i1] + l1, p2 = gbase[i2] + l2, p3 = gbase[i3] + l3;
            int* te = WSP(int, WS_TOPE) + rw * 4; float* tw = WSP(float, WS_TOPW) + rw * 4; int* tp = WSP(int, WS_TPOS) + rw * 4; int* rt = WSP(int, WS_ROWTOK);
            te[0] = i0; te[1] = i1; te[2] = i2; te[3] = i3; tw[0] = w0; tw[1] = w1; tw[2] = w2; tw[3] = w3; tp[0] = p0; tp[1] = p1; tp[2] = p2; tp[3] = p3;
            rt[(size_t)i0 * NTOK + p0] = rw * 4; rt[(size_t)i1 * NTOK + p1] = rw * 4 + 1; rt[(size_t)i2 * NTOK + p2] = rw * 4 + 2; rt[(size_t)i3 * NTOK + p3] = rw * 4 + 3; }
        if (MOE1_FP6) route_h2_fp6(WSP(bf16_t, WS_X1) + (size_t)(gp * 64) * D, gsl, shl, p.ws + WS_H2 + (size_t)(gp * 64) * D, rsd);
        else route_h2_out(xr, p.g_ffn, sc, sh, p.ws + WS_H2 + (size_t)row * D + kb0, rsd[hf * 32 + r32], kb0);
        __syncthreads();
    }
}
__device__ __forceinline__ void phase_final_r(const bf16_t* __restrict__ Y, const bf16_t* __restrict__ X1, const float* __restrict__ modp, const int* __restrict__ tope, const int* __restrict__ tpos, const float* __restrict__ topw, const float* __restrict__ gfin, float* __restrict__ outp, LAS unsigned char* lds, int G, int bid) {
    const int lane = threadIdx.x & 63, wid = threadIdx.x >> 6; const LAS int* tp = (const LAS int*)(lds + LDS_TP);
    int e_n = 0, ps_n = 0; float wk_n = 0.f;
    { const int r0 = bid * 8 + wid; if (r0 < NTOK && lane < 4) { e_n = tope[r0 * 4 + lane]; ps_n = tpos[r0 * 4 + lane]; wk_n = topw[r0 * 4 + lane]; } }
    for (int row = bid * 8 + wid; row < NTOK; row += G * 8) {
        const int b = row / SEQ; const float* g2 = modp + (size_t)b * NMOD * D + 5 * D;
        int slot = 0; float wk = 0.f;
        if (lane < 4) { slot = tp[e_n] * 256 + ps_n; wk = wk_n; }
        { const int nr = row + G * 8; if (nr < NTOK && lane < 4) { e_n = tope[nr * 4 + lane]; ps_n = tpos[nr * 4 + lane]; wk_n = topw[nr * 4 + lane]; } }
        const int sl0 = __shfl(slot, 0), sl1 = __shfl(slot, 1), sl2 = __shfl(slot, 2), sl3 = __shfl(slot, 3);
        const float ysc = Y_FP8 ? 1.f / Y_SCALE : 1.f, q0 = __shfl(wk, 0) * ysc, q1 = __shfl(wk, 1) * ysc, q2 = __shfl(wk, 2) * ysc, q3 = __shfl(wk, 3) * ysc;
        f32x4 v[8]; float ss = 0.f;
#pragma unroll
        for (int j = 0; j < 8; ++j) { const int k = (j * 64 + lane) * 4;
            f32x4 m;
            if (Y_FP8) { const unsigned char* Y8 = (const unsigned char*)Y;
                const int a0 = *(const int*)(Y8 + (size_t)sl0 * D + k), a1 = *(const int*)(Y8 + (size_t)sl1 * D + k), a2 = *(const int*)(Y8 + (size_t)sl2 * D + k), a3 = *(const int*)(Y8 + (size_t)sl3 * D + k);
                const auto l0 = __builtin_amdgcn_cvt_pk_f32_fp8(a0, false), h0 = __builtin_amdgcn_cvt_pk_f32_fp8(a0, true), l1 = __builtin_amdgcn_cvt_pk_f32_fp8(a1, false), h1 = __builtin_amdgcn_cvt_pk_f32_fp8(a1, true);
                const auto l2 = __builtin_amdgcn_cvt_pk_f32_fp8(a2, false), h2 = __builtin_amdgcn_cvt_pk_f32_fp8(a2, true), l3 = __builtin_amdgcn_cvt_pk_f32_fp8(a3, false), h3 = __builtin_amdgcn_cvt_pk_f32_fp8(a3, true);
                m[0] = q0 * l0[0] + q1 * l1[0] + q2 * l2[0] + q3 * l3[0]; m[1] = q0 * l0[1] + q1 * l1[1] + q2 * l2[1] + q3 * l3[1];
                m[2] = q0 * h0[0] + q1 * h1[0] + q2 * h2[0] + q3 * h3[0]; m[3] = q0 * h0[1] + q1 * h1[1] + q2 * h2[1] + q3 * h3[1];
            } else {
            const u32x2 a0 = *(const u32x2*)(Y + (size_t)sl0 * D + k), a1 = *(const u32x2*)(Y + (size_t)sl1 * D + k), a2 = *(const u32x2*)(Y + (size_t)sl2 * D + k), a3 = *(const u32x2*)(Y + (size_t)sl3 * D + k);
            m[0] = q0 * __uint_as_float(a0.x << 16) + q1 * __uint_as_float(a1.x << 16) + q2 * __uint_as_float(a2.x << 16) + q3 * __uint_as_float(a3.x << 16);
            m[1] = q0 * __uint_as_float(a0.x & 0xffff0000u) + q1 * __uint_as_float(a1.x & 0xffff0000u) + q2 * __uint_as_float(a2.x & 0xffff0000u) + q3 * __uint_as_float(a3.x & 0xffff0000u);
            m[2] = q0 * __uint_as_float(a0.y << 16) + q1 * __uint_as_float(a1.y << 16) + q2 * __uint_as_float(a2.y << 16) + q3 * __uint_as_float(a3.y << 16);
            m[3] = q0 * __uint_as_float(a0.y & 0xffff0000u) + q1 * __uint_as_float(a1.y & 0xffff0000u) + q2 * __uint_as_float(a2.y & 0xffff0000u) + q3 * __uint_as_float(a3.y & 0xffff0000u);
            }
            { const u32x2 xw = *(const u32x2*)(X1 + (size_t)row * D + k); f32x4 xv; xv[0] = __uint_as_float(xw.x << 16); xv[1] = __uint_as_float(xw.x & 0xffff0000u); xv[2] = __uint_as_float(xw.y << 16); xv[3] = __uint_as_float(xw.y & 0xffff0000u);
              v[j] = xv + *(const f32x4*)(g2 + k) * m; }
            ss += (v[j][0] * v[j][0] + v[j][1] * v[j][1]) + (v[j][2] * v[j][2] + v[j][3] * v[j][3]); }
#pragma unroll
        for (int o = 32; o >= 1; o >>= 1) ss += __shfl_xor(ss, o);
        const float rstd = 1.0f / sqrtf(ss * (1.f / D) + EPS);
#pragma unroll
        for (int j = 0; j < 8; ++j) { const int k = (j * 64 + lane) * 4; *(f32x4*)(outp + (size_t)row * D + k) = v[j] * rstd * *(const f32x4*)(gfin + k); }
    }
}
__device__ __forceinline__ void phase_final(const P& p, LAS unsigned char* lds, int G, int bid) { phase_final_r(WSP(bf16_t, WS_Y), WSP(bf16_t, WS_X1), WSP(float, WS_MOD), WSP(int, WS_TOPE), WSP(int, WS_TPOS), WSP(float, WS_TOPW), p.g_final, p.out, lds, G, bid); }

namespace at {
constexpr int VSTR = 144, VT = 128 * VSTR;
constexpr int LDS_AL = 90112, LDS_FLAG = LDS_AL + 1024;
constexpr float LOG2E = 1.4426950408889634f;
__device__ __forceinline__ bf16x8 packf(const f32x16& x, int s) { u32x4 w; w.x = pk2(x[8 * s], x[8 * s + 1]); w.y = pk2(x[8 * s + 2], x[8 * s + 3]); w.z = pk2(x[8 * s + 4], x[8 * s + 5]); w.w = pk2(x[8 * s + 6], x[8 * s + 7]); return __builtin_bit_cast(bf16x8, w); }
#define AT_MFMA(a, b, c) __builtin_amdgcn_mfma_f32_32x32x16_bf16((a), (b), (c), 0, 0, 0)

template <bool MLA>
__device__ __forceinline__ void attn_unit(const P& p, LAS unsigned char* lds, const int b, const int h, const int qb) {
    constexpr int DK = MLA ? 192 : 128, KSTR = MLA ? 400 : 272, KT = 64 * KSTR, BUF = KT + VT, NQF = DK / 16, NKR = MLA ? 3 : 2;
    static_assert(2 * (64 * 400 + VT) <= LDS_AL, "attention LDS map");
    const int tid = threadIdx.x, wid = __builtin_amdgcn_readfirstlane(tid >> 6), lane = tid & 63, r32 = lane & 31, hi = lane >> 5;
    const int q0 = qb * 256, qw = q0 + 32 * wid, qi = qw + r32, nt = (q0 + 256) / 64;
    const bf16_t* Kn = MLA ? WSP(bf16_t, WS_KNOPE) : WSP(bf16_t, WS_SBK);
    const bf16_t* Kr = WSP(bf16_t, WS_KROPE);
    const bf16_t* Vt = WSP(bf16_t, MLA ? WS_VMT : WS_SBVT) + (size_t)(b * 8 + h) * 128 * SEQ;
    LAS float* al = (LAS float*)(lds + LDS_AL) + wid * 32;
    LAS int* flag = (LAS int*)(lds + LDS_FLAG);
    bf16x8 qf[NQF];
    { const char* qb_ = MLA ? (const char*)WSP(bf16_t, WS_QMLA) + ((size_t)(b * SEQ + qw) * 1536 + h * 192) * 2 : (const char*)WSP(bf16_t, WS_SBQ) + ((size_t)(b * SEQ + qw) * 1024 + h * 128) * 2;
      const unsigned qo = (unsigned)((r32 * (MLA ? 1536 : 1024) + 8 * hi) * 2);
#pragma unroll
      for (int s = 0; s < NQF; ++s) qf[s] = *(const bf16x8*)(qb_ + qo + 32 * s); }
    bf16x8 tri0, tri1, ones;
#pragma unroll
    for (int j = 0; j < 8; ++j) { const int k0_ = 8 * (j >> 2) + 4 * hi + (j & 3); tri0[j] = (k0_ > r32) ? (short)0x3F80 : (short)0; tri1[j] = (16 + k0_ > r32) ? (short)0x3F80 : (short)0; ones[j] = (short)0x3F80; }
    u32x4 kreg[NKR], vreg[2];
    const unsigned kofs0 = (unsigned)(((tid >> 4) * 1024 + (tid & 15) * 8) * 2), kofs1 = kofs0 + 32u * 1024u * 2u;
    const unsigned rofs = (unsigned)(((tid >> 3) * 64 + (tid & 7) * 8) * 2);
    const unsigned vofs0 = (unsigned)(((tid >> 3) * SEQ + (tid & 7) * 8) * 2), vofs1 = vofs0 + 64u * SEQ * 2u;
    const unsigned kw0 = (unsigned)((tid >> 4) * KSTR + (tid & 15) * 16), kw1 = kw0 + 32u * KSTR, rw = (unsigned)((tid >> 3) * KSTR + 256 + (tid & 7) * 16);
    const unsigned vw0 = (unsigned)(KT + (tid >> 3) * VSTR + (16 * ((tid & 7) >> 1) + 4 * (tid & 1)) * 2), vw1 = vw0 + 64u * VSTR;
    const char* Knb = (const char*)Kn + ((size_t)b * SEQ * 1024 + h * 128) * 2; const char* Krb = (const char*)Kr + (size_t)b * SEQ * 64 * 2; const char* Vtb = (const char*)Vt;
#define AT_LOAD(tile) do { const int k0_ = (tile) * 64; const char* kp_ = Knb + (size_t)k0_ * 2048; const char* vp_ = Vtb + (size_t)k0_ * 2; \
        kreg[0] = *(const u32x4*)(kp_ + kofs0); kreg[1] = *(const u32x4*)(kp_ + kofs1); if (MLA) kreg[NKR - 1] = *(const u32x4*)(Krb + (size_t)k0_ * 128 + rofs); \
        vreg[0] = *(const u32x4*)(vp_ + vofs0); vreg[1] = *(const u32x4*)(vp_ + vofs1); } while (0)
#define AT_WRITE(buf) do { LAS unsigned char* kb_ = lds + (buf) * BUF; \
        *(LAS u32x4*)(kb_ + kw0) = kreg[0]; *(LAS u32x4*)(kb_ + kw1) = kreg[1]; if (MLA) *(LAS u32x4*)(kb_ + rw) = kreg[NKR - 1]; \
        { u32x2 lo_, hi_; lo_.x = vreg[0].x; lo_.y = vreg[0].y; hi_.x = vreg[0].z; hi_.y = vreg[0].w; *(LAS u32x2*)(kb_ + vw0) = lo_; *(LAS u32x2*)(kb_ + vw0 + 16) = hi_; } \
        { u32x2 lo_, hi_; lo_.x = vreg[1].x; lo_.y = vreg[1].y; hi_.x = vreg[1].z; hi_.y = vreg[1].w; *(LAS u32x2*)(kb_ + vw1) = lo_; *(LAS u32x2*)(kb_ + vw1 + 16) = hi_; } } while (0)
    f32x16 o[4];
#pragma unroll
    for (int d0 = 0; d0 < 4; ++d0)
#pragma unroll
        for (int r = 0; r < 16; ++r) o[d0][r] = 0.f;
    float m_run = -1e30f, l_run = 0.f, R2 = 0.f;
    if (!MLA && tid < 8) flag[tid] = 0;
    AT_LOAD(MLA ? 0 : nt - 1);
    AT_WRITE(0);
    __syncthreads();
    for (int it = 0; it < nt; ++it) {
        const int tile = MLA ? it : nt - 1 - it, cb = it & 1, k0 = tile * 64;
        const bool more = it + 1 < nt;
        if (more) AT_LOAD(MLA ? tile + 1 : tile - 1);
        const bool active = MLA ? (k0 <= qw + 31) : (k0 < qw + 31 && !__all(R2 < -160.f));
        if (active) {
            const LAS unsigned char* kb = lds + cb * BUF;
            f32x16 p0, p1;
#pragma unroll
            for (int r = 0; r < 16; ++r) { p0[r] = 0.f; p1[r] = 0.f; }
#pragma unroll
            for (int s = 0; s < NQF; ++s) { const bf16x8 a0 = *(const LAS bf16x8*)(kb + r32 * KSTR + s * 32 + hi * 16), a1 = *(const LAS bf16x8*)(kb + (32 + r32) * KSTR + s * 32 + hi * 16);
                p0 = AT_MFMA(a0, qf[s], p0); p1 = AT_MFMA(a1, qf[s], p1); if ((s & 3) == 3) __builtin_amdgcn_sched_barrier(0); }
            const int dq = qi - k0 - 4 * hi;
            bf16x8 pf0, pf1, pf2, pf3;
            if (MLA) {
                float pm = -3.0e38f;
                if (k0 + 63 > qw) {
#pragma unroll
                    for (int r = 0; r < 16; ++r) { const int c = (r & 3) + 8 * (r >> 2);
                        if (c > dq) p0[r] = -__builtin_inff(); if (c + 32 > dq) p1[r] = -__builtin_inff(); }
                }
#pragma unroll
                for (int r = 0; r < 16; ++r) pm = fmaxf(pm, fmaxf(p0[r], p1[r]));
                pm = fmaxf(pm, __shfl_xor(pm, 32));
                const float mn = fmaxf(m_run, pm), alpha = __builtin_amdgcn_exp2f(m_run - mn); m_run = mn;
                float ps = 0.f;
#pragma unroll
                for (int r = 0; r < 16; ++r) { p0[r] = __builtin_amdgcn_exp2f(p0[r] - mn); p1[r] = __builtin_amdgcn_exp2f(p1[r] - mn); ps += p0[r] + p1[r]; }
                ps += __shfl_xor(ps, 32);
                l_run = l_run * alpha + ps;
                if (__any(alpha < 1.f)) { if (hi == 0) al[r32] = alpha; asm volatile("s_waitcnt lgkmcnt(0)" ::: "memory");
#pragma unroll
                    for (int r = 0; r < 16; ++r) { const float a = al[(r & 3) + 8 * (r >> 2) + 4 * hi];
#pragma unroll
                        for (int d0 = 0; d0 < 4; ++d0) o[d0][r] *= a; } }
                pf0 = packf(p0, 0); pf1 = packf(p0, 1); pf2 = packf(p1, 0); pf3 = packf(p1, 1);
            } else {
                if (k0 + 63 >= qw) {
#pragma unroll
                    for (int r = 0; r < 16; ++r) { const int c = (r & 3) + 8 * (r >> 2); if (c >= dq) p0[r] = -__builtin_inff(); if (c + 32 >= dq) p1[r] = -__builtin_inff(); } }
                float lsum = 0.f; bf16x8 lf[4];
#pragma unroll
                for (int g = 0; g < 4; ++g) {
                    float Lv[8];
#pragma unroll
                    for (int j = 0; j < 8; ++j) { const int r = 8 * (g & 1) + j;
                        const float z = (g < 2 ? p0[r] : p1[r]);
                        const float t = __builtin_amdgcn_logf(1.f + __builtin_amdgcn_exp2f(-fabsf(z)));
                        const float L = -(fmaxf(z, 0.f) + t);
                        const float ls = fminf(z, 0.f) - t;
                        if (g < 2) p0[r] = ls; else p1[r] = ls;
                        Lv[j] = L; lsum += L; }
                    u32x4 w; w.x = pk2(Lv[0], Lv[1]); w.y = pk2(Lv[2], Lv[3]); w.z = pk2(Lv[4], Lv[5]); w.w = pk2(Lv[6], Lv[7]); lf[g] = __builtin_bit_cast(bf16x8, w);
                }
                p0 = AT_MFMA(tri0, lf[0], p0); p0 = AT_MFMA(tri1, lf[1], p0); p0 = AT_MFMA(ones, lf[2], p0); p0 = AT_MFMA(ones, lf[3], p0);
                p1 = AT_MFMA(tri0, lf[2], p1); p1 = AT_MFMA(tri1, lf[3], p1);
#pragma unroll
                for (int r = 0; r < 16; ++r) { p0[r] = __builtin_amdgcn_exp2f(p0[r] + R2); p1[r] = __builtin_amdgcn_exp2f(p1[r] + R2); }
                lsum += __shfl_xor(lsum, 32);
                R2 += lsum;
                pf0 = packf(p0, 0); pf1 = packf(p0, 1); pf2 = packf(p1, 0); pf3 = packf(p1, 1);
            }
            const LAS unsigned char* vb = kb + KT;
#pragma unroll
            for (int d0 = 0; d0 < 4; ++d0) { const LAS unsigned char* vr = vb + (32 * d0 + r32) * VSTR + hi * 16;
                o[d0] = AT_MFMA(pf0, *(const LAS bf16x8*)(vr), o[d0]); o[d0] = AT_MFMA(pf1, *(const LAS bf16x8*)(vr + 32), o[d0]);
                o[d0] = AT_MFMA(pf2, *(const LAS bf16x8*)(vr + 64), o[d0]); o[d0] = AT_MFMA(pf3, *(const LAS bf16x8*)(vr + 96), o[d0]); __builtin_amdgcn_sched_barrier(0); }
        }
        if (more) AT_WRITE(cb ^ 1);
        if (!MLA) { const bool dn = __all(R2 < -160.f); if (lane == 0) flag[wid] = dn ? 1 : 0; }
        __syncthreads();
        if (!MLA) { int all = 1;
#pragma unroll
            for (int w8 = 0; w8 < 8; ++w8) all &= flag[w8];
            if (all) break; }
    }
    if (!MLA) __syncthreads();
    if (MLA) { if (hi == 0) al[r32] = 1.0f / l_run; asm volatile("s_waitcnt lgkmcnt(0)" ::: "memory"); }
    char* Ob = (char*)(WSP(bf16_t, WS_MIXED) + (size_t)(b * SEQ + qw) * 2048 + (MLA ? 1024 : 0) + h * 128);
    const bool odd = (r32 & 1) != 0;
    const unsigned oo = (unsigned)((4 * hi * 2048 + r32) * 2) + (odd ? 4094u : 0u);
#pragma unroll
    for (int q = 0; q < 8; ++q) { const int ra = 2 * q, c = (ra & 3) + 8 * (ra >> 2); const float iva = MLA ? al[c + 4 * hi] : 1.f, ivb = MLA ? al[c + 1 + 4 * hi] : 1.f;
#pragma unroll
        for (int d0 = 0; d0 < 4; ++d0) { const float A = o[d0][ra] * iva, Bv = o[d0][ra + 1] * ivb;
            const float snd = odd ? A : Bv;
            const float rcv = __int_as_float(__builtin_amdgcn_update_dpp(0, __float_as_int(snd), 0xB1, 0xF, 0xF, true));
            const unsigned w = odd ? pk2(rcv, Bv) : pk2(A, rcv);
            *(unsigned*)(Ob + oo + (unsigned)((c * 2048 + d0 * 32) * 2)) = w; } }
    __syncthreads();
#undef AT_LOAD
#undef AT_WRITE
}
__device__ __forceinline__ void conv_queue(const P& p, LAS unsigned char* lds, int* ctr, int max_tiles) {
    constexpr int NM1 = NE * 16 * 16, NM2 = NE * 16 * 8, NMT = NM1 + NM2;
    LAS int* qs = (LAS int*)(lds + LDS_FLAG + 96); LAS unsigned char* Tb = lds + 16384;
    const int tid = threadIdx.x, kq = tid >> 6, nc = tid & 63;
    int pulled = 0;
#define CQ_CAN (max_tiles < 0 || pulled < max_tiles)
#define CQ_PULL(dst) do { __syncthreads(); if (tid == 0) qs[0] = CQ_CAN ? atomicAdd(ctr, 1) : NMT; __syncthreads(); dst = qs[0]; ++pulled; } while (0)
    int t_cur, t_nxt;
    CQ_PULL(t_cur); if (t_cur >= NMT) { __syncthreads(); return; }
    CQ_PULL(t_nxt);
    f32x4 a[4][4];
#define CQ_SRC(t, src, ldw) const float* src; int ldw; { const bool w1_ = (t) < NM1; const int t2_ = w1_ ? (t) : (t) - NM1, e_ = w1_ ? t2_ >> 8 : t2_ >> 7, r_ = w1_ ? t2_ & 255 : t2_ & 127; \
        ldw = w1_ ? 4096 : 2048; const int k0_ = (w1_ ? r_ >> 4 : r_ >> 3) * 128, n0_ = (w1_ ? r_ & 15 : r_ & 7) * 256; \
        src = (w1_ ? p.w1 + (size_t)e_ * 2048 * 4096 : p.w2 + (size_t)e_ * 2048 * 2048) + (size_t)(k0_ + 4 * kq) * ldw + n0_ + 4 * nc; }
#define CQ_LOAD(buf, slab, src, ldw) do { _Pragma("unroll") for (int r_ = 0; r_ < 4; ++r_) a[buf][r_] = __builtin_nontemporal_load((const f32x4*)(src + (size_t)((slab) * 32 + r_) * ldw)); } while (0)
#define CQ_PUT(buf, slab) do { if (cur_w1) { _Pragma("unroll") for (int j_ = 0; j_ < 4; ++j_) { u32x2 d_; d_.x = pk2(a[buf][0][j_], a[buf][1][j_]); d_.y = pk2(a[buf][2][j_], a[buf][3][j_]); \
            *(LAS u32x2*)(Tb + (4 * nc + j_) * 264 + ((slab) * 32 + 4 * kq) * 2) = d_; } } \
        else { _Pragma("unroll") for (int j_ = 0; j_ < 4; ++j_) *(LAS unsigned*)(Tb + (4 * nc + j_) * 132 + ((slab) * 32 + 4 * kq)) = pk4_fp8_sc(a[buf][0][j_], a[buf][1][j_], a[buf][2][j_], a[buf][3][j_], W8_INV); } } while (0)
    { CQ_SRC(t_cur, s0, l0); CQ_LOAD(0, 0, s0, l0); CQ_LOAD(1, 1, s0, l0); CQ_LOAD(2, 2, s0, l0); CQ_LOAD(3, 3, s0, l0); }
    for (int it = 0;; ++it) {
        const bool more = t_nxt < NMT, cur_w1 = t_cur < NM1;
        if (tid == 0) qs[1 + (it & 1)] = (more && CQ_CAN) ? atomicAdd(ctr, 1) : NMT;
        ++pulled;
        CQ_PUT(0, 0); CQ_PUT(1, 1);
        CQ_SRC(t_nxt < NMT ? t_nxt : 0, s1, l1);
        if (more) { CQ_LOAD(0, 0, s1, l1); CQ_LOAD(1, 1, s1, l1); }
        CQ_PUT(2, 2); CQ_PUT(3, 3);
        __syncthreads();
        { const int t2_ = cur_w1 ? t_cur : t_cur - NM1, e_ = cur_w1 ? t2_ >> 8 : t2_ >> 7, r_ = cur_w1 ? t2_ & 255 : t2_ & 127;
          const int k0 = (cur_w1 ? r_ >> 4 : r_ >> 3) * 128, n0 = (cur_w1 ? r_ & 15 : r_ & 7) * 256;
          if (cur_w1) {
              unsigned char* Bt = p.ws + WS_W1_T + (size_t)e_ * 4096 * 2048;
#pragma unroll 1
              for (int ps = 0; ps < 2; ++ps) { const int id = tid + 512 * ps, n = id >> 2, q = id & 3; const LAS u32x2* tp_ = (const LAS u32x2*)(Tb + n * 264 + q * 64);
                  u32x16 wv;
#pragma unroll
                  for (int i = 0; i < 8; ++i) { const u32x2 w = tp_[i]; wv[2 * i] = w.x; wv[2 * i + 1] = w.y; }
                  u32x4 lo, hi; fp6_block_bf16(wv, lo, hi);
                  unsigned char* dst = Bt + (size_t)DmW1{}(n0 + n) * 2048 + k0 + 16 * q;
                  __builtin_nontemporal_store(lo, (u32x4*)dst); __builtin_nontemporal_store(hi, (u32x4*)(dst + 64)); }
          } else {
              unsigned char* Bt = p.ws + WS_W2_T + (size_t)e_ * 2048 * 2048;
#pragma unroll
              for (int ps = 0; ps < 4; ++ps) { const int n = ps * 64 + (tid >> 3), c = tid & 7; const LAS unsigned* tp_ = (const LAS unsigned*)(Tb + n * 132 + 16 * c);
                  u32x4 w; w.x = tp_[0]; w.y = tp_[1]; w.z = tp_[2]; w.w = tp_[3];
                  __builtin_nontemporal_store(w, (u32x4*)(Bt + (size_t)(n0 + n) * 2048 + k0 + 16 * c)); }
          } }
        __syncthreads();
        if (!more) break;
        CQ_LOAD(2, 2, s1, l1); CQ_LOAD(3, 3, s1, l1);
        t_cur = t_nxt; t_nxt = qs[1 + (it & 1)];
    }
#undef CQ_PULL
#undef CQ_CAN
#undef CQ_SRC
#undef CQ_LOAD
#undef CQ_PUT
    __syncthreads();
}
__device__ __forceinline__ void attn_queues(const P& p, LAS unsigned char* lds, int* ctr, const int xg) {
    LAS int* qs = (LAS int*)(lds + LDS_FLAG + 64);
    const int tid = threadIdx.x, nq = xg >= 0 ? 4 * 16 : NB * 8 * 16;
    int* c0 = ctr + (xg >= 0 ? xg : 0); int* c1 = ctr + 64 + (xg >= 0 ? xg : 0);
    {   if (tid == 0) qs[0] = atomicAdd(c0, 1);
        __syncthreads();
        int v = qs[0];
        while (v < nq) {
            __syncthreads();
            if (tid == 0) qs[0] = atomicAdd(c0, 1);
            const int bh = xg >= 0 ? xg * 4 + 2 * (v >> 5) + (v & 1) : (v & 31), qb = 15 - (xg >= 0 ? ((v & 31) >> 1) : (v >> 5));
            attn_unit<true>(p, lds, bh >> 3, bh & 7, qb);
            v = qs[0];
        }
        __syncthreads();
    }
    {   if (tid == 0) qs[0] = atomicAdd(c1, 1);
        __syncthreads();
        int v = qs[0];
        while (v < nq) {
            __syncthreads();
            if (tid == 0) qs[0] = atomicAdd(c1, 1);
            const int bh = xg >= 0 ? xg * 4 + 2 * (v >> 5) + (v & 1) : (v & 31), qb = 15 - (xg >= 0 ? ((v & 31) >> 1) : (v >> 5));
            attn_unit<false>(p, lds, bh >> 3, bh & 7, qb);
            v = qs[0];
        }
        __syncthreads();
    }
}
__device__ __forceinline__ void phase_attn(const P& p, LAS unsigned char* lds, int G, int bid) {
    int* ctr = (int*)(p.ws + WS_CTL + 61440); const int xg = (G == 256) ? (bid & 7) : -1;
    if (MOE_FP8 && ((bid >> 3) & 7) < 3) { conv_queue(p, lds, ctr + 128, -1); attn_queues(p, lds, ctr, xg); }
    else { attn_queues(p, lds, ctr, xg); if (MOE_FP8) conv_queue(p, lds, ctr + 128, -1); }
}
}

__device__ __forceinline__ void phase_normmod(const P& p, const float* x, const float* g, int shift_idx, int scale_idx, bf16_t* out, int G, int bid) { phase_normmod_r(WSP(float, WS_MOD), x, g, shift_idx, scale_idx, out, G, bid); }
template <class Sched>
__device__ __forceinline__ void moe_tables(const P& p, LAS unsigned char* lds, int G, int bid, bool gather, const float* bias, int bias_ld) {
    LAS int* tp = (LAS int*)(lds + LDS_TP); LAS int* cn = (LAS int*)(lds + LDS_CNT); LAS unsigned short* gidx = (LAS unsigned short*)(lds + LDS_GIDX); LAS float* bl = (LAS float*)(lds + LDS_BIAS);
    const int tid = threadIdx.x;
    if (tid < 32) cn[tid] = WSP(int, WS_CNT)[tid];
    __syncthreads();
    if (tid == 0) { int s = 0; for (int e = 0; e < 32; ++e) { tp[e] = s; s += (cn[e] + 255) >> 8; } tp[32] = s; tp[63] = 0; }
    __syncthreads();
    if (tid < 20) { Sched S; S.init(tp, G, bid); pg::Unit u; tp[40 + tid] = S.next(tid, u) ? u.e : 0; }
    __syncthreads();
    if (tid == 0) tp[63] = 1;
    __syncthreads();
    if (bias) {
        Sched S; S.init(tp, G, bid);
        const int t = tid & 255, i0 = tid >> 8;
        float bv[9]; int rv[9]; bool ok[9];
#pragma unroll
        for (int j = 0; j < 9; ++j) { pg::Unit u; u.e = 0; u.pn = 0; u.pm = 0; ok[j] = S.next(i0 + 2 * j, u);
            const size_t bo = ok[j] ? (size_t)u.e * bias_ld + u.pn * 256 + t : 0;
            bv[j] = bias[bo];
            rv[j] = 0;
            if (gather) { const int e_ = ok[j] ? u.e : 0, r = ok[j] ? (u.pm - tp[e_]) * 256 + t : 0; const bool gk = ok[j] && r < cn[e_];
                const int v = WSP(int, WS_ROWTOK)[gk ? (size_t)e_ * NTOK + r : 0]; rv[j] = gk ? (v >> 2) : 0; } }
#pragma unroll
        for (int j = 0; j < 9; ++j) if (ok[j]) { const int i = i0 + 2 * j; bl[i * 256 + t] = bv[j]; if (gather) gidx[i * 256 + t] = (unsigned short)rv[j]; }
        __syncthreads();
    }
}

__global__ void __launch_bounds__(512, 2) mega(P p, int lo, int hi, int bar_idx) {
    extern __shared__ __attribute__((aligned(16))) unsigned char lds_raw[];
    LAS unsigned char* lds = (LAS unsigned char*)lds_raw;
    const int tid = threadIdx.x, G = gridDim.x, bid = blockIdx.x;
    if (tid < 4) ((LAS unsigned*)(lds + LDS_MISC))[tid] = 0u;
    __syncthreads();
    XcdBarrier bar = xcd_barrier_post((unsigned*)(p.ws + WS_CTL) + bar_idx * XCD_BAR_WORDS, (volatile LAS unsigned*)(lds + LDS_MISC));
#define IN(k) (lo <= (k) && (k) < hi)
#define RUN(k, ...) do { __VA_ARGS__; } while (0)
#define SEAM(k) do { if (IN(k) && IN((k) + 1)) xcd_barrier(bar); } while (0)
    if (IN(0)) RUN(0, phase_prologue(p, lds, G, bid));
    SEAM(0);
    if (IN(1)) RUN(1, { phase_cb(p, lds, bid); phase_normmod(p, p.x, p.g_attn, 0, 1, WSP(bf16_t, WS_H), G, bid); });
    SEAM(1);
    if (IN(2)) RUN(2, {
        const bool ch = (G == 256);
        pg::DenseOrder S1; S1.init(64, 12, G, bid, 8, 4); pg::EpiProjMain E1{p};
        pg::DenseOrder S2; S2.init(4, 64, G, bid); pg::EpiVt<false> E2{p, WS_SBVT};
        pg::KropeOrder S3{G, bid}; pg::EpiKropeP E3{p};
        const bf16_t* A2 = WSP(bf16_t, WS_WIN_T) + (size_t)2048 * 2048;
        const char* b2n = nullptr; unsigned q00 = 0, q01 = 0, q10 = 0, q11 = 0; const char* b3n = nullptr; unsigned k00 = 0, k01 = 0, k10 = 0, k11 = 0;
        if (ch) { pg::first_unit_of(S2, WSP(bf16_t, WS_H), 4096, b2n, q00, q01, q10, q11); pg::first_unit_of(S3, WSP(bf16_t, WS_WIN_T), 4096, b3n, k00, k01, k10, k11); }
        pg::gemm_phase<0>(lds, WSP(bf16_t, WS_H), WSP(bf16_t, WS_WIN_T), 4096, S1, E1, nullptr, 0, false, ch, A2, b2n, q00, q01, q10, q11);
        pg::gemm_phase<0>(lds, A2, WSP(bf16_t, WS_H), 4096, S2, E2, nullptr, 0, ch, ch, WSP(bf16_t, WS_H), b3n, k00, k01, k10, k11);
        pg::gemm_phase<0>(lds, WSP(bf16_t, WS_H), WSP(bf16_t, WS_WIN_T), 4096, S3, E3, nullptr, 8, ch, false);
    });
    SEAM(2);
    if (IN(3)) RUN(3, {
        krope_fixup(WSP(float, WS_G_QRAW), WSP(float2, WS_CS), WSP(bf16_t, WS_KROPE), G, bid);
        const bool ch = (G == 256);
        pg::DenseOrder S1; S1.init(64, 6, G, bid); pg::EpiQ E1{p};
        pg::DenseOrder S2; S2.init(64, 4, G, bid); pg::EpiKnope E2{p};
        pg::DenseOrder S3; S3.init(4, 64, G, bid); pg::EpiVt<true> E3{p, WS_VMT};
        const bf16_t* A3 = WSP(bf16_t, WS_WKV_T) + (size_t)1024 * 512;
        const char* b2n = nullptr; unsigned q00 = 0, q01 = 0, q10 = 0, q11 = 0; const char* b3n = nullptr; unsigned k00 = 0, k01 = 0, k10 = 0, k11 = 0;
        if (ch) { pg::first_unit_of(S2, WSP(bf16_t, WS_WKV_T), 1024, b2n, q00, q01, q10, q11); pg::first_unit_of(S3, WSP(bf16_t, WS_KVLAT), 1024, b3n, k00, k01, k10, k11); }
        pg::gemm_phase<0>(lds, WSP(bf16_t, WS_QLAT), WSP(bf16_t, WS_WQ_T), 1024, S1, E1, nullptr, 0, false, ch, WSP(bf16_t, WS_KVLAT), b2n, q00, q01, q10, q11);
        pg::gemm_phase<0>(lds, WSP(bf16_t, WS_KVLAT), WSP(bf16_t, WS_WKV_T), 1024, S2, E2, nullptr, 0, ch, ch, A3, b3n, k00, k01, k10, k11);
        pg::gemm_phase<0>(lds, A3, WSP(bf16_t, WS_KVLAT), 1024, S3, E3, nullptr, 0, ch, false);
        if (MOE_FP8 && G == 256 && bid >= 128) at::conv_queue(p, lds, (int*)(p.ws + WS_CTL + 61440) + 128, 3);
    });
    SEAM(3);
    if (IN(4)) RUN(4, at::phase_attn(p, lds, G, bid));
    SEAM(4);
    if (IN(5)) RUN(5, { pg::DenseOrder S; S.init(64, 8, G, bid); pg::EpiOut E{p};
        pg::gemm_phase<0>(lds, WSP(bf16_t, WS_MIXED), WSP(bf16_t, WS_WOUT_T), 4096, S, E, nullptr); });
    SEAM(5);
    if (IN(6)) phase_route(p, lds, G, bid);
    SEAM(6);
    if (IN(7)) RUN(7, { typedef pg::MoeOrder<16, true> SO; moe_tables<SO>(p, lds, G, bid, true, p.b1, 4096);
        SO S; S.init((const LAS int*)(lds + LDS_TP), G, bid); pg::EpiMoe1 E{p, WS_ACT, (const LAS float*)(lds + LDS_BIAS)};
        pg::gemm_phase<MOE1_FP6 ? 2 : 1>(lds, p.ws + WS_H2, p.ws + WS_W1_T, 2048, S, E, (const LAS int*)(lds + LDS_GIDX)); });
    SEAM(7);
    if (IN(8)) RUN(8, { typedef pg::MoeOrder<8, false> SO; moe_tables<SO>(p, lds, G, bid, false, p.b2, 2048);
        SO S; S.init((const LAS int*)(lds + LDS_TP), G, bid); pg::EpiMoe2 E{p, (const LAS float*)(lds + LDS_BIAS)};
        pg::gemm_phase<1>(lds, p.ws + WS_ACT, p.ws + WS_W2_T, 2048, S, E, nullptr); });
    SEAM(8);
    if (IN(9)) RUN(9, { moe_tables<pg::MoeOrder<8, false> >(p, lds, G, bid, false, nullptr, 0); phase_final(p, lds, G, bid); });
#undef IN
#undef SEAM
}

extern "C" void kernel_launch(void* const* d_in, const int* in_sizes, int n_in, void* d_out, int out_size, void* d_ws, size_t ws_size, hipStream_t stream) {
    if (n_in != 20 || out_size != NTOK * D || ws_size < WS_END2) { fprintf(stderr, "kernel_launch: unexpected shapes (n_in %d out %d ws %zu need %zu)\n", n_in, out_size, ws_size, (size_t)WS_END2); return; }
    P p{};
    p.x = (const float*)d_in[0]; p.c = (const float*)d_in[1]; p.pos = (const int*)d_in[2]; p.g_attn = (const float*)d_in[3]; p.w_mod = (const float*)d_in[4]; p.b_mod = (const float*)d_in[5];
    p.w_in = (const float*)d_in[6]; p.g_q = (const float*)d_in[7]; p.w_q_up = (const float*)d_in[8]; p.g_kv = (const float*)d_in[9]; p.w_kv_up = (const float*)d_in[10]; p.w_out = (const float*)d_in[11];
    p.g_ffn = (const float*)d_in[12]; p.w_router = (const float*)d_in[13]; p.b_router = (const float*)d_in[14]; p.w1 = (const float*)d_in[15]; p.b1 = (const float*)d_in[16]; p.w2 = (const float*)d_in[17];
    p.b2 = (const float*)d_in[18]; p.g_final = (const float*)d_in[19]; p.out = (float*)d_out; p.ws = (unsigned char*)d_ws;
    static int grid = 0;
    if (grid == 0) {
        int dev = 0, cus = 0, per_cu = 0;
        if (hipGetDevice(&dev) != hipSuccess || hipDeviceGetAttribute(&cus, hipDeviceAttributeMultiprocessorCount, dev) != hipSuccess || cus <= 0) cus = 256;
        if (hipFuncSetAttribute((const void*)mega, hipFuncAttributeMaxDynamicSharedMemorySize, LDS_BYTES) != hipSuccess) fprintf(stderr, "kernel_launch: hipFuncSetAttribute failed\n");
        if (hipOccupancyMaxActiveBlocksPerMultiprocessor(&per_cu, (const void*)mega, 512, LDS_BYTES) != hipSuccess || per_cu < 1) fprintf(stderr, "kernel_launch: occupancy query says %d\n", per_cu);
        (void)hipGetLastError();
        grid = cus;
    }
    (void)hipMemsetAsync((char*)d_ws + WS_CTL, 0, 65536, stream);
    mega<<<grid, 512, LDS_BYTES, stream>>>(p, 0, 10, 0);
}
```
